# Optimizing an MI355X kernel written in HIP

```python
import math
import jax, jax.numpy as jnp
from jax import lax
import numpy as np

D_MODEL = 1024
BATCH = 8
SEQ = 4096
DEPTH = 1

MEM_LEN = 256
A_HEADS = 8
A_HEAD_DIM = 64
A_PAIRS = ((128, 1), (512, 4), (2048, 16))
B_HEADS = 4
B_QK_DIM = 64
B_V_DIM = 2 * B_QK_DIM
A_WIDTH = A_HEADS * A_HEAD_DIM
B_QK_WIDTH = B_HEADS * 2 * B_QK_DIM
B_V_WIDTH = B_HEADS * B_V_DIM
MIX_WIDTH = A_WIDTH + B_V_WIDTH
IN_WIDTH = 3 * A_WIDTH + 2 * B_QK_WIDTH + B_V_WIDTH
Q_BLOCK = 128
ROPE_THETA = 500000.0
ROT_DIM = A_HEAD_DIM // 4
M_HEADS = 4
M_HEAD_DIM = D_MODEL // M_HEADS
N_EXPERTS = 256
TOP_K = 8
N_GROUPS = 8
TOPK_GROUPS = 4
EXPERT_DIM = 256
SHARED_DIM = 256
ROUTED_SCALE = 2.5
MOE_BLOCK = 128
LN_EPS = 1e-5
SUBLN_EPS = 1e-5
DN_ALPHA = (2 * DEPTH) ** 0.25
DN_BETA = (8 * DEPTH) ** -0.25

kernel_name = 'hybrid_dilated_diff_moe_block'


def layer_norm(x, g, b):
    xf = x.astype(jnp.float32)
    mu = xf.mean(-1, keepdims=True)
    var = jnp.square(xf - mu).mean(-1, keepdims=True)
    return ((xf - mu) * lax.rsqrt(var + LN_EPS) * g.astype(jnp.float32) + b.astype(jnp.float32)).astype(x.dtype)


def rope_tables(positions):
    inv = ROPE_THETA ** (-jnp.arange(0, ROT_DIM, 2, dtype=jnp.float32) / ROT_DIM)
    ang = positions.astype(jnp.float32)[..., None] * inv
    return jnp.cos(ang), jnp.sin(ang)


def apply_partial_rope(t, cos, sin):
    half = cos.shape[-1]
    bshape = cos.shape[:2] + (1,) * (t.ndim - 3) + (half,)
    c = cos.reshape(bshape).astype(t.dtype)
    s = sin.reshape(bshape).astype(t.dtype)
    t1, t2, tp = t[..., :half], t[..., half:2 * half], t[..., 2 * half:]
    return jnp.concatenate([t1 * c - t2 * s, t2 * c + t1 * s, tp], axis=-1)


def dilated_window_branch(q, k, v, window, dilation):
    Bn, Sn, H, E = q.shape
    blk = window // dilation
    L = Sn // dilation
    nblk = -(-L // blk)
    Lp = nblk * blk

    def to_sub(t):
        t = t.reshape(Bn, L, dilation, H, E).transpose(0, 2, 1, 3, 4)
        t = jnp.pad(t, ((0, 0), (0, 0), (0, Lp - L), (0, 0), (0, 0)))
        return t.reshape(Bn, dilation, nblk, blk, H, E)

    def band(t):
        prev = jnp.pad(t[:, :, :-1], ((0, 0), (0, 0), (1, 0), (0, 0), (0, 0), (0, 0)))
        return jnp.concatenate([prev, t], axis=3)

    qs = to_sub(q)
    kb, vb = band(to_sub(k)), band(to_sub(v))
    s = jnp.einsum('brnqhe,brnkhe->brnhqk', qs, kb).astype(jnp.float32)
    qi = jnp.arange(blk)[:, None]
    ki = jnp.arange(2 * blk)[None, :]
    dist = blk + qi - ki
    n_idx = jnp.arange(nblk)[:, None, None]
    valid = (dist >= 0) & (dist <= blk) & ((n_idx - 1) * blk + ki >= 0)
    s = jnp.where(valid[:, None], s, -jnp.inf)
    m = s.max(-1, keepdims=True)
    p = jnp.exp(s - m)
    den = p.sum(-1, keepdims=True)
    o = jnp.einsum('brnhqk,brnkhe->brnqhe', p, vb.astype(jnp.float32)) / jnp.swapaxes(den, 3, 4)
    lse = jnp.swapaxes((m + jnp.log(den))[..., 0], 3, 4)
    o = o.reshape(Bn, dilation, Lp, H, E)[:, :, :L].transpose(0, 2, 1, 3, 4).reshape(Bn, Sn, H, E)
    lse = lse.reshape(Bn, dilation, Lp, H)[:, :, :L].transpose(0, 2, 1, 3).reshape(Bn, Sn, H)
    return o, lse


def dilated_mixture_attention(q, k, v):
    outs, lses = [], []
    for window, dilation in A_PAIRS:
        o, lse = dilated_window_branch(q, k, v, window, dilation)
        outs.append(o)
        lses.append(lse)
    wts = jax.nn.softmax(jnp.stack(lses), axis=0)
    return jnp.einsum('pbsh,pbshe->bshe', wts, jnp.stack(outs)).astype(q.dtype)


def diff_attention(q, k, v, lam, lambda_init, subln_g):
    Bn, Sn, H, _, E = q.shape
    nq = Sn // Q_BLOCK
    qb = q.reshape(Bn, nq, Q_BLOCK, H, 2, E).transpose(1, 0, 2, 3, 4, 5)
    kpos = jnp.arange(Sn)
    vf = v.astype(jnp.float32)

    def block(args):
        qblk, start = args
        s = jnp.einsum('bqhce,bkhce->bhcqk', qblk, k).astype(jnp.float32)
        qpos = start + jnp.arange(Q_BLOCK)
        s = jnp.where(kpos[None, :] <= qpos[:, None], s, -jnp.inf)
        p = jax.nn.softmax(s, axis=-1)
        a = p[:, :, 0] - lam * p[:, :, 1]
        return jnp.einsum('bhqk,bkhe->bqhe', a, vf)

    o = lax.map(block, (qb, jnp.arange(nq) * Q_BLOCK))
    o = o.transpose(1, 0, 2, 3, 4).reshape(Bn, Sn, H, 2 * E)
    o = o * lax.rsqrt(jnp.mean(jnp.square(o), -1, keepdims=True) + SUBLN_EPS) * subln_g.astype(jnp.float32)
    return (o * (1.0 - lambda_init)).astype(q.dtype)


def hybrid_mixer(h, cos, sin, w_in, w_out, lq1, lk1, lq2, lk2, subln_g, lambda_init):
    Bn, Sn, _ = h.shape
    proj = h @ w_in
    qa, ka, va, qb, kb, vb = jnp.split(
        proj, [A_WIDTH, 2 * A_WIDTH, 3 * A_WIDTH, 3 * A_WIDTH + B_QK_WIDTH, 3 * A_WIDTH + 2 * B_QK_WIDTH], axis=-1)
    qa = apply_partial_rope(qa.reshape(Bn, Sn, A_HEADS, A_HEAD_DIM), cos, sin) * (A_HEAD_DIM ** -0.5)
    ka = apply_partial_rope(ka.reshape(Bn, Sn, A_HEADS, A_HEAD_DIM), cos, sin)
    va = va.reshape(Bn, Sn, A_HEADS, A_HEAD_DIM)
    oa = dilated_mixture_attention(qa, ka, va).reshape(Bn, Sn, A_WIDTH)
    qb = apply_partial_rope(qb.reshape(Bn, Sn, B_HEADS, 2, B_QK_DIM), cos, sin) * (B_QK_DIM ** -0.5)
    kb = apply_partial_rope(kb.reshape(Bn, Sn, B_HEADS, 2, B_QK_DIM), cos, sin)
    vb = vb.reshape(Bn, Sn, B_HEADS, B_V_DIM)
    lam = (jnp.exp(jnp.sum(lq1.astype(jnp.float32) * lk1.astype(jnp.float32)))
           - jnp.exp(jnp.sum(lq2.astype(jnp.float32) * lk2.astype(jnp.float32))) + lambda_init)
    ob = diff_attention(qb, kb, vb, lam, lambda_init, subln_g).reshape(Bn, Sn, B_V_WIDTH)
    return jnp.concatenate([oa, ob], axis=-1) @ w_out


def memory_cross_attention(h, mem, wq, wkv, wo):
    Bn, Sn, D = h.shape
    q = (h @ wq).reshape(Bn, Sn, M_HEADS, M_HEAD_DIM)
    kv = (mem @ wkv).reshape(Bn, mem.shape[1], 2, M_HEADS, M_HEAD_DIM)
    s = jnp.einsum('bqhe,bkhe->bhqk', q, kv[:, :, 0]).astype(jnp.float32) * (M_HEAD_DIM ** -0.5)
    p = jax.nn.softmax(s, axis=-1)
    o = jnp.einsum('bhqk,bkhe->bqhe', p.astype(h.dtype), kv[:, :, 1]).reshape(Bn, Sn, D)
    return o @ wo


def swiglu(x, wg, wu, wd):
    return (jax.nn.silu(x @ wg) * (x @ wu)) @ wd


def moe_ffn(h, w_router, e_bias, w_gate, w_up, w_down, ws_gate, ws_up, ws_down):
    Bn, Sn, D = h.shape
    xt = h.reshape(-1, D)
    T = xt.shape[0]
    scores = jax.nn.sigmoid((xt @ w_router).astype(jnp.float32))
    biased = scores + e_bias.astype(jnp.float32)
    group_score = lax.top_k(biased.reshape(T, N_GROUPS, -1), 2)[0].sum(-1)
    top_groups = lax.top_k(group_score, TOPK_GROUPS)[1]
    gmask = jnp.any(top_groups[..., None] == jnp.arange(N_GROUPS), axis=1)
    masked = jnp.where(jnp.repeat(gmask, N_EXPERTS // N_GROUPS, axis=1), biased, -jnp.inf)
    idx = lax.top_k(masked, TOP_K)[1]
    w = jnp.take_along_axis(scores, idx, axis=1)
    w = w / w.sum(-1, keepdims=True) * ROUTED_SCALE
    A = T * TOP_K
    flat_e = idx.reshape(A)
    flat_tok = jnp.repeat(jnp.arange(T, dtype=jnp.int32), TOP_K)
    flat_w = w.reshape(A)
    order = jnp.argsort(flat_e)
    se, stok, sw = flat_e[order], flat_tok[order], flat_w[order]
    counts = jnp.bincount(flat_e, length=N_EXPERTS)
    starts = jnp.cumsum(counts) - counts
    padded = (counts + MOE_BLOCK - 1) // MOE_BLOCK * MOE_BLOCK
    pend = jnp.cumsum(padded)
    pstart = pend - padded
    dest = pstart[se] + jnp.arange(A) - starts[se]
    n_rows = (-(-A // MOE_BLOCK) + N_EXPERTS) * MOE_BLOCK
    nb = n_rows // MOE_BLOCK
    row_tok = jnp.zeros((n_rows,), jnp.int32).at[dest].set(stok)
    row_w = jnp.zeros((n_rows,), jnp.float32).at[dest].set(sw)
    block_e = jnp.minimum(jnp.searchsorted(pend, jnp.arange(nb) * MOE_BLOCK, side='right'), N_EXPERTS - 1)

    def expert_block(args):
        tok, wt, e = args
        xb = xt[tok]
        return swiglu(xb, w_gate[e], w_up[e], w_down[e]).astype(jnp.float32) * wt[:, None]

    y = lax.map(expert_block, (row_tok.reshape(nb, MOE_BLOCK), row_w.reshape(nb, MOE_BLOCK), block_e))
    routed = jnp.zeros((T, D), jnp.float32).at[row_tok].add(y.reshape(n_rows, D))
    shared = swiglu(xt, ws_gate, ws_up, ws_down).astype(jnp.float32)
    return (routed + shared).astype(h.dtype).reshape(Bn, Sn, D)


def setup_inputs(seed: int = 0) -> dict:
    key = jax.random.key(seed)
    ks = jax.random.split(key, 32)
    D, E, F = D_MODEL, N_EXPERTS, EXPERT_DIM
    nrm = lambda k, shape, scale: jax.random.normal(k, shape, jnp.float32) * scale
    x = nrm(ks[0], (BATCH, SEQ, D), 1.0)
    mem = nrm(ks[1], (BATCH, MEM_LEN, D), 1.0)
    offset = jax.random.randint(ks[2], (BATCH, 1), 0, 1024, dtype=jnp.int32)
    positions = (offset + jnp.arange(SEQ, dtype=jnp.int32)[None, :]).astype(jnp.int32)
    col_scale = jnp.concatenate([
        jnp.ones((2 * A_WIDTH,), jnp.float32), jnp.full((A_WIDTH,), DN_BETA, jnp.float32),
        jnp.ones((2 * B_QK_WIDTH,), jnp.float32), jnp.full((B_V_WIDTH,), DN_BETA, jnp.float32)])
    w_in = nrm(ks[3], (DEPTH, D, IN_WIDTH), D ** -0.5) * col_scale
    w_out = nrm(ks[4], (DEPTH, MIX_WIDTH, D), MIX_WIDTH ** -0.5 * DN_BETA)
    lambda_q1 = nrm(ks[5], (DEPTH, B_QK_DIM), 0.1)
    lambda_k1 = nrm(ks[6], (DEPTH, B_QK_DIM), 0.1)
    lambda_q2 = nrm(ks[7], (DEPTH, B_QK_DIM), 0.1)
    lambda_k2 = nrm(ks[8], (DEPTH, B_QK_DIM), 0.1)
    subln_g = 1.0 + nrm(ks[9], (DEPTH, B_V_DIM), 0.02)
    ln1_g = 1.0 + nrm(ks[10], (DEPTH, D), 0.02)
    ln1_b = nrm(ks[11], (DEPTH, D), 0.02)
    wq_mem = nrm(ks[12], (DEPTH, D, D), D ** -0.5)
    wkv_mem = nrm(ks[13], (DEPTH, D, 2 * D), D ** -0.5)
    wo_mem = nrm(ks[14], (DEPTH, D, D), D ** -0.5 * DN_BETA)
    ln2_g = 1.0 + nrm(ks[15], (DEPTH, D), 0.02)
    ln2_b = nrm(ks[16], (DEPTH, D), 0.02)
    w_router = nrm(ks[17], (DEPTH, D, E), D ** -0.5)
    e_bias = nrm(ks[18], (DEPTH, E), 0.01)
    w_gate = nrm(ks[19], (DEPTH, E, D, F), D ** -0.5)
    w_up = nrm(ks[20], (DEPTH, E, D, F), D ** -0.5)
    w_down = nrm(ks[21], (DEPTH, E, F, D), F ** -0.5 * DN_BETA)
    ws_gate = nrm(ks[22], (DEPTH, D, SHARED_DIM), D ** -0.5)
    ws_up = nrm(ks[23], (DEPTH, D, SHARED_DIM), D ** -0.5)
    ws_down = nrm(ks[24], (DEPTH, SHARED_DIM, D), SHARED_DIM ** -0.5 * DN_BETA)
    ln3_g = 1.0 + nrm(ks[25], (DEPTH, D), 0.02)
    ln3_b = nrm(ks[26], (DEPTH, D), 0.02)
    return {'x': x, 'mem': mem, 'positions': positions, 'w_in': w_in, 'w_out': w_out,
            'lambda_q1': lambda_q1, 'lambda_k1': lambda_k1, 'lambda_q2': lambda_q2, 'lambda_k2': lambda_k2,
            'subln_g': subln_g, 'ln1_g': ln1_g, 'ln1_b': ln1_b,
            'wq_mem': wq_mem, 'wkv_mem': wkv_mem, 'wo_mem': wo_mem, 'ln2_g': ln2_g, 'ln2_b': ln2_b,
            'w_router': w_router, 'e_bias': e_bias, 'w_gate': w_gate, 'w_up': w_up, 'w_down': w_down,
            'ws_gate': ws_gate, 'ws_up': ws_up, 'ws_down': ws_down, 'ln3_g': ln3_g, 'ln3_b': ln3_b}


def reference(x, mem, positions, w_in, w_out, lambda_q1, lambda_k1, lambda_q2, lambda_k2,
              subln_g, ln1_g, ln1_b, wq_mem, wkv_mem, wo_mem, ln2_g, ln2_b,
              w_router, e_bias, w_gate, w_up, w_down, ws_gate, ws_up, ws_down, ln3_g, ln3_b):
    cos, sin = rope_tables(positions)
    h = x
    for l in range(DEPTH):
        lambda_init = 0.8 - 0.6 * math.exp(-0.3 * l)
        mix = hybrid_mixer(h, cos, sin, w_in[l], w_out[l], lambda_q1[l], lambda_k1[l],
                           lambda_q2[l], lambda_k2[l], subln_g[l], lambda_init)
        h = layer_norm(DN_ALPHA * h + mix, ln1_g[l], ln1_b[l])
        h = layer_norm(DN_ALPHA * h + memory_cross_attention(h, mem, wq_mem[l], wkv_mem[l], wo_mem[l]),
                       ln2_g[l], ln2_b[l])
        h = layer_norm(DN_ALPHA * h + moe_ffn(h, w_router[l], e_bias[l], w_gate[l], w_up[l], w_down[l],
                                              ws_gate[l], ws_up[l], ws_down[l]),
                       ln3_g[l], ln3_b[l])
    return h
```

```cpp
#include <hip/hip_runtime.h>
#include <cstdio>
#include <cstdint>
#include <cmath>

constexpr int BATCH = 8, SEQ = 4096, DM = 1024, T = BATCH * SEQ;
constexpr int MEML = 256;
constexpr int INW = 3072;
constexpr int NEXP = 256, TOPK = 8, EDIM = 256;
constexpr int AROWS = T * TOPK;
constexpr float LN_EPS = 1e-5f, SUBLN_EPS = 1e-5f;
constexpr float DN_ALPHA = 1.189207115002721f;
constexpr float LOG2E = 1.4426950408889634f;
constexpr float QSCALE64 = 0.125f * LOG2E;
constexpr float QSCALE256 = 0.0625f * LOG2E;
constexpr float LAMBDA_INIT = 0.2f;
constexpr float ROUTED_SCALE = 2.5f;

constexpr size_t MiB = 1u << 20;
constexpr size_t WS_CNT = 0;
constexpr size_t WS_START = 4096;
constexpr size_t WS_SCAL = 8192;
constexpr size_t WS_CS = 1 * MiB;
constexpr size_t WS_RIDX = 4 * MiB, WS_RW = 5 * MiB, WS_RRANK = 6 * MiB, WS_POS = 7 * MiB;
constexpr size_t WS_ROWTOK = 8 * MiB, WS_ROWW = 10 * MiB;
constexpr size_t WS_LSEA = 12 * MiB;
constexpr size_t WS_KVM = 16 * MiB;
constexpr size_t WS_H2 = 192 * MiB;
constexpr size_t WS_MIXIN = 192 * MiB;
constexpr size_t WS_Y1 = 256 * MiB;
constexpr size_t WS_H1 = 320 * MiB;
constexpr size_t WS_HB = 256 * MiB;
constexpr size_t WS_Y = 448 * MiB;
constexpr size_t WS_SS = 448 * MiB;
constexpr size_t WS_DD = 576 * MiB;
constexpr size_t WS_PROJ = 704 * MiB;
constexpr size_t WS_QM = 704 * MiB;
constexpr size_t WS_MO = 768 * MiB;
constexpr size_t WS_Y2 = 832 * MiB;
constexpr size_t WS_PARTA = 896 * MiB;
constexpr size_t WS_LOGITS = 896 * MiB;

typedef unsigned short bf16;
__device__ __forceinline__ float bf2f(bf16 v) { return __uint_as_float(((unsigned)v) << 16); }
__device__ __forceinline__ bf16 f2bf(float f) { unsigned u = __float_as_uint(f); return (bf16)((u + 0x7fffu + ((u >> 16) & 1u)) >> 16); }

struct P {
    const float *x, *mem; const int* pos;
    const float *w_in, *w_out, *lq1, *lk1, *lq2, *lk2, *subln_g, *ln1_g, *ln1_b;
    const float *wq, *wkv, *wo, *ln2_g, *ln2_b, *w_router, *e_bias, *w_gate, *w_up, *w_down;
    const float *ws_gate, *ws_up, *ws_down, *ln3_g, *ln3_b;
    float* out; unsigned char* ws;
};

__host__ __device__ __forceinline__ int sigma_dim(int p) { return p < 16 ? (p >> 1) + 8 * (p & 1) : p; }
__device__ __forceinline__ int proj_src_col(int c) {
    const int seg = c >> 9;
    if (seg == 2 || seg == 5) return c;
    return (c & ~63) | sigma_dim(c & 63);
}

__global__ void prep_kernel(P p) {
    const int i = blockIdx.x * blockDim.x + threadIdx.x;
    if (i < T * 8) {
        const int t = i >> 3, j = i & 7;
        const float inv = powf(500000.0f, -(float)(2 * j) / 16.0f);
        const float ang = (float)p.pos[t] * inv;
        float2* cs = (float2*)(p.ws + WS_CS);
        cs[i] = make_float2(cosf(ang), sinf(ang));
    }
    if (i < 256) ((int*)(p.ws + WS_CNT))[i] = 0;
    if (i == 0) {
        float a = 0.f, b = 0.f;
        for (int k = 0; k < 64; ++k) { a += p.lq1[k] * p.lk1[k]; b += p.lq2[k] * p.lk2[k]; }
        ((float*)(p.ws + WS_SCAL))[0] = expf(a) - expf(b) + LAMBDA_INIT;
    }
}

template <class F> __global__ void __launch_bounds__(256) ngemm(F f) {
    __shared__ float As[16][65], Bs[16][65];
    const int g = blockIdx.z, M = f.rows(g);
    const int m0 = blockIdx.x * 64, n0 = blockIdx.y * 64;
    if (m0 >= M) return;
    const int K = f.kdim();
    const int tid = threadIdx.x, tx = tid & 15, ty = tid >> 4;
    float acc[4][4];
#pragma unroll
    for (int i = 0; i < 4; ++i)
#pragma unroll
        for (int j = 0; j < 4; ++j) acc[i][j] = 0.f;
    for (int k0 = 0; k0 < K; k0 += 16) {
#pragma unroll
        for (int i = 0; i < 4; ++i) {
            const int idx = tid + i * 256;
            { const int k = idx & 15, r = idx >> 4; As[k][r] = (m0 + r < M) ? f.a(g, m0 + r, k0 + k) : 0.f; }
            { const int c = idx & 63, k = idx >> 6; Bs[k][c] = f.b(g, k0 + k, n0 + c); }
        }
        __syncthreads();
#pragma unroll
        for (int k = 0; k < 16; ++k) {
            float av[4], bv[4];
#pragma unroll
            for (int i = 0; i < 4; ++i) { av[i] = As[k][ty * 4 + i]; bv[i] = Bs[k][tx * 4 + i]; }
#pragma unroll
            for (int i = 0; i < 4; ++i)
#pragma unroll
                for (int j = 0; j < 4; ++j) acc[i][j] += av[i] * bv[j];
        }
        __syncthreads();
    }
#pragma unroll
    for (int i = 0; i < 4; ++i) { const int r = m0 + ty * 4 + i; if (r < M) f.epi(g, r, n0 + tx * 4, acc[i]); }
}

struct FInProj {
    P p;
    __device__ int rows(int) const { return T; }
    __device__ int kdim() const { return DM; }
    __device__ float a(int, int r, int k) const { return bf2f(f2bf(p.x[(size_t)r * DM + k])); }
    __device__ float b(int, int k, int c) const { return bf2f(f2bf(p.w_in[(size_t)k * INW + proj_src_col(c)])); }
    __device__ void epi(int, int r, int c0, const float (&v)[4]) const {
        bf16* proj = (bf16*)(p.ws + WS_PROJ);
        const int seg = c0 >> 9; float o[4] = {v[0], v[1], v[2], v[3]};
        if (seg != 2 && seg != 5) {
            const int pp = c0 & 63;
            if (pp < 16) {
                const float2* cs = (const float2*)(p.ws + WS_CS) + (size_t)r * 8;
#pragma unroll
                for (int q = 0; q < 2; ++q) { const float2 c = cs[(pp >> 1) + q]; const float t1 = v[2 * q], t2 = v[2 * q + 1]; o[2 * q] = t1 * c.x - t2 * c.y; o[2 * q + 1] = t2 * c.x + t1 * c.y; }
            }
            if (seg == 0 || seg == 3) {
#pragma unroll
                for (int q = 0; q < 4; ++q) o[q] *= QSCALE64;
            }
        }
#pragma unroll
        for (int q = 0; q < 4; ++q) proj[(size_t)r * INW + c0 + q] = f2bf(o[q]);
    }
};
struct FOutProj {
    P p;
    __device__ int rows(int) const { return T; }
    __device__ int kdim() const { return DM; }
    __device__ float a(int, int r, int k) const { return bf2f(((const bf16*)(p.ws + WS_MIXIN))[(size_t)r * DM + k]); }
    __device__ float b(int, int k, int c) const { return bf2f(f2bf(p.w_out[(size_t)k * DM + c])); }
    __device__ void epi(int, int r, int c0, const float (&v)[4]) const {
        bf16* y = (bf16*)(p.ws + WS_Y1);
#pragma unroll
        for (int q = 0; q < 4; ++q) y[(size_t)r * DM + c0 + q] = f2bf(DN_ALPHA * p.x[(size_t)r * DM + c0 + q] + v[q]);
    }
};
struct FQMem {
    P p;
    __device__ int rows(int) const { return T; }
    __device__ int kdim() const { return DM; }
    __device__ float a(int, int r, int k) const { return bf2f(((const bf16*)(p.ws + WS_H1))[(size_t)r * DM + k]); }
    __device__ float b(int, int k, int c) const { return bf2f(f2bf(p.wq[(size_t)k * DM + c])); }
    __device__ void epi(int, int r, int c0, const float (&v)[4]) const {
        bf16* y = (bf16*)(p.ws + WS_QM);
#pragma unroll
        for (int q = 0; q < 4; ++q) y[(size_t)r * DM + c0 + q] = f2bf(v[q] * QSCALE256);
    }
};
struct FKV {
    P p;
    __device__ int rows(int) const { return BATCH * MEML; }
    __device__ int kdim() const { return DM; }
    __device__ float a(int, int r, int k) const { return bf2f(f2bf(p.mem[(size_t)r * DM + k])); }
    __device__ float b(int, int k, int c) const { return bf2f(f2bf(p.wkv[(size_t)k * 2048 + c])); }
    __device__ void epi(int, int r, int c0, const float (&v)[4]) const {
        bf16* y = (bf16*)(p.ws + WS_KVM);
#pragma unroll
        for (int q = 0; q < 4; ++q) y[(size_t)r * 2048 + c0 + q] = f2bf(v[q]);
    }
};
struct FMemS {
    P p;
    __device__ int rows(int) const { return T; }
    __device__ int kdim() const { return 256; }
    __device__ float a(int g, int r, int k) const { return bf2f(((const bf16*)(p.ws + WS_QM))[(size_t)r * DM + g * 256 + k]); }
    __device__ float b(int g, int k, int c) const { const int bb = (blockIdx.x * 64) / SEQ; return bf2f(((const bf16*)(p.ws + WS_KVM))[(size_t)(bb * MEML + c) * 2048 + g * 256 + k]); }
    __device__ void epi(int g, int r, int c0, const float (&v)[4]) const {
        float* s = (float*)(p.ws + WS_SS);
#pragma unroll
        for (int q = 0; q < 4; ++q) s[(size_t)r * DM + g * 256 + c0 + q] = v[q];
    }
};
struct FMemO {
    P p;
    __device__ int rows(int) const { return T; }
    __device__ int kdim() const { return 256; }
    __device__ float a(int g, int r, int k) const { return bf2f(f2bf(((const float*)(p.ws + WS_SS))[(size_t)r * DM + g * 256 + k])); }
    __device__ float b(int g, int k, int c) const { const int bb = (blockIdx.x * 64) / SEQ; return bf2f(((const bf16*)(p.ws + WS_KVM))[(size_t)(bb * MEML + k) * 2048 + 1024 + g * 256 + c]); }
    __device__ void epi(int g, int r, int c0, const float (&v)[4]) const {
        bf16* y = (bf16*)(p.ws + WS_MO);
#pragma unroll
        for (int q = 0; q < 4; ++q) y[(size_t)r * DM + g * 256 + c0 + q] = f2bf(v[q]);
    }
};
struct FWo {
    P p;
    __device__ int rows(int) const { return T; }
    __device__ int kdim() const { return DM; }
    __device__ float a(int, int r, int k) const { return bf2f(((const bf16*)(p.ws + WS_MO))[(size_t)r * DM + k]); }
    __device__ float b(int, int k, int c) const { return bf2f(f2bf(p.wo[(size_t)k * DM + c])); }
    __device__ void epi(int, int r, int c0, const float (&v)[4]) const {
        bf16* y = (bf16*)(p.ws + WS_Y2); const bf16* h1 = (const bf16*)(p.ws + WS_H1);
#pragma unroll
        for (int q = 0; q < 4; ++q) y[(size_t)r * DM + c0 + q] = f2bf(DN_ALPHA * bf2f(h1[(size_t)r * DM + c0 + q]) + v[q]);
    }
};
struct FRouter {
    P p;
    __device__ int rows(int) const { return T; }
    __device__ int kdim() const { return DM; }
    __device__ float a(int, int r, int k) const { return bf2f(((const bf16*)(p.ws + WS_H2))[(size_t)r * DM + k]); }
    __device__ float b(int, int k, int c) const { return bf2f(f2bf(p.w_router[(size_t)k * NEXP + c])); }
    __device__ void epi(int, int r, int c0, const float (&v)[4]) const {
        float* y = (float*)(p.ws + WS_LOGITS);
#pragma unroll
        for (int q = 0; q < 4; ++q) y[(size_t)r * NEXP + c0 + q] = v[q];
    }
};
struct FMoe1 {
    P p;
    __device__ int rows(int g) const { const int* st = (const int*)(p.ws + WS_START); return g < NEXP ? st[g + 1] - st[g] : T; }
    __device__ int kdim() const { return DM; }
    __device__ float a(int g, int r, int k) const {
        const int* st = (const int*)(p.ws + WS_START); const int* rt = (const int*)(p.ws + WS_ROWTOK);
        const int tok = g < NEXP ? rt[st[g] + r] : r;
        return bf2f(((const bf16*)(p.ws + WS_H2))[(size_t)tok * DM + k]);
    }
    __device__ float b(int g, int k, int c) const {
        const float* w = (c & 1) ? (g < NEXP ? p.w_up + (size_t)g * DM * EDIM : p.ws_up) : (g < NEXP ? p.w_gate + (size_t)g * DM * EDIM : p.ws_gate);
        return bf2f(f2bf(w[(size_t)k * EDIM + (c >> 1)]));
    }
    __device__ void epi(int g, int r, int c0, const float (&v)[4]) const {
        const int* st = (const int*)(p.ws + WS_START); bf16* H = (bf16*)(p.ws + WS_HB);
        const size_t row = g < NEXP ? (size_t)st[g] + r : (size_t)AROWS + r;
#pragma unroll
        for (int q = 0; q < 2; ++q) { const float gg = v[2 * q], uu = v[2 * q + 1]; H[row * EDIM + (c0 >> 1) + q] = f2bf(gg / (1.f + expf(-gg)) * uu); }
    }
};
struct FMoe2 {
    P p;
    __device__ int rows(int g) const { const int* st = (const int*)(p.ws + WS_START); return g < NEXP ? st[g + 1] - st[g] : T; }
    __device__ int kdim() const { return EDIM; }
    __device__ float a(int g, int r, int k) const {
        const int* st = (const int*)(p.ws + WS_START); const bf16* H = (const bf16*)(p.ws + WS_HB);
        const size_t row = g < NEXP ? (size_t)st[g] + r : (size_t)AROWS + r;
        return bf2f(H[row * EDIM + k]);
    }
    __device__ float b(int g, int k, int c) const { const float* w = g < NEXP ? p.w_down + (size_t)g * EDIM * DM : p.ws_down; return bf2f(f2bf(w[(size_t)k * DM + c])); }
    __device__ void epi(int g, int r, int c0, const float (&v)[4]) const {
        const int* st = (const int*)(p.ws + WS_START); bf16* Y = (bf16*)(p.ws + WS_Y);
        const size_t row = g < NEXP ? (size_t)st[g] + r : (size_t)AROWS + r;
        const float w = g < NEXP ? ((const float*)(p.ws + WS_ROWW))[row] : 1.f;
#pragma unroll
        for (int q = 0; q < 4; ++q) Y[row * DM + c0 + q] = f2bf(v[q] * w);
    }
};

__global__ void __launch_bounds__(256) nattnA(P p) {
    const int i = blockIdx.x * blockDim.x + threadIdx.x;
    if (i >= 3 * 8 * T) return;
    const int t = i % T, h = (i / T) & 7, br = i / (8 * T);
    const int dil = br == 0 ? 1 : (br == 1 ? 4 : 16);
    const int s = t % SEQ, b0 = t - s;
    const bf16* proj = (const bf16*)(p.ws + WS_PROJ);
    float q[64], o[64];
#pragma unroll
    for (int e = 0; e < 64; ++e) { q[e] = bf2f(proj[(size_t)t * INW + h * 64 + e]); o[e] = 0.f; }
    float m = -INFINITY, l = 0.f;
    for (int j = 0; j <= 128; ++j) {
        const int ks = s - j * dil; if (ks < 0) break;
        const bf16* kr = proj + (size_t)(b0 + ks) * INW + 512 + h * 64;
        const bf16* vr = proj + (size_t)(b0 + ks) * INW + 1024 + h * 64;
        float sc = 0.f;
#pragma unroll
        for (int e = 0; e < 64; ++e) sc += q[e] * bf2f(kr[e]);
        const float mn = fmaxf(m, sc), al = exp2f(m - mn), pe = exp2f(sc - mn);
        l = l * al + pe;
#pragma unroll
        for (int e = 0; e < 64; ++e) o[e] = o[e] * al + pe * bf2f(vr[e]);
        m = mn;
    }
    bf16* pa = (bf16*)(p.ws + WS_PARTA) + ((size_t)br * T + t) * 512 + h * 64;
    const float il = 1.f / l;
#pragma unroll
    for (int e = 0; e < 64; ++e) pa[e] = f2bf(o[e] * il);
    ((float*)(p.ws + WS_LSEA))[((size_t)br * T + t) * 8 + h] = m + log2f(l);
}
__global__ void mergeA(P p) {
    const int i = blockIdx.x * blockDim.x + threadIdx.x;
    if (i >= T * 512) return;
    const int t = i >> 9, c = i & 511, h = c >> 6;
    const float* lse = (const float*)(p.ws + WS_LSEA);
    const float l0 = lse[(size_t)t * 8 + h], l1 = lse[((size_t)T + t) * 8 + h], l2 = lse[((size_t)2 * T + t) * 8 + h];
    const float mx = fmaxf(l0, fmaxf(l1, l2));
    const float w0 = exp2f(l0 - mx), w1 = exp2f(l1 - mx), w2 = exp2f(l2 - mx), inv = 1.f / (w0 + w1 + w2);
    const bf16* pa = (const bf16*)(p.ws + WS_PARTA);
    const float v = (w0 * bf2f(pa[(size_t)t * 512 + c]) + w1 * bf2f(pa[((size_t)T + t) * 512 + c]) + w2 * bf2f(pa[((size_t)2 * T + t) * 512 + c])) * inv;
    ((bf16*)(p.ws + WS_MIXIN))[(size_t)t * DM + c] = f2bf(v);
}
__global__ void __launch_bounds__(256) nattnB(P p) {
    const int i = blockIdx.x * blockDim.x + threadIdx.x;
    if (i >= 16 * T) return;
    const int t = i % T, ch = (i / T) & 3, h = i / (4 * T);
    const int s = t % SEQ, b0 = t - s;
    const bf16* proj = (const bf16*)(p.ws + WS_PROJ);
    float q0[64], q1[64], o0[32], o1[32];
#pragma unroll
    for (int e = 0; e < 64; ++e) { q0[e] = bf2f(proj[(size_t)t * INW + 1536 + h * 128 + e]); q1[e] = bf2f(proj[(size_t)t * INW + 1536 + h * 128 + 64 + e]); }
#pragma unroll
    for (int e = 0; e < 32; ++e) { o0[e] = 0.f; o1[e] = 0.f; }
    float m0 = -INFINITY, l0 = 0.f, m1 = -INFINITY, l1 = 0.f;
    for (int ks = 0; ks <= s; ++ks) {
        const bf16* kr = proj + (size_t)(b0 + ks) * INW + 2048 + h * 128;
        const bf16* vr = proj + (size_t)(b0 + ks) * INW + 2560 + h * 128 + ch * 32;
        float s0 = 0.f, s1 = 0.f;
#pragma unroll
        for (int e = 0; e < 64; ++e) { s0 += q0[e] * bf2f(kr[e]); s1 += q1[e] * bf2f(kr[64 + e]); }
        const float mn0 = fmaxf(m0, s0), a0 = exp2f(m0 - mn0), p0 = exp2f(s0 - mn0);
        const float mn1 = fmaxf(m1, s1), a1 = exp2f(m1 - mn1), p1 = exp2f(s1 - mn1);
        l0 = l0 * a0 + p0; l1 = l1 * a1 + p1; m0 = mn0; m1 = mn1;
#pragma unroll
        for (int e = 0; e < 32; ++e) { const float v = bf2f(vr[e]); o0[e] = o0[e] * a0 + p0 * v; o1[e] = o1[e] * a1 + p1 * v; }
    }
    const float lam = ((const float*)(p.ws + WS_SCAL))[0];
    float* dd = (float*)(p.ws + WS_DD) + (size_t)t * 512 + h * 128 + ch * 32;
    const float i0 = 1.f / l0, i1 = 1.f / l1;
#pragma unroll
    for (int e = 0; e < 32; ++e) dd[e] = o0[e] * i0 - lam * o1[e] * i1;
}
__global__ void sublnB(P p) {
    const int w = (blockIdx.x * blockDim.x + threadIdx.x) >> 6, lane = threadIdx.x & 63;
    if (w >= T * 4) return;
    const int t = w >> 2, h = w & 3;
    const float* dd = (const float*)(p.ws + WS_DD) + (size_t)t * 512 + h * 128;
    const float a = dd[lane], b = dd[lane + 64];
    float ss = a * a + b * b;
    for (int o = 1; o < 64; o <<= 1) ss += __shfl_xor(ss, o);
    const float r = rsqrtf(ss * (1.f / 128.f) + SUBLN_EPS) * (1.f - LAMBDA_INIT);
    bf16* mx = (bf16*)(p.ws + WS_MIXIN) + (size_t)t * DM + 512 + h * 128;
    mx[lane] = f2bf(a * r * p.subln_g[lane]); mx[lane + 64] = f2bf(b * r * p.subln_g[lane + 64]);
}
__global__ void softmaxM(P p) {
    const int w = (blockIdx.x * blockDim.x + threadIdx.x) >> 6, lane = threadIdx.x & 63;
    if (w >= T * 4) return;
    float* s = (float*)(p.ws + WS_SS) + (size_t)w * 256;
    float v[4]; float mx = -INFINITY;
#pragma unroll
    for (int j = 0; j < 4; ++j) { v[j] = s[lane + 64 * j]; mx = fmaxf(mx, v[j]); }
    for (int o = 1; o < 64; o <<= 1) mx = fmaxf(mx, __shfl_xor(mx, o));
    float sum = 0.f;
#pragma unroll
    for (int j = 0; j < 4; ++j) { v[j] = exp2f(v[j] - mx); sum += v[j]; }
    for (int o = 1; o < 64; o <<= 1) sum += __shfl_xor(sum, o);
    const float inv = 1.f / sum;
#pragma unroll
    for (int j = 0; j < 4; ++j) s[lane + 64 * j] = v[j] * inv;
}

__global__ void __launch_bounds__(256) ln_pass(const bf16* __restrict__ in, bf16* __restrict__ outp, const float* __restrict__ g, const float* __restrict__ b) {
    const int w = (blockIdx.x * blockDim.x + threadIdx.x) >> 6, lane = threadIdx.x & 63;
    if (w >= T) return;
    const bf16* r = in + (size_t)w * DM;
    float v[16]; float s = 0.f;
#pragma unroll
    for (int j = 0; j < 4; ++j) { const uint2 u = *(const uint2*)(r + j * 256 + lane * 4);
        v[4 * j] = __uint_as_float(u.x << 16); v[4 * j + 1] = __uint_as_float(u.x & 0xffff0000u); v[4 * j + 2] = __uint_as_float(u.y << 16); v[4 * j + 3] = __uint_as_float(u.y & 0xffff0000u); }
#pragma unroll
    for (int j = 0; j < 16; ++j) s += v[j];
    for (int o = 1; o < 64; o <<= 1) s += __shfl_xor(s, o);
    const float mu = s * (1.f / DM); float q = 0.f;
#pragma unroll
    for (int j = 0; j < 16; ++j) { v[j] -= mu; q += v[j] * v[j]; }
    for (int o = 1; o < 64; o <<= 1) q += __shfl_xor(q, o);
    const float rs = rsqrtf(q * (1.f / DM) + LN_EPS);
#pragma unroll
    for (int j = 0; j < 4; ++j) { const int c = j * 256 + lane * 4; const float4 gg = *(const float4*)(g + c), bb = *(const float4*)(b + c);
        uint2 u; u.x = (unsigned)f2bf(v[4 * j] * rs * gg.x + bb.x) | ((unsigned)f2bf(v[4 * j + 1] * rs * gg.y + bb.y) << 16);
        u.y = (unsigned)f2bf(v[4 * j + 2] * rs * gg.z + bb.z) | ((unsigned)f2bf(v[4 * j + 3] * rs * gg.w + bb.w) << 16);
        *(uint2*)(outp + (size_t)w * DM + c) = u; }
}

__global__ void __launch_bounds__(256) route_pass(P p) {
    const int w = (blockIdx.x * blockDim.x + threadIdx.x) >> 6, lane = threadIdx.x & 63;
    if (w >= T) return;
    const float4 lg = *(const float4*)((const float*)(p.ws + WS_LOGITS) + (size_t)w * NEXP + lane * 4);
    const float4 eb = *(const float4*)(p.e_bias + lane * 4);
    float sc[4] = {1.f / (1.f + expf(-lg.x)), 1.f / (1.f + expf(-lg.y)), 1.f / (1.f + expf(-lg.z)), 1.f / (1.f + expf(-lg.w))};
    float bs[4] = {sc[0] + eb.x, sc[1] + eb.y, sc[2] + eb.z, sc[3] + eb.w};
    float m1 = fmaxf(bs[0], bs[1]), m2 = fminf(bs[0], bs[1]);
    { const float c = bs[2]; const float n1 = fmaxf(m1, c); m2 = fmaxf(m2, fminf(m1, c)); m1 = n1; }
    { const float c = bs[3]; const float n1 = fmaxf(m1, c); m2 = fmaxf(m2, fminf(m1, c)); m1 = n1; }
#pragma unroll
    for (int o = 1; o < 8; o <<= 1) { const float b1 = __shfl_xor(m1, o), b2 = __shfl_xor(m2, o); const float n1 = fmaxf(m1, b1); m2 = fmaxf(fminf(m1, b1), fmaxf(m2, b2)); m1 = n1; }
    const float gs = m1 + m2; const int grp = lane >> 3;
    int rank = 0;
#pragma unroll
    for (int g2 = 0; g2 < 8; ++g2) { const float o = __shfl(gs, g2 * 8); rank += (o > gs || (o == gs && g2 < grp)) ? 1 : 0; }
    const bool sel = rank < 4;
    float cand[4];
#pragma unroll
    for (int j = 0; j < 4; ++j) cand[j] = sel ? bs[j] : -INFINITY;
    int myidx = 0; float myw = 0.f; float wsum = 0.f;
    for (int k = 0; k < TOPK; ++k) {
        float bv = cand[0]; int bi = lane * 4;
#pragma unroll
        for (int j = 1; j < 4; ++j) if (cand[j] > bv) { bv = cand[j]; bi = lane * 4 + j; }
#pragma unroll
        for (int o = 1; o < 64; o <<= 1) { const float ov = __shfl_xor(bv, o); const int oi = __shfl_xor(bi, o); if (ov > bv || (ov == bv && oi < bi)) { bv = ov; bi = oi; } }
        const int own = bi >> 2, el = bi & 3;
        const float sv = el == 0 ? sc[0] : (el == 1 ? sc[1] : (el == 2 ? sc[2] : sc[3]));
        const float wv = __shfl(sv, own);
        if (lane == own) { if (el == 0) cand[0] = -INFINITY; else if (el == 1) cand[1] = -INFINITY; else if (el == 2) cand[2] = -INFINITY; else cand[3] = -INFINITY; }
        wsum += wv;
        if (lane == k) { myidx = bi; myw = wv; }
    }
    if (lane < TOPK) {
        const float wn = myw / wsum * ROUTED_SCALE;
        const int rk = atomicAdd((int*)(p.ws + WS_CNT) + myidx, 1);
        ((int*)(p.ws + WS_RIDX))[(size_t)w * 8 + lane] = myidx;
        ((float*)(p.ws + WS_RW))[(size_t)w * 8 + lane] = wn;
        ((int*)(p.ws + WS_RRANK))[(size_t)w * 8 + lane] = rk;
    }
}
__global__ void scan_pass(P p) {
    __shared__ int sh[256];
    const int i = threadIdx.x; const int c = ((const int*)(p.ws + WS_CNT))[i];
    sh[i] = c; __syncthreads();
    for (int o = 1; o < 256; o <<= 1) { const int v = i >= o ? sh[i - o] : 0; __syncthreads(); sh[i] += v; __syncthreads(); }
    int* st = (int*)(p.ws + WS_START);
    st[i + 1] = sh[i]; if (i == 0) st[0] = 0;
}
__global__ void scatter_pass(P p) {
    const int i = blockIdx.x * blockDim.x + threadIdx.x;
    if (i >= T * 8) return;
    const int e = ((const int*)(p.ws + WS_RIDX))[i], rk = ((const int*)(p.ws + WS_RRANK))[i];
    const int pos = ((const int*)(p.ws + WS_START))[e] + rk;
    ((int*)(p.ws + WS_ROWTOK))[pos] = i >> 3;
    ((float*)(p.ws + WS_ROWW))[pos] = ((const float*)(p.ws + WS_RW))[i];
    ((int*)(p.ws + WS_POS))[i] = pos;
}
__global__ void __launch_bounds__(256) combine_pass(P p) {
    const int w = (blockIdx.x * blockDim.x + threadIdx.x) >> 6, lane = threadIdx.x & 63;
    if (w >= T) return;
    const bf16* h2 = (const bf16*)(p.ws + WS_H2) + (size_t)w * DM;
    const bf16* Y = (const bf16*)(p.ws + WS_Y);
    const int* pos = (const int*)(p.ws + WS_POS) + (size_t)w * 8;
    float v[16];
#pragma unroll
    for (int j = 0; j < 4; ++j) { const uint2 u = *(const uint2*)(h2 + j * 256 + lane * 4);
        v[4 * j] = DN_ALPHA * __uint_as_float(u.x << 16); v[4 * j + 1] = DN_ALPHA * __uint_as_float(u.x & 0xffff0000u); v[4 * j + 2] = DN_ALPHA * __uint_as_float(u.y << 16); v[4 * j + 3] = DN_ALPHA * __uint_as_float(u.y & 0xffff0000u); }
#pragma unroll
    for (int k = 0; k < 9; ++k) {
        const size_t row = k < 8 ? (size_t)pos[k < 8 ? k : 0] : (size_t)AROWS + w;
        const bf16* yr = Y + row * DM;
#pragma unroll
        for (int j = 0; j < 4; ++j) { const uint2 u = *(const uint2*)(yr + j * 256 + lane * 4);
            v[4 * j] += __uint_as_float(u.x << 16); v[4 * j + 1] += __uint_as_float(u.x & 0xffff0000u); v[4 * j + 2] += __uint_as_float(u.y << 16); v[4 * j + 3] += __uint_as_float(u.y & 0xffff0000u); }
    }
    float s = 0.f;
#pragma unroll
    for (int j = 0; j < 16; ++j) s += v[j];
    for (int o = 1; o < 64; o <<= 1) s += __shfl_xor(s, o);
    const float mu = s * (1.f / DM); float q = 0.f;
#pragma unroll
    for (int j = 0; j < 16; ++j) { v[j] -= mu; q += v[j] * v[j]; }
    for (int o = 1; o < 64; o <<= 1) q += __shfl_xor(q, o);
    const float rs = rsqrtf(q * (1.f / DM) + LN_EPS);
#pragma unroll
    for (int j = 0; j < 4; ++j) { const int c = j * 256 + lane * 4; const float4 gg = *(const float4*)(p.ln3_g + c), bb = *(const float4*)(p.ln3_b + c);
        float4 o; o.x = v[4 * j] * rs * gg.x + bb.x; o.y = v[4 * j + 1] * rs * gg.y + bb.y; o.z = v[4 * j + 2] * rs * gg.z + bb.z; o.w = v[4 * j + 3] * rs * gg.w + bb.w;
        *(float4*)(p.out + (size_t)w * DM + c) = o; }
}

extern "C" void kernel_launch(void* const* d_in, const int* in_sizes, int n_in, void* d_out, int out_size, void* d_ws, size_t ws_size, hipStream_t stream) {
    P p{};
    p.x = (const float*)d_in[0]; p.mem = (const float*)d_in[1]; p.pos = (const int*)d_in[2];
    p.w_in = (const float*)d_in[3]; p.w_out = (const float*)d_in[4]; p.lq1 = (const float*)d_in[5]; p.lk1 = (const float*)d_in[6]; p.lq2 = (const float*)d_in[7]; p.lk2 = (const float*)d_in[8];
    p.subln_g = (const float*)d_in[9]; p.ln1_g = (const float*)d_in[10]; p.ln1_b = (const float*)d_in[11];
    p.wq = (const float*)d_in[12]; p.wkv = (const float*)d_in[13]; p.wo = (const float*)d_in[14]; p.ln2_g = (const float*)d_in[15]; p.ln2_b = (const float*)d_in[16];
    p.w_router = (const float*)d_in[17]; p.e_bias = (const float*)d_in[18]; p.w_gate = (const float*)d_in[19]; p.w_up = (const float*)d_in[20]; p.w_down = (const float*)d_in[21];
    p.ws_gate = (const float*)d_in[22]; p.ws_up = (const float*)d_in[23]; p.ws_down = (const float*)d_in[24]; p.ln3_g = (const float*)d_in[25]; p.ln3_b = (const float*)d_in[26];
    p.out = (float*)d_out; p.ws = (unsigned char*)d_ws;
    unsigned char* ws = p.ws;
    prep_kernel<<<T * 8 / 256, 256, 0, stream>>>(p);
    ngemm<FInProj><<<dim3(T / 64, INW / 64, 1), 256, 0, stream>>>(FInProj{p});
    nattnA<<<3 * 8 * T / 256, 256, 0, stream>>>(p);
    mergeA<<<T * 512 / 256, 256, 0, stream>>>(p);
    nattnB<<<16 * T / 256, 256, 0, stream>>>(p);
    sublnB<<<T * 4 / 4, 256, 0, stream>>>(p);
    ngemm<FOutProj><<<dim3(T / 64, DM / 64, 1), 256, 0, stream>>>(FOutProj{p});
    ln_pass<<<T / 4, 256, 0, stream>>>((const bf16*)(ws + WS_Y1), (bf16*)(ws + WS_H1), p.ln1_g, p.ln1_b);
    ngemm<FQMem><<<dim3(T / 64, DM / 64, 1), 256, 0, stream>>>(FQMem{p});
    ngemm<FKV><<<dim3(BATCH * MEML / 64, 2048 / 64, 1), 256, 0, stream>>>(FKV{p});
    ngemm<FMemS><<<dim3(T / 64, 256 / 64, 4), 256, 0, stream>>>(FMemS{p});
    softmaxM<<<T * 4 / 4, 256, 0, stream>>>(p);
    ngemm<FMemO><<<dim3(T / 64, 256 / 64, 4), 256, 0, stream>>>(FMemO{p});
    ngemm<FWo><<<dim3(T / 64, DM / 64, 1), 256, 0, stream>>>(FWo{p});
    ln_pass<<<T / 4, 256, 0, stream>>>((const bf16*)(ws + WS_Y2), (bf16*)(ws + WS_H2), p.ln2_g, p.ln2_b);
    ngemm<FRouter><<<dim3(T / 64, NEXP / 64, 1), 256, 0, stream>>>(FRouter{p});
    route_pass<<<T / 4, 256, 0, stream>>>(p);
    scan_pass<<<1, 256, 0, stream>>>(p);
    scatter_pass<<<T * 8 / 256, 256, 0, stream>>>(p);
    ngemm<FMoe1><<<dim3(T / 64, 512 / 64, NEXP + 1), 256, 0, stream>>>(FMoe1{p});
    ngemm<FMoe2><<<dim3(T / 64, DM / 64, NEXP + 1), 256, 0, stream>>>(FMoe2{p});
    combine_pass<<<T / 4, 256, 0, stream>>>(p);
}
```

```cpp
#define MK_MODE 2
#define NAIVE_MASK 0
#include <hip/hip_runtime.h>
#include <hip/hip_cooperative_groups.h>
#include <cstdio>
#include <cstdint>
#include <cmath>
namespace cg = cooperative_groups;

constexpr int BATCH = 8, SEQ = 4096, DM = 1024, T = BATCH * SEQ;
constexpr int MEML = 256;
constexpr int INW = 3072;
constexpr int NEXP = 256, TOPK = 8, EDIM = 256;
constexpr int AROWS = T * TOPK;
constexpr float LN_EPS = 1e-5f, SUBLN_EPS = 1e-5f;
constexpr float DN_ALPHA = 1.189207115002721f;
constexpr float LOG2E = 1.4426950408889634f;
constexpr float QSCALE64 = 0.125f * LOG2E;
constexpr float QSCALE256 = 0.0625f * LOG2E;
constexpr float LAMBDA_INIT = 0.2f;
constexpr float ROUTED_SCALE = 2.5f;

constexpr size_t MiB = 1u << 20;
constexpr size_t WS_CNT = 0;
constexpr size_t WS_START = 4096;
constexpr size_t WS_SCAL = 8192;
constexpr size_t WS_NRT = 12288;
constexpr size_t WS_TILETAB = 16384;
constexpr size_t WS_BAR = 65536;
constexpr size_t WS_CS = 1 * MiB;
constexpr size_t WS_RIDX = 4 * MiB, WS_RW = 5 * MiB, WS_RRANK = 6 * MiB, WS_POS = 7 * MiB;
constexpr size_t WS_ROWTOK = 8 * MiB, WS_ROWW = 10 * MiB;
constexpr size_t WS_LSEA = 12 * MiB;
constexpr size_t WS_KVM = 16 * MiB;
constexpr size_t WS_MEMB = 24 * MiB;
constexpr size_t WS_WINT = 32 * MiB;
constexpr size_t WS_WOUTT = 38 * MiB;
constexpr size_t WS_WQT = 40 * MiB;
constexpr size_t WS_WKVT = 42 * MiB;
constexpr size_t WS_WOT = 46 * MiB;
constexpr size_t WS_WRT = 48 * MiB;
constexpr size_t WS_WTD = 64 * MiB;
constexpr size_t WS_H2 = 193 * MiB;
constexpr size_t WS_MIXIN = 193 * MiB;
constexpr size_t WS_Y1 = 257 * MiB;
constexpr size_t WS_DD = 257 * MiB;
constexpr size_t WS_H1 = 321 * MiB;
constexpr size_t WS_HB = 257 * MiB;
constexpr size_t WS_WTGU = 401 * MiB;
constexpr size_t WS_Y = 448 * MiB;
constexpr size_t WS_PROJ = 658 * MiB;
constexpr size_t WS_QM = 658 * MiB;
constexpr size_t WS_MO = 722 * MiB;
constexpr size_t WS_Y2 = 786 * MiB;
constexpr size_t WS_PARTA = 850 * MiB;
constexpr size_t WS_LOGITS = 850 * MiB;
constexpr size_t WS_SS = 850 * MiB;
constexpr size_t WS_XB = 946 * MiB;
constexpr size_t WS_END = 1024 * MiB;

typedef unsigned short bf16;
__device__ __forceinline__ float bf2f(bf16 v) { return __uint_as_float(((unsigned)v) << 16); }
__device__ __forceinline__ bf16 f2bf(float f) { unsigned u = __float_as_uint(f); return (bf16)((u + 0x7fffu + ((u >> 16) & 1u)) >> 16); }

struct P {
    const float *x, *mem; const int* pos;
    const float *w_in, *w_out, *lq1, *lk1, *lq2, *lk2, *subln_g, *ln1_g, *ln1_b;
    const float *wq, *wkv, *wo, *ln2_g, *ln2_b, *w_router, *e_bias, *w_gate, *w_up, *w_down;
    const float *ws_gate, *ws_up, *ws_down, *ln3_g, *ln3_b;
    float* out; unsigned char* ws;
};

__host__ __device__ __forceinline__ int sigma_dim(int p) { return p < 16 ? (p >> 1) + 8 * (p & 1) : p; }
__device__ __forceinline__ int proj_src_col(int c) {
    const int seg = c >> 9;
    if (seg == 2 || seg == 5) return c;
    return (c & ~63) | sigma_dim(c & 63);
}

__global__ void prep_kernel(P p) {
    const int i = blockIdx.x * blockDim.x + threadIdx.x;
    if (i < T * 8) {
        const int t = i >> 3, j = i & 7;
        const float inv = powf(500000.0f, -(float)(2 * j) / 16.0f);
        const float ang = (float)p.pos[t] * inv;
        float2* cs = (float2*)(p.ws + WS_CS);
        cs[i] = make_float2(cosf(ang), sinf(ang));
    }
    if (i < 256) ((int*)(p.ws + WS_CNT))[i] = 0;
    if (i == 0) {
        float a = 0.f, b = 0.f;
        for (int k = 0; k < 64; ++k) { a += p.lq1[k] * p.lk1[k]; b += p.lq2[k] * p.lk2[k]; }
        ((float*)(p.ws + WS_SCAL))[0] = expf(a) - expf(b) + LAMBDA_INIT;
    }
}

template <class F> __global__ void __launch_bounds__(256) ngemm(F f) {
    __shared__ float As[16][65], Bs[16][65];
    const int g = blockIdx.z, M = f.rows(g);
    const int m0 = blockIdx.x * 64, n0 = blockIdx.y * 64;
    if (m0 >= M) return;
    const int K = f.kdim();
    const int tid = threadIdx.x, tx = tid & 15, ty = tid >> 4;
    float acc[4][4];
#pragma unroll
    for (int i = 0; i < 4; ++i)
#pragma unroll
        for (int j = 0; j < 4; ++j) acc[i][j] = 0.f;
    for (int k0 = 0; k0 < K; k0 += 16) {
#pragma unroll
        for (int i = 0; i < 4; ++i) {
            const int idx = tid + i * 256;
            { const int k = idx & 15, r = idx >> 4; As[k][r] = (m0 + r < M) ? f.a(g, m0 + r, k0 + k) : 0.f; }
            { const int c = idx & 63, k = idx >> 6; Bs[k][c] = f.b(g, k0 + k, n0 + c); }
        }
        __syncthreads();
#pragma unroll
        for (int k = 0; k < 16; ++k) {
            float av[4], bv[4];
#pragma unroll
            for (int i = 0; i < 4; ++i) { av[i] = As[k][ty * 4 + i]; bv[i] = Bs[k][tx * 4 + i]; }
#pragma unroll
            for (int i = 0; i < 4; ++i)
#pragma unroll
                for (int j = 0; j < 4; ++j) acc[i][j] += av[i] * bv[j];
        }
        __syncthreads();
    }
#pragma unroll
    for (int i = 0; i < 4; ++i) { const int r = m0 + ty * 4 + i; if (r < M) f.epi(g, r, n0 + tx * 4, acc[i]); }
}

struct FInProj {
    P p;
    __device__ int rows(int) const { return T; }
    __device__ int kdim() const { return DM; }
    __device__ float a(int, int r, int k) const { return bf2f(f2bf(p.x[(size_t)r * DM + k])); }
    __device__ float b(int, int k, int c) const { return bf2f(f2bf(p.w_in[(size_t)k * INW + proj_src_col(c)])); }
    __device__ void epi(int, int r, int c0, const float (&v)[4]) const {
        bf16* proj = (bf16*)(p.ws + WS_PROJ);
        const int seg = c0 >> 9; float o[4] = {v[0], v[1], v[2], v[3]};
        if (seg != 2 && seg != 5) {
            const int pp = c0 & 63;
            if (pp < 16) {
                const float2* cs = (const float2*)(p.ws + WS_CS) + (size_t)r * 8;
#pragma unroll
                for (int q = 0; q < 2; ++q) { const float2 c = cs[(pp >> 1) + q]; const float t1 = v[2 * q], t2 = v[2 * q + 1]; o[2 * q] = t1 * c.x - t2 * c.y; o[2 * q + 1] = t2 * c.x + t1 * c.y; }
            }
            if (seg == 0 || seg == 3) {
#pragma unroll
                for (int q = 0; q < 4; ++q) o[q] *= QSCALE64;
            }
        }
#pragma unroll
        for (int q = 0; q < 4; ++q) proj[(size_t)r * INW + c0 + q] = f2bf(o[q]);
    }
};
struct FOutProj {
    P p;
    __device__ int rows(int) const { return T; }
    __device__ int kdim() const { return DM; }
    __device__ float a(int, int r, int k) const { return bf2f(((const bf16*)(p.ws + WS_MIXIN))[(size_t)r * DM + k]); }
    __device__ float b(int, int k, int c) const { return bf2f(f2bf(p.w_out[(size_t)k * DM + c])); }
    __device__ void epi(int, int r, int c0, const float (&v)[4]) const {
        bf16* y = (bf16*)(p.ws + WS_Y1);
#pragma unroll
        for (int q = 0; q < 4; ++q) y[(size_t)r * DM + c0 + q] = f2bf(DN_ALPHA * p.x[(size_t)r * DM + c0 + q] + v[q]);
    }
};
struct FQMem {
    P p;
    __device__ int rows(int) const { return T; }
    __device__ int kdim() const { return DM; }
    __device__ float a(int, int r, int k) const { return bf2f(((const bf16*)(p.ws + WS_H1))[(size_t)r * DM + k]); }
    __device__ float b(int, int k, int c) const { return bf2f(f2bf(p.wq[(size_t)k * DM + c])); }
    __device__ void epi(int, int r, int c0, const float (&v)[4]) const {
        bf16* y = (bf16*)(p.ws + WS_QM);
#pragma unroll
        for (int q = 0; q < 4; ++q) y[(size_t)r * DM + c0 + q] = f2bf(v[q] * QSCALE256);
    }
};
struct FKV {
    P p;
    __device__ int rows(int) const { return BATCH * MEML; }
    __device__ int kdim() const { return DM; }
    __device__ float a(int, int r, int k) const { return bf2f(f2bf(p.mem[(size_t)r * DM + k])); }
    __device__ float b(int, int k, int c) const { return bf2f(f2bf(p.wkv[(size_t)k * 2048 + c])); }
    __device__ void epi(int, int r, int c0, const float (&v)[4]) const {
        bf16* y = (bf16*)(p.ws + WS_KVM);
#pragma unroll
        for (int q = 0; q < 4; ++q) y[(size_t)r * 2048 + c0 + q] = f2bf(v[q]);
    }
};
struct FMemS {
    P p;
    __device__ int rows(int) const { return T; }
    __device__ int kdim() const { return 256; }
    __device__ float a(int g, int r, int k) const { return bf2f(((const bf16*)(p.ws + WS_QM))[(size_t)r * DM + g * 256 + k]); }
    __device__ float b(int g, int k, int c) const { const int bb = (blockIdx.x * 64) / SEQ; return bf2f(((const bf16*)(p.ws + WS_KVM))[(size_t)(bb * MEML + c) * 2048 + g * 256 + k]); }
    __device__ void epi(int g, int r, int c0, const float (&v)[4]) const {
        float* s = (float*)(p.ws + WS_SS);
#pragma unroll
        for (int q = 0; q < 4; ++q) s[(size_t)r * DM + g * 256 + c0 + q] = v[q];
    }
};
struct FMemO {
    P p;
    __device__ int rows(int) const { return T; }
    __device__ int kdim() const { return 256; }
    __device__ float a(int g, int r, int k) const { return bf2f(f2bf(((const float*)(p.ws + WS_SS))[(size_t)r * DM + g * 256 + k])); }
    __device__ float b(int g, int k, int c) const { const int bb = (blockIdx.x * 64) / SEQ; return bf2f(((const bf16*)(p.ws + WS_KVM))[(size_t)(bb * MEML + k) * 2048 + 1024 + g * 256 + c]); }
    __device__ void epi(int g, int r, int c0, const float (&v)[4]) const {
        bf16* y = (bf16*)(p.ws + WS_MO);
#pragma unroll
        for (int q = 0; q < 4; ++q) y[(size_t)r * DM + g * 256 + c0 + q] = f2bf(v[q]);
    }
};
struct FWo {
    P p;
    __device__ int rows(int) const { return T; }
    __device__ int kdim() const { return DM; }
    __device__ float a(int, int r, int k) const { return bf2f(((const bf16*)(p.ws + WS_MO))[(size_t)r * DM + k]); }
    __device__ float b(int, int k, int c) const { return bf2f(f2bf(p.wo[(size_t)k * DM + c])); }
    __device__ void epi(int, int r, int c0, const float (&v)[4]) const {
        bf16* y = (bf16*)(p.ws + WS_Y2); const bf16* h1 = (const bf16*)(p.ws + WS_H1);
#pragma unroll
        for (int q = 0; q < 4; ++q) y[(size_t)r * DM + c0 + q] = f2bf(DN_ALPHA * bf2f(h1[(size_t)r * DM + c0 + q]) + v[q]);
    }
};
struct FRouter {
    P p;
    __device__ int rows(int) const { return T; }
    __device__ int kdim() const { return DM; }
    __device__ float a(int, int r, int k) const { return bf2f(((const bf16*)(p.ws + WS_H2))[(size_t)r * DM + k]); }
    __device__ float b(int, int k, int c) const { return bf2f(f2bf(p.w_router[(size_t)k * NEXP + c])); }
    __device__ void epi(int, int r, int c0, const float (&v)[4]) const {
        float* y = (float*)(p.ws + WS_LOGITS);
#pragma unroll
        for (int q = 0; q < 4; ++q) y[(size_t)r * NEXP + c0 + q] = v[q];
    }
};
struct FMoe1 {
    P p;
    __device__ int rows(int g) const { const int* st = (const int*)(p.ws + WS_START); return g < NEXP ? st[g + 1] - st[g] : T; }
    __device__ int kdim() const { return DM; }
    __device__ float a(int g, int r, int k) const {
        const int* st = (const int*)(p.ws + WS_START); const int* rt = (const int*)(p.ws + WS_ROWTOK);
        const int tok = g < NEXP ? rt[st[g] + r] : r;
        return bf2f(((const bf16*)(p.ws + WS_H2))[(size_t)tok * DM + k]);
    }
    __device__ float b(int g, int k, int c) const {
        const float* w = (c & 1) ? (g < NEXP ? p.w_up + (size_t)g * DM * EDIM : p.ws_up) : (g < NEXP ? p.w_gate + (size_t)g * DM * EDIM : p.ws_gate);
        return bf2f(f2bf(w[(size_t)k * EDIM + (c >> 1)]));
    }
    __device__ void epi(int g, int r, int c0, const float (&v)[4]) const {
        const int* st = (const int*)(p.ws + WS_START); bf16* H = (bf16*)(p.ws + WS_HB);
        const size_t row = g < NEXP ? (size_t)st[g] + r : (size_t)AROWS + r;
#pragma unroll
        for (int q = 0; q < 2; ++q) { const float gg = v[2 * q], uu = v[2 * q + 1]; H[row * EDIM + (c0 >> 1) + q] = f2bf(gg / (1.f + expf(-gg)) * uu); }
    }
};
struct FMoe2 {
    P p;
    __device__ int rows(int g) const { const int* st = (const int*)(p.ws + WS_START); return g < NEXP ? st[g + 1] - st[g] : T; }
    __device__ int kdim() const { return EDIM; }
    __device__ float a(int g, int r, int k) const {
        const int* st = (const int*)(p.ws + WS_START); const bf16* H = (const bf16*)(p.ws + WS_HB);
        const size_t row = g < NEXP ? (size_t)st[g] + r : (size_t)AROWS + r;
        return bf2f(H[row * EDIM + k]);
    }
    __device__ float b(int g, int k, int c) const { const float* w = g < NEXP ? p.w_down + (size_t)g * EDIM * DM : p.ws_down; return bf2f(f2bf(w[(size_t)k * DM + c])); }
    __device__ void epi(int g, int r, int c0, const float (&v)[4]) const {
        const int* st = (const int*)(p.ws + WS_START); bf16* Y = (bf16*)(p.ws + WS_Y);
        const size_t row = g < NEXP ? (size_t)st[g] + r : (size_t)AROWS + r;
        const float w = g < NEXP ? ((const float*)(p.ws + WS_ROWW))[row] : 1.f;
#pragma unroll
        for (int q = 0; q < 4; ++q) Y[row * DM + c0 + q] = f2bf(v[q] * w);
    }
};

__global__ void __launch_bounds__(256) nattnA(P p) {
    const int i = blockIdx.x * blockDim.x + threadIdx.x;
    if (i >= 3 * 8 * T) return;
    const int t = i % T, h = (i / T) & 7, br = i / (8 * T);
    const int dil = br == 0 ? 1 : (br == 1 ? 4 : 16);
    const int s = t % SEQ, b0 = t - s;
    const bf16* proj = (const bf16*)(p.ws + WS_PROJ);
    float q[64], o[64];
#pragma unroll
    for (int e = 0; e < 64; ++e) { q[e] = bf2f(proj[(size_t)t * INW + h * 64 + e]); o[e] = 0.f; }
    float m = -INFINITY, l = 0.f;
    for (int j = 0; j <= 128; ++j) {
        const int ks = s - j * dil; if (ks < 0) break;
        const bf16* kr = proj + (size_t)(b0 + ks) * INW + 512 + h * 64;
        const bf16* vr = proj + (size_t)(b0 + ks) * INW + 1024 + h * 64;
        float sc = 0.f;
#pragma unroll
        for (int e = 0; e < 64; ++e) sc += q[e] * bf2f(kr[e]);
        const float mn = fmaxf(m, sc), al = exp2f(m - mn), pe = exp2f(sc - mn);
        l = l * al + pe;
#pragma unroll
        for (int e = 0; e < 64; ++e) o[e] = o[e] * al + pe * bf2f(vr[e]);
        m = mn;
    }
    bf16* pa = (bf16*)(p.ws + WS_PARTA) + ((size_t)br * T + t) * 512 + h * 64;
    const float il = 1.f / l;
#pragma unroll
    for (int e = 0; e < 64; ++e) pa[e] = f2bf(o[e] * il);
    ((float*)(p.ws + WS_LSEA))[((size_t)br * T + t) * 8 + h] = m + log2f(l);
}
__global__ void mergeA(P p) {
    const int i = blockIdx.x * blockDim.x + threadIdx.x;
    if (i >= T * 512) return;
    const int t = i >> 9, c = i & 511, h = c >> 6;
    const float* lse = (const float*)(p.ws + WS_LSEA);
    const float l0 = lse[(size_t)t * 8 + h], l1 = lse[((size_t)T + t) * 8 + h], l2 = lse[((size_t)2 * T + t) * 8 + h];
    const float mx = fmaxf(l0, fmaxf(l1, l2));
    const float w0 = exp2f(l0 - mx), w1 = exp2f(l1 - mx), w2 = exp2f(l2 - mx), inv = 1.f / (w0 + w1 + w2);
    const bf16* pa = (const bf16*)(p.ws + WS_PARTA);
    const float v = (w0 * bf2f(pa[(size_t)t * 512 + c]) + w1 * bf2f(pa[((size_t)T + t) * 512 + c]) + w2 * bf2f(pa[((size_t)2 * T + t) * 512 + c])) * inv;
    ((bf16*)(p.ws + WS_MIXIN))[(size_t)t * DM + c] = f2bf(v);
}
__global__ void __launch_bounds__(256) nattnB(P p) {
    const int i = blockIdx.x * blockDim.x + threadIdx.x;
    if (i >= 16 * T) return;
    const int t = i % T, ch = (i / T) & 3, h = i / (4 * T);
    const int s = t % SEQ, b0 = t - s;
    const bf16* proj = (const bf16*)(p.ws + WS_PROJ);
    float q0[64], q1[64], o0[32], o1[32];
#pragma unroll
    for (int e = 0; e < 64; ++e) { q0[e] = bf2f(proj[(size_t)t * INW + 1536 + h * 128 + e]); q1[e] = bf2f(proj[(size_t)t * INW + 1536 + h * 128 + 64 + e]); }
#pragma unroll
    for (int e = 0; e < 32; ++e) { o0[e] = 0.f; o1[e] = 0.f; }
    float m0 = -INFINITY, l0 = 0.f, m1 = -INFINITY, l1 = 0.f;
    for (int ks = 0; ks <= s; ++ks) {
        const bf16* kr = proj + (size_t)(b0 + ks) * INW + 2048 + h * 128;
        const bf16* vr = proj + (size_t)(b0 + ks) * INW + 2560 + h * 128 + ch * 32;
        float s0 = 0.f, s1 = 0.f;
#pragma unroll
        for (int e = 0; e < 64; ++e) { s0 += q0[e] * bf2f(kr[e]); s1 += q1[e] * bf2f(kr[64 + e]); }
        const float mn0 = fmaxf(m0, s0), a0 = exp2f(m0 - mn0), p0 = exp2f(s0 - mn0);
        const float mn1 = fmaxf(m1, s1), a1 = exp2f(m1 - mn1), p1 = exp2f(s1 - mn1);
        l0 = l0 * a0 + p0; l1 = l1 * a1 + p1; m0 = mn0; m1 = mn1;
#pragma unroll
        for (int e = 0; e < 32; ++e) { const float v = bf2f(vr[e]); o0[e] = o0[e] * a0 + p0 * v; o1[e] = o1[e] * a1 + p1 * v; }
    }
    const float lam = ((const float*)(p.ws + WS_SCAL))[0];
    float* dd = (float*)(p.ws + WS_DD) + (size_t)t * 512 + h * 128 + ch * 32;
    const float i0 = 1.f / l0, i1 = 1.f / l1;
#pragma unroll
    for (int e = 0; e < 32; ++e) dd[e] = o0[e] * i0 - lam * o1[e] * i1;
}
__global__ void sublnB(P p) {
    const int w = (blockIdx.x * blockDim.x + threadIdx.x) >> 6, lane = threadIdx.x & 63;
    if (w >= T * 4) return;
    const int t = w >> 2, h = w & 3;
    const float* dd = (const float*)(p.ws + WS_DD) + (size_t)t * 512 + h * 128;
    const float a = dd[lane], b = dd[lane + 64];
    float ss = a * a + b * b;
    for (int o = 1; o < 64; o <<= 1) ss += __shfl_xor(ss, o);
    const float r = rsqrtf(ss * (1.f / 128.f) + SUBLN_EPS) * (1.f - LAMBDA_INIT);
    bf16* mx = (bf16*)(p.ws + WS_MIXIN) + (size_t)t * DM + 512 + h * 128;
    mx[lane] = f2bf(a * r * p.subln_g[lane]); mx[lane + 64] = f2bf(b * r * p.subln_g[lane + 64]);
}
__global__ void softmaxM(P p) {
    const int w = (blockIdx.x * blockDim.x + threadIdx.x) >> 6, lane = threadIdx.x & 63;
    if (w >= T * 4) return;
    float* s = (float*)(p.ws + WS_SS) + (size_t)w * 256;
    float v[4]; float mx = -INFINITY;
#pragma unroll
    for (int j = 0; j < 4; ++j) { v[j] = s[lane + 64 * j]; mx = fmaxf(mx, v[j]); }
    for (int o = 1; o < 64; o <<= 1) mx = fmaxf(mx, __shfl_xor(mx, o));
    float sum = 0.f;
#pragma unroll
    for (int j = 0; j < 4; ++j) { v[j] = exp2f(v[j] - mx); sum += v[j]; }
    for (int o = 1; o < 64; o <<= 1) sum += __shfl_xor(sum, o);
    const float inv = 1.f / sum;
#pragma unroll
    for (int j = 0; j < 4; ++j) s[lane + 64 * j] = v[j] * inv;
}

__global__ void __launch_bounds__(256) ln_pass(const bf16* __restrict__ in, bf16* __restrict__ outp, const float* __restrict__ g, const float* __restrict__ b) {
    const int w = (blockIdx.x * blockDim.x + threadIdx.x) >> 6, lane = threadIdx.x & 63;
    if (w >= T) return;
    const bf16* r = in + (size_t)w * DM;
    float v[16]; float s = 0.f;
#pragma unroll
    for (int j = 0; j < 4; ++j) { const uint2 u = *(const uint2*)(r + j * 256 + lane * 4);
        v[4 * j] = __uint_as_float(u.x << 16); v[4 * j + 1] = __uint_as_float(u.x & 0xffff0000u); v[4 * j + 2] = __uint_as_float(u.y << 16); v[4 * j + 3] = __uint_as_float(u.y & 0xffff0000u); }
#pragma unroll
    for (int j = 0; j < 16; ++j) s += v[j];
    for (int o = 1; o < 64; o <<= 1) s += __shfl_xor(s, o);
    const float mu = s * (1.f / DM); float q = 0.f;
#pragma unroll
    for (int j = 0; j < 16; ++j) { v[j] -= mu; q += v[j] * v[j]; }
    for (int o = 1; o < 64; o <<= 1) q += __shfl_xor(q, o);
    const float rs = rsqrtf(q * (1.f / DM) + LN_EPS);
#pragma unroll
    for (int j = 0; j < 4; ++j) { const int c = j * 256 + lane * 4; const float4 gg = *(const float4*)(g + c), bb = *(const float4*)(b + c);
        uint2 u; u.x = (unsigned)f2bf(v[4 * j] * rs * gg.x + bb.x) | ((unsigned)f2bf(v[4 * j + 1] * rs * gg.y + bb.y) << 16);
        u.y = (unsigned)f2bf(v[4 * j + 2] * rs * gg.z + bb.z) | ((unsigned)f2bf(v[4 * j + 3] * rs * gg.w + bb.w) << 16);
        *(uint2*)(outp + (size_t)w * DM + c) = u; }
}

__global__ void __launch_bounds__(256) route_pass(P p) {
    const int w = (blockIdx.x * blockDim.x + threadIdx.x) >> 6, lane = threadIdx.x & 63;
    if (w >= T) return;
    const float4 lg = *(const float4*)((const float*)(p.ws + WS_LOGITS) + (size_t)w * NEXP + lane * 4);
    const float4 eb = *(const float4*)(p.e_bias + lane * 4);
    float sc[4] = {1.f / (1.f + expf(-lg.x)), 1.f / (1.f + expf(-lg.y)), 1.f / (1.f + expf(-lg.z)), 1.f / (1.f + expf(-lg.w))};
    float bs[4] = {sc[0] + eb.x, sc[1] + eb.y, sc[2] + eb.z, sc[3] + eb.w};
    float m1 = fmaxf(bs[0], bs[1]), m2 = fminf(bs[0], bs[1]);
    { const float c = bs[2]; const float n1 = fmaxf(m1, c); m2 = fmaxf(m2, fminf(m1, c)); m1 = n1; }
    { const float c = bs[3]; const float n1 = fmaxf(m1, c); m2 = fmaxf(m2, fminf(m1, c)); m1 = n1; }
#pragma unroll
    for (int o = 1; o < 8; o <<= 1) { const float b1 = __shfl_xor(m1, o), b2 = __shfl_xor(m2, o); const float n1 = fmaxf(m1, b1); m2 = fmaxf(fminf(m1, b1), fmaxf(m2, b2)); m1 = n1; }
    const float gs = m1 + m2; const int grp = lane >> 3;
    int rank = 0;
#pragma unroll
    for (int g2 = 0; g2 < 8; ++g2) { const float o = __shfl(gs, g2 * 8); rank += (o > gs || (o == gs && g2 < grp)) ? 1 : 0; }
    const bool sel = rank < 4;
    float cand[4];
#pragma unroll
    for (int j = 0; j < 4; ++j) cand[j] = sel ? bs[j] : -INFINITY;
    int myidx = 0; float myw = 0.f; float wsum = 0.f;
    for (int k = 0; k < TOPK; ++k) {
        float bv = cand[0]; int bi = lane * 4;
#pragma unroll
        for (int j = 1; j < 4; ++j) if (cand[j] > bv) { bv = cand[j]; bi = lane * 4 + j; }
#pragma unroll
        for (int o = 1; o < 64; o <<= 1) { const float ov = __shfl_xor(bv, o); const int oi = __shfl_xor(bi, o); if (ov > bv || (ov == bv && oi < bi)) { bv = ov; bi = oi; } }
        const int own = bi >> 2, el = bi & 3;
        const float sv = el == 0 ? sc[0] : (el == 1 ? sc[1] : (el == 2 ? sc[2] : sc[3]));
        const float wv = __shfl(sv, own);
        if (lane == own) { if (el == 0) cand[0] = -INFINITY; else if (el == 1) cand[1] = -INFINITY; else if (el == 2) cand[2] = -INFINITY; else cand[3] = -INFINITY; }
        wsum += wv;
        if (lane == k) { myidx = bi; myw = wv; }
    }
    if (lane < TOPK) {
        const float wn = myw / wsum * ROUTED_SCALE;
        const int rk = atomicAdd((int*)(p.ws + WS_CNT) + myidx, 1);
        ((int*)(p.ws + WS_RIDX))[(size_t)w * 8 + lane] = myidx;
        ((float*)(p.ws + WS_RW))[(size_t)w * 8 + lane] = wn;
        ((int*)(p.ws + WS_RRANK))[(size_t)w * 8 + lane] = rk;
    }
}
__global__ void scan_pass(P p) {
    __shared__ int sh[256];
    const int i = threadIdx.x; const int c = ((const int*)(p.ws + WS_CNT))[i];
    sh[i] = c; __syncthreads();
    for (int o = 1; o < 256; o <<= 1) { const int v = i >= o ? sh[i - o] : 0; __syncthreads(); sh[i] += v; __syncthreads(); }
    int* st = (int*)(p.ws + WS_START);
    st[i + 1] = sh[i]; if (i == 0) st[0] = 0;
}
__global__ void scatter_pass(P p) {
    const int i = blockIdx.x * blockDim.x + threadIdx.x;
    if (i >= T * 8) return;
    const int e = ((const int*)(p.ws + WS_RIDX))[i], rk = ((const int*)(p.ws + WS_RRANK))[i];
    const int pos = ((const int*)(p.ws + WS_START))[e] + rk;
    ((int*)(p.ws + WS_ROWTOK))[pos] = i >> 3;
    ((float*)(p.ws + WS_ROWW))[pos] = ((const float*)(p.ws + WS_RW))[i];
    ((int*)(p.ws + WS_POS))[i] = pos;
}
__global__ void __launch_bounds__(256) combine_pass(P p) {
    const int w = (blockIdx.x * blockDim.x + threadIdx.x) >> 6, lane = threadIdx.x & 63;
    if (w >= T) return;
    const bf16* h2 = (const bf16*)(p.ws + WS_H2) + (size_t)w * DM;
    const bf16* Y = (const bf16*)(p.ws + WS_Y);
    const int* pos = (const int*)(p.ws + WS_POS) + (size_t)w * 8;
    float v[16];
#pragma unroll
    for (int j = 0; j < 4; ++j) { const uint2 u = *(const uint2*)(h2 + j * 256 + lane * 4);
        v[4 * j] = DN_ALPHA * __uint_as_float(u.x << 16); v[4 * j + 1] = DN_ALPHA * __uint_as_float(u.x & 0xffff0000u); v[4 * j + 2] = DN_ALPHA * __uint_as_float(u.y << 16); v[4 * j + 3] = DN_ALPHA * __uint_as_float(u.y & 0xffff0000u); }
#pragma unroll
    for (int k = 0; k < 9; ++k) {
        const size_t row = k < 8 ? (size_t)pos[k < 8 ? k : 0] : (size_t)AROWS + w;
        const bf16* yr = Y + row * DM;
#pragma unroll
        for (int j = 0; j < 4; ++j) { const uint2 u = *(const uint2*)(yr + j * 256 + lane * 4);
            v[4 * j] += __uint_as_float(u.x << 16); v[4 * j + 1] += __uint_as_float(u.x & 0xffff0000u); v[4 * j + 2] += __uint_as_float(u.y << 16); v[4 * j + 3] += __uint_as_float(u.y & 0xffff0000u); }
    }
    float s = 0.f;
#pragma unroll
    for (int j = 0; j < 16; ++j) s += v[j];
    for (int o = 1; o < 64; o <<= 1) s += __shfl_xor(s, o);
    const float mu = s * (1.f / DM); float q = 0.f;
#pragma unroll
    for (int j = 0; j < 16; ++j) { v[j] -= mu; q += v[j] * v[j]; }
    for (int o = 1; o < 64; o <<= 1) q += __shfl_xor(q, o);
    const float rs = rsqrtf(q * (1.f / DM) + LN_EPS);
#pragma unroll
    for (int j = 0; j < 4; ++j) { const int c = j * 256 + lane * 4; const float4 gg = *(const float4*)(p.ln3_g + c), bb = *(const float4*)(p.ln3_b + c);
        float4 o; o.x = v[4 * j] * rs * gg.x + bb.x; o.y = v[4 * j + 1] * rs * gg.y + bb.y; o.z = v[4 * j + 2] * rs * gg.z + bb.z; o.w = v[4 * j + 3] * rs * gg.w + bb.w;
        *(float4*)(p.out + (size_t)w * DM + c) = o; }
}

#define LAS __attribute__((address_space(3)))
typedef short bf16x8 __attribute__((ext_vector_type(8)));
typedef short s16x4 __attribute__((ext_vector_type(4)));
typedef float f32x2 __attribute__((ext_vector_type(2)));
typedef float f32x4 __attribute__((ext_vector_type(4)));
typedef float f32x16 __attribute__((ext_vector_type(16)));
typedef unsigned u32x2 __attribute__((ext_vector_type(2)));
typedef unsigned u32x4 __attribute__((ext_vector_type(4)));
typedef __bf16 bf16x2_t __attribute__((ext_vector_type(2)));

constexpr int NWAVES = 8, NTHR = 512;
constexpr int LDS_BYTES = 147456;

__device__ __forceinline__ unsigned cvtpk(float lo, float hi) { f32x2 v = {lo, hi}; bf16x2_t b = __builtin_convertvector(v, bf16x2_t); return __builtin_bit_cast(unsigned, b); }
__device__ __forceinline__ int ld_i32_agent(const int* p) { return __hip_atomic_load(p, __ATOMIC_RELAXED, __HIP_MEMORY_SCOPE_AGENT); }
__device__ __forceinline__ float fast_exp2(float x) { return __builtin_amdgcn_exp2f(x); }
__device__ __forceinline__ float fast_rcp(float x) { return __builtin_amdgcn_rcpf(x); }

namespace gm {
constexpr int BM = 256, BK = 64, HALF = 128, HTB = HALF * BK * 2, STAGE_BYTES = 8 * HTB, NXCD = 8, WGM = 8;
__device__ __forceinline__ int lds_byte(int r, int c) { const int st = (r >> 4) * 2 + (c >> 5), rr = r & 15, cc = c & 31, ob = rr * 64 + cc * 2; return st * 1024 + (ob ^ (((ob >> 9) & 1) << 5)); }
__device__ __forceinline__ void stage_rc(int b, int& R, int& C) { const int st = b / 1024, sb = b % 1024, swz = sb ^ (((sb >> 9) & 1) << 5); R = (st >> 1) * 16 + swz / 64; C = (st & 1) * 32 + (swz % 64) / 2; }
__device__ __forceinline__ int perm32(int rho) { const int n = rho >> 4, i = rho & 15; return 8 * (i >> 2) + 4 * n + (i & 3); }

struct Unit { int pm, pn, e, nvalid, rowbase; const char* bptr; };

struct DenseSched {
    static constexpr bool GATHER_A = false;
    int nM, nN, nwg, G, c, K; const char* Bt;
    __device__ void init(int M, int N, int K_, const void* Bt_, int G_, int c_) { nM = M / BM; nN = N / BM; nwg = nM * nN; G = G_; c = c_; K = K_; Bt = (const char*)Bt_; }
    __device__ bool next(int i, Unit& u) const {
        const long L = (long)i * G + c; if (L >= nwg) return false;
        int wgid = (int)L; { const int q = nwg / NXCD, r = nwg % NXCD, xcd = wgid % NXCD, off = wgid / NXCD; wgid = (xcd < r ? xcd * (q + 1) : r * (q + 1) + (xcd - r) * q) + off; }
        const int nig = WGM * nN, gid = wgid / nig, fm = gid * WGM, gsz = (nM - fm) < WGM ? (nM - fm) : WGM;
        u.pm = fm + ((wgid % nig) % gsz); u.pn = (wgid % nig) / gsz; u.e = 0; u.nvalid = 256; u.rowbase = u.pm * 256;
        u.bptr = Bt + (size_t)u.pn * 256 * K * 2; return true;
    }
    __device__ unsigned aoff(const Unit& u, int r) const { return (unsigned)(u.rowbase + r) * (unsigned)(K * 2); }
    __device__ size_t abase(const Unit& u) const { return (size_t)u.rowbase * (size_t)(K * 2); }
};
template <int NPN_LOG2, int KB  , bool GATHER> struct MoeSched {
    static constexpr bool GATHER_A = GATHER;
    const int* tab; int nunits, G, c; const char* Wt; size_t estride; const int* rowtok;
    __device__ bool next(int i, Unit& u) const {
        int uidx; if (G == 256) { uidx = ((i * 8 + (c & 7)) * 32) + (c >> 3); } else uidx = i * G + c;
        if (uidx >= nunits) return false;
        const int rt = uidx >> NPN_LOG2; u.pn = uidx & ((1 << NPN_LOG2) - 1);
        u.e = __builtin_amdgcn_readfirstlane(ld_i32_agent(tab + 4 * rt)); u.pm = __builtin_amdgcn_readfirstlane(ld_i32_agent(tab + 4 * rt + 1));
        u.rowbase = __builtin_amdgcn_readfirstlane(ld_i32_agent(tab + 4 * rt + 2)); u.nvalid = __builtin_amdgcn_readfirstlane(ld_i32_agent(tab + 4 * rt + 3));
        u.bptr = Wt + (size_t)u.e * estride + (size_t)u.pn * 256 * KB * 2; return true;
    }
    __device__ unsigned aoff(const Unit& u, int r) const {
        if (GATHER) { int tok; if (u.e < NEXP) { const int rr = r < u.nvalid ? r : u.nvalid - 1; tok = ld_i32_agent(rowtok + u.rowbase + rr); } else tok = u.rowbase - AROWS + r; return (unsigned)tok * (unsigned)(KB * 2); }
        return (unsigned)(u.rowbase + r) * (unsigned)(KB * 2);
    }
    __device__ size_t abase(const Unit& u) const { return (size_t)u.rowbase * (size_t)(KB * 2); }
};

typedef f32x4 Acc[2][2][4][2];
__device__ __forceinline__ u32x4 pack8(const f32x4 a, const f32x4 b) { u32x4 w; w.x = cvtpk(a[0], a[1]); w.y = cvtpk(a[2], a[3]); w.z = cvtpk(b[0], b[1]); w.w = cvtpk(b[2], b[3]); return w; }

struct EpiInProj {
    static constexpr bool PERM = true; bf16* proj; const float* cs;
    __device__ __forceinline__ void operator()(const Acc& acc, const Unit& u, int wr, int wc, int fr, int fq) const {
#pragma unroll
        for (int ai = 0; ai < 2; ++ai)
#pragma unroll
            for (int m = 0; m < 4; ++m) { const int row = u.pm * 256 + ai * 128 + wr * 64 + m * 16 + fr;
#pragma unroll
                for (int bj = 0; bj < 2; ++bj) { const int c0 = u.pn * 256 + bj * 128 + wc * 32 + 8 * fq; const int seg = c0 >> 9;
                    f32x4 v0 = acc[ai][bj][m][0], v1 = acc[ai][bj][m][1];
                    if (seg != 2 && seg != 5) {
                        if ((c0 & 63) < 16) { const int j0 = (c0 & 63) >> 1; const f32x4 ca = *(const f32x4*)(cs + (size_t)row * 16 + 2 * j0), cb = *(const f32x4*)(cs + (size_t)row * 16 + 2 * j0 + 4);
                            { const float t1 = v0[0], t2 = v0[1]; v0[0] = t1 * ca[0] - t2 * ca[1]; v0[1] = t2 * ca[0] + t1 * ca[1]; }
                            { const float t1 = v0[2], t2 = v0[3]; v0[2] = t1 * ca[2] - t2 * ca[3]; v0[3] = t2 * ca[2] + t1 * ca[3]; }
                            { const float t1 = v1[0], t2 = v1[1]; v1[0] = t1 * cb[0] - t2 * cb[1]; v1[1] = t2 * cb[0] + t1 * cb[1]; }
                            { const float t1 = v1[2], t2 = v1[3]; v1[2] = t1 * cb[2] - t2 * cb[3]; v1[3] = t2 * cb[2] + t1 * cb[3]; } }
                        if (seg == 0 || seg == 3) { v0 = v0 * QSCALE64; v1 = v1 * QSCALE64; }
                    }
                    *(u32x4*)(proj + (size_t)row * INW + c0) = pack8(v0, v1); } }
    }
};
struct EpiOutProj {
    static constexpr bool PERM = true; bf16* y; const float* x;
    __device__ __forceinline__ void operator()(const Acc& acc, const Unit& u, int wr, int wc, int fr, int fq) const {
#pragma unroll
        for (int ai = 0; ai < 2; ++ai)
#pragma unroll
            for (int m = 0; m < 4; ++m) { const int row = u.pm * 256 + ai * 128 + wr * 64 + m * 16 + fr;
#pragma unroll
                for (int bj = 0; bj < 2; ++bj) { const int c0 = u.pn * 256 + bj * 128 + wc * 32 + 8 * fq;
                    const f32x4 x0 = *(const f32x4*)(x + (size_t)row * DM + c0), x1 = *(const f32x4*)(x + (size_t)row * DM + c0 + 4);
                    *(u32x4*)(y + (size_t)row * DM + c0) = pack8(x0 * DN_ALPHA + acc[ai][bj][m][0], x1 * DN_ALPHA + acc[ai][bj][m][1]); } }
    }
};
struct EpiScale {
    static constexpr bool PERM = true; bf16* o; int ldc; float sc;
    __device__ __forceinline__ void operator()(const Acc& acc, const Unit& u, int wr, int wc, int fr, int fq) const {
#pragma unroll
        for (int ai = 0; ai < 2; ++ai)
#pragma unroll
            for (int m = 0; m < 4; ++m) { const int row = u.pm * 256 + ai * 128 + wr * 64 + m * 16 + fr;
#pragma unroll
                for (int bj = 0; bj < 2; ++bj) { const int c0 = u.pn * 256 + bj * 128 + wc * 32 + 8 * fq;
                    *(u32x4*)(o + (size_t)row * ldc + c0) = pack8(acc[ai][bj][m][0] * sc, acc[ai][bj][m][1] * sc); } }
    }
};
struct EpiWo {
    static constexpr bool PERM = true; bf16* y; const bf16* h1;
    __device__ __forceinline__ void operator()(const Acc& acc, const Unit& u, int wr, int wc, int fr, int fq) const {
#pragma unroll
        for (int ai = 0; ai < 2; ++ai)
#pragma unroll
            for (int m = 0; m < 4; ++m) { const int row = u.pm * 256 + ai * 128 + wr * 64 + m * 16 + fr;
#pragma unroll
                for (int bj = 0; bj < 2; ++bj) { const int c0 = u.pn * 256 + bj * 128 + wc * 32 + 8 * fq;
                    const u32x4 hv = *(const u32x4*)(h1 + (size_t)row * DM + c0);
                    f32x4 a, b; a[0] = __uint_as_float(hv.x << 16); a[1] = __uint_as_float(hv.x & 0xffff0000u); a[2] = __uint_as_float(hv.y << 16); a[3] = __uint_as_float(hv.y & 0xffff0000u);
                    b[0] = __uint_as_float(hv.z << 16); b[1] = __uint_as_float(hv.z & 0xffff0000u); b[2] = __uint_as_float(hv.w << 16); b[3] = __uint_as_float(hv.w & 0xffff0000u);
                    *(u32x4*)(y + (size_t)row * DM + c0) = pack8(a * DN_ALPHA + acc[ai][bj][m][0], b * DN_ALPHA + acc[ai][bj][m][1]); } }
    }
};
struct EpiF32 {
    static constexpr bool PERM = false; float* C; int ldc;
    __device__ __forceinline__ void operator()(const Acc& acc, const Unit& u, int wr, int wc, int fr, int fq) const {
#pragma unroll
        for (int ai = 0; ai < 2; ++ai)
#pragma unroll
            for (int m = 0; m < 4; ++m) { const int row = u.pm * 256 + ai * 128 + wr * 64 + m * 16 + fr;
#pragma unroll
                for (int bj = 0; bj < 2; ++bj)
#pragma unroll
                    for (int n = 0; n < 2; ++n) *(f32x4*)(C + (size_t)row * ldc + u.pn * 256 + bj * 128 + wc * 32 + n * 16 + 4 * fq) = acc[ai][bj][m][n]; }
    }
};
__device__ __forceinline__ float silu_mul(float g, float uu) { return g * fast_rcp(1.f + fast_exp2(-g * LOG2E)) * uu; }
struct EpiMoe1 {
    static constexpr bool PERM = true; bf16* H;
    __device__ __forceinline__ void operator()(const Acc& acc, const Unit& u, int wr, int wc, int fr, int fq) const {
#pragma unroll
        for (int ai = 0; ai < 2; ++ai)
#pragma unroll
            for (int m = 0; m < 4; ++m) { const int rl = ai * 128 + wr * 64 + m * 16 + fr;
                if (rl < u.nvalid) { const f32x4 g0 = acc[ai][0][m][0], g1 = acc[ai][0][m][1], u0 = acc[ai][1][m][0], u1 = acc[ai][1][m][1]; f32x4 h0, h1;
#pragma unroll
                    for (int q = 0; q < 4; ++q) { h0[q] = silu_mul(g0[q], u0[q]); h1[q] = silu_mul(g1[q], u1[q]); }
                    *(u32x4*)(H + (size_t)(u.rowbase + rl) * EDIM + u.pn * 128 + wc * 32 + 8 * fq) = pack8(h0, h1); } }
    }
};
struct EpiMoe2 {
    static constexpr bool PERM = true; bf16* Y; const float* roww;
    __device__ __forceinline__ void operator()(const Acc& acc, const Unit& u, int wr, int wc, int fr, int fq) const {
#pragma unroll
        for (int ai = 0; ai < 2; ++ai)
#pragma unroll
            for (int m = 0; m < 4; ++m) { const int rl = ai * 128 + wr * 64 + m * 16 + fr;
                if (rl < u.nvalid) { const size_t row = (size_t)(u.rowbase + rl); const float w = u.e < NEXP ? __hip_atomic_load(roww + row, __ATOMIC_RELAXED, __HIP_MEMORY_SCOPE_AGENT) : 1.f;
#pragma unroll
                    for (int bj = 0; bj < 2; ++bj) *(u32x4*)(Y + row * DM + u.pn * 256 + bj * 128 + wc * 32 + 8 * fq) = pack8(acc[ai][bj][m][0] * w, acc[ai][bj][m][1] * w); } }
    }
};

template <class Epi, class Sched>
__device__ __forceinline__ void gemm_phase(LAS unsigned char* lds, const char* Abase, const int K, const Sched& S, const Epi& E) {
    const int tid = threadIdx.x, wid = __builtin_amdgcn_readfirstlane(tid >> 6), lane = tid & 63, wr = wid >> 2, wc = wid & 3, fr = lane & 15, fq = lane >> 4;
    const int nt = K / BK;
    int Rr[2]; unsigned Cb[2], voffB[2];
#pragma unroll
    for (int i = 0; i < 2; ++i) { int R, C; stage_rc(tid * 16 + i * 8192, R, C); const int Rb = Epi::PERM ? ((R & ~31) + perm32(R & 31)) : R; Rr[i] = R; Cb[i] = (unsigned)C * 2u; voffB[i] = (unsigned)(Rb * K + C) * 2u; }
    const size_t kstep = (size_t)(BK * 2);
    const size_t hstep = (size_t)HALF * K * 2;
    const unsigned ldsw = (unsigned)wid * 1024u;
    const int aoff = lds_byte(wr * 64 + fr, fq * 8), boff = lds_byte(wc * 32 + fr, fq * 8);
#define G_SA(b, h) (((b) * 2 + (h)) * HTB)
#define G_SB(b, h) ((4 + (b) * 2 + (h)) * HTB)
#define G_STAGE(bufoff, gbase, voff) do { _Pragma("unroll") for (int _i = 0; _i < 2; ++_i) \
        __builtin_amdgcn_global_load_lds((const unsigned*)((const char*)(gbase) + (voff)[_i]), (LAS unsigned*)(lds + (bufoff) + ldsw + _i * 8192), 16, 0, 0); } while (0)
#define G_LDA(dst, b, h) do { _Pragma("unroll") for (int m = 0; m < 4; ++m) _Pragma("unroll") for (int k = 0; k < 2; ++k) dst[m][k] = *(const LAS bf16x8*)(lds + G_SA(b, h) + aoff + m * 2048 + k * 1024); } while (0)
#define G_LDB(dst, b, h) do { _Pragma("unroll") for (int n = 0; n < 2; ++n) _Pragma("unroll") for (int k = 0; k < 2; ++k) dst[n][k] = *(const LAS bf16x8*)(lds + G_SB(b, h) + boff + n * 2048 + k * 1024); } while (0)
#define G_MMA(ai, bj, At, Bt) do { __builtin_amdgcn_s_setprio(1); _Pragma("unroll") for (int m = 0; m < 4; ++m) _Pragma("unroll") for (int n = 0; n < 2; ++n) _Pragma("unroll") for (int k = 0; k < 2; ++k) \
        acc[ai][bj][m][n] = __builtin_amdgcn_mfma_f32_16x16x32_bf16(Bt[n][k], At[m][k], acc[ai][bj][m][n], 0, 0, 0); __builtin_amdgcn_s_setprio(0); } while (0)
#define G_WAIT_V(n) asm volatile("s_waitcnt vmcnt(" #n ")" ::: "memory")
#define G_WAIT_L(n) asm volatile("s_waitcnt lgkmcnt(" #n ")" ::: "memory")
#define G_BAR __builtin_amdgcn_s_barrier()
#define G_SCHED __builtin_amdgcn_sched_barrier(0)
    Unit cur, nxt; int ui = 0;
    if (!S.next(0, cur)) return;
    Acc acc;
#pragma unroll
    for (int a = 0; a < 2; ++a)
#pragma unroll
        for (int b = 0; b < 2; ++b)
#pragma unroll
            for (int m = 0; m < 4; ++m)
#pragma unroll
                for (int n = 0; n < 2; ++n) acc[a][b][m][n] = (f32x4){0.f, 0.f, 0.f, 0.f};
    bf16x8 At[4][2], B0[2][2], B1[2][2];
    constexpr bool GA = Sched::GATHER_A;
    unsigned vAc0[2], vAc1[2], vAn0[2], vAn1[2];
    const char* cA = Abase; const char* nA = Abase;
#pragma unroll
    for (int i = 0; i < 2; ++i) {
        if constexpr (GA) { vAc0[i] = S.aoff(cur, Rr[i]) + Cb[i]; vAc1[i] = S.aoff(cur, 128 + Rr[i]) + Cb[i]; }
        else { vAc0[i] = (unsigned)Rr[i] * (unsigned)(K * 2) + Cb[i]; vAc1[i] = (unsigned)(128 + Rr[i]) * (unsigned)(K * 2) + Cb[i]; vAn0[i] = vAc0[i]; vAn1[i] = vAc1[i]; }
    }
    if constexpr (!GA) cA = Abase + S.abase(cur);
    const char* cB = cur.bptr;
    G_STAGE(G_SB(0, 0), cB, voffB); G_STAGE(G_SB(0, 1), cB + hstep, voffB); G_STAGE(G_SA(0, 0), cA, vAc0); G_STAGE(G_SA(0, 1), cA, vAc1);
    if (wr == 1) G_BAR;
    G_WAIT_V(2); G_BAR;
    G_STAGE(G_SB(1, 0), cB + kstep, voffB); G_STAGE(G_SA(1, 0), cA + kstep, vAc0); G_STAGE(G_SB(1, 1), cB + hstep + kstep, voffB);
    G_WAIT_V(6); G_BAR;
    for (;;) {
        const bool has_next = S.next(ui + 1, nxt);
        const char* nB = has_next ? nxt.bptr : cB;
        if constexpr (GA) {
#pragma unroll
            for (int i = 0; i < 2; ++i) { vAn0[i] = has_next ? S.aoff(nxt, Rr[i]) + Cb[i] : vAc0[i]; vAn1[i] = has_next ? S.aoff(nxt, 128 + Rr[i]) + Cb[i] : vAc1[i]; }
        } else { nA = has_next ? Abase + S.abase(nxt) : cA; }
#pragma unroll 1
        for (int t = 0; t < nt; t += 2) {
            const bool last = (t == nt - 2);
            const char* a1 = cA + (size_t)(t + 1) * kstep;
            const char* a2 = last ? nA : cA + (size_t)(t + 2) * kstep; const char* b2 = last ? nB : cB + (size_t)(t + 2) * kstep;
            const char* a3 = a2 + kstep; const char* b3 = b2 + kstep;
            unsigned v20[2], v21[2];
#pragma unroll
            for (int i = 0; i < 2; ++i) { if constexpr (GA) { v20[i] = last ? vAn0[i] : vAc0[i]; v21[i] = last ? vAn1[i] : vAc1[i]; } else { v20[i] = vAc0[i]; v21[i] = vAc1[i]; } }
            G_LDB(B0, 0, 0); G_LDB(B1, 0, 1); G_SCHED; G_LDA(At, 0, 0); G_STAGE(G_SA(1, 1), a1, vAc1);
            G_WAIT_V(8); G_WAIT_L(0); G_BAR; G_MMA(0, 0, At, B0); G_MMA(0, 1, At, B1); G_BAR; G_SCHED;
            G_LDA(At, 0, 1); G_STAGE(G_SB(0, 0), b2, voffB); G_STAGE(G_SB(0, 1), b2 + hstep, voffB); G_STAGE(G_SA(0, 0), a2, v20);
            G_WAIT_V(8); G_WAIT_L(0); G_BAR; G_MMA(1, 0, At, B0); G_MMA(1, 1, At, B1); G_BAR; G_SCHED;
            G_LDB(B0, 1, 0); G_LDB(B1, 1, 1); G_SCHED; G_LDA(At, 1, 0); G_STAGE(G_SA(0, 1), a2, v21);
            G_WAIT_V(8); G_WAIT_L(0); G_BAR; G_MMA(0, 0, At, B0); G_MMA(0, 1, At, B1); G_BAR; G_SCHED;
            G_LDA(At, 1, 1); G_STAGE(G_SB(1, 0), b3, voffB); G_STAGE(G_SB(1, 1), b3 + hstep, voffB); G_STAGE(G_SA(1, 0), a3, v20);
            G_WAIT_V(8); G_WAIT_L(0); G_BAR; G_MMA(1, 0, At, B0); G_MMA(1, 1, At, B1); G_BAR; G_SCHED;
        }
        if (wr == 0) G_BAR;
        E(acc, cur, wr, wc, fr, fq);
        if (!has_next) break;
#pragma unroll
        for (int a = 0; a < 2; ++a)
#pragma unroll
            for (int b = 0; b < 2; ++b)
#pragma unroll
                for (int m = 0; m < 4; ++m)
#pragma unroll
                    for (int n = 0; n < 2; ++n) acc[a][b][m][n] = (f32x4){0.f, 0.f, 0.f, 0.f};
        cur = nxt; cB = nB; ++ui;
        if constexpr (GA) {
#pragma unroll
            for (int i = 0; i < 2; ++i) { vAc0[i] = vAn0[i]; vAc1[i] = vAn1[i]; }
        } else cA = nA;
        if (wr == 1) G_BAR;
    }
    G_WAIT_V(0);
    G_BAR;
#undef G_SA
#undef G_SB
#undef G_STAGE
#undef G_LDA
#undef G_LDB
#undef G_MMA
#undef G_WAIT_V
#undef G_WAIT_L
#undef G_BAR
#undef G_SCHED
}
}

namespace fa {
__device__ __forceinline__ int crow(int r, int hi) { return (r & 3) + 8 * (r >> 2) + 4 * hi; }
typedef short v4i16_t __attribute__((ext_vector_type(4)));
__device__ __forceinline__ s16x4 vtr(const LAS char* p) { return __builtin_bit_cast(s16x4, __builtin_amdgcn_ds_read_tr16_b64_v4i16((LAS v4i16_t*)p)); }
__device__ __forceinline__ float halfmax(float m) { auto rr = __builtin_amdgcn_permlane32_swap(__float_as_uint(m), __float_as_uint(m), false, false); return fmaxf(__uint_as_float(rr[0]), __uint_as_float(rr[1])); }
__device__ __forceinline__ float halfsum(float m) { auto rr = __builtin_amdgcn_permlane32_swap(__float_as_uint(m), __float_as_uint(m), false, false); return __uint_as_float(rr[0]) + __uint_as_float(rr[1]); }

template <int NQ, int KSTR> __device__ __forceinline__ f32x16 qk(const LAS char* Kl, int j, const bf16x8 (&qf)[NQ], int lane) {
    f32x16 s = {0.f, 0.f, 0.f, 0.f, 0.f, 0.f, 0.f, 0.f, 0.f, 0.f, 0.f, 0.f, 0.f, 0.f, 0.f, 0.f};
    const LAS char* kp = Kl + (32 * j + (lane & 31)) * KSTR + (lane >> 5) * 16;
#pragma unroll
    for (int ds = 0; ds < NQ; ++ds) { const bf16x8 kf = *(const LAS bf16x8*)(kp + ds * 32); s = __builtin_amdgcn_mfma_f32_32x32x16_bf16(kf, qf[ds], s, 0, 0, 0); }
    return s;
}
template <int NO> __device__ __forceinline__ void softmax_step(f32x16& p0, f32x16& p1, float& m, float& l, f32x16 (&o)[NO], bf16x8 (&pf)[4]) {
    float mx = fmaxf(p0[0], p1[0]);
#pragma unroll
    for (int r = 1; r < 16; ++r) mx = fmaxf(mx, fmaxf(p0[r], p1[r]));
    mx = halfmax(mx);
    const float mn = fmaxf(m, mx), mu = (mn == -INFINITY) ? 0.f : mn;
    const float al = fast_exp2(m - mu);
    float sum = 0.f;
#pragma unroll
    for (int r = 0; r < 16; ++r) { p0[r] = fast_exp2(p0[r] - mu); p1[r] = fast_exp2(p1[r] - mu); sum += p0[r] + p1[r]; }
    l = l * al + sum; m = mn;
#pragma unroll
    for (int d = 0; d < NO; ++d)
#pragma unroll
        for (int r = 0; r < 16; ++r) o[d][r] *= al;
#pragma unroll
    for (int s = 0; s < 2; ++s) {
        u32x4 a, b;
        a.x = cvtpk(p0[8 * s], p0[8 * s + 1]); a.y = cvtpk(p0[8 * s + 2], p0[8 * s + 3]); a.z = cvtpk(p0[8 * s + 4], p0[8 * s + 5]); a.w = cvtpk(p0[8 * s + 6], p0[8 * s + 7]);
        b.x = cvtpk(p1[8 * s], p1[8 * s + 1]); b.y = cvtpk(p1[8 * s + 2], p1[8 * s + 3]); b.z = cvtpk(p1[8 * s + 4], p1[8 * s + 5]); b.w = cvtpk(p1[8 * s + 6], p1[8 * s + 7]);
        pf[s] = __builtin_bit_cast(bf16x8, a); pf[2 + s] = __builtin_bit_cast(bf16x8, b);
    }
}
template <int NO, int VSTR> __device__ __forceinline__ void pv(f32x16 (&o)[NO], const LAS char* Vl, const bf16x8 (&pf)[4], int lane) {
    const LAS char* vb = Vl + (4 * (lane >> 5) + ((lane & 15) >> 2)) * VSTR + (16 * ((lane >> 4) & 1) + 4 * (lane & 3)) * 2;
#pragma unroll
    for (int d = 0; d < NO; ++d)
#pragma unroll
        for (int ks = 0; ks < 4; ++ks) {
            const s16x4 lo = vtr(vb + (16 * ks) * VSTR + d * 64), hi = vtr(vb + (16 * ks + 8) * VSTR + d * 64);
            const bf16x8 vf = (bf16x8){lo[0], lo[1], lo[2], lo[3], hi[0], hi[1], hi[2], hi[3]};
            o[d] = __builtin_amdgcn_mfma_f32_32x32x16_bf16(vf, pf[ks], o[d], 0, 0, 0);
        }
}
template <int NO> __device__ __forceinline__ void store_o(const f32x16 (&o)[NO], float inv, bf16* rowp, int hi) {
#pragma unroll
    for (int d = 0; d < NO; ++d)
#pragma unroll
        for (int g = 0; g < 4; ++g) { u32x2 w; w.x = cvtpk(o[d][4 * g] * inv, o[d][4 * g + 1] * inv); w.y = cvtpk(o[d][4 * g + 2] * inv, o[d][4 * g + 3] * inv);
            *(u32x2*)(rowp + 32 * d + 8 * g + 4 * hi) = w; }
}
}

__device__ __forceinline__ void diff_unit(const P& p, int b, int h, int qb, LAS unsigned char* ldsu, float lam) {
    constexpr int KSTR = 144, VSTR = 320, KB = 64 * KSTR, VB = 64 * VSTR, BUF = 2 * KB + VB;
    LAS char* lds = (LAS char*)ldsu;
    const int tid = threadIdx.x, lane = tid & 63, wid = __builtin_amdgcn_readfirstlane(tid >> 6), hi = lane >> 5;
    const int comp = wid >> 2, w4 = wid & 3;
    const bf16* proj = (const bf16*)(p.ws + WS_PROJ);
    const size_t rb = (size_t)b * SEQ;
    const int q0 = qb * 128, qmin = q0 + 32 * w4, qpos = qmin + (lane & 31);
    bf16x8 qf[4];
#pragma unroll
    for (int ds = 0; ds < 4; ++ds) qf[ds] = *(const bf16x8*)(proj + (rb + qpos) * INW + 1536 + h * 128 + comp * 64 + ds * 16 + hi * 8);
    const int ntiles = 2 * qb + 2;
    const int krow = tid >> 3, kch = tid & 7;
    const bf16* ksrc = proj + (rb + krow) * INW + 2048 + h * 128 + kch * 8;
    const int vrow0 = tid >> 4, vch = tid & 15;
    const bf16* vsrc = proj + (rb + vrow0) * INW + 2560 + h * 128 + vch * 8;
    const int kdst = krow * KSTR + kch * 16, vdst = 2 * KB + vrow0 * VSTR + vch * 16;
    u32x4 rk0, rk1, rv0, rv1;
    { rk0 = *(const u32x4*)(ksrc); rk1 = *(const u32x4*)(ksrc + 64); rv0 = *(const u32x4*)(vsrc); rv1 = *(const u32x4*)(vsrc + (size_t)32 * INW); }
    *(LAS u32x4*)(lds + kdst) = rk0; *(LAS u32x4*)(lds + KB + kdst) = rk1; *(LAS u32x4*)(lds + vdst) = rv0; *(LAS u32x4*)(lds + vdst + 32 * VSTR) = rv1;
    __syncthreads();
    float m = -INFINITY, l = 0.f; f32x16 o[4];
#pragma unroll
    for (int d = 0; d < 4; ++d)
#pragma unroll
        for (int r = 0; r < 16; ++r) o[d][r] = 0.f;
    for (int kt = 0; kt < ntiles; ++kt) {
        const bool more = kt + 1 < ntiles;
        if (more) { const size_t off = (size_t)(kt + 1) * 64 * INW; rk0 = *(const u32x4*)(ksrc + off); rk1 = *(const u32x4*)(ksrc + off + 64); rv0 = *(const u32x4*)(vsrc + off); rv1 = *(const u32x4*)(vsrc + off + (size_t)32 * INW); }
        const LAS char* buf = lds + (kt & 1) * BUF;
        const int k0 = kt * 64;
        if (k0 <= qmin + 31) {
            const LAS char* Kl = buf + comp * KB;
            f32x16 p0 = fa::qk<4, KSTR>(Kl, 0, qf, lane), p1 = fa::qk<4, KSTR>(Kl, 1, qf, lane);
            if (k0 + 63 > qmin) {
#pragma unroll
                for (int r = 0; r < 16; ++r) { const int key = k0 + fa::crow(r, hi); if (key > qpos) p0[r] = -INFINITY; if (key + 32 > qpos) p1[r] = -INFINITY; }
            }
            bf16x8 pf[4];
            fa::softmax_step<4>(p0, p1, m, l, o, pf);
            fa::pv<4, VSTR>(o, buf + 2 * KB, pf, lane);
        }
        if (more) { LAS char* nb = lds + ((kt + 1) & 1) * BUF; *(LAS u32x4*)(nb + kdst) = rk0; *(LAS u32x4*)(nb + KB + kdst) = rk1; *(LAS u32x4*)(nb + vdst) = rv0; *(LAS u32x4*)(nb + vdst + 32 * VSTR) = rv1; }
        __syncthreads();
    }
    l = fa::halfsum(l);
    const float inv = fast_rcp(l);
    LAS float* ex = (LAS float*)lds + w4 * 4096;
    if (comp == 1) {
#pragma unroll
        for (int d = 0; d < 4; ++d)
#pragma unroll
            for (int r = 0; r < 16; ++r) ex[(d * 16 + r) * 64 + lane] = o[d][r] * inv;
    }
    __syncthreads();
    if (comp == 0) {
        float ss = 0.f;
#pragma unroll
        for (int d = 0; d < 4; ++d)
#pragma unroll
            for (int r = 0; r < 16; ++r) { const float v = o[d][r] * inv - lam * ex[(d * 16 + r) * 64 + lane]; o[d][r] = v; ss += v * v; }
        ss = fa::halfsum(ss);
        const float rs = rsqrtf(ss * (1.f / 128.f) + SUBLN_EPS) * (1.f - LAMBDA_INIT);
        bf16* rowp = (bf16*)(p.ws + WS_MIXIN) + (rb + qpos) * DM + 512 + h * 128;
#pragma unroll
        for (int d = 0; d < 4; ++d)
#pragma unroll
            for (int g = 0; g < 4; ++g) { const int dd = 32 * d + 8 * g + 4 * hi; const f32x4 gg = *(const f32x4*)(p.subln_g + dd);
                u32x2 w; w.x = cvtpk(o[d][4 * g] * rs * gg[0], o[d][4 * g + 1] * rs * gg[1]); w.y = cvtpk(o[d][4 * g + 2] * rs * gg[2], o[d][4 * g + 3] * rs * gg[3]);
                *(u32x2*)(rowp + dd) = w; }
    }
    __syncthreads();
}

__device__ __forceinline__ void dil_unit(const P& p, int b, int h, int br, int grp, LAS unsigned char* ldsu) {
    constexpr int KSTR = 144, VSTR = 192, KALL = 384 * KSTR;
    LAS char* lds = (LAS char*)ldsu;
    const int tid = threadIdx.x, lane = tid & 63, wid = __builtin_amdgcn_readfirstlane(tid >> 6), hi = lane >> 5;
    const int dil = br == 0 ? 1 : (br == 1 ? 4 : 16), ngr = 16 / dil, res = grp / ngr, i0 = 256 * (grp % ngr);
    const bf16* proj = (const bf16*)(p.ws + WS_PROJ);
    const size_t rb = (size_t)b * SEQ;
#pragma unroll
    for (int i = 0; i < 6; ++i) { const int pidx = tid + 512 * i, row = pidx >> 3, ch = pidx & 7; int kidx = i0 - 128 + row; if (kidx < 0) kidx = 0;
        const bf16* src = proj + (rb + (size_t)kidx * dil + res) * INW + h * 64 + ch * 8;
        const u32x4 kv = *(const u32x4*)(src + 512), vv = *(const u32x4*)(src + 1024);
        *(LAS u32x4*)(lds + row * KSTR + ch * 16) = kv; *(LAS u32x4*)(lds + KALL + row * VSTR + ch * 16) = vv; }
    const int qi = i0 + 32 * wid + (lane & 31);
    const size_t qrow = rb + (size_t)qi * dil + res;
    bf16x8 qf[4];
#pragma unroll
    for (int ds = 0; ds < 4; ++ds) qf[ds] = *(const bf16x8*)(proj + qrow * INW + h * 64 + ds * 16 + hi * 8);
    __syncthreads();
    float m = -INFINITY, l = 0.f; f32x16 o[2];
#pragma unroll
    for (int d = 0; d < 2; ++d)
#pragma unroll
        for (int r = 0; r < 16; ++r) o[d][r] = 0.f;
#pragma unroll 1
    for (int kk = 0; kk < 3; ++kk) {
        const int kt = (wid >> 1) + kk;
        const LAS char* Kl = lds + kt * 64 * KSTR;
        f32x16 p0 = fa::qk<4, KSTR>(Kl, 0, qf, lane), p1 = fa::qk<4, KSTR>(Kl, 1, qf, lane);
        const int kb = i0 - 128 + 64 * kt;
#pragma unroll
        for (int r = 0; r < 16; ++r) { const int k0i = kb + fa::crow(r, hi), k1i = k0i + 32;
            if (k0i < 0 || k0i > qi || qi - k0i > 128) p0[r] = -INFINITY;
            if (k1i < 0 || k1i > qi || qi - k1i > 128) p1[r] = -INFINITY; }
        bf16x8 pf[4];
        fa::softmax_step<2>(p0, p1, m, l, o, pf);
        fa::pv<2, VSTR>(o, lds + KALL + kt * 64 * VSTR, pf, lane);
    }
    l = fa::halfsum(l);
    const float inv = fast_rcp(l);
    fa::store_o<2>(o, inv, (bf16*)(p.ws + WS_PARTA) + ((size_t)br * T + qrow) * 512 + h * 64, hi);
    if (hi == 0) ((float*)(p.ws + WS_LSEA))[((size_t)br * T + qrow) * 8 + h] = m + log2f(l);
    __syncthreads();
}

__device__ __forceinline__ void mem_unit(const P& p, int b, int h, int qblk, LAS unsigned char* ldsu) {
    constexpr int KSTR = 528, VSTR = 192, KB = 64 * KSTR, VB = 64 * VSTR, BUF = KB + VB;
    LAS char* lds = (LAS char*)ldsu;
    const int tid = threadIdx.x, lane = tid & 63, wid = __builtin_amdgcn_readfirstlane(tid >> 6), hi = lane >> 5;
    const bf16* qm = (const bf16*)(p.ws + WS_QM); const bf16* kvm = (const bf16*)(p.ws + WS_KVM);
    const size_t qrow = (size_t)b * SEQ + qblk * 256 + 32 * wid + (lane & 31);
    bf16x8 qf[16];
#pragma unroll
    for (int ds = 0; ds < 16; ++ds) qf[ds] = *(const bf16x8*)(qm + qrow * DM + h * 256 + ds * 16 + hi * 8);
    const bf16* kbase = kvm + (size_t)(b * MEML) * 2048 + h * 256;
#pragma unroll 1
    for (int quarter = 0; quarter < 4; ++quarter) {
        const bf16* vbase = kvm + (size_t)(b * MEML) * 2048 + 1024 + h * 256 + quarter * 64;
        u32x4 rk[4], rv;
#define MEM_LOAD(kt) do { _Pragma("unroll") for (int i = 0; i < 4; ++i) { const int pidx = tid + 512 * i, row = pidx >> 5, ch = pidx & 31; rk[i] = *(const u32x4*)(kbase + (size_t)((kt) * 64 + row) * 2048 + ch * 8); } \
        { const int row = tid >> 3, ch = tid & 7; rv = *(const u32x4*)(vbase + (size_t)((kt) * 64 + row) * 2048 + ch * 8); } } while (0)
#define MEM_WRITE(bufp) do { _Pragma("unroll") for (int i = 0; i < 4; ++i) { const int pidx = tid + 512 * i, row = pidx >> 5, ch = pidx & 31; *(LAS u32x4*)((bufp) + row * KSTR + ch * 16) = rk[i]; } \
        { const int row = tid >> 3, ch = tid & 7; *(LAS u32x4*)((bufp) + KB + row * VSTR + ch * 16) = rv; } } while (0)
        MEM_LOAD(0); MEM_WRITE(lds);
        __syncthreads();
        float m = -INFINITY, l = 0.f; f32x16 o[2];
#pragma unroll
        for (int d = 0; d < 2; ++d)
#pragma unroll
            for (int r = 0; r < 16; ++r) o[d][r] = 0.f;
#pragma unroll 1
        for (int kt = 0; kt < 4; ++kt) {
            const bool more = kt < 3;
            if (more) MEM_LOAD(kt + 1);
            const LAS char* buf = lds + (kt & 1) * BUF;
            f32x16 p0 = fa::qk<16, KSTR>(buf, 0, qf, lane), p1 = fa::qk<16, KSTR>(buf, 1, qf, lane);
            bf16x8 pf[4];
            fa::softmax_step<2>(p0, p1, m, l, o, pf);
            fa::pv<2, VSTR>(o, buf + KB, pf, lane);
            if (more) { LAS char* nb = lds + ((kt + 1) & 1) * BUF; MEM_WRITE(nb); }
            __syncthreads();
        }
#undef MEM_LOAD
#undef MEM_WRITE
        l = fa::halfsum(l);
        fa::store_o<2>(o, fast_rcp(l), (bf16*)(p.ws + WS_MO) + qrow * DM + h * 256 + quarter * 64, hi);
    }
}

struct Ctx { int tid, lane, wave, G, vcu, gw, ngw; LAS unsigned char* lds; };

template <class RowMap> __device__ __forceinline__ void transpose_tile(const float* W, int N, int k0, int n0, bf16* dst, int dstK, LAS float* scr, int lane, const RowMap& rm) {
    f32x4 v[16];
#pragma unroll
    for (int i = 0; i < 16; ++i) v[i] = *(const f32x4*)(W + (size_t)(k0 + 4 * i + (lane >> 4)) * N + n0 + (lane & 15) * 4);
#pragma unroll
    for (int i = 0; i < 16; ++i) { LAS float* s = scr + (4 * i + (lane >> 4)) * 65 + (lane & 15) * 4; s[0] = v[i][0]; s[1] = v[i][1]; s[2] = v[i][2]; s[3] = v[i][3]; }
    asm volatile("s_waitcnt lgkmcnt(0)" ::: "memory");
    const int c = lane & 7;
#pragma unroll
    for (int j = 0; j < 8; ++j) { const int n = (lane >> 3) + 8 * j; const LAS float* s = scr + (8 * c) * 65 + n;
        u32x4 w; w.x = cvtpk(s[0], s[65]); w.y = cvtpk(s[2 * 65], s[3 * 65]); w.z = cvtpk(s[4 * 65], s[5 * 65]); w.w = cvtpk(s[6 * 65], s[7 * 65]);
        *(u32x4*)(dst + (size_t)rm(n0 + n) * dstK + k0 + 8 * c) = w; }
    asm volatile("s_waitcnt lgkmcnt(0)" ::: "memory");
}
struct RmId { __device__ int operator()(int n) const { return n; } };
struct RmInProj { __device__ int operator()(int n) const { const int seg = n >> 9; if (seg == 2 || seg == 5) return n; const int d = n & 63; return (n & ~63) | (d < 16 ? 2 * (d & 7) + (d >> 3) : d); } };
struct RmGU { int up; __device__ int operator()(int n) const { return (n >> 7) * 256 + up * 128 + (n & 127); } };

__device__ __forceinline__ void phase_prologue(const P& p, const Ctx& c) {
    LAS float* scr = (LAS float*)(c.lds + c.wave * 16640);
    unsigned char* ws = p.ws;
    constexpr int I_IN = 16 * 48, I_SQ = 16 * 16, I_KV = 16 * 32, I_R = 16 * 4, I_E = 64;
    constexpr int ND = I_IN + 3 * I_SQ + I_KV + I_R;
    const int NIT = ND + 3 * I_E * (NEXP + 1);
    for (int it = c.gw; it < NIT; it += c.ngw) {
        int r = it;
        if (r < I_IN) { transpose_tile(p.w_in, INW, (r / 48) * 64, (r % 48) * 64, (bf16*)(ws + WS_WINT), DM, scr, c.lane, RmInProj{}); continue; } r -= I_IN;
        if (r < I_SQ) { transpose_tile(p.w_out, DM, (r / 16) * 64, (r % 16) * 64, (bf16*)(ws + WS_WOUTT), DM, scr, c.lane, RmId{}); continue; } r -= I_SQ;
        if (r < I_SQ) { transpose_tile(p.wq, DM, (r / 16) * 64, (r % 16) * 64, (bf16*)(ws + WS_WQT), DM, scr, c.lane, RmId{}); continue; } r -= I_SQ;
        if (r < I_KV) { transpose_tile(p.wkv, 2048, (r / 32) * 64, (r % 32) * 64, (bf16*)(ws + WS_WKVT), DM, scr, c.lane, RmId{}); continue; } r -= I_KV;
        if (r < I_SQ) { transpose_tile(p.wo, DM, (r / 16) * 64, (r % 16) * 64, (bf16*)(ws + WS_WOT), DM, scr, c.lane, RmId{}); continue; } r -= I_SQ;
        if (r < I_R) { transpose_tile(p.w_router, NEXP, (r / 4) * 64, (r % 4) * 64, (bf16*)(ws + WS_WRT), DM, scr, c.lane, RmId{}); continue; } r -= I_R;
        const int e = r / (3 * I_E), q = r % (3 * I_E), which = q / I_E, ti = q % I_E;
        if (which == 0) { const float* W = e < NEXP ? p.w_gate + (size_t)e * DM * EDIM : p.ws_gate; transpose_tile(W, EDIM, (ti / 4) * 64, (ti % 4) * 64, (bf16*)(ws + WS_WTGU) + (size_t)e * 512 * DM, DM, scr, c.lane, RmGU{0}); }
        else if (which == 1) { const float* W = e < NEXP ? p.w_up + (size_t)e * DM * EDIM : p.ws_up; transpose_tile(W, EDIM, (ti / 4) * 64, (ti % 4) * 64, (bf16*)(ws + WS_WTGU) + (size_t)e * 512 * DM, DM, scr, c.lane, RmGU{1}); }
        else { const float* W = e < NEXP ? p.w_down + (size_t)e * EDIM * DM : p.ws_down; transpose_tile(W, DM, (ti / 16) * 64, (ti % 16) * 64, (bf16*)(ws + WS_WTD) + (size_t)e * DM * EDIM, EDIM, scr, c.lane, RmId{}); }
    }
    const int gt = c.vcu * NTHR + c.tid, ngt = c.G * NTHR;
    for (int i = gt; i < T * DM / 8; i += ngt) { const f32x4 a = *(const f32x4*)(p.x + (size_t)i * 8), b = *(const f32x4*)(p.x + (size_t)i * 8 + 4); *(u32x4*)((bf16*)(ws + WS_XB) + (size_t)i * 8) = gm::pack8(a, b); }
    for (int i = gt; i < BATCH * MEML * DM / 8; i += ngt) { const f32x4 a = *(const f32x4*)(p.mem + (size_t)i * 8), b = *(const f32x4*)(p.mem + (size_t)i * 8 + 4); *(u32x4*)((bf16*)(ws + WS_MEMB) + (size_t)i * 8) = gm::pack8(a, b); }
    for (int i = gt; i < T * 8; i += ngt) { const int t = i >> 3, j = i & 7; const float inv = powf(500000.0f, -(float)(2 * j) / 16.0f); const float ang = (float)p.pos[t] * inv;
        ((float2*)(ws + WS_CS))[i] = make_float2(cosf(ang), sinf(ang)); }
    if (gt < 256) ((int*)(ws + WS_CNT))[gt] = 0;
    if (gt == 0) { float a = 0.f, b = 0.f; for (int k = 0; k < 64; ++k) { a += p.lq1[k] * p.lk1[k]; b += p.lq2[k] * p.lk2[k]; } ((float*)(ws + WS_SCAL))[0] = expf(a) - expf(b) + LAMBDA_INIT; }
}

__device__ __forceinline__ void unpack8(const u32x4 u, float (&v)[8]) {
    v[0] = __uint_as_float(u.x << 16); v[1] = __uint_as_float(u.x & 0xffff0000u); v[2] = __uint_as_float(u.y << 16); v[3] = __uint_as_float(u.y & 0xffff0000u);
    v[4] = __uint_as_float(u.z << 16); v[5] = __uint_as_float(u.z & 0xffff0000u); v[6] = __uint_as_float(u.w << 16); v[7] = __uint_as_float(u.w & 0xffff0000u);
}
__device__ __forceinline__ void phase_merge(const P& p, const Ctx& c) {
    const int gt = c.vcu * NTHR + c.tid, ngt = c.G * NTHR;
    const float* lse = (const float*)(p.ws + WS_LSEA); const bf16* pa = (const bf16*)(p.ws + WS_PARTA); bf16* mx = (bf16*)(p.ws + WS_MIXIN);
    for (int i = gt; i < T * 64; i += ngt) {
        const int t = i >> 6, c8 = (i & 63) * 8, h = c8 >> 6;
        const float l0 = lse[(size_t)t * 8 + h], l1 = lse[((size_t)T + t) * 8 + h], l2 = lse[((size_t)2 * T + t) * 8 + h];
        const float mxl = fmaxf(l0, fmaxf(l1, l2));
        float w0 = fast_exp2(l0 - mxl), w1 = fast_exp2(l1 - mxl), w2 = fast_exp2(l2 - mxl); const float inv = 1.f / (w0 + w1 + w2); w0 *= inv; w1 *= inv; w2 *= inv;
        float a[8], b[8], d[8];
        unpack8(*(const u32x4*)(pa + (size_t)t * 512 + c8), a); unpack8(*(const u32x4*)(pa + ((size_t)T + t) * 512 + c8), b); unpack8(*(const u32x4*)(pa + ((size_t)2 * T + t) * 512 + c8), d);
        u32x4 o; o.x = cvtpk(w0 * a[0] + w1 * b[0] + w2 * d[0], w0 * a[1] + w1 * b[1] + w2 * d[1]); o.y = cvtpk(w0 * a[2] + w1 * b[2] + w2 * d[2], w0 * a[3] + w1 * b[3] + w2 * d[3]);
        o.z = cvtpk(w0 * a[4] + w1 * b[4] + w2 * d[4], w0 * a[5] + w1 * b[5] + w2 * d[5]); o.w = cvtpk(w0 * a[6] + w1 * b[6] + w2 * d[6], w0 * a[7] + w1 * b[7] + w2 * d[7]);
        *(u32x4*)(mx + (size_t)t * DM + c8) = o;
    }
}
__device__ __forceinline__ void phase_ln(const bf16* in, bf16* outp, const float* g, const float* bb_, const Ctx& c) {
    for (int w = c.gw; w < T; w += c.ngw) {
        const bf16* r = in + (size_t)w * DM; float v[16]; float s = 0.f;
#pragma unroll
        for (int j = 0; j < 4; ++j) { const u32x2 u = *(const u32x2*)(r + j * 256 + c.lane * 4);
            v[4 * j] = __uint_as_float(u.x << 16); v[4 * j + 1] = __uint_as_float(u.x & 0xffff0000u); v[4 * j + 2] = __uint_as_float(u.y << 16); v[4 * j + 3] = __uint_as_float(u.y & 0xffff0000u); }
#pragma unroll
        for (int j = 0; j < 16; ++j) s += v[j];
#pragma unroll
        for (int o = 1; o < 64; o <<= 1) s += __shfl_xor(s, o);
        const float mu = s * (1.f / DM); float q = 0.f;
#pragma unroll
        for (int j = 0; j < 16; ++j) { v[j] -= mu; q += v[j] * v[j]; }
#pragma unroll
        for (int o = 1; o < 64; o <<= 1) q += __shfl_xor(q, o);
        const float rs = rsqrtf(q * (1.f / DM) + LN_EPS);
#pragma unroll
        for (int j = 0; j < 4; ++j) { const int cc = j * 256 + c.lane * 4; const f32x4 gg = *(const f32x4*)(g + cc), bb = *(const f32x4*)(bb_ + cc);
            u32x2 u; u.x = cvtpk(v[4 * j] * rs * gg[0] + bb[0], v[4 * j + 1] * rs * gg[1] + bb[1]); u.y = cvtpk(v[4 * j + 2] * rs * gg[2] + bb[2], v[4 * j + 3] * rs * gg[3] + bb[3]);
            *(u32x2*)(outp + (size_t)w * DM + cc) = u; }
    }
}
__device__ __forceinline__ void phase_route(const P& p, const Ctx& c) {
    const int lane = c.lane;
    for (int w = c.gw; w < T; w += c.ngw) {
        const f32x4 lg = *(const f32x4*)((const float*)(p.ws + WS_LOGITS) + (size_t)w * NEXP + lane * 4);
        const f32x4 eb = *(const f32x4*)(p.e_bias + lane * 4);
        float sc[4], bs[4];
#pragma unroll
        for (int j = 0; j < 4; ++j) { sc[j] = 1.f / (1.f + expf(-lg[j])); bs[j] = sc[j] + eb[j]; }
        float m1 = fmaxf(bs[0], bs[1]), m2 = fminf(bs[0], bs[1]);
        { const float cc = bs[2]; const float n1 = fmaxf(m1, cc); m2 = fmaxf(m2, fminf(m1, cc)); m1 = n1; }
        { const float cc = bs[3]; const float n1 = fmaxf(m1, cc); m2 = fmaxf(m2, fminf(m1, cc)); m1 = n1; }
#pragma unroll
        for (int o = 1; o < 8; o <<= 1) { const float b1 = __shfl_xor(m1, o), b2 = __shfl_xor(m2, o); const float n1 = fmaxf(m1, b1); m2 = fmaxf(fminf(m1, b1), fmaxf(m2, b2)); m1 = n1; }
        const float gs = m1 + m2; const int grp = lane >> 3; int rank = 0;
#pragma unroll
        for (int g2 = 0; g2 < 8; ++g2) { const float o = __shfl(gs, g2 * 8); rank += (o > gs || (o == gs && g2 < grp)) ? 1 : 0; }
        const bool sel = rank < 4;
        float cand[4];
#pragma unroll
        for (int j = 0; j < 4; ++j) cand[j] = sel ? bs[j] : -INFINITY;
        int myidx = 0; float myw = 0.f, wsum = 0.f;
#pragma unroll 1
        for (int k = 0; k < TOPK; ++k) {
            float bv = cand[0]; int bi = lane * 4;
#pragma unroll
            for (int j = 1; j < 4; ++j) if (cand[j] > bv) { bv = cand[j]; bi = lane * 4 + j; }
#pragma unroll
            for (int o = 1; o < 64; o <<= 1) { const float ov = __shfl_xor(bv, o); const int oi = __shfl_xor(bi, o); if (ov > bv || (ov == bv && oi < bi)) { bv = ov; bi = oi; } }
            const int own = bi >> 2, el = bi & 3;
            const float sv = el == 0 ? sc[0] : (el == 1 ? sc[1] : (el == 2 ? sc[2] : sc[3]));
            const float wv = __shfl(sv, own);
            if (lane == own) { if (el == 0) cand[0] = -INFINITY; else if (el == 1) cand[1] = -INFINITY; else if (el == 2) cand[2] = -INFINITY; else cand[3] = -INFINITY; }
            wsum += wv;
            if (lane == k) { myidx = bi; myw = wv; }
        }
        if (lane < TOPK) {
            const int rk = atomicAdd((int*)(p.ws + WS_CNT) + myidx, 1);
            ((int*)(p.ws + WS_RIDX))[(size_t)w * 8 + lane] = myidx;
            ((float*)(p.ws + WS_RW))[(size_t)w * 8 + lane] = myw / wsum * ROUTED_SCALE;
            ((int*)(p.ws + WS_RRANK))[(size_t)w * 8 + lane] = rk;
        }
    }
}
__device__ __forceinline__ void phase_scatter(const P& p, const Ctx& c) {
    LAS int* sh = (LAS int*)c.lds;
    const int tid = c.tid;
    int cnt = 0;
    if (tid < 256) { cnt = ld_i32_agent((const int*)(p.ws + WS_CNT) + tid); sh[tid] = cnt; sh[256 + tid] = (cnt + 255) >> 8; }
    __syncthreads();
    for (int o = 1; o < 256; o <<= 1) { int v = 0, v2 = 0; if (tid < 256 && tid >= o) { v = sh[tid - o]; v2 = sh[256 + tid - o]; } __syncthreads(); if (tid < 256) { sh[tid] += v; sh[256 + tid] += v2; } __syncthreads(); }
    if (blockIdx.x == 0) {
        int* st = (int*)(p.ws + WS_START); int* tab = (int*)(p.ws + WS_TILETAB);
        if (tid < 256) { const int st_e = sh[tid] - cnt; st[tid + 1] = sh[tid]; if (tid == 0) st[0] = 0;
            const int nte = (cnt + 255) >> 8, tb = sh[256 + tid] - nte;
            for (int ti = 0; ti < nte; ++ti) { int* q = tab + 4 * (tb + ti); q[0] = tid; q[1] = ti; q[2] = st_e + 256 * ti; q[3] = min(256, cnt - 256 * ti); } }
        const int nrt_r = sh[511];
        if (tid < 128) { int* q = tab + 4 * (nrt_r + tid); q[0] = NEXP; q[1] = tid; q[2] = AROWS + 256 * tid; q[3] = 256; }
        if (tid == 0) ((int*)(p.ws + WS_NRT))[0] = nrt_r + 128;
    }
    const int gt = c.vcu * NTHR + tid, ngt = c.G * NTHR;
    for (int i = gt; i < T * 8; i += ngt) {
        const int e = ((const int*)(p.ws + WS_RIDX))[i], rk = ((const int*)(p.ws + WS_RRANK))[i];
        const int pos = (e == 0 ? 0 : sh[e - 1]) + rk;
        ((int*)(p.ws + WS_ROWTOK))[pos] = i >> 3;
        ((float*)(p.ws + WS_ROWW))[pos] = ((const float*)(p.ws + WS_RW))[i];
        ((int*)(p.ws + WS_POS))[i] = pos;
    }
    __syncthreads();
}
__device__ __forceinline__ void phase_combine(const P& p, const Ctx& c) {
    const int lane = c.lane;
    const bf16* Y = (const bf16*)(p.ws + WS_Y);
    for (int w = c.gw; w < T; w += c.ngw) {
        const bf16* h2 = (const bf16*)(p.ws + WS_H2) + (size_t)w * DM;
        const int* pos = (const int*)(p.ws + WS_POS) + (size_t)w * 8;
        float v[16];
#pragma unroll
        for (int j = 0; j < 4; ++j) { const u32x2 u = *(const u32x2*)(h2 + j * 256 + lane * 4);
            v[4 * j] = DN_ALPHA * __uint_as_float(u.x << 16); v[4 * j + 1] = DN_ALPHA * __uint_as_float(u.x & 0xffff0000u); v[4 * j + 2] = DN_ALPHA * __uint_as_float(u.y << 16); v[4 * j + 3] = DN_ALPHA * __uint_as_float(u.y & 0xffff0000u); }
#pragma unroll
        for (int k = 0; k < 9; ++k) {
            const size_t row = k < 8 ? (size_t)pos[k < 8 ? k : 0] : (size_t)AROWS + w;
            const bf16* yr = Y + row * DM;
#pragma unroll
            for (int j = 0; j < 4; ++j) { const u32x2 u = *(const u32x2*)(yr + j * 256 + lane * 4);
                v[4 * j] += __uint_as_float(u.x << 16); v[4 * j + 1] += __uint_as_float(u.x & 0xffff0000u); v[4 * j + 2] += __uint_as_float(u.y << 16); v[4 * j + 3] += __uint_as_float(u.y & 0xffff0000u); }
        }
        float s = 0.f;
#pragma unroll
        for (int j = 0; j < 16; ++j) s += v[j];
#pragma unroll
        for (int o = 1; o < 64; o <<= 1) s += __shfl_xor(s, o);
        const float mu = s * (1.f / DM); float q = 0.f;
#pragma unroll
        for (int j = 0; j < 16; ++j) { v[j] -= mu; q += v[j] * v[j]; }
#pragma unroll
        for (int o = 1; o < 64; o <<= 1) q += __shfl_xor(q, o);
        const float rs = rsqrtf(q * (1.f / DM) + LN_EPS);
#pragma unroll
        for (int j = 0; j < 4; ++j) { const int cc = j * 256 + lane * 4; const f32x4 gg = *(const f32x4*)(p.ln3_g + cc), bb = *(const f32x4*)(p.ln3_b + cc);
            f32x4 o; o[0] = v[4 * j] * rs * gg[0] + bb[0]; o[1] = v[4 * j + 1] * rs * gg[1] + bb[1]; o[2] = v[4 * j + 2] * rs * gg[2] + bb[2]; o[3] = v[4 * j + 3] * rs * gg[3] + bb[3];
            *(f32x4*)(p.out + (size_t)w * DM + cc) = o; }
    }
}

enum Phase { PH_PROLOGUE = 0, PH_INPROJ, PH_ATTN, PH_MERGE, PH_OUTPROJ, PH_LN1, PH_QMEM, PH_MEMATTN, PH_WO, PH_LN2, PH_ROUTER, PH_ROUTE, PH_SCATTER, PH_MOE1, PH_MOE2, PH_COMBINE, PH_COUNT };
struct MKArgs { P p; int ph_lo, ph_hi; };

__global__ void __launch_bounds__(NTHR, 2) mk_fwd(MKArgs a) {
    extern __shared__ __attribute__((aligned(16))) unsigned char lds_raw[];
    LAS unsigned char* lds = (LAS unsigned char*)lds_raw;
    const P& p = a.p;
    Ctx c; c.tid = threadIdx.x; c.lane = c.tid & 63; c.wave = __builtin_amdgcn_readfirstlane(c.tid >> 6); c.G = gridDim.x;
    { const int bx = blockIdx.x; c.vcu = (c.G % 8 == 0) ? (bx % 8) * (c.G / 8) + bx / 8 : bx; }
    c.gw = c.vcu * NWAVES + c.wave; c.ngw = c.G * NWAVES; c.lds = lds;
    unsigned char* ws = p.ws;
    const int lo = a.ph_lo, hi = a.ph_hi;
#ifdef ONLY_PH
#define IN(k) ((k) == ONLY_PH)
#else
#define IN(k) (lo <= (k) && (k) < hi)
#endif
#define SEAM(k) do { if (IN(k) && IN((k) + 1)) { cg::this_grid().sync(); } } while (0)

    if (IN(PH_PROLOGUE)) { phase_prologue(p, c); SEAM(PH_PROLOGUE); }

    if (IN(PH_INPROJ)) {
        { gm::DenseSched S; S.init(T, INW, DM, ws + WS_WINT, c.G, (int)blockIdx.x);
          gm::EpiInProj E{(bf16*)(ws + WS_PROJ), (const float*)(ws + WS_CS)};
          gm::gemm_phase(lds, (const char*)(ws + WS_XB), DM, S, E); }
        { gm::DenseSched S; S.init(BATCH * MEML, 2048, DM, ws + WS_WKVT, c.G, (int)blockIdx.x);
          gm::EpiScale E{(bf16*)(ws + WS_KVM), 2048, 1.f};
          gm::gemm_phase(lds, (const char*)(ws + WS_MEMB), DM, S, E); }
        SEAM(PH_INPROJ);
    }

    if (IN(PH_ATTN)) {
        const float lam = __hip_atomic_load((const float*)(ws + WS_SCAL), __ATOMIC_RELAXED, __HIP_MEMORY_SCOPE_AGENT);
        if (c.G == 256) { const int bh = c.vcu >> 3, s = c.vcu & 7;
            for (int i = 0; i < 4; ++i) { const int qb = (i == 0) ? s : (i == 1) ? 15 - s : (i == 2) ? 16 + s : 31 - s; diff_unit(p, bh >> 2, bh & 3, qb, lds, lam); } }
        else { for (int u = blockIdx.x; u < 1024; u += c.G) diff_unit(p, u >> 7, (u >> 5) & 3, u & 31, lds, lam); }
        for (int u = c.vcu; u < 3072; u += c.G) { const int grp = u & 15, t3 = u >> 4, br = t3 % 3, bh = t3 / 3; dil_unit(p, bh >> 3, bh & 7, br, grp, lds); }
        SEAM(PH_ATTN);
    }

    if (IN(PH_MERGE)) { phase_merge(p, c); SEAM(PH_MERGE); }

    if (IN(PH_OUTPROJ)) {
        gm::DenseSched S; S.init(T, DM, DM, ws + WS_WOUTT, c.G, (int)blockIdx.x);
        gm::EpiOutProj E{(bf16*)(ws + WS_Y1), p.x};
        gm::gemm_phase(lds, (const char*)(ws + WS_MIXIN), DM, S, E);
        SEAM(PH_OUTPROJ);
    }
    if (IN(PH_LN1)) { phase_ln((const bf16*)(ws + WS_Y1), (bf16*)(ws + WS_H1), p.ln1_g, p.ln1_b, c); SEAM(PH_LN1); }

    if (IN(PH_QMEM)) {
        gm::DenseSched S; S.init(T, DM, DM, ws + WS_WQT, c.G, (int)blockIdx.x);
        gm::EpiScale E{(bf16*)(ws + WS_QM), DM, QSCALE256};
        gm::gemm_phase(lds, (const char*)(ws + WS_H1), DM, S, E);
        SEAM(PH_QMEM);
    }
    if (IN(PH_MEMATTN)) {
        for (int u = c.vcu; u < 512; u += c.G) { const int qblk = u & 15, bh = u >> 4; mem_unit(p, bh >> 2, bh & 3, qblk, lds); }
        SEAM(PH_MEMATTN);
    }
    if (IN(PH_WO)) {
        gm::DenseSched S; S.init(T, DM, DM, ws + WS_WOT, c.G, (int)blockIdx.x);
        gm::EpiWo E{(bf16*)(ws + WS_Y2), (const bf16*)(ws + WS_H1)};
        gm::gemm_phase(lds, (const char*)(ws + WS_MO), DM, S, E);
        SEAM(PH_WO);
    }
    if (IN(PH_LN2)) { phase_ln((const bf16*)(ws + WS_Y2), (bf16*)(ws + WS_H2), p.ln2_g, p.ln2_b, c); SEAM(PH_LN2); }

    if (IN(PH_ROUTER)) {
        gm::DenseSched S; S.init(T, NEXP, DM, ws + WS_WRT, c.G, (int)blockIdx.x);
        gm::EpiF32 E{(float*)(ws + WS_LOGITS), NEXP};
        gm::gemm_phase(lds, (const char*)(ws + WS_H2), DM, S, E);
        SEAM(PH_ROUTER);
    }
    if (IN(PH_ROUTE)) { phase_route(p, c); SEAM(PH_ROUTE); }
    if (IN(PH_SCATTER)) { phase_scatter(p, c); SEAM(PH_SCATTER); }

    if (IN(PH_MOE1)) {
        const int nrt = __builtin_amdgcn_readfirstlane(ld_i32_agent((const int*)(ws + WS_NRT)));
        gm::MoeSched<1, DM, true> S{(const int*)(ws + WS_TILETAB), nrt * 2, c.G, (int)blockIdx.x, (const char*)(ws + WS_WTGU), (size_t)512 * DM * 2, (const int*)(ws + WS_ROWTOK)};
        gm::EpiMoe1 E{(bf16*)(ws + WS_HB)};
        gm::gemm_phase(lds, (const char*)(ws + WS_H2), DM, S, E);
        SEAM(PH_MOE1);
    }
    if (IN(PH_MOE2)) {
        const int nrt = __builtin_amdgcn_readfirstlane(ld_i32_agent((const int*)(ws + WS_NRT)));
        gm::MoeSched<2, EDIM, false> S{(const int*)(ws + WS_TILETAB), nrt * 4, c.G, (int)blockIdx.x, (const char*)(ws + WS_WTD), (size_t)DM * EDIM * 2, nullptr};
        gm::EpiMoe2 E{(bf16*)(ws + WS_Y), (const float*)(ws + WS_ROWW)};
        gm::gemm_phase(lds, (const char*)(ws + WS_HB), EDIM, S, E);
        SEAM(PH_MOE2);
    }
    if (IN(PH_COMBINE)) { phase_combine(p, c); }
#undef IN
#undef SEAM
}

#ifndef MK_MODE
#define MK_MODE 1
#endif
#ifndef NAIVE_MASK
#define NAIVE_MASK 0
#endif

static void fill_params(P& p, void* const* d_in, void* d_out, void* d_ws) {
    p.x = (const float*)d_in[0]; p.mem = (const float*)d_in[1]; p.pos = (const int*)d_in[2];
    p.w_in = (const float*)d_in[3]; p.w_out = (const float*)d_in[4]; p.lq1 = (const float*)d_in[5]; p.lk1 = (const float*)d_in[6]; p.lq2 = (const float*)d_in[7]; p.lk2 = (const float*)d_in[8];
    p.subln_g = (const float*)d_in[9]; p.ln1_g = (const float*)d_in[10]; p.ln1_b = (const float*)d_in[11];
    p.wq = (const float*)d_in[12]; p.wkv = (const float*)d_in[13]; p.wo = (const float*)d_in[14]; p.ln2_g = (const float*)d_in[15]; p.ln2_b = (const float*)d_in[16];
    p.w_router = (const float*)d_in[17]; p.e_bias = (const float*)d_in[18]; p.w_gate = (const float*)d_in[19]; p.w_up = (const float*)d_in[20]; p.w_down = (const float*)d_in[21];
    p.ws_gate = (const float*)d_in[22]; p.ws_up = (const float*)d_in[23]; p.ws_down = (const float*)d_in[24]; p.ln3_g = (const float*)d_in[25]; p.ln3_b = (const float*)d_in[26];
    p.out = (float*)d_out; p.ws = (unsigned char*)d_ws;
}

extern "C" void kernel_launch(void* const* d_in, const int* in_sizes, int n_in, void* d_out, int out_size, void* d_ws, size_t ws_size, hipStream_t stream) {
    static int grid = 0;
    if (grid == 0) {
        if (n_in != 27 || out_size != T * DM || ws_size < WS_END) { fprintf(stderr, "kernel_launch: unexpected shapes: n_in %d out %d ws %zu (need %zu)\n", n_in, out_size, ws_size, (size_t)WS_END); grid = -1; return; }
        int dev = 0, cus = 0, per_cu = 0;
        (void)hipGetDevice(&dev); (void)hipDeviceGetAttribute(&cus, hipDeviceAttributeMultiprocessorCount, dev);
        if (hipFuncSetAttribute((const void*)mk_fwd, hipFuncAttributeMaxDynamicSharedMemorySize, LDS_BYTES) != hipSuccess) { fprintf(stderr, "kernel_launch: hipFuncSetAttribute failed\n"); grid = -1; return; }
        if (hipOccupancyMaxActiveBlocksPerMultiprocessor(&per_cu, (const void*)mk_fwd, NTHR, LDS_BYTES) != hipSuccess || per_cu < 1) { fprintf(stderr, "kernel_launch: occupancy query says %d blocks/CU\n", per_cu); per_cu = 1; }
        (void)hipGetLastError();
        grid = cus;
        fprintf(stderr, "kernel_launch: cus %d per_cu %d grid %d\n", cus, per_cu, grid);
    }
    if (grid < 0) return;
    MKArgs a{};
    fill_params(a.p, d_in, d_out, d_ws);
    P p = a.p; unsigned char* ws = p.ws;
#if MK_MODE == 1
    a.ph_lo = 0; a.ph_hi = PH_COUNT;
    void* args[] = {&a};
    hipError_t e = hipLaunchCooperativeKernel((const void*)mk_fwd, dim3(grid), dim3(NTHR), args, LDS_BYTES, stream);
    if (e != hipSuccess) fprintf(stderr, "cooperative launch failed: %s (grid %d)\n", hipGetErrorString(e), grid);
#elif MK_MODE == 2
    auto run = [&](int lo, int hi) { a.ph_lo = lo; a.ph_hi = hi; hipLaunchKernelGGL(mk_fwd, dim3(grid), dim3(NTHR), LDS_BYTES, stream, a); };
    auto nv = [&](int k) { return ((NAIVE_MASK >> k) & 1) != 0; };
    run(PH_PROLOGUE, PH_PROLOGUE + 1);
    if (nv(PH_INPROJ)) { ngemm<FInProj><<<dim3(T / 64, INW / 64, 1), 256, 0, stream>>>(FInProj{p}); ngemm<FKV><<<dim3(BATCH * MEML / 64, 2048 / 64, 1), 256, 0, stream>>>(FKV{p}); } else run(PH_INPROJ, PH_INPROJ + 1);
    if (nv(PH_ATTN)) { nattnA<<<3 * 8 * T / 256, 256, 0, stream>>>(p); nattnB<<<16 * T / 256, 256, 0, stream>>>(p); sublnB<<<T * 4 / 4, 256, 0, stream>>>(p); } else run(PH_ATTN, PH_ATTN + 1);
    if (nv(PH_MERGE)) mergeA<<<T * 512 / 256, 256, 0, stream>>>(p); else run(PH_MERGE, PH_MERGE + 1);
    if (nv(PH_OUTPROJ)) ngemm<FOutProj><<<dim3(T / 64, DM / 64, 1), 256, 0, stream>>>(FOutProj{p}); else run(PH_OUTPROJ, PH_OUTPROJ + 1);
    if (nv(PH_LN1)) ln_pass<<<T / 4, 256, 0, stream>>>((const bf16*)(ws + WS_Y1), (bf16*)(ws + WS_H1), p.ln1_g, p.ln1_b); else run(PH_LN1, PH_LN1 + 1);
    if (nv(PH_QMEM)) ngemm<FQMem><<<dim3(T / 64, DM / 64, 1), 256, 0, stream>>>(FQMem{p}); else run(PH_QMEM, PH_QMEM + 1);
    if (nv(PH_MEMATTN)) { ngemm<FMemS><<<dim3(T / 64, 256 / 64, 4), 256, 0, stream>>>(FMemS{p}); softmaxM<<<T * 4 / 4, 256, 0, stream>>>(p); ngemm<FMemO><<<dim3(T / 64, 256 / 64, 4), 256, 0, stream>>>(FMemO{p}); } else run(PH_MEMATTN, PH_MEMATTN + 1);
    if (nv(PH_WO)) ngemm<FWo><<<dim3(T / 64, DM / 64, 1), 256, 0, stream>>>(FWo{p}); else run(PH_WO, PH_WO + 1);
    if (nv(PH_LN2)) ln_pass<<<T / 4, 256, 0, stream>>>((const bf16*)(ws + WS_Y2), (bf16*)(ws + WS_H2), p.ln2_g, p.ln2_b); else run(PH_LN2, PH_LN2 + 1);
    if (nv(PH_ROUTER)) ngemm<FRouter><<<dim3(T / 64, NEXP / 64, 1), 256, 0, stream>>>(FRouter{p}); else run(PH_ROUTER, PH_ROUTER + 1);
    if (nv(PH_ROUTE)) route_pass<<<T / 4, 256, 0, stream>>>(p); else run(PH_ROUTE, PH_ROUTE + 1);
    run(PH_SCATTER, PH_SCATTER + 1);
    if (nv(PH_MOE1)) ngemm<FMoe1><<<dim3(T / 64, 512 / 64, NEXP + 1), 256, 0, stream>>>(FMoe1{p}); else run(PH_MOE1, PH_MOE1 + 1);
    if (nv(PH_MOE2)) ngemm<FMoe2><<<dim3(T / 64, DM / 64, NEXP + 1), 256, 0, stream>>>(FMoe2{p}); else run(PH_MOE2, PH_MOE2 + 1);
    if (nv(PH_COMBINE)) combine_pass<<<T / 4, 256, 0, stream>>>(p); else run(PH_COMBINE, PH_COMBINE + 1);
#else
    prep_kernel<<<T * 8 / 256, 256, 0, stream>>>(p);
    ngemm<FInProj><<<dim3(T / 64, INW / 64, 1), 256, 0, stream>>>(FInProj{p});
    nattnA<<<3 * 8 * T / 256, 256, 0, stream>>>(p);
    mergeA<<<T * 512 / 256, 256, 0, stream>>>(p);
    nattnB<<<16 * T / 256, 256, 0, stream>>>(p);
    sublnB<<<T * 4 / 4, 256, 0, stream>>>(p);
    ngemm<FOutProj><<<dim3(T / 64, DM / 64, 1), 256, 0, stream>>>(FOutProj{p});
    ln_pass<<<T / 4, 256, 0, stream>>>((const bf16*)(ws + WS_Y1), (bf16*)(ws + WS_H1), p.ln1_g, p.ln1_b);
    ngemm<FQMem><<<dim3(T / 64, DM / 64, 1), 256, 0, stream>>>(FQMem{p});
    ngemm<FKV><<<dim3(BATCH * MEML / 64, 2048 / 64, 1), 256, 0, stream>>>(FKV{p});
    ngemm<FMemS><<<dim3(T / 64, 256 / 64, 4), 256, 0, stream>>>(FMemS{p});
    softmaxM<<<T * 4 / 4, 256, 0, stream>>>(p);
    ngemm<FMemO><<<dim3(T / 64, 256 / 64, 4), 256, 0, stream>>>(FMemO{p});
    ngemm<FWo><<<dim3(T / 64, DM / 64, 1), 256, 0, stream>>>(FWo{p});
    ln_pass<<<T / 4, 256, 0, stream>>>((const bf16*)(ws + WS_Y2), (bf16*)(ws + WS_H2), p.ln2_g, p.ln2_b);
    ngemm<FRouter><<<dim3(T / 64, NEXP / 64, 1), 256, 0, stream>>>(FRouter{p});
    route_pass<<<T / 4, 256, 0, stream>>>(p);
    scan_pass<<<1, 256, 0, stream>>>(p);
    scatter_pass<<<T * 8 / 256, 256, 0, stream>>>(p);
    ngemm<FMoe1><<<dim3(T / 64, 512 / 64, NEXP + 1), 256, 0, stream>>>(FMoe1{p});
    ngemm<FMoe2><<<dim3(T / 64, DM / 64, NEXP + 1), 256, 0, stream>>>(FMoe2{p});
    combine_pass<<<T / 4, 256, 0, stream>>>(p);
#endif
}
```

```cpp
#define MK_MODE 1
#define NAIVE_MASK 0
#include <hip/hip_runtime.h>
#include <hip/hip_cooperative_groups.h>
#include <cstdio>
#include <cstdint>
#include <cmath>
namespace cg = cooperative_groups;

constexpr int BATCH = 8, SEQ = 4096, DM = 1024, T = BATCH * SEQ;
constexpr int MEML = 256;
constexpr int INW = 3072;
constexpr int NEXP = 256, TOPK = 8, EDIM = 256;
constexpr int AROWS = T * TOPK;
constexpr float LN_EPS = 1e-5f, SUBLN_EPS = 1e-5f;
constexpr float DN_ALPHA = 1.189207115002721f;
constexpr float LOG2E = 1.4426950408889634f;
constexpr float QSCALE64 = 0.125f * LOG2E;
constexpr float QSCALE256 = 0.0625f * LOG2E;
constexpr float LAMBDA_INIT = 0.2f;
constexpr float ROUTED_SCALE = 2.5f;

constexpr size_t MiB = 1u << 20;
constexpr size_t WS_CNT = 0;
constexpr size_t WS_START = 4096;
constexpr size_t WS_SCAL = 8192;
constexpr size_t WS_NRT = 12288;
constexpr size_t WS_TILETAB = 16384;
constexpr size_t WS_BAR = 65536;
constexpr size_t WS_CS = 1 * MiB;
constexpr size_t WS_RIDX = 4 * MiB, WS_RW = 5 * MiB, WS_RRANK = 6 * MiB, WS_POS = 7 * MiB;
constexpr size_t WS_ROWTOK = 8 * MiB, WS_ROWW = 10 * MiB;
constexpr size_t WS_LSEA = 12 * MiB;
constexpr size_t WS_KVM = 16 * MiB;
constexpr size_t WS_MEMB = 24 * MiB;
constexpr size_t WS_WINT = 32 * MiB;
constexpr size_t WS_WOUTT = 38 * MiB;
constexpr size_t WS_WQT = 40 * MiB;
constexpr size_t WS_WKVT = 42 * MiB;
constexpr size_t WS_WOT = 46 * MiB;
constexpr size_t WS_WRT = 48 * MiB;
constexpr size_t WS_WTD = 64 * MiB;
constexpr size_t WS_H2 = 193 * MiB;
constexpr size_t WS_MIXIN = 193 * MiB;
constexpr size_t WS_Y1 = 257 * MiB;
constexpr size_t WS_DD = 257 * MiB;
constexpr size_t WS_H1 = 321 * MiB;
constexpr size_t WS_HB = 257 * MiB;
constexpr size_t WS_WTGU = 401 * MiB;
constexpr size_t WS_Y = 448 * MiB;
constexpr size_t WS_PROJ = 658 * MiB;
constexpr size_t WS_QM = 658 * MiB;
constexpr size_t WS_MO = 722 * MiB;
constexpr size_t WS_Y2 = 786 * MiB;
constexpr size_t WS_PARTA = 850 * MiB;
constexpr size_t WS_LOGITS = 850 * MiB;
constexpr size_t WS_SS = 850 * MiB;
constexpr size_t WS_XB = 946 * MiB;
constexpr size_t WS_END = 1024 * MiB;

typedef unsigned short bf16;
__device__ __forceinline__ float bf2f(bf16 v) { return __uint_as_float(((unsigned)v) << 16); }
__device__ __forceinline__ bf16 f2bf(float f) { unsigned u = __float_as_uint(f); return (bf16)((u + 0x7fffu + ((u >> 16) & 1u)) >> 16); }

struct P {
    const float *x, *mem; const int* pos;
    const float *w_in, *w_out, *lq1, *lk1, *lq2, *lk2, *subln_g, *ln1_g, *ln1_b;
    const float *wq, *wkv, *wo, *ln2_g, *ln2_b, *w_router, *e_bias, *w_gate, *w_up, *w_down;
    const float *ws_gate, *ws_up, *ws_down, *ln3_g, *ln3_b;
    float* out; unsigned char* ws;
};

__host__ __device__ __forceinline__ int sigma_dim(int p) { return p < 16 ? (p >> 1) + 8 * (p & 1) : p; }
__device__ __forceinline__ int proj_src_col(int c) {
    const int seg = c >> 9;
    if (seg == 2 || seg == 5) return c;
    return (c & ~63) | sigma_dim(c & 63);
}

__global__ void prep_kernel(P p) {
    const int i = blockIdx.x * blockDim.x + threadIdx.x;
    if (i < T * 8) {
        const int t = i >> 3, j = i & 7;
        const float inv = powf(500000.0f, -(float)(2 * j) / 16.0f);
        const float ang = (float)p.pos[t] * inv;
        float2* cs = (float2*)(p.ws + WS_CS);
        cs[i] = make_float2(cosf(ang), sinf(ang));
    }
    if (i < 256) ((int*)(p.ws + WS_CNT))[i] = 0;
    if (i == 0) {
        float a = 0.f, b = 0.f;
        for (int k = 0; k < 64; ++k) { a += p.lq1[k] * p.lk1[k]; b += p.lq2[k] * p.lk2[k]; }
        ((float*)(p.ws + WS_SCAL))[0] = expf(a) - expf(b) + LAMBDA_INIT;
    }
}

template <class F> __global__ void __launch_bounds__(256) ngemm(F f) {
    __shared__ float As[16][65], Bs[16][65];
    const int g = blockIdx.z, M = f.rows(g);
    const int m0 = blockIdx.x * 64, n0 = blockIdx.y * 64;
    if (m0 >= M) return;
    const int K = f.kdim();
    const int tid = threadIdx.x, tx = tid & 15, ty = tid >> 4;
    float acc[4][4];
#pragma unroll
    for (int i = 0; i < 4; ++i)
#pragma unroll
        for (int j = 0; j < 4; ++j) acc[i][j] = 0.f;
    for (int k0 = 0; k0 < K; k0 += 16) {
#pragma unroll
        for (int i = 0; i < 4; ++i) {
            const int idx = tid + i * 256;
            { const int k = idx & 15, r = idx >> 4; As[k][r] = (m0 + r < M) ? f.a(g, m0 + r, k0 + k) : 0.f; }
            { const int c = idx & 63, k = idx >> 6; Bs[k][c] = f.b(g, k0 + k, n0 + c); }
        }
        __syncthreads();
#pragma unroll
        for (int k = 0; k < 16; ++k) {
            float av[4], bv[4];
#pragma unroll
            for (int i = 0; i < 4; ++i) { av[i] = As[k][ty * 4 + i]; bv[i] = Bs[k][tx * 4 + i]; }
#pragma unroll
            for (int i = 0; i < 4; ++i)
#pragma unroll
                for (int j = 0; j < 4; ++j) acc[i][j] += av[i] * bv[j];
        }
        __syncthreads();
    }
#pragma unroll
    for (int i = 0; i < 4; ++i) { const int r = m0 + ty * 4 + i; if (r < M) f.epi(g, r, n0 + tx * 4, acc[i]); }
}

struct FInProj {
    P p;
    __device__ int rows(int) const { return T; }
    __device__ int kdim() const { return DM; }
    __device__ float a(int, int r, int k) const { return bf2f(f2bf(p.x[(size_t)r * DM + k])); }
    __device__ float b(int, int k, int c) const { return bf2f(f2bf(p.w_in[(size_t)k * INW + proj_src_col(c)])); }
    __device__ void epi(int, int r, int c0, const float (&v)[4]) const {
        bf16* proj = (bf16*)(p.ws + WS_PROJ);
        const int seg = c0 >> 9; float o[4] = {v[0], v[1], v[2], v[3]};
        if (seg != 2 && seg != 5) {
            const int pp = c0 & 63;
            if (pp < 16) {
                const float2* cs = (const float2*)(p.ws + WS_CS) + (size_t)r * 8;
#pragma unroll
                for (int q = 0; q < 2; ++q) { const float2 c = cs[(pp >> 1) + q]; const float t1 = v[2 * q], t2 = v[2 * q + 1]; o[2 * q] = t1 * c.x - t2 * c.y; o[2 * q + 1] = t2 * c.x + t1 * c.y; }
            }
            if (seg == 0 || seg == 3) {
#pragma unroll
                for (int q = 0; q < 4; ++q) o[q] *= QSCALE64;
            }
        }
#pragma unroll
        for (int q = 0; q < 4; ++q) proj[(size_t)r * INW + c0 + q] = f2bf(o[q]);
    }
};
struct FOutProj {
    P p;
    __device__ int rows(int) const { return T; }
    __device__ int kdim() const { return DM; }
    __device__ float a(int, int r, int k) const { return bf2f(((const bf16*)(p.ws + WS_MIXIN))[(size_t)r * DM + k]); }
    __device__ float b(int, int k, int c) const { return bf2f(f2bf(p.w_out[(size_t)k * DM + c])); }
    __device__ void epi(int, int r, int c0, const float (&v)[4]) const {
        bf16* y = (bf16*)(p.ws + WS_Y1);
#pragma unroll
        for (int q = 0; q < 4; ++q) y[(size_t)r * DM + c0 + q] = f2bf(DN_ALPHA * p.x[(size_t)r * DM + c0 + q] + v[q]);
    }
};
struct FQMem {
    P p;
    __device__ int rows(int) const { return T; }
    __device__ int kdim() const { return DM; }
    __device__ float a(int, int r, int k) const { return bf2f(((const bf16*)(p.ws + WS_H1))[(size_t)r * DM + k]); }
    __device__ float b(int, int k, int c) const { return bf2f(f2bf(p.wq[(size_t)k * DM + c])); }
    __device__ void epi(int, int r, int c0, const float (&v)[4]) const {
        bf16* y = (bf16*)(p.ws + WS_QM);
#pragma unroll
        for (int q = 0; q < 4; ++q) y[(size_t)r * DM + c0 + q] = f2bf(v[q] * QSCALE256);
    }
};
struct FKV {
    P p;
    __device__ int rows(int) const { return BATCH * MEML; }
    __device__ int kdim() const { return DM; }
    __device__ float a(int, int r, int k) const { return bf2f(f2bf(p.mem[(size_t)r * DM + k])); }
    __device__ float b(int, int k, int c) const { return bf2f(f2bf(p.wkv[(size_t)k * 2048 + c])); }
    __device__ void epi(int, int r, int c0, const float (&v)[4]) const {
        bf16* y = (bf16*)(p.ws + WS_KVM);
#pragma unroll
        for (int q = 0; q < 4; ++q) y[(size_t)r * 2048 + c0 + q] = f2bf(v[q]);
    }
};
struct FMemS {
    P p;
    __device__ int rows(int) const { return T; }
    __device__ int kdim() const { return 256; }
    __device__ float a(int g, int r, int k) const { return bf2f(((const bf16*)(p.ws + WS_QM))[(size_t)r * DM + g * 256 + k]); }
    __device__ float b(int g, int k, int c) const { const int bb = (blockIdx.x * 64) / SEQ; return bf2f(((const bf16*)(p.ws + WS_KVM))[(size_t)(bb * MEML + c) * 2048 + g * 256 + k]); }
    __device__ void epi(int g, int r, int c0, const float (&v)[4]) const {
        float* s = (float*)(p.ws + WS_SS);
#pragma unroll
        for (int q = 0; q < 4; ++q) s[(size_t)r * DM + g * 256 + c0 + q] = v[q];
    }
};
struct FMemO {
    P p;
    __device__ int rows(int) const { return T; }
    __device__ int kdim() const { return 256; }
    __device__ float a(int g, int r, int k) const { return bf2f(f2bf(((const float*)(p.ws + WS_SS))[(size_t)r * DM + g * 256 + k])); }
    __device__ float b(int g, int k, int c) const { const int bb = (blockIdx.x * 64) / SEQ; return bf2f(((const bf16*)(p.ws + WS_KVM))[(size_t)(bb * MEML + k) * 2048 + 1024 + g * 256 + c]); }
    __device__ void epi(int g, int r, int c0, const float (&v)[4]) const {
        bf16* y = (bf16*)(p.ws + WS_MO);
#pragma unroll
        for (int q = 0; q < 4; ++q) y[(size_t)r * DM + g * 256 + c0 + q] = f2bf(v[q]);
    }
};
struct FWo {
    P p;
    __device__ int rows(int) const { return T; }
    __device__ int kdim() const { return DM; }
    __device__ float a(int, int r, int k) const { return bf2f(((const bf16*)(p.ws + WS_MO))[(size_t)r * DM + k]); }
    __device__ float b(int, int k, int c) const { return bf2f(f2bf(p.wo[(size_t)k * DM + c])); }
    __device__ void epi(int, int r, int c0, const float (&v)[4]) const {
        bf16* y = (bf16*)(p.ws + WS_Y2); const bf16* h1 = (const bf16*)(p.ws + WS_H1);
#pragma unroll
        for (int q = 0; q < 4; ++q) y[(size_t)r * DM + c0 + q] = f2bf(DN_ALPHA * bf2f(h1[(size_t)r * DM + c0 + q]) + v[q]);
    }
};
struct FRouter {
    P p;
    __device__ int rows(int) const { return T; }
    __device__ int kdim() const { return DM; }
    __device__ float a(int, int r, int k) const { return bf2f(((const bf16*)(p.ws + WS_H2))[(size_t)r * DM + k]); }
    __device__ float b(int, int k, int c) const { return bf2f(f2bf(p.w_router[(size_t)k * NEXP + c])); }
    __device__ void epi(int, int r, int c0, const float (&v)[4]) const {
        float* y = (float*)(p.ws + WS_LOGITS);
#pragma unroll
        for (int q = 0; q < 4; ++q) y[(size_t)r * NEXP + c0 + q] = v[q];
    }
};
struct FMoe1 {
    P p;
    __device__ int rows(int g) const { const int* st = (const int*)(p.ws + WS_START); return g < NEXP ? st[g + 1] - st[g] : T; }
    __device__ int kdim() const { return DM; }
    __device__ float a(int g, int r, int k) const {
        const int* st = (const int*)(p.ws + WS_START); const int* rt = (const int*)(p.ws + WS_ROWTOK);
        const int tok = g < NEXP ? rt[st[g] + r] : r;
        return bf2f(((const bf16*)(p.ws + WS_H2))[(size_t)tok * DM + k]);
    }
    __device__ float b(int g, int k, int c) const {
        const float* w = (c & 1) ? (g < NEXP ? p.w_up + (size_t)g * DM * EDIM : p.ws_up) : (g < NEXP ? p.w_gate + (size_t)g * DM * EDIM : p.ws_gate);
        return bf2f(f2bf(w[(size_t)k * EDIM + (c >> 1)]));
    }
    __device__ void epi(int g, int r, int c0, const float (&v)[4]) const {
        const int* st = (const int*)(p.ws + WS_START); bf16* H = (bf16*)(p.ws + WS_HB);
        const size_t row = g < NEXP ? (size_t)st[g] + r : (size_t)AROWS + r;
#pragma unroll
        for (int q = 0; q < 2; ++q) { const float gg = v[2 * q], uu = v[2 * q + 1]; H[row * EDIM + (c0 >> 1) + q] = f2bf(gg / (1.f + expf(-gg)) * uu); }
    }
};
struct FMoe2 {
    P p;
    __device__ int rows(int g) const { const int* st = (const int*)(p.ws + WS_START); return g < NEXP ? st[g + 1] - st[g] : T; }
    __device__ int kdim() const { return EDIM; }
    __device__ float a(int g, int r, int k) const {
        const int* st = (const int*)(p.ws + WS_START); const bf16* H = (const bf16*)(p.ws + WS_HB);
        const size_t row = g < NEXP ? (size_t)st[g] + r : (size_t)AROWS + r;
        return bf2f(H[row * EDIM + k]);
    }
    __device__ float b(int g, int k, int c) const { const float* w = g < NEXP ? p.w_down + (size_t)g * EDIM * DM : p.ws_down; return bf2f(f2bf(w[(size_t)k * DM + c])); }
    __device__ void epi(int g, int r, int c0, const float (&v)[4]) const {
        const int* st = (const int*)(p.ws + WS_START); bf16* Y = (bf16*)(p.ws + WS_Y);
        const size_t row = g < NEXP ? (size_t)st[g] + r : (size_t)AROWS + r;
        const float w = g < NEXP ? ((const float*)(p.ws + WS_ROWW))[row] : 1.f;
#pragma unroll
        for (int q = 0; q < 4; ++q) Y[row * DM + c0 + q] = f2bf(v[q] * w);
    }
};

__global__ void __launch_bounds__(256) nattnA(P p) {
    const int i = blockIdx.x * blockDim.x + threadIdx.x;
    if (i >= 3 * 8 * T) return;
    const int t = i % T, h = (i / T) & 7, br = i / (8 * T);
    const int dil = br == 0 ? 1 : (br == 1 ? 4 : 16);
    const int s = t % SEQ, b0 = t - s;
    const bf16* proj = (const bf16*)(p.ws + WS_PROJ);
    float q[64], o[64];
#pragma unroll
    for (int e = 0; e < 64; ++e) { q[e] = bf2f(proj[(size_t)t * INW + h * 64 + e]); o[e] = 0.f; }
    float m = -INFINITY, l = 0.f;
    for (int j = 0; j <= 128; ++j) {
        const int ks = s - j * dil; if (ks < 0) break;
        const bf16* kr = proj + (size_t)(b0 + ks) * INW + 512 + h * 64;
        const bf16* vr = proj + (size_t)(b0 + ks) * INW + 1024 + h * 64;
        float sc = 0.f;
#pragma unroll
        for (int e = 0; e < 64; ++e) sc += q[e] * bf2f(kr[e]);
        const float mn = fmaxf(m, sc), al = exp2f(m - mn), pe = exp2f(sc - mn);
        l = l * al + pe;
#pragma unroll
        for (int e = 0; e < 64; ++e) o[e] = o[e] * al + pe * bf2f(vr[e]);
        m = mn;
    }
    bf16* pa = (bf16*)(p.ws + WS_PARTA) + ((size_t)br * T + t) * 512 + h * 64;
    const float il = 1.f / l;
#pragma unroll
    for (int e = 0; e < 64; ++e) pa[e] = f2bf(o[e] * il);
    ((float*)(p.ws + WS_LSEA))[((size_t)br * T + t) * 8 + h] = m + log2f(l);
}
__global__ void mergeA(P p) {
    const int i = blockIdx.x * blockDim.x + threadIdx.x;
    if (i >= T * 512) return;
    const int t = i >> 9, c = i & 511, h = c >> 6;
    const float* lse = (const float*)(p.ws + WS_LSEA);
    const float l0 = lse[(size_t)t * 8 + h], l1 = lse[((size_t)T + t) * 8 + h], l2 = lse[((size_t)2 * T + t) * 8 + h];
    const float mx = fmaxf(l0, fmaxf(l1, l2));
    const float w0 = exp2f(l0 - mx), w1 = exp2f(l1 - mx), w2 = exp2f(l2 - mx), inv = 1.f / (w0 + w1 + w2);
    const bf16* pa = (const bf16*)(p.ws + WS_PARTA);
    const float v = (w0 * bf2f(pa[(size_t)t * 512 + c]) + w1 * bf2f(pa[((size_t)T + t) * 512 + c]) + w2 * bf2f(pa[((size_t)2 * T + t) * 512 + c])) * inv;
    ((bf16*)(p.ws + WS_MIXIN))[(size_t)t * DM + c] = f2bf(v);
}
__global__ void __launch_bounds__(256) nattnB(P p) {
    const int i = blockIdx.x * blockDim.x + threadIdx.x;
    if (i >= 16 * T) return;
    const int t = i % T, ch = (i / T) & 3, h = i / (4 * T);
    const int s = t % SEQ, b0 = t - s;
    const bf16* proj = (const bf16*)(p.ws + WS_PROJ);
    float q0[64], q1[64], o0[32], o1[32];
#pragma unroll
    for (int e = 0; e < 64; ++e) { q0[e] = bf2f(proj[(size_t)t * INW + 1536 + h * 128 + e]); q1[e] = bf2f(proj[(size_t)t * INW + 1536 + h * 128 + 64 + e]); }
#pragma unroll
    for (int e = 0; e < 32; ++e) { o0[e] = 0.f; o1[e] = 0.f; }
    float m0 = -INFINITY, l0 = 0.f, m1 = -INFINITY, l1 = 0.f;
    for (int ks = 0; ks <= s; ++ks) {
        const bf16* kr = proj + (size_t)(b0 + ks) * INW + 2048 + h * 128;
        const bf16* vr = proj + (size_t)(b0 + ks) * INW + 2560 + h * 128 + ch * 32;
        float s0 = 0.f, s1 = 0.f;
#pragma unroll
        for (int e = 0; e < 64; ++e) { s0 += q0[e] * bf2f(kr[e]); s1 += q1[e] * bf2f(kr[64 + e]); }
        const float mn0 = fmaxf(m0, s0), a0 = exp2f(m0 - mn0), p0 = exp2f(s0 - mn0);
        const float mn1 = fmaxf(m1, s1), a1 = exp2f(m1 - mn1), p1 = exp2f(s1 - mn1);
        l0 = l0 * a0 + p0; l1 = l1 * a1 + p1; m0 = mn0; m1 = mn1;
#pragma unroll
        for (int e = 0; e < 32; ++e) { const float v = bf2f(vr[e]); o0[e] = o0[e] * a0 + p0 * v; o1[e] = o1[e] * a1 + p1 * v; }
    }
    const float lam = ((const float*)(p.ws + WS_SCAL))[0];
    float* dd = (float*)(p.ws + WS_DD) + (size_t)t * 512 + h * 128 + ch * 32;
    const float i0 = 1.f / l0, i1 = 1.f / l1;
#pragma unroll
    for (int e = 0; e < 32; ++e) dd[e] = o0[e] * i0 - lam * o1[e] * i1;
}
__global__ void sublnB(P p) {
    const int w = (blockIdx.x * blockDim.x + threadIdx.x) >> 6, lane = threadIdx.x & 63;
    if (w >= T * 4) return;
    const int t = w >> 2, h = w & 3;
    const float* dd = (const float*)(p.ws + WS_DD) + (size_t)t * 512 + h * 128;
    const float a = dd[lane], b = dd[lane + 64];
    float ss = a * a + b * b;
    for (int o = 1; o < 64; o <<= 1) ss += __shfl_xor(ss, o);
    const float r = rsqrtf(ss * (1.f / 128.f) + SUBLN_EPS) * (1.f - LAMBDA_INIT);
    bf16* mx = (bf16*)(p.ws + WS_MIXIN) + (size_t)t * DM + 512 + h * 128;
    mx[lane] = f2bf(a * r * p.subln_g[lane]); mx[lane + 64] = f2bf(b * r * p.subln_g[lane + 64]);
}
__global__ void softmaxM(P p) {
    const int w = (blockIdx.x * blockDim.x + threadIdx.x) >> 6, lane = threadIdx.x & 63;
    if (w >= T * 4) return;
    float* s = (float*)(p.ws + WS_SS) + (size_t)w * 256;
    float v[4]; float mx = -INFINITY;
#pragma unroll
    for (int j = 0; j < 4; ++j) { v[j] = s[lane + 64 * j]; mx = fmaxf(mx, v[j]); }
    for (int o = 1; o < 64; o <<= 1) mx = fmaxf(mx, __shfl_xor(mx, o));
    float sum = 0.f;
#pragma unroll
    for (int j = 0; j < 4; ++j) { v[j] = exp2f(v[j] - mx); sum += v[j]; }
    for (int o = 1; o < 64; o <<= 1) sum += __shfl_xor(sum, o);
    const float inv = 1.f / sum;
#pragma unroll
    for (int j = 0; j < 4; ++j) s[lane + 64 * j] = v[j] * inv;
}

__global__ void __launch_bounds__(256) ln_pass(const bf16* __restrict__ in, bf16* __restrict__ outp, const float* __restrict__ g, const float* __restrict__ b) {
    const int w = (blockIdx.x * blockDim.x + threadIdx.x) >> 6, lane = threadIdx.x & 63;
    if (w >= T) return;
    const bf16* r = in + (size_t)w * DM;
    float v[16]; float s = 0.f;
#pragma unroll
    for (int j = 0; j < 4; ++j) { const uint2 u = *(const uint2*)(r + j * 256 + lane * 4);
        v[4 * j] = __uint_as_float(u.x << 16); v[4 * j + 1] = __uint_as_float(u.x & 0xffff0000u); v[4 * j + 2] = __uint_as_float(u.y << 16); v[4 * j + 3] = __uint_as_float(u.y & 0xffff0000u); }
#pragma unroll
    for (int j = 0; j < 16; ++j) s += v[j];
    for (int o = 1; o < 64; o <<= 1) s += __shfl_xor(s, o);
    const float mu = s * (1.f / DM); float q = 0.f;
#pragma unroll
    for (int j = 0; j < 16; ++j) { v[j] -= mu; q += v[j] * v[j]; }
    for (int o = 1; o < 64; o <<= 1) q += __shfl_xor(q, o);
    const float rs = rsqrtf(q * (1.f / DM) + LN_EPS);
#pragma unroll
    for (int j = 0; j < 4; ++j) { const int c = j * 256 + lane * 4; const float4 gg = *(const float4*)(g + c), bb = *(const float4*)(b + c);
        uint2 u; u.x = (unsigned)f2bf(v[4 * j] * rs * gg.x + bb.x) | ((unsigned)f2bf(v[4 * j + 1] * rs * gg.y + bb.y) << 16);
        u.y = (unsigned)f2bf(v[4 * j + 2] * rs * gg.z + bb.z) | ((unsigned)f2bf(v[4 * j + 3] * rs * gg.w + bb.w) << 16);
        *(uint2*)(outp + (size_t)w * DM + c) = u; }
}

__global__ void __launch_bounds__(256) route_pass(P p) {
    const int w = (blockIdx.x * blockDim.x + threadIdx.x) >> 6, lane = threadIdx.x & 63;
    if (w >= T) return;
    const float4 lg = *(const float4*)((const float*)(p.ws + WS_LOGITS) + (size_t)w * NEXP + lane * 4);
    const float4 eb = *(const float4*)(p.e_bias + lane * 4);
    float sc[4] = {1.f / (1.f + expf(-lg.x)), 1.f / (1.f + expf(-lg.y)), 1.f / (1.f + expf(-lg.z)), 1.f / (1.f + expf(-lg.w))};
    float bs[4] = {sc[0] + eb.x, sc[1] + eb.y, sc[2] + eb.z, sc[3] + eb.w};
    float m1 = fmaxf(bs[0], bs[1]), m2 = fminf(bs[0], bs[1]);
    { const float c = bs[2]; const float n1 = fmaxf(m1, c); m2 = fmaxf(m2, fminf(m1, c)); m1 = n1; }
    { const float c = bs[3]; const float n1 = fmaxf(m1, c); m2 = fmaxf(m2, fminf(m1, c)); m1 = n1; }
#pragma unroll
    for (int o = 1; o < 8; o <<= 1) { const float b1 = __shfl_xor(m1, o), b2 = __shfl_xor(m2, o); const float n1 = fmaxf(m1, b1); m2 = fmaxf(fminf(m1, b1), fmaxf(m2, b2)); m1 = n1; }
    const float gs = m1 + m2; const int grp = lane >> 3;
    int rank = 0;
#pragma unroll
    for (int g2 = 0; g2 < 8; ++g2) { const float o = __shfl(gs, g2 * 8); rank += (o > gs || (o == gs && g2 < grp)) ? 1 : 0; }
    const bool sel = rank < 4;
    float cand[4];
#pragma unroll
    for (int j = 0; j < 4; ++j) cand[j] = sel ? bs[j] : -INFINITY;
    int myidx = 0; float myw = 0.f; float wsum = 0.f;
    for (int k = 0; k < TOPK; ++k) {
        float bv = cand[0]; int bi = lane * 4;
#pragma unroll
        for (int j = 1; j < 4; ++j) if (cand[j] > bv) { bv = cand[j]; bi = lane * 4 + j; }
#pragma unroll
        for (int o = 1; o < 64; o <<= 1) { const float ov = __shfl_xor(bv, o); const int oi = __shfl_xor(bi, o); if (ov > bv || (ov == bv && oi < bi)) { bv = ov; bi = oi; } }
        const int own = bi >> 2, el = bi & 3;
        const float sv = el == 0 ? sc[0] : (el == 1 ? sc[1] : (el == 2 ? sc[2] : sc[3]));
        const float wv = __shfl(sv, own);
        if (lane == own) { if (el == 0) cand[0] = -INFINITY; else if (el == 1) cand[1] = -INFINITY; else if (el == 2) cand[2] = -INFINITY; else cand[3] = -INFINITY; }
        wsum += wv;
        if (lane == k) { myidx = bi; myw = wv; }
    }
    if (lane < TOPK) {
        const float wn = myw / wsum * ROUTED_SCALE;
        const int rk = atomicAdd((int*)(p.ws + WS_CNT) + myidx, 1);
        ((int*)(p.ws + WS_RIDX))[(size_t)w * 8 + lane] = myidx;
        ((float*)(p.ws + WS_RW))[(size_t)w * 8 + lane] = wn;
        ((int*)(p.ws + WS_RRANK))[(size_t)w * 8 + lane] = rk;
    }
}
__global__ void scan_pass(P p) {
    __shared__ int sh[256];
    const int i = threadIdx.x; const int c = ((const int*)(p.ws + WS_CNT))[i];
    sh[i] = c; __syncthreads();
    for (int o = 1; o < 256; o <<= 1) { const int v = i >= o ? sh[i - o] : 0; __syncthreads(); sh[i] += v; __syncthreads(); }
    int* st = (int*)(p.ws + WS_START);
    st[i + 1] = sh[i]; if (i == 0) st[0] = 0;
}
__global__ void scatter_pass(P p) {
    const int i = blockIdx.x * blockDim.x + threadIdx.x;
    if (i >= T * 8) return;
    const int e = ((const int*)(p.ws + WS_RIDX))[i], rk = ((const int*)(p.ws + WS_RRANK))[i];
    const int pos = ((const int*)(p.ws + WS_START))[e] + rk;
    ((int*)(p.ws + WS_ROWTOK))[pos] = i >> 3;
    ((float*)(p.ws + WS_ROWW))[pos] = ((const float*)(p.ws + WS_RW))[i];
    ((int*)(p.ws + WS_POS))[i] = pos;
}
__global__ void __launch_bounds__(256) combine_pass(P p) {
    const int w = (blockIdx.x * blockDim.x + threadIdx.x) >> 6, lane = threadIdx.x & 63;
    if (w >= T) return;
    const bf16* h2 = (const bf16*)(p.ws + WS_H2) + (size_t)w * DM;
    const bf16* Y = (const bf16*)(p.ws + WS_Y);
    const int* pos = (const int*)(p.ws + WS_POS) + (size_t)w * 8;
    float v[16];
#pragma unroll
    for (int j = 0; j < 4; ++j) { const uint2 u = *(const uint2*)(h2 + j * 256 + lane * 4);
        v[4 * j] = DN_ALPHA * __uint_as_float(u.x << 16); v[4 * j + 1] = DN_ALPHA * __uint_as_float(u.x & 0xffff0000u); v[4 * j + 2] = DN_ALPHA * __uint_as_float(u.y << 16); v[4 * j + 3] = DN_ALPHA * __uint_as_float(u.y & 0xffff0000u); }
#pragma unroll
    for (int k = 0; k < 9; ++k) {
        const size_t row = k < 8 ? (size_t)pos[k < 8 ? k : 0] : (size_t)AROWS + w;
        const bf16* yr = Y + row * DM;
#pragma unroll
        for (int j = 0; j < 4; ++j) { const uint2 u = *(const uint2*)(yr + j * 256 + lane * 4);
            v[4 * j] += __uint_as_float(u.x << 16); v[4 * j + 1] += __uint_as_float(u.x & 0xffff0000u); v[4 * j + 2] += __uint_as_float(u.y << 16); v[4 * j + 3] += __uint_as_float(u.y & 0xffff0000u); }
    }
    float s = 0.f;
#pragma unroll
    for (int j = 0; j < 16; ++j) s += v[j];
    for (int o = 1; o < 64; o <<= 1) s += __shfl_xor(s, o);
    const float mu = s * (1.f / DM); float q = 0.f;
#pragma unroll
    for (int j = 0; j < 16; ++j) { v[j] -= mu; q += v[j] * v[j]; }
    for (int o = 1; o < 64; o <<= 1) q += __shfl_xor(q, o);
    const float rs = rsqrtf(q * (1.f / DM) + LN_EPS);
#pragma unroll
    for (int j = 0; j < 4; ++j) { const int c = j * 256 + lane * 4; const float4 gg = *(const float4*)(p.ln3_g + c), bb = *(const float4*)(p.ln3_b + c);
        float4 o; o.x = v[4 * j] * rs * gg.x + bb.x; o.y = v[4 * j + 1] * rs * gg.y + bb.y; o.z = v[4 * j + 2] * rs * gg.z + bb.z; o.w = v[4 * j + 3] * rs * gg.w + bb.w;
        *(float4*)(p.out + (size_t)w * DM + c) = o; }
}

#define LAS __attribute__((address_space(3)))
typedef short bf16x8 __attribute__((ext_vector_type(8)));
typedef short s16x4 __attribute__((ext_vector_type(4)));
typedef float f32x2 __attribute__((ext_vector_type(2)));
typedef float f32x4 __attribute__((ext_vector_type(4)));
typedef float f32x16 __attribute__((ext_vector_type(16)));
typedef unsigned u32x2 __attribute__((ext_vector_type(2)));
typedef unsigned u32x4 __attribute__((ext_vector_type(4)));
typedef __bf16 bf16x2_t __attribute__((ext_vector_type(2)));

constexpr int NWAVES = 8, NTHR = 512;
constexpr int LDS_BYTES = 147456;

__device__ __forceinline__ unsigned cvtpk(float lo, float hi) { f32x2 v = {lo, hi}; bf16x2_t b = __builtin_convertvector(v, bf16x2_t); return __builtin_bit_cast(unsigned, b); }
__device__ __forceinline__ int ld_i32_agent(const int* p) { return __hip_atomic_load(p, __ATOMIC_RELAXED, __HIP_MEMORY_SCOPE_AGENT); }
__device__ __forceinline__ float fast_exp2(float x) { return __builtin_amdgcn_exp2f(x); }
__device__ __forceinline__ float fast_rcp(float x) { return __builtin_amdgcn_rcpf(x); }

namespace gm {
constexpr int BM = 256, BK = 64, HALF = 128, HTB = HALF * BK * 2, STAGE_BYTES = 8 * HTB, NXCD = 8, WGM = 8;
__device__ __forceinline__ int lds_byte(int r, int c) { const int st = (r >> 4) * 2 + (c >> 5), rr = r & 15, cc = c & 31, ob = rr * 64 + cc * 2; return st * 1024 + (ob ^ (((ob >> 9) & 1) << 5)); }
__device__ __forceinline__ void stage_rc(int b, int& R, int& C) { const int st = b / 1024, sb = b % 1024, swz = sb ^ (((sb >> 9) & 1) << 5); R = (st >> 1) * 16 + swz / 64; C = (st & 1) * 32 + (swz % 64) / 2; }
__device__ __forceinline__ int perm32(int rho) { const int n = rho >> 4, i = rho & 15; return 8 * (i >> 2) + 4 * n + (i & 3); }

struct Unit { int pm, pn, e, nvalid, rowbase; const char* bptr; };

struct DenseSched {
    static constexpr bool GATHER_A = false;
    int nM, nN, nwg, G, c, K; const char* Bt;
    __device__ void init(int M, int N, int K_, const void* Bt_, int G_, int c_) { nM = M / BM; nN = N / BM; nwg = nM * nN; G = G_; c = c_; K = K_; Bt = (const char*)Bt_; }
    __device__ bool next(int i, Unit& u) const {
        const long L = (long)i * G + c; if (L >= nwg) return false;
        int wgid = (int)L; { const int q = nwg / NXCD, r = nwg % NXCD, xcd = wgid % NXCD, off = wgid / NXCD; wgid = (xcd < r ? xcd * (q + 1) : r * (q + 1) + (xcd - r) * q) + off; }
        const int nig = WGM * nN, gid = wgid / nig, fm = gid * WGM, gsz = (nM - fm) < WGM ? (nM - fm) : WGM;
        u.pm = fm + ((wgid % nig) % gsz); u.pn = (wgid % nig) / gsz; u.e = 0; u.nvalid = 256; u.rowbase = u.pm * 256;
        u.bptr = Bt + (size_t)u.pn * 256 * K * 2; return true;
    }
    __device__ unsigned aoff(const Unit& u, int r) const { return (unsigned)(u.rowbase + r) * (unsigned)(K * 2); }
    __device__ size_t abase(const Unit& u) const { return (size_t)u.rowbase * (size_t)(K * 2); }
};
template <int NPN_LOG2, int KB  , bool GATHER> struct MoeSched {
    static constexpr bool GATHER_A = GATHER;
    const int* tab; int nunits, G, c; const char* Wt; size_t estride; const int* rowtok;
    __device__ bool next(int i, Unit& u) const {
        int uidx; if (G == 256) { uidx = ((i * 8 + (c & 7)) * 32) + (c >> 3); } else uidx = i * G + c;
        if (uidx >= nunits) return false;
        const int rt = uidx >> NPN_LOG2; u.pn = uidx & ((1 << NPN_LOG2) - 1);
        u.e = __builtin_amdgcn_readfirstlane(ld_i32_agent(tab + 4 * rt)); u.pm = __builtin_amdgcn_readfirstlane(ld_i32_agent(tab + 4 * rt + 1));
        u.rowbase = __builtin_amdgcn_readfirstlane(ld_i32_agent(tab + 4 * rt + 2)); u.nvalid = __builtin_amdgcn_readfirstlane(ld_i32_agent(tab + 4 * rt + 3));
        u.bptr = Wt + (size_t)u.e * estride + (size_t)u.pn * 256 * KB * 2; return true;
    }
    __device__ unsigned aoff(const Unit& u, int r) const {
        if (GATHER) { int tok; if (u.e < NEXP) { const int rr = r < u.nvalid ? r : u.nvalid - 1; tok = ld_i32_agent(rowtok + u.rowbase + rr); } else tok = u.rowbase - AROWS + r; return (unsigned)tok * (unsigned)(KB * 2); }
        return (unsigned)(u.rowbase + r) * (unsigned)(KB * 2);
    }
    __device__ size_t abase(const Unit& u) const { return (size_t)u.rowbase * (size_t)(KB * 2); }
};

typedef f32x4 Acc[2][2][4][2];
__device__ __forceinline__ u32x4 pack8(const f32x4 a, const f32x4 b) { u32x4 w; w.x = cvtpk(a[0], a[1]); w.y = cvtpk(a[2], a[3]); w.z = cvtpk(b[0], b[1]); w.w = cvtpk(b[2], b[3]); return w; }

struct EpiInProj {
    static constexpr bool PERM = true; bf16* proj; const float* cs;
    __device__ __forceinline__ void operator()(const Acc& acc, const Unit& u, int wr, int wc, int fr, int fq) const {
#pragma unroll
        for (int ai = 0; ai < 2; ++ai)
#pragma unroll
            for (int m = 0; m < 4; ++m) { const int row = u.pm * 256 + ai * 128 + wr * 64 + m * 16 + fr;
#pragma unroll
                for (int bj = 0; bj < 2; ++bj) { const int c0 = u.pn * 256 + bj * 128 + wc * 32 + 8 * fq; const int seg = c0 >> 9;
                    f32x4 v0 = acc[ai][bj][m][0], v1 = acc[ai][bj][m][1];
                    if (seg != 2 && seg != 5) {
                        if ((c0 & 63) < 16) { const int j0 = (c0 & 63) >> 1; const f32x4 ca = *(const f32x4*)(cs + (size_t)row * 16 + 2 * j0), cb = *(const f32x4*)(cs + (size_t)row * 16 + 2 * j0 + 4);
                            { const float t1 = v0[0], t2 = v0[1]; v0[0] = t1 * ca[0] - t2 * ca[1]; v0[1] = t2 * ca[0] + t1 * ca[1]; }
                            { const float t1 = v0[2], t2 = v0[3]; v0[2] = t1 * ca[2] - t2 * ca[3]; v0[3] = t2 * ca[2] + t1 * ca[3]; }
                            { const float t1 = v1[0], t2 = v1[1]; v1[0] = t1 * cb[0] - t2 * cb[1]; v1[1] = t2 * cb[0] + t1 * cb[1]; }
                            { const float t1 = v1[2], t2 = v1[3]; v1[2] = t1 * cb[2] - t2 * cb[3]; v1[3] = t2 * cb[2] + t1 * cb[3]; } }
                        if (seg == 0 || seg == 3) { v0 = v0 * QSCALE64; v1 = v1 * QSCALE64; }
                    }
                    *(u32x4*)(proj + (size_t)row * INW + c0) = pack8(v0, v1); } }
    }
};
struct EpiOutProj {
    static constexpr bool PERM = true; bf16* y; const float* x;
    __device__ __forceinline__ void operator()(const Acc& acc, const Unit& u, int wr, int wc, int fr, int fq) const {
#pragma unroll
        for (int ai = 0; ai < 2; ++ai)
#pragma unroll
            for (int m = 0; m < 4; ++m) { const int row = u.pm * 256 + ai * 128 + wr * 64 + m * 16 + fr;
#pragma unroll
                for (int bj = 0; bj < 2; ++bj) { const int c0 = u.pn * 256 + bj * 128 + wc * 32 + 8 * fq;
                    const f32x4 x0 = *(const f32x4*)(x + (size_t)row * DM + c0), x1 = *(const f32x4*)(x + (size_t)row * DM + c0 + 4);
                    *(u32x4*)(y + (size_t)row * DM + c0) = pack8(x0 * DN_ALPHA + acc[ai][bj][m][0], x1 * DN_ALPHA + acc[ai][bj][m][1]); } }
    }
};
struct EpiScale {
    static constexpr bool PERM = true; bf16* o; int ldc; float sc;
    __device__ __forceinline__ void operator()(const Acc& acc, const Unit& u, int wr, int wc, int fr, int fq) const {
#pragma unroll
        for (int ai = 0; ai < 2; ++ai)
#pragma unroll
            for (int m = 0; m < 4; ++m) { const int row = u.pm * 256 + ai * 128 + wr * 64 + m * 16 + fr;
#pragma unroll
                for (int bj = 0; bj < 2; ++bj) { const int c0 = u.pn * 256 + bj * 128 + wc * 32 + 8 * fq;
                    *(u32x4*)(o + (size_t)row * ldc + c0) = pack8(acc[ai][bj][m][0] * sc, acc[ai][bj][m][1] * sc); } }
    }
};
struct EpiWo {
    static constexpr bool PERM = true; bf16* y; const bf16* h1;
    __device__ __forceinline__ void operator()(const Acc& acc, const Unit& u, int wr, int wc, int fr, int fq) const {
#pragma unroll
        for (int ai = 0; ai < 2; ++ai)
#pragma unroll
            for (int m = 0; m < 4; ++m) { const int row = u.pm * 256 + ai * 128 + wr * 64 + m * 16 + fr;
#pragma unroll
                for (int bj = 0; bj < 2; ++bj) { const int c0 = u.pn * 256 + bj * 128 + wc * 32 + 8 * fq;
                    const u32x4 hv = *(const u32x4*)(h1 + (size_t)row * DM + c0);
                    f32x4 a, b; a[0] = __uint_as_float(hv.x << 16); a[1] = __uint_as_float(hv.x & 0xffff0000u); a[2] = __uint_as_float(hv.y << 16); a[3] = __uint_as_float(hv.y & 0xffff0000u);
                    b[0] = __uint_as_float(hv.z << 16); b[1] = __uint_as_float(hv.z & 0xffff0000u); b[2] = __uint_as_float(hv.w << 16); b[3] = __uint_as_float(hv.w & 0xffff0000u);
                    *(u32x4*)(y + (size_t)row * DM + c0) = pack8(a * DN_ALPHA + acc[ai][bj][m][0], b * DN_ALPHA + acc[ai][bj][m][1]); } }
    }
};
struct EpiF32 {
    static constexpr bool PERM = false; float* C; int ldc;
    __device__ __forceinline__ void operator()(const Acc& acc, const Unit& u, int wr, int wc, int fr, int fq) const {
#pragma unroll
        for (int ai = 0; ai < 2; ++ai)
#pragma unroll
            for (int m = 0; m < 4; ++m) { const int row = u.pm * 256 + ai * 128 + wr * 64 + m * 16 + fr;
#pragma unroll
                for (int bj = 0; bj < 2; ++bj)
#pragma unroll
                    for (int n = 0; n < 2; ++n) *(f32x4*)(C + (size_t)row * ldc + u.pn * 256 + bj * 128 + wc * 32 + n * 16 + 4 * fq) = acc[ai][bj][m][n]; }
    }
};
__device__ __forceinline__ float silu_mul(float g, float uu) { return g * fast_rcp(1.f + fast_exp2(-g * LOG2E)) * uu; }
struct EpiMoe1 {
    static constexpr bool PERM = true; bf16* H;
    __device__ __forceinline__ void operator()(const Acc& acc, const Unit& u, int wr, int wc, int fr, int fq) const {
#pragma unroll
        for (int ai = 0; ai < 2; ++ai)
#pragma unroll
            for (int m = 0; m < 4; ++m) { const int rl = ai * 128 + wr * 64 + m * 16 + fr;
                if (rl < u.nvalid) { const f32x4 g0 = acc[ai][0][m][0], g1 = acc[ai][0][m][1], u0 = acc[ai][1][m][0], u1 = acc[ai][1][m][1]; f32x4 h0, h1;
#pragma unroll
                    for (int q = 0; q < 4; ++q) { h0[q] = silu_mul(g0[q], u0[q]); h1[q] = silu_mul(g1[q], u1[q]); }
                    *(u32x4*)(H + (size_t)(u.rowbase + rl) * EDIM + u.pn * 128 + wc * 32 + 8 * fq) = pack8(h0, h1); } }
    }
};
struct EpiMoe2 {
    static constexpr bool PERM = true; bf16* Y; const float* roww;
    __device__ __forceinline__ void operator()(const Acc& acc, const Unit& u, int wr, int wc, int fr, int fq) const {
#pragma unroll
        for (int ai = 0; ai < 2; ++ai)
#pragma unroll
            for (int m = 0; m < 4; ++m) { const int rl = ai * 128 + wr * 64 + m * 16 + fr;
                if (rl < u.nvalid) { const size_t row = (size_t)(u.rowbase + rl); const float w = u.e < NEXP ? __hip_atomic_load(roww + row, __ATOMIC_RELAXED, __HIP_MEMORY_SCOPE_AGENT) : 1.f;
#pragma unroll
                    for (int bj = 0; bj < 2; ++bj) *(u32x4*)(Y + row * DM + u.pn * 256 + bj * 128 + wc * 32 + 8 * fq) = pack8(acc[ai][bj][m][0] * w, acc[ai][bj][m][1] * w); } }
    }
};

template <class Epi, class Sched>
__device__ __forceinline__ void gemm_phase(LAS unsigned char* lds, const char* Abase, const int K, const Sched& S, const Epi& E) {
    const int tid = threadIdx.x, wid = __builtin_amdgcn_readfirstlane(tid >> 6), lane = tid & 63, wr = wid >> 2, wc = wid & 3, fr = lane & 15, fq = lane >> 4;
    const int nt = K / BK;
    int Rr[2]; unsigned Cb[2], voffB[2];
#pragma unroll
    for (int i = 0; i < 2; ++i) { int R, C; stage_rc(tid * 16 + i * 8192, R, C); const int Rb = Epi::PERM ? ((R & ~31) + perm32(R & 31)) : R; Rr[i] = R; Cb[i] = (unsigned)C * 2u; voffB[i] = (unsigned)(Rb * K + C) * 2u; }
    const size_t kstep = (size_t)(BK * 2);
    const size_t hstep = (size_t)HALF * K * 2;
    const unsigned ldsw = (unsigned)wid * 1024u;
    const int aoff = lds_byte(wr * 64 + fr, fq * 8), boff = lds_byte(wc * 32 + fr, fq * 8);
#define G_SA(b, h) (((b) * 2 + (h)) * HTB)
#define G_SB(b, h) ((4 + (b) * 2 + (h)) * HTB)
#define G_STAGE(bufoff, gbase, voff) do { _Pragma("unroll") for (int _i = 0; _i < 2; ++_i) \
        __builtin_amdgcn_global_load_lds((const unsigned*)((const char*)(gbase) + (voff)[_i]), (LAS unsigned*)(lds + (bufoff) + ldsw + _i * 8192), 16, 0, 0); } while (0)
#define G_LDA(dst, b, h) do { _Pragma("unroll") for (int m = 0; m < 4; ++m) _Pragma("unroll") for (int k = 0; k < 2; ++k) dst[m][k] = *(const LAS bf16x8*)(lds + G_SA(b, h) + aoff + m * 2048 + k * 1024); } while (0)
#define G_LDB(dst, b, h) do { _Pragma("unroll") for (int n = 0; n < 2; ++n) _Pragma("unroll") for (int k = 0; k < 2; ++k) dst[n][k] = *(const LAS bf16x8*)(lds + G_SB(b, h) + boff + n * 2048 + k * 1024); } while (0)
#define G_MMA(ai, bj, At, Bt) do { __builtin_amdgcn_s_setprio(1); _Pragma("unroll") for (int m = 0; m < 4; ++m) _Pragma("unroll") for (int n = 0; n < 2; ++n) _Pragma("unroll") for (int k = 0; k < 2; ++k) \
        acc[ai][bj][m][n] = __builtin_amdgcn_mfma_f32_16x16x32_bf16(Bt[n][k], At[m][k], acc[ai][bj][m][n], 0, 0, 0); __builtin_amdgcn_s_setprio(0); } while (0)
#define G_WAIT_V(n) asm volatile("s_waitcnt vmcnt(" #n ")" ::: "memory")
#define G_WAIT_L(n) asm volatile("s_waitcnt lgkmcnt(" #n ")" ::: "memory")
#define G_BAR __builtin_amdgcn_s_barrier()
#define G_SCHED __builtin_amdgcn_sched_barrier(0)
    Unit cur, nxt; int ui = 0;
    if (!S.next(0, cur)) return;
    Acc acc;
#pragma unroll
    for (int a = 0; a < 2; ++a)
#pragma unroll
        for (int b = 0; b < 2; ++b)
#pragma unroll
            for (int m = 0; m < 4; ++m)
#pragma unroll
                for (int n = 0; n < 2; ++n) acc[a][b][m][n] = (f32x4){0.f, 0.f, 0.f, 0.f};
    bf16x8 At[4][2], B0[2][2], B1[2][2];
    constexpr bool GA = Sched::GATHER_A;
    unsigned vAc0[2], vAc1[2], vAn0[2], vAn1[2];
    const char* cA = Abase; const char* nA = Abase;
#pragma unroll
    for (int i = 0; i < 2; ++i) {
        if constexpr (GA) { vAc0[i] = S.aoff(cur, Rr[i]) + Cb[i]; vAc1[i] = S.aoff(cur, 128 + Rr[i]) + Cb[i]; }
        else { vAc0[i] = (unsigned)Rr[i] * (unsigned)(K * 2) + Cb[i]; vAc1[i] = (unsigned)(128 + Rr[i]) * (unsigned)(K * 2) + Cb[i]; vAn0[i] = vAc0[i]; vAn1[i] = vAc1[i]; }
    }
    if constexpr (!GA) cA = Abase + S.abase(cur);
    const char* cB = cur.bptr;
    G_STAGE(G_SB(0, 0), cB, voffB); G_STAGE(G_SB(0, 1), cB + hstep, voffB); G_STAGE(G_SA(0, 0), cA, vAc0); G_STAGE(G_SA(0, 1), cA, vAc1);
    if (wr == 1) G_BAR;
    G_WAIT_V(2); G_BAR;
    G_STAGE(G_SB(1, 0), cB + kstep, voffB); G_STAGE(G_SA(1, 0), cA + kstep, vAc0); G_STAGE(G_SB(1, 1), cB + hstep + kstep, voffB);
    G_WAIT_V(6); G_BAR;
    for (;;) {
        const bool has_next = S.next(ui + 1, nxt);
        const char* nB = has_next ? nxt.bptr : cB;
        if constexpr (GA) {
#pragma unroll
            for (int i = 0; i < 2; ++i) { vAn0[i] = has_next ? S.aoff(nxt, Rr[i]) + Cb[i] : vAc0[i]; vAn1[i] = has_next ? S.aoff(nxt, 128 + Rr[i]) + Cb[i] : vAc1[i]; }
        } else { nA = has_next ? Abase + S.abase(nxt) : cA; }
#pragma unroll 1
        for (int t = 0; t < nt; t += 2) {
            const bool last = (t == nt - 2);
            const char* a1 = cA + (size_t)(t + 1) * kstep;
            const char* a2 = last ? nA : cA + (size_t)(t + 2) * kstep; const char* b2 = last ? nB : cB + (size_t)(t + 2) * kstep;
            const char* a3 = a2 + kstep; const char* b3 = b2 + kstep;
            unsigned v20[2], v21[2];
#pragma unroll
            for (int i = 0; i < 2; ++i) { if constexpr (GA) { v20[i] = last ? vAn0[i] : vAc0[i]; v21[i] = last ? vAn1[i] : vAc1[i]; } else { v20[i] = vAc0[i]; v21[i] = vAc1[i]; } }
            G_LDB(B0, 0, 0); G_LDB(B1, 0, 1); G_SCHED; G_LDA(At, 0, 0); G_STAGE(G_SA(1, 1), a1, vAc1);
            G_WAIT_V(8); G_WAIT_L(0); G_BAR; G_MMA(0, 0, At, B0); G_MMA(0, 1, At, B1); G_BAR; G_SCHED;
            G_LDA(At, 0, 1); G_STAGE(G_SB(0, 0), b2, voffB); G_STAGE(G_SB(0, 1), b2 + hstep, voffB); G_STAGE(G_SA(0, 0), a2, v20);
            G_WAIT_V(8); G_WAIT_L(0); G_BAR; G_MMA(1, 0, At, B0); G_MMA(1, 1, At, B1); G_BAR; G_SCHED;
            G_LDB(B0, 1, 0); G_LDB(B1, 1, 1); G_SCHED; G_LDA(At, 1, 0); G_STAGE(G_SA(0, 1), a2, v21);
            G_WAIT_V(8); G_WAIT_L(0); G_BAR; G_MMA(0, 0, At, B0); G_MMA(0, 1, At, B1); G_BAR; G_SCHED;
            G_LDA(At, 1, 1); G_STAGE(G_SB(1, 0), b3, voffB); G_STAGE(G_SB(1, 1), b3 + hstep, voffB); G_STAGE(G_SA(1, 0), a3, v20);
            G_WAIT_V(8); G_WAIT_L(0); G_BAR; G_MMA(1, 0, At, B0); G_MMA(1, 1, At, B1); G_BAR; G_SCHED;
        }
        if (wr == 0) G_BAR;
        E(acc, cur, wr, wc, fr, fq);
        if (!has_next) break;
#pragma unroll
        for (int a = 0; a < 2; ++a)
#pragma unroll
            for (int b = 0; b < 2; ++b)
#pragma unroll
                for (int m = 0; m < 4; ++m)
#pragma unroll
                    for (int n = 0; n < 2; ++n) acc[a][b][m][n] = (f32x4){0.f, 0.f, 0.f, 0.f};
        cur = nxt; cB = nB; ++ui;
        if constexpr (GA) {
#pragma unroll
            for (int i = 0; i < 2; ++i) { vAc0[i] = vAn0[i]; vAc1[i] = vAn1[i]; }
        } else cA = nA;
        if (wr == 1) G_BAR;
    }
    G_WAIT_V(0);
    G_BAR;
#undef G_SA
#undef G_SB
#undef G_STAGE
#undef G_LDA
#undef G_LDB
#undef G_MMA
#undef G_WAIT_V
#undef G_WAIT_L
#undef G_BAR
#undef G_SCHED
}
}

namespace fa {
__device__ __forceinline__ int crow(int r, int hi) { return (r & 3) + 8 * (r >> 2) + 4 * hi; }
typedef short v4i16_t __attribute__((ext_vector_type(4)));
__device__ __forceinline__ s16x4 vtr(const LAS char* p) { return __builtin_bit_cast(s16x4, __builtin_amdgcn_ds_read_tr16_b64_v4i16((LAS v4i16_t*)p)); }
__device__ __forceinline__ float halfmax(float m) { auto rr = __builtin_amdgcn_permlane32_swap(__float_as_uint(m), __float_as_uint(m), false, false); return fmaxf(__uint_as_float(rr[0]), __uint_as_float(rr[1])); }
__device__ __forceinline__ float halfsum(float m) { auto rr = __builtin_amdgcn_permlane32_swap(__float_as_uint(m), __float_as_uint(m), false, false); return __uint_as_float(rr[0]) + __uint_as_float(rr[1]); }

template <int NQ, int KSTR> __device__ __forceinline__ f32x16 qk(const LAS char* Kl, int j, const bf16x8 (&qf)[NQ], int lane) {
    f32x16 s = {0.f, 0.f, 0.f, 0.f, 0.f, 0.f, 0.f, 0.f, 0.f, 0.f, 0.f, 0.f, 0.f, 0.f, 0.f, 0.f};
    const LAS char* kp = Kl + (32 * j + (lane & 31)) * KSTR + (lane >> 5) * 16;
#pragma unroll
    for (int ds = 0; ds < NQ; ++ds) { const bf16x8 kf = *(const LAS bf16x8*)(kp + ds * 32); s = __builtin_amdgcn_mfma_f32_32x32x16_bf16(kf, qf[ds], s, 0, 0, 0); }
    return s;
}
template <int NO> __device__ __forceinline__ void softmax_step(f32x16& p0, f32x16& p1, float& m, float& l, f32x16 (&o)[NO], bf16x8 (&pf)[4]) {
    float mx = fmaxf(p0[0], p1[0]);
#pragma unroll
    for (int r = 1; r < 16; ++r) mx = fmaxf(mx, fmaxf(p0[r], p1[r]));
    mx = halfmax(mx);
    const float mn = fmaxf(m, mx), mu = (mn == -INFINITY) ? 0.f : mn;
    const float al = fast_exp2(m - mu);
    float sum = 0.f;
#pragma unroll
    for (int r = 0; r < 16; ++r) { p0[r] = fast_exp2(p0[r] - mu); p1[r] = fast_exp2(p1[r] - mu); sum += p0[r] + p1[r]; }
    l = l * al + sum; m = mn;
#pragma unroll
    for (int d = 0; d < NO; ++d)
#pragma unroll
        for (int r = 0; r < 16; ++r) o[d][r] *= al;
#pragma unroll
    for (int s = 0; s < 2; ++s) {
        u32x4 a, b;
        a.x = cvtpk(p0[8 * s], p0[8 * s + 1]); a.y = cvtpk(p0[8 * s + 2], p0[8 * s + 3]); a.z = cvtpk(p0[8 * s + 4], p0[8 * s + 5]); a.w = cvtpk(p0[8 * s + 6], p0[8 * s + 7]);
        b.x = cvtpk(p1[8 * s], p1[8 * s + 1]); b.y = cvtpk(p1[8 * s + 2], p1[8 * s + 3]); b.z = cvtpk(p1[8 * s + 4], p1[8 * s + 5]); b.w = cvtpk(p1[8 * s + 6], p1[8 * s + 7]);
        pf[s] = __builtin_bit_cast(bf16x8, a); pf[2 + s] = __builtin_bit_cast(bf16x8, b);
    }
}
template <int NO, int VSTR> __device__ __forceinline__ void pv(f32x16 (&o)[NO], const LAS char* Vl, const bf16x8 (&pf)[4], int lane) {
    const LAS char* vb = Vl + (4 * (lane >> 5) + ((lane & 15) >> 2)) * VSTR + (16 * ((lane >> 4) & 1) + 4 * (lane & 3)) * 2;
#pragma unroll
    for (int d = 0; d < NO; ++d)
#pragma unroll
        for (int ks = 0; ks < 4; ++ks) {
            const s16x4 lo = vtr(vb + (16 * ks) * VSTR + d * 64), hi = vtr(vb + (16 * ks + 8) * VSTR + d * 64);
            const bf16x8 vf = (bf16x8){lo[0], lo[1], lo[2], lo[3], hi[0], hi[1], hi[2], hi[3]};
            o[d] = __builtin_amdgcn_mfma_f32_32x32x16_bf16(vf, pf[ks], o[d], 0, 0, 0);
        }
}
template <int NO> __device__ __forceinline__ void store_o(const f32x16 (&o)[NO], float inv, bf16* rowp, int hi) {
#pragma unroll
    for (int d = 0; d < NO; ++d)
#pragma unroll
        for (int g = 0; g < 4; ++g) { u32x2 w; w.x = cvtpk(o[d][4 * g] * inv, o[d][4 * g + 1] * inv); w.y = cvtpk(o[d][4 * g + 2] * inv, o[d][4 * g + 3] * inv);
            *(u32x2*)(rowp + 32 * d + 8 * g + 4 * hi) = w; }
}
}

__device__ __forceinline__ void diff_unit(const P& p, int b, int h, int qb, LAS unsigned char* ldsu, float lam) {
    constexpr int KSTR = 144, VSTR = 320, KB = 64 * KSTR, VB = 64 * VSTR, BUF = 2 * KB + VB;
    LAS char* lds = (LAS char*)ldsu;
    const int tid = threadIdx.x, lane = tid & 63, wid = __builtin_amdgcn_readfirstlane(tid >> 6), hi = lane >> 5;
    const int comp = wid >> 2, w4 = wid & 3;
    const bf16* proj = (const bf16*)(p.ws + WS_PROJ);
    const size_t rb = (size_t)b * SEQ;
    const int q0 = qb * 128, qmin = q0 + 32 * w4, qpos = qmin + (lane & 31);
    bf16x8 qf[4];
#pragma unroll
    for (int ds = 0; ds < 4; ++ds) qf[ds] = *(const bf16x8*)(proj + (rb + qpos) * INW + 1536 + h * 128 + comp * 64 + ds * 16 + hi * 8);
    const int ntiles = 2 * qb + 2;
    const int krow = tid >> 3, kch = tid & 7;
    const bf16* ksrc = proj + (rb + krow) * INW + 2048 + h * 128 + kch * 8;
    const int vrow0 = tid >> 4, vch = tid & 15;
    const bf16* vsrc = proj + (rb + vrow0) * INW + 2560 + h * 128 + vch * 8;
    const int kdst = krow * KSTR + kch * 16, vdst = 2 * KB + vrow0 * VSTR + vch * 16;
    u32x4 rk0, rk1, rv0, rv1;
    { rk0 = *(const u32x4*)(ksrc); rk1 = *(const u32x4*)(ksrc + 64); rv0 = *(const u32x4*)(vsrc); rv1 = *(const u32x4*)(vsrc + (size_t)32 * INW); }
    *(LAS u32x4*)(lds + kdst) = rk0; *(LAS u32x4*)(lds + KB + kdst) = rk1; *(LAS u32x4*)(lds + vdst) = rv0; *(LAS u32x4*)(lds + vdst + 32 * VSTR) = rv1;
    __syncthreads();
    float m = -INFINITY, l = 0.f; f32x16 o[4];
#pragma unroll
    for (int d = 0; d < 4; ++d)
#pragma unroll
        for (int r = 0; r < 16; ++r) o[d][r] = 0.f;
    for (int kt = 0; kt < ntiles; ++kt) {
        const bool more = kt + 1 < ntiles;
        if (more) { const size_t off = (size_t)(kt + 1) * 64 * INW; rk0 = *(const u32x4*)(ksrc + off); rk1 = *(const u32x4*)(ksrc + off + 64); rv0 = *(const u32x4*)(vsrc + off); rv1 = *(const u32x4*)(vsrc + off + (size_t)32 * INW); }
        const LAS char* buf = lds + (kt & 1) * BUF;
        const int k0 = kt * 64;
        if (k0 <= qmin + 31) {
            const LAS char* Kl = buf + comp * KB;
            f32x16 p0 = fa::qk<4, KSTR>(Kl, 0, qf, lane), p1 = fa::qk<4, KSTR>(Kl, 1, qf, lane);
            if (k0 + 63 > qmin) {
#pragma unroll
                for (int r = 0; r < 16; ++r) { const int key = k0 + fa::crow(r, hi); if (key > qpos) p0[r] = -INFINITY; if (key + 32 > qpos) p1[r] = -INFINITY; }
            }
            bf16x8 pf[4];
            fa::softmax_step<4>(p0, p1, m, l, o, pf);
            fa::pv<4, VSTR>(o, buf + 2 * KB, pf, lane);
        }
        if (more) { LAS char* nb = lds + ((kt + 1) & 1) * BUF; *(LAS u32x4*)(nb + kdst) = rk0; *(LAS u32x4*)(nb + KB + kdst) = rk1; *(LAS u32x4*)(nb + vdst) = rv0; *(LAS u32x4*)(nb + vdst + 32 * VSTR) = rv1; }
        __syncthreads();
    }
    l = fa::halfsum(l);
    const float inv = fast_rcp(l);
    LAS float* ex = (LAS float*)lds + w4 * 4096;
    if (comp == 1) {
#pragma unroll
        for (int d = 0; d < 4; ++d)
#pragma unroll
            for (int r = 0; r < 16; ++r) ex[(d * 16 + r) * 64 + lane] = o[d][r] * inv;
    }
    __syncthreads();
    if (comp == 0) {
        float ss = 0.f;
#pragma unroll
        for (int d = 0; d < 4; ++d)
#pragma unroll
            for (int r = 0; r < 16; ++r) { const float v = o[d][r] * inv - lam * ex[(d * 16 + r) * 64 + lane]; o[d][r] = v; ss += v * v; }
        ss = fa::halfsum(ss);
        const float rs = rsqrtf(ss * (1.f / 128.f) + SUBLN_EPS) * (1.f - LAMBDA_INIT);
        bf16* rowp = (bf16*)(p.ws + WS_MIXIN) + (rb + qpos) * DM + 512 + h * 128;
#pragma unroll
        for (int d = 0; d < 4; ++d)
#pragma unroll
            for (int g = 0; g < 4; ++g) { const int dd = 32 * d + 8 * g + 4 * hi; const f32x4 gg = *(const f32x4*)(p.subln_g + dd);
                u32x2 w; w.x = cvtpk(o[d][4 * g] * rs * gg[0], o[d][4 * g + 1] * rs * gg[1]); w.y = cvtpk(o[d][4 * g + 2] * rs * gg[2], o[d][4 * g + 3] * rs * gg[3]);
                *(u32x2*)(rowp + dd) = w; }
    }
    __syncthreads();
}

__device__ __forceinline__ void dil_unit(const P& p, int b, int h, int br, int grp, LAS unsigned char* ldsu) {
    constexpr int KSTR = 144, VSTR = 192, KALL = 384 * KSTR;
    LAS char* lds = (LAS char*)ldsu;
    const int tid = threadIdx.x, lane = tid & 63, wid = __builtin_amdgcn_readfirstlane(tid >> 6), hi = lane >> 5;
    const int dil = br == 0 ? 1 : (br == 1 ? 4 : 16), ngr = 16 / dil, res = grp / ngr, i0 = 256 * (grp % ngr);
    const bf16* proj = (const bf16*)(p.ws + WS_PROJ);
    const size_t rb = (size_t)b * SEQ;
#pragma unroll
    for (int i = 0; i < 6; ++i) { const int pidx = tid + 512 * i, row = pidx >> 3, ch = pidx & 7; int kidx = i0 - 128 + row; if (kidx < 0) kidx = 0;
        const bf16* src = proj + (rb + (size_t)kidx * dil + res) * INW + h * 64 + ch * 8;
        const u32x4 kv = *(const u32x4*)(src + 512), vv = *(const u32x4*)(src + 1024);
        *(LAS u32x4*)(lds + row * KSTR + ch * 16) = kv; *(LAS u32x4*)(lds + KALL + row * VSTR + ch * 16) = vv; }
    const int qi = i0 + 32 * wid + (lane & 31);
    const size_t qrow = rb + (size_t)qi * dil + res;
    bf16x8 qf[4];
#pragma unroll
    for (int ds = 0; ds < 4; ++ds) qf[ds] = *(const bf16x8*)(proj + qrow * INW + h * 64 + ds * 16 + hi * 8);
    __syncthreads();
    float m = -INFINITY, l = 0.f; f32x16 o[2];
#pragma unroll
    for (int d = 0; d < 2; ++d)
#pragma unroll
        for (int r = 0; r < 16; ++r) o[d][r] = 0.f;
#pragma unroll 1
    for (int kk = 0; kk < 3; ++kk) {
        const int kt = (wid >> 1) + kk;
        const LAS char* Kl = lds + kt * 64 * KSTR;
        f32x16 p0 = fa::qk<4, KSTR>(Kl, 0, qf, lane), p1 = fa::qk<4, KSTR>(Kl, 1, qf, lane);
        const int kb = i0 - 128 + 64 * kt;
#pragma unroll
        for (int r = 0; r < 16; ++r) { const int k0i = kb + fa::crow(r, hi), k1i = k0i + 32;
            if (k0i < 0 || k0i > qi || qi - k0i > 128) p0[r] = -INFINITY;
            if (k1i < 0 || k1i > qi || qi - k1i > 128) p1[r] = -INFINITY; }
        bf16x8 pf[4];
        fa::softmax_step<2>(p0, p1, m, l, o, pf);
        fa::pv<2, VSTR>(o, lds + KALL + kt * 64 * VSTR, pf, lane);
    }
    l = fa::halfsum(l);
    const float inv = fast_rcp(l);
    fa::store_o<2>(o, inv, (bf16*)(p.ws + WS_PARTA) + ((size_t)br * T + qrow) * 512 + h * 64, hi);
    if (hi == 0) ((float*)(p.ws + WS_LSEA))[((size_t)br * T + qrow) * 8 + h] = m + log2f(l);
    __syncthreads();
}

__device__ __forceinline__ void mem_unit(const P& p, int b, int h, int qblk, LAS unsigned char* ldsu) {
    constexpr int KSTR = 528, VSTR = 192, KB = 64 * KSTR, VB = 64 * VSTR, BUF = KB + VB;
    LAS char* lds = (LAS char*)ldsu;
    const int tid = threadIdx.x, lane = tid & 63, wid = __builtin_amdgcn_readfirstlane(tid >> 6), hi = lane >> 5;
    const bf16* qm = (const bf16*)(p.ws + WS_QM); const bf16* kvm = (const bf16*)(p.ws + WS_KVM);
    const size_t qrow = (size_t)b * SEQ + qblk * 256 + 32 * wid + (lane & 31);
    bf16x8 qf[16];
#pragma unroll
    for (int ds = 0; ds < 16; ++ds) qf[ds] = *(const bf16x8*)(qm + qrow * DM + h * 256 + ds * 16 + hi * 8);
    const bf16* kbase = kvm + (size_t)(b * MEML) * 2048 + h * 256;
#pragma unroll 1
    for (int quarter = 0; quarter < 4; ++quarter) {
        const bf16* vbase = kvm + (size_t)(b * MEML) * 2048 + 1024 + h * 256 + quarter * 64;
        u32x4 rk[4], rv;
#define MEM_LOAD(kt) do { _Pragma("unroll") for (int i = 0; i < 4; ++i) { const int pidx = tid + 512 * i, row = pidx >> 5, ch = pidx & 31; rk[i] = *(const u32x4*)(kbase + (size_t)((kt) * 64 + row) * 2048 + ch * 8); } \
        { const int row = tid >> 3, ch = tid & 7; rv = *(const u32x4*)(vbase + (size_t)((kt) * 64 + row) * 2048 + ch * 8); } } while (0)
#define MEM_WRITE(bufp) do { _Pragma("unroll") for (int i = 0; i < 4; ++i) { const int pidx = tid + 512 * i, row = pidx >> 5, ch = pidx & 31; *(LAS u32x4*)((bufp) + row * KSTR + ch * 16) = rk[i]; } \
        { const int row = tid >> 3, ch = tid & 7; *(LAS u32x4*)((bufp) + KB + row * VSTR + ch * 16) = rv; } } while (0)
        MEM_LOAD(0); MEM_WRITE(lds);
        __syncthreads();
        float m = -INFINITY, l = 0.f; f32x16 o[2];
#pragma unroll
        for (int d = 0; d < 2; ++d)
#pragma unroll
            for (int r = 0; r < 16; ++r) o[d][r] = 0.f;
#pragma unroll 1
        for (int kt = 0; kt < 4; ++kt) {
            const bool more = kt < 3;
            if (more) MEM_LOAD(kt + 1);
            const LAS char* buf = lds + (kt & 1) * BUF;
            f32x16 p0 = fa::qk<16, KSTR>(buf, 0, qf, lane), p1 = fa::qk<16, KSTR>(buf, 1, qf, lane);
            bf16x8 pf[4];
            fa::softmax_step<2>(p0, p1, m, l, o, pf);
            fa::pv<2, VSTR>(o, buf + KB, pf, lane);
            if (more) { LAS char* nb = lds + ((kt + 1) & 1) * BUF; MEM_WRITE(nb); }
            __syncthreads();
        }
#undef MEM_LOAD
#undef MEM_WRITE
        l = fa::halfsum(l);
        fa::store_o<2>(o, fast_rcp(l), (bf16*)(p.ws + WS_MO) + qrow * DM + h * 256 + quarter * 64, hi);
    }
}

struct Ctx { int tid, lane, wave, G, vcu, gw, ngw; LAS unsigned char* lds; };

template <class RowMap> __device__ __forceinline__ void transpose_tile(const float* W, int N, int k0, int n0, bf16* dst, int dstK, LAS float* scr, int lane, const RowMap& rm) {
    f32x4 v[16];
#pragma unroll
    for (int i = 0; i < 16; ++i) v[i] = *(const f32x4*)(W + (size_t)(k0 + 4 * i + (lane >> 4)) * N + n0 + (lane & 15) * 4);
#pragma unroll
    for (int i = 0; i < 16; ++i) { LAS float* s = scr + (4 * i + (lane >> 4)) * 65 + (lane & 15) * 4; s[0] = v[i][0]; s[1] = v[i][1]; s[2] = v[i][2]; s[3] = v[i][3]; }
    asm volatile("s_waitcnt lgkmcnt(0)" ::: "memory");
    const int c = lane & 7;
#pragma unroll
    for (int j = 0; j < 8; ++j) { const int n = (lane >> 3) + 8 * j; const LAS float* s = scr + (8 * c) * 65 + n;
        u32x4 w; w.x = cvtpk(s[0], s[65]); w.y = cvtpk(s[2 * 65], s[3 * 65]); w.z = cvtpk(s[4 * 65], s[5 * 65]); w.w = cvtpk(s[6 * 65], s[7 * 65]);
        *(u32x4*)(dst + (size_t)rm(n0 + n) * dstK + k0 + 8 * c) = w; }
    asm volatile("s_waitcnt lgkmcnt(0)" ::: "memory");
}
struct RmId { __device__ int operator()(int n) const { return n; } };
struct RmInProj { __device__ int operator()(int n) const { const int seg = n >> 9; if (seg == 2 || seg == 5) return n; const int d = n & 63; return (n & ~63) | (d < 16 ? 2 * (d & 7) + (d >> 3) : d); } };
struct RmGU { int up; __device__ int operator()(int n) const { return (n >> 7) * 256 + up * 128 + (n & 127); } };

__device__ __forceinline__ void phase_prologue(const P& p, const Ctx& c) {
    LAS float* scr = (LAS float*)(c.lds + c.wave * 16640);
    unsigned char* ws = p.ws;
    constexpr int I_IN = 16 * 48, I_SQ = 16 * 16, I_KV = 16 * 32, I_R = 16 * 4, I_E = 64;
    constexpr int ND = I_IN + 3 * I_SQ + I_KV + I_R;
    const int NIT = ND + 3 * I_E * (NEXP + 1);
    for (int it = c.gw; it < NIT; it += c.ngw) {
        int r = it;
        if (r < I_IN) { transpose_tile(p.w_in, INW, (r / 48) * 64, (r % 48) * 64, (bf16*)(ws + WS_WINT), DM, scr, c.lane, RmInProj{}); continue; } r -= I_IN;
        if (r < I_SQ) { transpose_tile(p.w_out, DM, (r / 16) * 64, (r % 16) * 64, (bf16*)(ws + WS_WOUTT), DM, scr, c.lane, RmId{}); continue; } r -= I_SQ;
        if (r < I_SQ) { transpose_tile(p.wq, DM, (r / 16) * 64, (r % 16) * 64, (bf16*)(ws + WS_WQT), DM, scr, c.lane, RmId{}); continue; } r -= I_SQ;
        if (r < I_KV) { transpose_tile(p.wkv, 2048, (r / 32) * 64, (r % 32) * 64, (bf16*)(ws + WS_WKVT), DM, scr, c.lane, RmId{}); continue; } r -= I_KV;
        if (r < I_SQ) { transpose_tile(p.wo, DM, (r / 16) * 64, (r % 16) * 64, (bf16*)(ws + WS_WOT), DM, scr, c.lane, RmId{}); continue; } r -= I_SQ;
        if (r < I_R) { transpose_tile(p.w_router, NEXP, (r / 4) * 64, (r % 4) * 64, (bf16*)(ws + WS_WRT), DM, scr, c.lane, RmId{}); continue; } r -= I_R;
        const int e = r / (3 * I_E), q = r % (3 * I_E), which = q / I_E, ti = q % I_E;
        if (which == 0) { const float* W = e < NEXP ? p.w_gate + (size_t)e * DM * EDIM : p.ws_gate; transpose_tile(W, EDIM, (ti / 4) * 64, (ti % 4) * 64, (bf16*)(ws + WS_WTGU) + (size_t)e * 512 * DM, DM, scr, c.lane, RmGU{0}); }
        else if (which == 1) { const float* W = e < NEXP ? p.w_up + (size_t)e * DM * EDIM : p.ws_up; transpose_tile(W, EDIM, (ti / 4) * 64, (ti % 4) * 64, (bf16*)(ws + WS_WTGU) + (size_t)e * 512 * DM, DM, scr, c.lane, RmGU{1}); }
        else { const float* W = e < NEXP ? p.w_down + (size_t)e * EDIM * DM : p.ws_down; transpose_tile(W, DM, (ti / 16) * 64, (ti % 16) * 64, (bf16*)(ws + WS_WTD) + (size_t)e * DM * EDIM, EDIM, scr, c.lane, RmId{}); }
    }
    const int gt = c.vcu * NTHR + c.tid, ngt = c.G * NTHR;
    for (int i = gt; i < T * DM / 8; i += ngt) { const f32x4 a = *(const f32x4*)(p.x + (size_t)i * 8), b = *(const f32x4*)(p.x + (size_t)i * 8 + 4); *(u32x4*)((bf16*)(ws + WS_XB) + (size_t)i * 8) = gm::pack8(a, b); }
    for (int i = gt; i < BATCH * MEML * DM / 8; i += ngt) { const f32x4 a = *(const f32x4*)(p.mem + (size_t)i * 8), b = *(const f32x4*)(p.mem + (size_t)i * 8 + 4); *(u32x4*)((bf16*)(ws + WS_MEMB) + (size_t)i * 8) = gm::pack8(a, b); }
    for (int i = gt; i < T * 8; i += ngt) { const int t = i >> 3, j = i & 7; const float inv = powf(500000.0f, -(float)(2 * j) / 16.0f); const float ang = (float)p.pos[t] * inv;
        ((float2*)(ws + WS_CS))[i] = make_float2(cosf(ang), sinf(ang)); }
    if (gt < 256) ((int*)(ws + WS_CNT))[gt] = 0;
    if (gt == 0) { float a = 0.f, b = 0.f; for (int k = 0; k < 64; ++k) { a += p.lq1[k] * p.lk1[k]; b += p.lq2[k] * p.lk2[k]; } ((float*)(ws + WS_SCAL))[0] = expf(a) - expf(b) + LAMBDA_INIT; }
}

__device__ __forceinline__ void unpack8(const u32x4 u, float (&v)[8]) {
    v[0] = __uint_as_float(u.x << 16); v[1] = __uint_as_float(u.x & 0xffff0000u); v[2] = __uint_as_float(u.y << 16); v[3] = __uint_as_float(u.y & 0xffff0000u);
    v[4] = __uint_as_float(u.z << 16); v[5] = __uint_as_float(u.z & 0xffff0000u); v[6] = __uint_as_float(u.w << 16); v[7] = __uint_as_float(u.w & 0xffff0000u);
}
__device__ __forceinline__ void phase_merge(const P& p, const Ctx& c) {
    const int gt = c.vcu * NTHR + c.tid, ngt = c.G * NTHR;
    const float* lse = (const float*)(p.ws + WS_LSEA); const bf16* pa = (const bf16*)(p.ws + WS_PARTA); bf16* mx = (bf16*)(p.ws + WS_MIXIN);
    for (int i = gt; i < T * 64; i += ngt) {
        const int t = i >> 6, c8 = (i & 63) * 8, h = c8 >> 6;
        const float l0 = lse[(size_t)t * 8 + h], l1 = lse[((size_t)T + t) * 8 + h], l2 = lse[((size_t)2 * T + t) * 8 + h];
        const float mxl = fmaxf(l0, fmaxf(l1, l2));
        float w0 = fast_exp2(l0 - mxl), w1 = fast_exp2(l1 - mxl), w2 = fast_exp2(l2 - mxl); const float inv = 1.f / (w0 + w1 + w2); w0 *= inv; w1 *= inv; w2 *= inv;
        float a[8], b[8], d[8];
        unpack8(*(const u32x4*)(pa + (size_t)t * 512 + c8), a); unpack8(*(const u32x4*)(pa + ((size_t)T + t) * 512 + c8), b); unpack8(*(const u32x4*)(pa + ((size_t)2 * T + t) * 512 + c8), d);
        u32x4 o; o.x = cvtpk(w0 * a[0] + w1 * b[0] + w2 * d[0], w0 * a[1] + w1 * b[1] + w2 * d[1]); o.y = cvtpk(w0 * a[2] + w1 * b[2] + w2 * d[2], w0 * a[3] + w1 * b[3] + w2 * d[3]);
        o.z = cvtpk(w0 * a[4] + w1 * b[4] + w2 * d[4], w0 * a[5] + w1 * b[5] + w2 * d[5]); o.w = cvtpk(w0 * a[6] + w1 * b[6] + w2 * d[6], w0 * a[7] + w1 * b[7] + w2 * d[7]);
        *(u32x4*)(mx + (size_t)t * DM + c8) = o;
    }
}
__device__ __forceinline__ void phase_ln(const bf16* in, bf16* outp, const float* g, const float* bb_, const Ctx& c) {
    for (int w = c.gw; w < T; w += c.ngw) {
        const bf16* r = in + (size_t)w * DM; float v[16]; float s = 0.f;
#pragma unroll
        for (int j = 0; j < 4; ++j) { const u32x2 u = *(const u32x2*)(r + j * 256 + c.lane * 4);
            v[4 * j] = __uint_as_float(u.x << 16); v[4 * j + 1] = __uint_as_float(u.x & 0xffff0000u); v[4 * j + 2] = __uint_as_float(u.y << 16); v[4 * j + 3] = __uint_as_float(u.y & 0xffff0000u); }
#pragma unroll
        for (int j = 0; j < 16; ++j) s += v[j];
#pragma unroll
        for (int o = 1; o < 64; o <<= 1) s += __shfl_xor(s, o);
        const float mu = s * (1.f / DM); float q = 0.f;
#pragma unroll
        for (int j = 0; j < 16; ++j) { v[j] -= mu; q += v[j] * v[j]; }
#pragma unroll
        for (int o = 1; o < 64; o <<= 1) q += __shfl_xor(q, o);
        const float rs = rsqrtf(q * (1.f / DM) + LN_EPS);
#pragma unroll
        for (int j = 0; j < 4; ++j) { const int cc = j * 256 + c.lane * 4; const f32x4 gg = *(const f32x4*)(g + cc), bb = *(const f32x4*)(bb_ + cc);
            u32x2 u; u.x = cvtpk(v[4 * j] * rs * gg[0] + bb[0], v[4 * j + 1] * rs * gg[1] + bb[1]); u.y = cvtpk(v[4 * j + 2] * rs * gg[2] + bb[2], v[4 * j + 3] * rs * gg[3] + bb[3]);
            *(u32x2*)(outp + (size_t)w * DM + cc) = u; }
    }
}
__device__ __forceinline__ void phase_route(const P& p, const Ctx& c) {
    const int lane = c.lane;
    for (int w = c.gw; w < T; w += c.ngw) {
        const f32x4 lg = *(const f32x4*)((const float*)(p.ws + WS_LOGITS) + (size_t)w * NEXP + lane * 4);
        const f32x4 eb = *(const f32x4*)(p.e_bias + lane * 4);
        float sc[4], bs[4];
#pragma unroll
        for (int j = 0; j < 4; ++j) { sc[j] = 1.f / (1.f + expf(-lg[j])); bs[j] = sc[j] + eb[j]; }
        float m1 = fmaxf(bs[0], bs[1]), m2 = fminf(bs[0], bs[1]);
        { const float cc = bs[2]; const float n1 = fmaxf(m1, cc); m2 = fmaxf(m2, fminf(m1, cc)); m1 = n1; }
        { const float cc = bs[3]; const float n1 = fmaxf(m1, cc); m2 = fmaxf(m2, fminf(m1, cc)); m1 = n1; }
#pragma unroll
        for (int o = 1; o < 8; o <<= 1) { const float b1 = __shfl_xor(m1, o), b2 = __shfl_xor(m2, o); const float n1 = fmaxf(m1, b1); m2 = fmaxf(fminf(m1, b1), fmaxf(m2, b2)); m1 = n1; }
        const float gs = m1 + m2; const int grp = lane >> 3; int rank = 0;
#pragma unroll
        for (int g2 = 0; g2 < 8; ++g2) { const float o = __shfl(gs, g2 * 8); rank += (o > gs || (o == gs && g2 < grp)) ? 1 : 0; }
        const bool sel = rank < 4;
        float cand[4];
#pragma unroll
        for (int j = 0; j < 4; ++j) cand[j] = sel ? bs[j] : -INFINITY;
        int myidx = 0; float myw = 0.f, wsum = 0.f;
#pragma unroll 1
        for (int k = 0; k < TOPK; ++k) {
            float bv = cand[0]; int bi = lane * 4;
#pragma unroll
            for (int j = 1; j < 4; ++j) if (cand[j] > bv) { bv = cand[j]; bi = lane * 4 + j; }
#pragma unroll
            for (int o = 1; o < 64; o <<= 1) { const float ov = __shfl_xor(bv, o); const int oi = __shfl_xor(bi, o); if (ov > bv || (ov == bv && oi < bi)) { bv = ov; bi = oi; } }
            const int own = bi >> 2, el = bi & 3;
            const float sv = el == 0 ? sc[0] : (el == 1 ? sc[1] : (el == 2 ? sc[2] : sc[3]));
            const float wv = __shfl(sv, own);
            if (lane == own) { if (el == 0) cand[0] = -INFINITY; else if (el == 1) cand[1] = -INFINITY; else if (el == 2) cand[2] = -INFINITY; else cand[3] = -INFINITY; }
            wsum += wv;
            if (lane == k) { myidx = bi; myw = wv; }
        }
        if (lane < TOPK) {
            const int rk = atomicAdd((int*)(p.ws + WS_CNT) + myidx, 1);
            ((int*)(p.ws + WS_RIDX))[(size_t)w * 8 + lane] = myidx;
            ((float*)(p.ws + WS_RW))[(size_t)w * 8 + lane] = myw / wsum * ROUTED_SCALE;
            ((int*)(p.ws + WS_RRANK))[(size_t)w * 8 + lane] = rk;
        }
    }
}
__device__ __forceinline__ void phase_scatter(const P& p, const Ctx& c) {
    LAS int* sh = (LAS int*)c.lds;
    const int tid = c.tid;
    int cnt = 0;
    if (tid < 256) { cnt = ld_i32_agent((const int*)(p.ws + WS_CNT) + tid); sh[tid] = cnt; sh[256 + tid] = (cnt + 255) >> 8; }
    __syncthreads();
    for (int o = 1; o < 256; o <<= 1) { int v = 0, v2 = 0; if (tid < 256 && tid >= o) { v = sh[tid - o]; v2 = sh[256 + tid - o]; } __syncthreads(); if (tid < 256) { sh[tid] += v; sh[256 + tid] += v2; } __syncthreads(); }
    if (blockIdx.x == 0) {
        int* st = (int*)(p.ws + WS_START); int* tab = (int*)(p.ws + WS_TILETAB);
        if (tid < 256) { const int st_e = sh[tid] - cnt; st[tid + 1] = sh[tid]; if (tid == 0) st[0] = 0;
            const int nte = (cnt + 255) >> 8, tb = sh[256 + tid] - nte;
            for (int ti = 0; ti < nte; ++ti) { int* q = tab + 4 * (tb + ti); q[0] = tid; q[1] = ti; q[2] = st_e + 256 * ti; q[3] = min(256, cnt - 256 * ti); } }
        const int nrt_r = sh[511];
        if (tid < 128) { int* q = tab + 4 * (nrt_r + tid); q[0] = NEXP; q[1] = tid; q[2] = AROWS + 256 * tid; q[3] = 256; }
        if (tid == 0) ((int*)(p.ws + WS_NRT))[0] = nrt_r + 128;
    }
    const int gt = c.vcu * NTHR + tid, ngt = c.G * NTHR;
    for (int i = gt; i < T * 8; i += ngt) {
        const int e = ((const int*)(p.ws + WS_RIDX))[i], rk = ((const int*)(p.ws + WS_RRANK))[i];
        const int pos = (e == 0 ? 0 : sh[e - 1]) + rk;
        ((int*)(p.ws + WS_ROWTOK))[pos] = i >> 3;
        ((float*)(p.ws + WS_ROWW))[pos] = ((const float*)(p.ws + WS_RW))[i];
        ((int*)(p.ws + WS_POS))[i] = pos;
    }
    __syncthreads();
}
__device__ __forceinline__ void phase_combine(const P& p, const Ctx& c) {
    const int lane = c.lane;
    const bf16* Y = (const bf16*)(p.ws + WS_Y);
    for (int w = c.gw; w < T; w += c.ngw) {
        const bf16* h2 = (const bf16*)(p.ws + WS_H2) + (size_t)w * DM;
        const int* pos = (const int*)(p.ws + WS_POS) + (size_t)w * 8;
        float v[16];
#pragma unroll
        for (int j = 0; j < 4; ++j) { const u32x2 u = *(const u32x2*)(h2 + j * 256 + lane * 4);
            v[4 * j] = DN_ALPHA * __uint_as_float(u.x << 16); v[4 * j + 1] = DN_ALPHA * __uint_as_float(u.x & 0xffff0000u); v[4 * j + 2] = DN_ALPHA * __uint_as_float(u.y << 16); v[4 * j + 3] = DN_ALPHA * __uint_as_float(u.y & 0xffff0000u); }
#pragma unroll
        for (int k = 0; k < 9; ++k) {
            const size_t row = k < 8 ? (size_t)pos[k < 8 ? k : 0] : (size_t)AROWS + w;
            const bf16* yr = Y + row * DM;
#pragma unroll
            for (int j = 0; j < 4; ++j) { const u32x2 u = *(const u32x2*)(yr + j * 256 + lane * 4);
                v[4 * j] += __uint_as_float(u.x << 16); v[4 * j + 1] += __uint_as_float(u.x & 0xffff0000u); v[4 * j + 2] += __uint_as_float(u.y << 16); v[4 * j + 3] += __uint_as_float(u.y & 0xffff0000u); }
        }
        float s = 0.f;
#pragma unroll
        for (int j = 0; j < 16; ++j) s += v[j];
#pragma unroll
        for (int o = 1; o < 64; o <<= 1) s += __shfl_xor(s, o);
        const float mu = s * (1.f / DM); float q = 0.f;
#pragma unroll
        for (int j = 0; j < 16; ++j) { v[j] -= mu; q += v[j] * v[j]; }
#pragma unroll
        for (int o = 1; o < 64; o <<= 1) q += __shfl_xor(q, o);
        const float rs = rsqrtf(q * (1.f / DM) + LN_EPS);
#pragma unroll
        for (int j = 0; j < 4; ++j) { const int cc = j * 256 + lane * 4; const f32x4 gg = *(const f32x4*)(p.ln3_g + cc), bb = *(const f32x4*)(p.ln3_b + cc);
            f32x4 o; o[0] = v[4 * j] * rs * gg[0] + bb[0]; o[1] = v[4 * j + 1] * rs * gg[1] + bb[1]; o[2] = v[4 * j + 2] * rs * gg[2] + bb[2]; o[3] = v[4 * j + 3] * rs * gg[3] + bb[3];
            *(f32x4*)(p.out + (size_t)w * DM + cc) = o; }
    }
}

enum Phase { PH_PROLOGUE = 0, PH_INPROJ, PH_ATTN, PH_MERGE, PH_OUTPROJ, PH_LN1, PH_QMEM, PH_MEMATTN, PH_WO, PH_LN2, PH_ROUTER, PH_ROUTE, PH_SCATTER, PH_MOE1, PH_MOE2, PH_COMBINE, PH_COUNT };
struct MKArgs { P p; int ph_lo, ph_hi; };

__global__ void __launch_bounds__(NTHR, 2) mk_fwd(MKArgs a) {
    extern __shared__ __attribute__((aligned(16))) unsigned char lds_raw[];
    LAS unsigned char* lds = (LAS unsigned char*)lds_raw;
    const P& p = a.p;
    Ctx c; c.tid = threadIdx.x; c.lane = c.tid & 63; c.wave = __builtin_amdgcn_readfirstlane(c.tid >> 6); c.G = gridDim.x;
    { const int bx = blockIdx.x; c.vcu = (c.G % 8 == 0) ? (bx % 8) * (c.G / 8) + bx / 8 : bx; }
    c.gw = c.vcu * NWAVES + c.wave; c.ngw = c.G * NWAVES; c.lds = lds;
    unsigned char* ws = p.ws;
    const int lo = a.ph_lo, hi = a.ph_hi;
#ifdef ONLY_PH
#define IN(k) ((k) == ONLY_PH)
#else
#define IN(k) (lo <= (k) && (k) < hi)
#endif
#define SEAM(k) do { if (IN(k) && IN((k) + 1)) { cg::this_grid().sync(); } } while (0)

    if (IN(PH_PROLOGUE)) { phase_prologue(p, c); SEAM(PH_PROLOGUE); }

    if (IN(PH_INPROJ)) {
        { gm::DenseSched S; S.init(T, INW, DM, ws + WS_WINT, c.G, (int)blockIdx.x);
          gm::EpiInProj E{(bf16*)(ws + WS_PROJ), (const float*)(ws + WS_CS)};
          gm::gemm_phase(lds, (const char*)(ws + WS_XB), DM, S, E); }
        { gm::DenseSched S; S.init(BATCH * MEML, 2048, DM, ws + WS_WKVT, c.G, (int)blockIdx.x);
          gm::EpiScale E{(bf16*)(ws + WS_KVM), 2048, 1.f};
          gm::gemm_phase(lds, (const char*)(ws + WS_MEMB), DM, S, E); }
        SEAM(PH_INPROJ);
    }

    if (IN(PH_ATTN)) {
        const float lam = __hip_atomic_load((const float*)(ws + WS_SCAL), __ATOMIC_RELAXED, __HIP_MEMORY_SCOPE_AGENT);
        if (c.G == 256) { const int bh = c.vcu >> 3, s = c.vcu & 7;
            for (int i = 0; i < 4; ++i) { const int qb = (i == 0) ? s : (i == 1) ? 15 - s : (i == 2) ? 16 + s : 31 - s; diff_unit(p, bh >> 2, bh & 3, qb, lds, lam); } }
        else { for (int u = blockIdx.x; u < 1024; u += c.G) diff_unit(p, u >> 7, (u >> 5) & 3, u & 31, lds, lam); }
        for (int u = c.vcu; u < 3072; u += c.G) { const int grp = u & 15, t3 = u >> 4, br = t3 % 3, bh = t3 / 3; dil_unit(p, bh >> 3, bh & 7, br, grp, lds); }
        SEAM(PH_ATTN);
    }

    if (IN(PH_MERGE)) { phase_merge(p, c); SEAM(PH_MERGE); }

    if (IN(PH_OUTPROJ)) {
        gm::DenseSched S; S.init(T, DM, DM, ws + WS_WOUTT, c.G, (int)blockIdx.x);
        gm::EpiOutProj E{(bf16*)(ws + WS_Y1), p.x};
        gm::gemm_phase(lds, (const char*)(ws + WS_MIXIN), DM, S, E);
        SEAM(PH_OUTPROJ);
    }
    if (IN(PH_LN1)) { phase_ln((const bf16*)(ws + WS_Y1), (bf16*)(ws + WS_H1), p.ln1_g, p.ln1_b, c); SEAM(PH_LN1); }

    if (IN(PH_QMEM)) {
        gm::DenseSched S; S.init(T, DM, DM, ws + WS_WQT, c.G, (int)blockIdx.x);
        gm::EpiScale E{(bf16*)(ws + WS_QM), DM, QSCALE256};
        gm::gemm_phase(lds, (const char*)(ws + WS_H1), DM, S, E);
        SEAM(PH_QMEM);
    }
    if (IN(PH_MEMATTN)) {
        for (int u = c.vcu; u < 512; u += c.G) { const int qblk = u & 15, bh = u >> 4; mem_unit(p, bh >> 2, bh & 3, qblk, lds); }
        SEAM(PH_MEMATTN);
    }
    if (IN(PH_WO)) {
        gm::DenseSched S; S.init(T, DM, DM, ws + WS_WOT, c.G, (int)blockIdx.x);
        gm::EpiWo E{(bf16*)(ws + WS_Y2), (const bf16*)(ws + WS_H1)};
        gm::gemm_phase(lds, (const char*)(ws + WS_MO), DM, S, E);
        SEAM(PH_WO);
    }
    if (IN(PH_LN2)) { phase_ln((const bf16*)(ws + WS_Y2), (bf16*)(ws + WS_H2), p.ln2_g, p.ln2_b, c); SEAM(PH_LN2); }

    if (IN(PH_ROUTER)) {
        gm::DenseSched S; S.init(T, NEXP, DM, ws + WS_WRT, c.G, (int)blockIdx.x);
        gm::EpiF32 E{(float*)(ws + WS_LOGITS), NEXP};
        gm::gemm_phase(lds, (const char*)(ws + WS_H2), DM, S, E);
        SEAM(PH_ROUTER);
    }
    if (IN(PH_ROUTE)) { phase_route(p, c); SEAM(PH_ROUTE); }
    if (IN(PH_SCATTER)) { phase_scatter(p, c); SEAM(PH_SCATTER); }

    if (IN(PH_MOE1)) {
        const int nrt = __builtin_amdgcn_readfirstlane(ld_i32_agent((const int*)(ws + WS_NRT)));
        gm::MoeSched<1, DM, true> S{(const int*)(ws + WS_TILETAB), nrt * 2, c.G, (int)blockIdx.x, (const char*)(ws + WS_WTGU), (size_t)512 * DM * 2, (const int*)(ws + WS_ROWTOK)};
        gm::EpiMoe1 E{(bf16*)(ws + WS_HB)};
        gm::gemm_phase(lds, (const char*)(ws + WS_H2), DM, S, E);
        SEAM(PH_MOE1);
    }
    if (IN(PH_MOE2)) {
        const int nrt = __builtin_amdgcn_readfirstlane(ld_i32_agent((const int*)(ws + WS_NRT)));
        gm::MoeSched<2, EDIM, false> S{(const int*)(ws + WS_TILETAB), nrt * 4, c.G, (int)blockIdx.x, (const char*)(ws + WS_WTD), (size_t)DM * EDIM * 2, nullptr};
        gm::EpiMoe2 E{(bf16*)(ws + WS_Y), (const float*)(ws + WS_ROWW)};
        gm::gemm_phase(lds, (const char*)(ws + WS_HB), EDIM, S, E);
        SEAM(PH_MOE2);
    }
    if (IN(PH_COMBINE)) { phase_combine(p, c); }
#undef IN
#undef SEAM
}

#ifndef MK_MODE
#define MK_MODE 1
#endif
#ifndef NAIVE_MASK
#define NAIVE_MASK 0
#endif

static void fill_params(P& p, void* const* d_in, void* d_out, void* d_ws) {
    p.x = (const float*)d_in[0]; p.mem = (const float*)d_in[1]; p.pos = (const int*)d_in[2];
    p.w_in = (const float*)d_in[3]; p.w_out = (const float*)d_in[4]; p.lq1 = (const float*)d_in[5]; p.lk1 = (const float*)d_in[6]; p.lq2 = (const float*)d_in[7]; p.lk2 = (const float*)d_in[8];
    p.subln_g = (const float*)d_in[9]; p.ln1_g = (const float*)d_in[10]; p.ln1_b = (const float*)d_in[11];
    p.wq = (const float*)d_in[12]; p.wkv = (const float*)d_in[13]; p.wo = (const float*)d_in[14]; p.ln2_g = (const float*)d_in[15]; p.ln2_b = (const float*)d_in[16];
    p.w_router = (const float*)d_in[17]; p.e_bias = (const float*)d_in[18]; p.w_gate = (const float*)d_in[19]; p.w_up = (const float*)d_in[20]; p.w_down = (const float*)d_in[21];
    p.ws_gate = (const float*)d_in[22]; p.ws_up = (const float*)d_in[23]; p.ws_down = (const float*)d_in[24]; p.ln3_g = (const float*)d_in[25]; p.ln3_b = (const float*)d_in[26];
    p.out = (float*)d_out; p.ws = (unsigned char*)d_ws;
}

extern "C" void kernel_launch(void* const* d_in, const int* in_sizes, int n_in, void* d_out, int out_size, void* d_ws, size_t ws_size, hipStream_t stream) {
    static int grid = 0;
    if (grid == 0) {
        if (n_in != 27 || out_size != T * DM || ws_size < WS_END) { fprintf(stderr, "kernel_launch: unexpected shapes: n_in %d out %d ws %zu (need %zu)\n", n_in, out_size, ws_size, (size_t)WS_END); grid = -1; return; }
        int dev = 0, cus = 0, per_cu = 0;
        (void)hipGetDevice(&dev); (void)hipDeviceGetAttribute(&cus, hipDeviceAttributeMultiprocessorCount, dev);
        if (hipFuncSetAttribute((const void*)mk_fwd, hipFuncAttributeMaxDynamicSharedMemorySize, LDS_BYTES) != hipSuccess) { fprintf(stderr, "kernel_launch: hipFuncSetAttribute failed\n"); grid = -1; return; }
        if (hipOccupancyMaxActiveBlocksPerMultiprocessor(&per_cu, (const void*)mk_fwd, NTHR, LDS_BYTES) != hipSuccess || per_cu < 1) { fprintf(stderr, "kernel_launch: occupancy query says %d blocks/CU\n", per_cu); per_cu = 1; }
        (void)hipGetLastError();
        grid = cus;
        fprintf(stderr, "kernel_launch: cus %d per_cu %d grid %d\n", cus, per_cu, grid);
    }
    if (grid < 0) return;
    MKArgs a{};
    fill_params(a.p, d_in, d_out, d_ws);
    P p = a.p; unsigned char* ws = p.ws;
#if MK_MODE == 1
    a.ph_lo = 0; a.ph_hi = PH_COUNT;
    void* args[] = {&a};
    hipError_t e = hipLaunchCooperativeKernel((const void*)mk_fwd, dim3(grid), dim3(NTHR), args, LDS_BYTES, stream);
    if (e != hipSuccess) fprintf(stderr, "cooperative launch failed: %s (grid %d)\n", hipGetErrorString(e), grid);
#elif MK_MODE == 2
    auto run = [&](int lo, int hi) { a.ph_lo = lo; a.ph_hi = hi; hipLaunchKernelGGL(mk_fwd, dim3(grid), dim3(NTHR), LDS_BYTES, stream, a); };
    auto nv = [&](int k) { return ((NAIVE_MASK >> k) & 1) != 0; };
    run(PH_PROLOGUE, PH_PROLOGUE + 1);
    if (nv(PH_INPROJ)) { ngemm<FInProj><<<dim3(T / 64, INW / 64, 1), 256, 0, stream>>>(FInProj{p}); ngemm<FKV><<<dim3(BATCH * MEML / 64, 2048 / 64, 1), 256, 0, stream>>>(FKV{p}); } else run(PH_INPROJ, PH_INPROJ + 1);
    if (nv(PH_ATTN)) { nattnA<<<3 * 8 * T / 256, 256, 0, stream>>>(p); nattnB<<<16 * T / 256, 256, 0, stream>>>(p); sublnB<<<T * 4 / 4, 256, 0, stream>>>(p); } else run(PH_ATTN, PH_ATTN + 1);
    if (nv(PH_MERGE)) mergeA<<<T * 512 / 256, 256, 0, stream>>>(p); else run(PH_MERGE, PH_MERGE + 1);
    if (nv(PH_OUTPROJ)) ngemm<FOutProj><<<dim3(T / 64, DM / 64, 1), 256, 0, stream>>>(FOutProj{p}); else run(PH_OUTPROJ, PH_OUTPROJ + 1);
    if (nv(PH_LN1)) ln_pass<<<T / 4, 256, 0, stream>>>((const bf16*)(ws + WS_Y1), (bf16*)(ws + WS_H1), p.ln1_g, p.ln1_b); else run(PH_LN1, PH_LN1 + 1);
    if (nv(PH_QMEM)) ngemm<FQMem><<<dim3(T / 64, DM / 64, 1), 256, 0, stream>>>(FQMem{p}); else run(PH_QMEM, PH_QMEM + 1);
    if (nv(PH_MEMATTN)) { ngemm<FMemS><<<dim3(T / 64, 256 / 64, 4), 256, 0, stream>>>(FMemS{p}); softmaxM<<<T * 4 / 4, 256, 0, stream>>>(p); ngemm<FMemO><<<dim3(T / 64, 256 / 64, 4), 256, 0, stream>>>(FMemO{p}); } else run(PH_MEMATTN, PH_MEMATTN + 1);
    if (nv(PH_WO)) ngemm<FWo><<<dim3(T / 64, DM / 64, 1), 256, 0, stream>>>(FWo{p}); else run(PH_WO, PH_WO + 1);
    if (nv(PH_LN2)) ln_pass<<<T / 4, 256, 0, stream>>>((const bf16*)(ws + WS_Y2), (bf16*)(ws + WS_H2), p.ln2_g, p.ln2_b); else run(PH_LN2, PH_LN2 + 1);
    if (nv(PH_ROUTER)) ngemm<FRouter><<<dim3(T / 64, NEXP / 64, 1), 256, 0, stream>>>(FRouter{p}); else run(PH_ROUTER, PH_ROUTER + 1);
    if (nv(PH_ROUTE)) route_pass<<<T / 4, 256, 0, stream>>>(p); else run(PH_ROUTE, PH_ROUTE + 1);
    run(PH_SCATTER, PH_SCATTER + 1);
    if (nv(PH_MOE1)) ngemm<FMoe1><<<dim3(T / 64, 512 / 64, NEXP + 1), 256, 0, stream>>>(FMoe1{p}); else run(PH_MOE1, PH_MOE1 + 1);
    if (nv(PH_MOE2)) ngemm<FMoe2><<<dim3(T / 64, DM / 64, NEXP + 1), 256, 0, stream>>>(FMoe2{p}); else run(PH_MOE2, PH_MOE2 + 1);
    if (nv(PH_COMBINE)) combine_pass<<<T / 4, 256, 0, stream>>>(p); else run(PH_COMBINE, PH_COMBINE + 1);
#else
    prep_kernel<<<T * 8 / 256, 256, 0, stream>>>(p);
    ngemm<FInProj><<<dim3(T / 64, INW / 64, 1), 256, 0, stream>>>(FInProj{p});
    nattnA<<<3 * 8 * T / 256, 256, 0, stream>>>(p);
    mergeA<<<T * 512 / 256, 256, 0, stream>>>(p);
    nattnB<<<16 * T / 256, 256, 0, stream>>>(p);
    sublnB<<<T * 4 / 4, 256, 0, stream>>>(p);
    ngemm<FOutProj><<<dim3(T / 64, DM / 64, 1), 256, 0, stream>>>(FOutProj{p});
    ln_pass<<<T / 4, 256, 0, stream>>>((const bf16*)(ws + WS_Y1), (bf16*)(ws + WS_H1), p.ln1_g, p.ln1_b);
    ngemm<FQMem><<<dim3(T / 64, DM / 64, 1), 256, 0, stream>>>(FQMem{p});
    ngemm<FKV><<<dim3(BATCH * MEML / 64, 2048 / 64, 1), 256, 0, stream>>>(FKV{p});
    ngemm<FMemS><<<dim3(T / 64, 256 / 64, 4), 256, 0, stream>>>(FMemS{p});
    softmaxM<<<T * 4 / 4, 256, 0, stream>>>(p);
    ngemm<FMemO><<<dim3(T / 64, 256 / 64, 4), 256, 0, stream>>>(FMemO{p});
    ngemm<FWo><<<dim3(T / 64, DM / 64, 1), 256, 0, stream>>>(FWo{p});
    ln_pass<<<T / 4, 256, 0, stream>>>((const bf16*)(ws + WS_Y2), (bf16*)(ws + WS_H2), p.ln2_g, p.ln2_b);
    ngemm<FRouter><<<dim3(T / 64, NEXP / 64, 1), 256, 0, stream>>>(FRouter{p});
    route_pass<<<T / 4, 256, 0, stream>>>(p);
    scan_pass<<<1, 256, 0, stream>>>(p);
    scatter_pass<<<T * 8 / 256, 256, 0, stream>>>(p);
    ngemm<FMoe1><<<dim3(T / 64, 512 / 64, NEXP + 1), 256, 0, stream>>>(FMoe1{p});
    ngemm<FMoe2><<<dim3(T / 64, DM / 64, NEXP + 1), 256, 0, stream>>>(FMoe2{p});
    combine_pass<<<T / 4, 256, 0, stream>>>(p);
#endif
}
```

```cpp
#define MK_MODE 1
#define NAIVE_MASK 0
#include <hip/hip_runtime.h>
#include <hip/hip_cooperative_groups.h>
#include <cstdio>
#include <cstdint>
#include <cmath>
namespace cg = cooperative_groups;

constexpr int BATCH = 8, SEQ = 4096, DM = 1024, T = BATCH * SEQ;
constexpr int MEML = 256;
constexpr int INW = 3072;
constexpr int NEXP = 256, TOPK = 8, EDIM = 256;
constexpr int AROWS = T * TOPK;
constexpr float LN_EPS = 1e-5f, SUBLN_EPS = 1e-5f;
constexpr float DN_ALPHA = 1.189207115002721f;
constexpr float LOG2E = 1.4426950408889634f;
constexpr float QSCALE64 = 0.125f * LOG2E;
constexpr float QSCALE256 = 0.0625f * LOG2E;
constexpr float LAMBDA_INIT = 0.2f;
constexpr float ROUTED_SCALE = 2.5f;

constexpr size_t MiB = 1u << 20;
constexpr size_t WS_CNT = 0;
constexpr size_t WS_START = 4096;
constexpr size_t WS_SCAL = 8192;
constexpr size_t WS_NRT = 12288;
constexpr size_t WS_TILETAB = 16384;
constexpr size_t WS_BAR = 65536;
constexpr size_t WS_CS = 1 * MiB;
constexpr size_t WS_RIDX = 4 * MiB, WS_RW = 5 * MiB, WS_RRANK = 6 * MiB, WS_POS = 7 * MiB;
constexpr size_t WS_ROWTOK = 8 * MiB, WS_ROWW = 10 * MiB;
constexpr size_t WS_LSEA = 12 * MiB;
constexpr size_t WS_KVM = 16 * MiB;
constexpr size_t WS_MEMB = 24 * MiB;
constexpr size_t WS_WINT = 32 * MiB;
constexpr size_t WS_WOUTT = 38 * MiB;
constexpr size_t WS_WQT = 40 * MiB;
constexpr size_t WS_WKVT = 42 * MiB;
constexpr size_t WS_WOT = 46 * MiB;
constexpr size_t WS_WRT = 48 * MiB;
constexpr size_t WS_WTD = 64 * MiB;
constexpr size_t WS_H2 = 193 * MiB;
constexpr size_t WS_MIXIN = 193 * MiB;
constexpr size_t WS_Y1 = 257 * MiB;
constexpr size_t WS_DD = 257 * MiB;
constexpr size_t WS_H1 = 321 * MiB;
constexpr size_t WS_HB = 257 * MiB;
constexpr size_t WS_WTGU = 401 * MiB;
constexpr size_t WS_Y = 448 * MiB;
constexpr size_t WS_PROJ = 658 * MiB;
constexpr size_t WS_QM = 658 * MiB;
constexpr size_t WS_MO = 722 * MiB;
constexpr size_t WS_Y2 = 786 * MiB;
constexpr size_t WS_PARTA = 850 * MiB;
constexpr size_t WS_LOGITS = 850 * MiB;
constexpr size_t WS_SS = 850 * MiB;
constexpr size_t WS_XB = 946 * MiB;
constexpr size_t WS_END = 1024 * MiB;

typedef unsigned short bf16;
__device__ __forceinline__ float bf2f(bf16 v) { return __uint_as_float(((unsigned)v) << 16); }
__device__ __forceinline__ bf16 f2bf(float f) { unsigned u = __float_as_uint(f); return (bf16)((u + 0x7fffu + ((u >> 16) & 1u)) >> 16); }

struct P {
    const float *x, *mem; const int* pos;
    const float *w_in, *w_out, *lq1, *lk1, *lq2, *lk2, *subln_g, *ln1_g, *ln1_b;
    const float *wq, *wkv, *wo, *ln2_g, *ln2_b, *w_router, *e_bias, *w_gate, *w_up, *w_down;
    const float *ws_gate, *ws_up, *ws_down, *ln3_g, *ln3_b;
    float* out; unsigned char* ws;
};

__host__ __device__ __forceinline__ int sigma_dim(int p) { return p < 16 ? (p >> 1) + 8 * (p & 1) : p; }
__device__ __forceinline__ int proj_src_col(int c) {
    const int seg = c >> 9;
    if (seg == 2 || seg == 5) return c;
    return (c & ~63) | sigma_dim(c & 63);
}

__global__ void prep_kernel(P p) {
    const int i = blockIdx.x * blockDim.x + threadIdx.x;
    if (i < T * 8) {
        const int t = i >> 3, j = i & 7;
        const float inv = powf(500000.0f, -(float)(2 * j) / 16.0f);
        const float ang = (float)p.pos[t] * inv;
        float2* cs = (float2*)(p.ws + WS_CS);
        cs[i] = make_float2(cosf(ang), sinf(ang));
    }
    if (i < 256) ((int*)(p.ws + WS_CNT))[i] = 0;
    if (i == 0) {
        float a = 0.f, b = 0.f;
        for (int k = 0; k < 64; ++k) { a += p.lq1[k] * p.lk1[k]; b += p.lq2[k] * p.lk2[k]; }
        ((float*)(p.ws + WS_SCAL))[0] = expf(a) - expf(b) + LAMBDA_INIT;
    }
}

template <class F> __global__ void __launch_bounds__(256) ngemm(F f) {
    __shared__ float As[16][65], Bs[16][65];
    const int g = blockIdx.z, M = f.rows(g);
    const int m0 = blockIdx.x * 64, n0 = blockIdx.y * 64;
    if (m0 >= M) return;
    const int K = f.kdim();
    const int tid = threadIdx.x, tx = tid & 15, ty = tid >> 4;
    float acc[4][4];
#pragma unroll
    for (int i = 0; i < 4; ++i)
#pragma unroll
        for (int j = 0; j < 4; ++j) acc[i][j] = 0.f;
    for (int k0 = 0; k0 < K; k0 += 16) {
#pragma unroll
        for (int i = 0; i < 4; ++i) {
            const int idx = tid + i * 256;
            { const int k = idx & 15, r = idx >> 4; As[k][r] = (m0 + r < M) ? f.a(g, m0 + r, k0 + k) : 0.f; }
            { const int c = idx & 63, k = idx >> 6; Bs[k][c] = f.b(g, k0 + k, n0 + c); }
        }
        __syncthreads();
#pragma unroll
        for (int k = 0; k < 16; ++k) {
            float av[4], bv[4];
#pragma unroll
            for (int i = 0; i < 4; ++i) { av[i] = As[k][ty * 4 + i]; bv[i] = Bs[k][tx * 4 + i]; }
#pragma unroll
            for (int i = 0; i < 4; ++i)
#pragma unroll
                for (int j = 0; j < 4; ++j) acc[i][j] += av[i] * bv[j];
        }
        __syncthreads();
    }
#pragma unroll
    for (int i = 0; i < 4; ++i) { const int r = m0 + ty * 4 + i; if (r < M) f.epi(g, r, n0 + tx * 4, acc[i]); }
}

struct FInProj {
    P p;
    __device__ int rows(int) const { return T; }
    __device__ int kdim() const { return DM; }
    __device__ float a(int, int r, int k) const { return bf2f(f2bf(p.x[(size_t)r * DM + k])); }
    __device__ float b(int, int k, int c) const { return bf2f(f2bf(p.w_in[(size_t)k * INW + proj_src_col(c)])); }
    __device__ void epi(int, int r, int c0, const float (&v)[4]) const {
        bf16* proj = (bf16*)(p.ws + WS_PROJ);
        const int seg = c0 >> 9; float o[4] = {v[0], v[1], v[2], v[3]};
        if (seg != 2 && seg != 5) {
            const int pp = c0 & 63;
            if (pp < 16) {
                const float2* cs = (const float2*)(p.ws + WS_CS) + (size_t)r * 8;
#pragma unroll
                for (int q = 0; q < 2; ++q) { const float2 c = cs[(pp >> 1) + q]; const float t1 = v[2 * q], t2 = v[2 * q + 1]; o[2 * q] = t1 * c.x - t2 * c.y; o[2 * q + 1] = t2 * c.x + t1 * c.y; }
            }
            if (seg == 0 || seg == 3) {
#pragma unroll
                for (int q = 0; q < 4; ++q) o[q] *= QSCALE64;
            }
        }
#pragma unroll
        for (int q = 0; q < 4; ++q) proj[(size_t)r * INW + c0 + q] = f2bf(o[q]);
    }
};
struct FOutProj {
    P p;
    __device__ int rows(int) const { return T; }
    __device__ int kdim() const { return DM; }
    __device__ float a(int, int r, int k) const { return bf2f(((const bf16*)(p.ws + WS_MIXIN))[(size_t)r * DM + k]); }
    __device__ float b(int, int k, int c) const { return bf2f(f2bf(p.w_out[(size_t)k * DM + c])); }
    __device__ void epi(int, int r, int c0, const float (&v)[4]) const {
        bf16* y = (bf16*)(p.ws + WS_Y1);
#pragma unroll
        for (int q = 0; q < 4; ++q) y[(size_t)r * DM + c0 + q] = f2bf(DN_ALPHA * p.x[(size_t)r * DM + c0 + q] + v[q]);
    }
};
struct FQMem {
    P p;
    __device__ int rows(int) const { return T; }
    __device__ int kdim() const { return DM; }
    __device__ float a(int, int r, int k) const { return bf2f(((const bf16*)(p.ws + WS_H1))[(size_t)r * DM + k]); }
    __device__ float b(int, int k, int c) const { return bf2f(f2bf(p.wq[(size_t)k * DM + c])); }
    __device__ void epi(int, int r, int c0, const float (&v)[4]) const {
        bf16* y = (bf16*)(p.ws + WS_QM);
#pragma unroll
        for (int q = 0; q < 4; ++q) y[(size_t)r * DM + c0 + q] = f2bf(v[q] * QSCALE256);
    }
};
struct FKV {
    P p;
    __device__ int rows(int) const { return BATCH * MEML; }
    __device__ int kdim() const { return DM; }
    __device__ float a(int, int r, int k) const { return bf2f(f2bf(p.mem[(size_t)r * DM + k])); }
    __device__ float b(int, int k, int c) const { return bf2f(f2bf(p.wkv[(size_t)k * 2048 + c])); }
    __device__ void epi(int, int r, int c0, const float (&v)[4]) const {
        bf16* y = (bf16*)(p.ws + WS_KVM);
#pragma unroll
        for (int q = 0; q < 4; ++q) y[(size_t)r * 2048 + c0 + q] = f2bf(v[q]);
    }
};
struct FMemS {
    P p;
    __device__ int rows(int) const { return T; }
    __device__ int kdim() const { return 256; }
    __device__ float a(int g, int r, int k) const { return bf2f(((const bf16*)(p.ws + WS_QM))[(size_t)r * DM + g * 256 + k]); }
    __device__ float b(int g, int k, int c) const { const int bb = (blockIdx.x * 64) / SEQ; return bf2f(((const bf16*)(p.ws + WS_KVM))[(size_t)(bb * MEML + c) * 2048 + g * 256 + k]); }
    __device__ void epi(int g, int r, int c0, const float (&v)[4]) const {
        float* s = (float*)(p.ws + WS_SS);
#pragma unroll
        for (int q = 0; q < 4; ++q) s[(size_t)r * DM + g * 256 + c0 + q] = v[q];
    }
};
struct FMemO {
    P p;
    __device__ int rows(int) const { return T; }
    __device__ int kdim() const { return 256; }
    __device__ float a(int g, int r, int k) const { return bf2f(f2bf(((const float*)(p.ws + WS_SS))[(size_t)r * DM + g * 256 + k])); }
    __device__ float b(int g, int k, int c) const { const int bb = (blockIdx.x * 64) / SEQ; return bf2f(((const bf16*)(p.ws + WS_KVM))[(size_t)(bb * MEML + k) * 2048 + 1024 + g * 256 + c]); }
    __device__ void epi(int g, int r, int c0, const float (&v)[4]) const {
        bf16* y = (bf16*)(p.ws + WS_MO);
#pragma unroll
        for (int q = 0; q < 4; ++q) y[(size_t)r * DM + g * 256 + c0 + q] = f2bf(v[q]);
    }
};
struct FWo {
    P p;
    __device__ int rows(int) const { return T; }
    __device__ int kdim() const { return DM; }
    __device__ float a(int, int r, int k) const { return bf2f(((const bf16*)(p.ws + WS_MO))[(size_t)r * DM + k]); }
    __device__ float b(int, int k, int c) const { return bf2f(f2bf(p.wo[(size_t)k * DM + c])); }
    __device__ void epi(int, int r, int c0, const float (&v)[4]) const {
        bf16* y = (bf16*)(p.ws + WS_Y2); const bf16* h1 = (const bf16*)(p.ws + WS_H1);
#pragma unroll
        for (int q = 0; q < 4; ++q) y[(size_t)r * DM + c0 + q] = f2bf(DN_ALPHA * bf2f(h1[(size_t)r * DM + c0 + q]) + v[q]);
    }
};
struct FRouter {
    P p;
    __device__ int rows(int) const { return T; }
    __device__ int kdim() const { return DM; }
    __device__ float a(int, int r, int k) const { return bf2f(((const bf16*)(p.ws + WS_H2))[(size_t)r * DM + k]); }
    __device__ float b(int, int k, int c) const { return bf2f(f2bf(p.w_router[(size_t)k * NEXP + c])); }
    __device__ void epi(int, int r, int c0, const float (&v)[4]) const {
        float* y = (float*)(p.ws + WS_LOGITS);
#pragma unroll
        for (int q = 0; q < 4; ++q) y[(size_t)r * NEXP + c0 + q] = v[q];
    }
};
struct FMoe1 {
    P p;
    __device__ int rows(int g) const { const int* st = (const int*)(p.ws + WS_START); return g < NEXP ? st[g + 1] - st[g] : T; }
    __device__ int kdim() const { return DM; }
    __device__ float a(int g, int r, int k) const {
        const int* st = (const int*)(p.ws + WS_START); const int* rt = (const int*)(p.ws + WS_ROWTOK);
        const int tok = g < NEXP ? rt[st[g] + r] : r;
        return bf2f(((const bf16*)(p.ws + WS_H2))[(size_t)tok * DM + k]);
    }
    __device__ float b(int g, int k, int c) const {
        const float* w = (c & 1) ? (g < NEXP ? p.w_up + (size_t)g * DM * EDIM : p.ws_up) : (g < NEXP ? p.w_gate + (size_t)g * DM * EDIM : p.ws_gate);
        return bf2f(f2bf(w[(size_t)k * EDIM + (c >> 1)]));
    }
    __device__ void epi(int g, int r, int c0, const float (&v)[4]) const {
        const int* st = (const int*)(p.ws + WS_START); bf16* H = (bf16*)(p.ws + WS_HB);
        const size_t row = g < NEXP ? (size_t)st[g] + r : (size_t)AROWS + r;
#pragma unroll
        for (int q = 0; q < 2; ++q) { const float gg = v[2 * q], uu = v[2 * q + 1]; H[row * EDIM + (c0 >> 1) + q] = f2bf(gg / (1.f + expf(-gg)) * uu); }
    }
};
struct FMoe2 {
    P p;
    __device__ int rows(int g) const { const int* st = (const int*)(p.ws + WS_START); return g < NEXP ? st[g + 1] - st[g] : T; }
    __device__ int kdim() const { return EDIM; }
    __device__ float a(int g, int r, int k) const {
        const int* st = (const int*)(p.ws + WS_START); const bf16* H = (const bf16*)(p.ws + WS_HB);
        const size_t row = g < NEXP ? (size_t)st[g] + r : (size_t)AROWS + r;
        return bf2f(H[row * EDIM + k]);
    }
    __device__ float b(int g, int k, int c) const { const float* w = g < NEXP ? p.w_down + (size_t)g * EDIM * DM : p.ws_down; return bf2f(f2bf(w[(size_t)k * DM + c])); }
    __device__ void epi(int g, int r, int c0, const float (&v)[4]) const {
        const int* st = (const int*)(p.ws + WS_START); bf16* Y = (bf16*)(p.ws + WS_Y);
        const size_t row = g < NEXP ? (size_t)st[g] + r : (size_t)AROWS + r;
        const float w = g < NEXP ? ((const float*)(p.ws + WS_ROWW))[row] : 1.f;
#pragma unroll
        for (int q = 0; q < 4; ++q) Y[row * DM + c0 + q] = f2bf(v[q] * w);
    }
};

__global__ void __launch_bounds__(256) nattnA(P p) {
    const int i = blockIdx.x * blockDim.x + threadIdx.x;
    if (i >= 3 * 8 * T) return;
    const int t = i % T, h = (i / T) & 7, br = i / (8 * T);
    const int dil = br == 0 ? 1 : (br == 1 ? 4 : 16);
    const int s = t % SEQ, b0 = t - s;
    const bf16* proj = (const bf16*)(p.ws + WS_PROJ);
    float q[64], o[64];
#pragma unroll
    for (int e = 0; e < 64; ++e) { q[e] = bf2f(proj[(size_t)t * INW + h * 64 + e]); o[e] = 0.f; }
    float m = -INFINITY, l = 0.f;
    for (int j = 0; j <= 128; ++j) {
        const int ks = s - j * dil; if (ks < 0) break;
        const bf16* kr = proj + (size_t)(b0 + ks) * INW + 512 + h * 64;
        const bf16* vr = proj + (size_t)(b0 + ks) * INW + 1024 + h * 64;
        float sc = 0.f;
#pragma unroll
        for (int e = 0; e < 64; ++e) sc += q[e] * bf2f(kr[e]);
        const float mn = fmaxf(m, sc), al = exp2f(m - mn), pe = exp2f(sc - mn);
        l = l * al + pe;
#pragma unroll
        for (int e = 0; e < 64; ++e) o[e] = o[e] * al + pe * bf2f(vr[e]);
        m = mn;
    }
    bf16* pa = (bf16*)(p.ws + WS_PARTA) + ((size_t)br * T + t) * 512 + h * 64;
    const float il = 1.f / l;
#pragma unroll
    for (int e = 0; e < 64; ++e) pa[e] = f2bf(o[e] * il);
    ((float*)(p.ws + WS_LSEA))[((size_t)br * T + t) * 8 + h] = m + log2f(l);
}
__global__ void mergeA(P p) {
    const int i = blockIdx.x * blockDim.x + threadIdx.x;
    if (i >= T * 512) return;
    const int t = i >> 9, c = i & 511, h = c >> 6;
    const float* lse = (const float*)(p.ws + WS_LSEA);
    const float l0 = lse[(size_t)t * 8 + h], l1 = lse[((size_t)T + t) * 8 + h], l2 = lse[((size_t)2 * T + t) * 8 + h];
    const float mx = fmaxf(l0, fmaxf(l1, l2));
    const float w0 = exp2f(l0 - mx), w1 = exp2f(l1 - mx), w2 = exp2f(l2 - mx), inv = 1.f / (w0 + w1 + w2);
    const bf16* pa = (const bf16*)(p.ws + WS_PARTA);
    const float v = (w0 * bf2f(pa[(size_t)t * 512 + c]) + w1 * bf2f(pa[((size_t)T + t) * 512 + c]) + w2 * bf2f(pa[((size_t)2 * T + t) * 512 + c])) * inv;
    ((bf16*)(p.ws + WS_MIXIN))[(size_t)t * DM + c] = f2bf(v);
}
__global__ void __launch_bounds__(256) nattnB(P p) {
    const int i = blockIdx.x * blockDim.x + threadIdx.x;
    if (i >= 16 * T) return;
    const int t = i % T, ch = (i / T) & 3, h = i / (4 * T);
    const int s = t % SEQ, b0 = t - s;
    const bf16* proj = (const bf16*)(p.ws + WS_PROJ);
    float q0[64], q1[64], o0[32], o1[32];
#pragma unroll
    for (int e = 0; e < 64; ++e) { q0[e] = bf2f(proj[(size_t)t * INW + 1536 + h * 128 + e]); q1[e] = bf2f(proj[(size_t)t * INW + 1536 + h * 128 + 64 + e]); }
#pragma unroll
    for (int e = 0; e < 32; ++e) { o0[e] = 0.f; o1[e] = 0.f; }
    float m0 = -INFINITY, l0 = 0.f, m1 = -INFINITY, l1 = 0.f;
    for (int ks = 0; ks <= s; ++ks) {
        const bf16* kr = proj + (size_t)(b0 + ks) * INW + 2048 + h * 128;
        const bf16* vr = proj + (size_t)(b0 + ks) * INW + 2560 + h * 128 + ch * 32;
        float s0 = 0.f, s1 = 0.f;
#pragma unroll
        for (int e = 0; e < 64; ++e) { s0 += q0[e] * bf2f(kr[e]); s1 += q1[e] * bf2f(kr[64 + e]); }
        const float mn0 = fmaxf(m0, s0), a0 = exp2f(m0 - mn0), p0 = exp2f(s0 - mn0);
        const float mn1 = fmaxf(m1, s1), a1 = exp2f(m1 - mn1), p1 = exp2f(s1 - mn1);
        l0 = l0 * a0 + p0; l1 = l1 * a1 + p1; m0 = mn0; m1 = mn1;
#pragma unroll
        for (int e = 0; e < 32; ++e) { const float v = bf2f(vr[e]); o0[e] = o0[e] * a0 + p0 * v; o1[e] = o1[e] * a1 + p1 * v; }
    }
    const float lam = ((const float*)(p.ws + WS_SCAL))[0];
    float* dd = (float*)(p.ws + WS_DD) + (size_t)t * 512 + h * 128 + ch * 32;
    const float i0 = 1.f / l0, i1 = 1.f / l1;
#pragma unroll
    for (int e = 0; e < 32; ++e) dd[e] = o0[e] * i0 - lam * o1[e] * i1;
}
__global__ void sublnB(P p) {
    const int w = (blockIdx.x * blockDim.x + threadIdx.x) >> 6, lane = threadIdx.x & 63;
    if (w >= T * 4) return;
    const int t = w >> 2, h = w & 3;
    const float* dd = (const float*)(p.ws + WS_DD) + (size_t)t * 512 + h * 128;
    const float a = dd[lane], b = dd[lane + 64];
    float ss = a * a + b * b;
    for (int o = 1; o < 64; o <<= 1) ss += __shfl_xor(ss, o);
    const float r = rsqrtf(ss * (1.f / 128.f) + SUBLN_EPS) * (1.f - LAMBDA_INIT);
    bf16* mx = (bf16*)(p.ws + WS_MIXIN) + (size_t)t * DM + 512 + h * 128;
    mx[lane] = f2bf(a * r * p.subln_g[lane]); mx[lane + 64] = f2bf(b * r * p.subln_g[lane + 64]);
}
__global__ void softmaxM(P p) {
    const int w = (blockIdx.x * blockDim.x + threadIdx.x) >> 6, lane = threadIdx.x & 63;
    if (w >= T * 4) return;
    float* s = (float*)(p.ws + WS_SS) + (size_t)w * 256;
    float v[4]; float mx = -INFINITY;
#pragma unroll
    for (int j = 0; j < 4; ++j) { v[j] = s[lane + 64 * j]; mx = fmaxf(mx, v[j]); }
    for (int o = 1; o < 64; o <<= 1) mx = fmaxf(mx, __shfl_xor(mx, o));
    float sum = 0.f;
#pragma unroll
    for (int j = 0; j < 4; ++j) { v[j] = exp2f(v[j] - mx); sum += v[j]; }
    for (int o = 1; o < 64; o <<= 1) sum += __shfl_xor(sum, o);
    const float inv = 1.f / sum;
#pragma unroll
    for (int j = 0; j < 4; ++j) s[lane + 64 * j] = v[j] * inv;
}

__global__ void __launch_bounds__(256) ln_pass(const bf16* __restrict__ in, bf16* __restrict__ outp, const float* __restrict__ g, const float* __restrict__ b) {
    const int w = (blockIdx.x * blockDim.x + threadIdx.x) >> 6, lane = threadIdx.x & 63;
    if (w >= T) return;
    const bf16* r = in + (size_t)w * DM;
    float v[16]; float s = 0.f;
#pragma unroll
    for (int j = 0; j < 4; ++j) { const uint2 u = *(const uint2*)(r + j * 256 + lane * 4);
        v[4 * j] = __uint_as_float(u.x << 16); v[4 * j + 1] = __uint_as_float(u.x & 0xffff0000u); v[4 * j + 2] = __uint_as_float(u.y << 16); v[4 * j + 3] = __uint_as_float(u.y & 0xffff0000u); }
#pragma unroll
    for (int j = 0; j < 16; ++j) s += v[j];
    for (int o = 1; o < 64; o <<= 1) s += __shfl_xor(s, o);
    const float mu = s * (1.f / DM); float q = 0.f;
#pragma unroll
    for (int j = 0; j < 16; ++j) { v[j] -= mu; q += v[j] * v[j]; }
    for (int o = 1; o < 64; o <<= 1) q += __shfl_xor(q, o);
    const float rs = rsqrtf(q * (1.f / DM) + LN_EPS);
#pragma unroll
    for (int j = 0; j < 4; ++j) { const int c = j * 256 + lane * 4; const float4 gg = *(const float4*)(g + c), bb = *(const float4*)(b + c);
        uint2 u; u.x = (unsigned)f2bf(v[4 * j] * rs * gg.x + bb.x) | ((unsigned)f2bf(v[4 * j + 1] * rs * gg.y + bb.y) << 16);
        u.y = (unsigned)f2bf(v[4 * j + 2] * rs * gg.z + bb.z) | ((unsigned)f2bf(v[4 * j + 3] * rs * gg.w + bb.w) << 16);
        *(uint2*)(outp + (size_t)w * DM + c) = u; }
}

__global__ void __launch_bounds__(256) route_pass(P p) {
    const int w = (blockIdx.x * blockDim.x + threadIdx.x) >> 6, lane = threadIdx.x & 63;
    if (w >= T) return;
    const float4 lg = *(const float4*)((const float*)(p.ws + WS_LOGITS) + (size_t)w * NEXP + lane * 4);
    const float4 eb = *(const float4*)(p.e_bias + lane * 4);
    float sc[4] = {1.f / (1.f + expf(-lg.x)), 1.f / (1.f + expf(-lg.y)), 1.f / (1.f + expf(-lg.z)), 1.f / (1.f + expf(-lg.w))};
    float bs[4] = {sc[0] + eb.x, sc[1] + eb.y, sc[2] + eb.z, sc[3] + eb.w};
    float m1 = fmaxf(bs[0], bs[1]), m2 = fminf(bs[0], bs[1]);
    { const float c = bs[2]; const float n1 = fmaxf(m1, c); m2 = fmaxf(m2, fminf(m1, c)); m1 = n1; }
    { const float c = bs[3]; const float n1 = fmaxf(m1, c); m2 = fmaxf(m2, fminf(m1, c)); m1 = n1; }
#pragma unroll
    for (int o = 1; o < 8; o <<= 1) { const float b1 = __shfl_xor(m1, o), b2 = __shfl_xor(m2, o); const float n1 = fmaxf(m1, b1); m2 = fmaxf(fminf(m1, b1), fmaxf(m2, b2)); m1 = n1; }
    const float gs = m1 + m2; const int grp = lane >> 3;
    int rank = 0;
#pragma unroll
    for (int g2 = 0; g2 < 8; ++g2) { const float o = __shfl(gs, g2 * 8); rank += (o > gs || (o == gs && g2 < grp)) ? 1 : 0; }
    const bool sel = rank < 4;
    float cand[4];
#pragma unroll
    for (int j = 0; j < 4; ++j) cand[j] = sel ? bs[j] : -INFINITY;
    int myidx = 0; float myw = 0.f; float wsum = 0.f;
    for (int k = 0; k < TOPK; ++k) {
        float bv = cand[0]; int bi = lane * 4;
#pragma unroll
        for (int j = 1; j < 4; ++j) if (cand[j] > bv) { bv = cand[j]; bi = lane * 4 + j; }
#pragma unroll
        for (int o = 1; o < 64; o <<= 1) { const float ov = __shfl_xor(bv, o); const int oi = __shfl_xor(bi, o); if (ov > bv || (ov == bv && oi < bi)) { bv = ov; bi = oi; } }
        const int own = bi >> 2, el = bi & 3;
        const float sv = el == 0 ? sc[0] : (el == 1 ? sc[1] : (el == 2 ? sc[2] : sc[3]));
        const float wv = __shfl(sv, own);
        if (lane == own) { if (el == 0) cand[0] = -INFINITY; else if (el == 1) cand[1] = -INFINITY; else if (el == 2) cand[2] = -INFINITY; else cand[3] = -INFINITY; }
        wsum += wv;
        if (lane == k) { myidx = bi; myw = wv; }
    }
    if (lane < TOPK) {
        const float wn = myw / wsum * ROUTED_SCALE;
        const int rk = atomicAdd((int*)(p.ws + WS_CNT) + myidx, 1);
        ((int*)(p.ws + WS_RIDX))[(size_t)w * 8 + lane] = myidx;
        ((float*)(p.ws + WS_RW))[(size_t)w * 8 + lane] = wn;
        ((int*)(p.ws + WS_RRANK))[(size_t)w * 8 + lane] = rk;
    }
}
__global__ void scan_pass(P p) {
    __shared__ int sh[256];
    const int i = threadIdx.x; const int c = ((const int*)(p.ws + WS_CNT))[i];
    sh[i] = c; __syncthreads();
    for (int o = 1; o < 256; o <<= 1) { const int v = i >= o ? sh[i - o] : 0; __syncthreads(); sh[i] += v; __syncthreads(); }
    int* st = (int*)(p.ws + WS_START);
    st[i + 1] = sh[i]; if (i == 0) st[0] = 0;
}
__global__ void scatter_pass(P p) {
    const int i = blockIdx.x * blockDim.x + threadIdx.x;
    if (i >= T * 8) return;
    const int e = ((const int*)(p.ws + WS_RIDX))[i], rk = ((const int*)(p.ws + WS_RRANK))[i];
    const int pos = ((const int*)(p.ws + WS_START))[e] + rk;
    ((int*)(p.ws + WS_ROWTOK))[pos] = i >> 3;
    ((float*)(p.ws + WS_ROWW))[pos] = ((const float*)(p.ws + WS_RW))[i];
    ((int*)(p.ws + WS_POS))[i] = pos;
}
__global__ void __launch_bounds__(256) combine_pass(P p) {
    const int w = (blockIdx.x * blockDim.x + threadIdx.x) >> 6, lane = threadIdx.x & 63;
    if (w >= T) return;
    const bf16* h2 = (const bf16*)(p.ws + WS_H2) + (size_t)w * DM;
    const bf16* Y = (const bf16*)(p.ws + WS_Y);
    const int* pos = (const int*)(p.ws + WS_POS) + (size_t)w * 8;
    float v[16];
#pragma unroll
    for (int j = 0; j < 4; ++j) { const uint2 u = *(const uint2*)(h2 + j * 256 + lane * 4);
        v[4 * j] = DN_ALPHA * __uint_as_float(u.x << 16); v[4 * j + 1] = DN_ALPHA * __uint_as_float(u.x & 0xffff0000u); v[4 * j + 2] = DN_ALPHA * __uint_as_float(u.y << 16); v[4 * j + 3] = DN_ALPHA * __uint_as_float(u.y & 0xffff0000u); }
#pragma unroll
    for (int k = 0; k < 9; ++k) {
        const size_t row = k < 8 ? (size_t)pos[k < 8 ? k : 0] : (size_t)AROWS + w;
        const bf16* yr = Y + row * DM;
#pragma unroll
        for (int j = 0; j < 4; ++j) { const uint2 u = *(const uint2*)(yr + j * 256 + lane * 4);
            v[4 * j] += __uint_as_float(u.x << 16); v[4 * j + 1] += __uint_as_float(u.x & 0xffff0000u); v[4 * j + 2] += __uint_as_float(u.y << 16); v[4 * j + 3] += __uint_as_float(u.y & 0xffff0000u); }
    }
    float s = 0.f;
#pragma unroll
    for (int j = 0; j < 16; ++j) s += v[j];
    for (int o = 1; o < 64; o <<= 1) s += __shfl_xor(s, o);
    const float mu = s * (1.f / DM); float q = 0.f;
#pragma unroll
    for (int j = 0; j < 16; ++j) { v[j] -= mu; q += v[j] * v[j]; }
    for (int o = 1; o < 64; o <<= 1) q += __shfl_xor(q, o);
    const float rs = rsqrtf(q * (1.f / DM) + LN_EPS);
#pragma unroll
    for (int j = 0; j < 4; ++j) { const int c = j * 256 + lane * 4; const float4 gg = *(const float4*)(p.ln3_g + c), bb = *(const float4*)(p.ln3_b + c);
        float4 o; o.x = v[4 * j] * rs * gg.x + bb.x; o.y = v[4 * j + 1] * rs * gg.y + bb.y; o.z = v[4 * j + 2] * rs * gg.z + bb.z; o.w = v[4 * j + 3] * rs * gg.w + bb.w;
        *(float4*)(p.out + (size_t)w * DM + c) = o; }
}

#define LAS __attribute__((address_space(3)))
typedef short bf16x8 __attribute__((ext_vector_type(8)));
typedef short s16x4 __attribute__((ext_vector_type(4)));
typedef float f32x2 __attribute__((ext_vector_type(2)));
typedef float f32x4 __attribute__((ext_vector_type(4)));
typedef float f32x16 __attribute__((ext_vector_type(16)));
typedef unsigned u32x2 __attribute__((ext_vector_type(2)));
typedef unsigned u32x4 __attribute__((ext_vector_type(4)));
typedef __bf16 bf16x2_t __attribute__((ext_vector_type(2)));

constexpr int NWAVES = 8, NTHR = 512;
constexpr int LDS_BYTES = 147456;

__device__ __forceinline__ unsigned cvtpk(float lo, float hi) { f32x2 v = {lo, hi}; bf16x2_t b = __builtin_convertvector(v, bf16x2_t); return __builtin_bit_cast(unsigned, b); }
__device__ __forceinline__ int ld_i32_agent(const int* p) { return __hip_atomic_load(p, __ATOMIC_RELAXED, __HIP_MEMORY_SCOPE_AGENT); }
__device__ __forceinline__ float fast_exp2(float x) { return __builtin_amdgcn_exp2f(x); }
__device__ __forceinline__ float fast_rcp(float x) { return __builtin_amdgcn_rcpf(x); }

namespace gm {
constexpr int BM = 256, BK = 64, HALF = 128, HTB = HALF * BK * 2, STAGE_BYTES = 8 * HTB, NXCD = 8, WGM = 8;
__device__ __forceinline__ int lds_byte(int r, int c) { const int st = (r >> 4) * 2 + (c >> 5), rr = r & 15, cc = c & 31, ob = rr * 64 + cc * 2; return st * 1024 + (ob ^ (((ob >> 9) & 1) << 5)); }
__device__ __forceinline__ void stage_rc(int b, int& R, int& C) { const int st = b / 1024, sb = b % 1024, swz = sb ^ (((sb >> 9) & 1) << 5); R = (st >> 1) * 16 + swz / 64; C = (st & 1) * 32 + (swz % 64) / 2; }
__device__ __forceinline__ int perm32(int rho) { const int n = rho >> 4, i = rho & 15; return 8 * (i >> 2) + 4 * n + (i & 3); }

struct Unit { int pm, pn, e, nvalid, rowbase; const char* bptr; };

struct DenseSched {
    static constexpr bool GATHER_A = false;
    int nM, nN, nwg, G, c, K; const char* Bt;
    __device__ void init(int M, int N, int K_, const void* Bt_, int G_, int c_) { nM = M / BM; nN = N / BM; nwg = nM * nN; G = G_; c = c_; K = K_; Bt = (const char*)Bt_; }
    __device__ bool next(int i, Unit& u) const {
        const long L = (long)i * G + c; if (L >= nwg) return false;
        int wgid = (int)L; { const int q = nwg / NXCD, r = nwg % NXCD, xcd = wgid % NXCD, off = wgid / NXCD; wgid = (xcd < r ? xcd * (q + 1) : r * (q + 1) + (xcd - r) * q) + off; }
        const int nig = WGM * nN, gid = wgid / nig, fm = gid * WGM, gsz = (nM - fm) < WGM ? (nM - fm) : WGM;
        u.pm = fm + ((wgid % nig) % gsz); u.pn = (wgid % nig) / gsz; u.e = 0; u.nvalid = 256; u.rowbase = u.pm * 256;
        u.bptr = Bt + (size_t)u.pn * 256 * K * 2; return true;
    }
    __device__ unsigned aoff(const Unit& u, int r) const { return (unsigned)(u.rowbase + r) * (unsigned)(K * 2); }
    __device__ size_t abase(const Unit& u) const { return (size_t)u.rowbase * (size_t)(K * 2); }
};
template <int NPN_LOG2, int KB  , bool GATHER> struct MoeSched {
    static constexpr bool GATHER_A = GATHER;
    const int* tab; int nunits, G, c; const char* Wt; size_t estride; const int* rowtok;
    __device__ bool next(int i, Unit& u) const {
        int uidx; if (G == 256) { uidx = ((i * 8 + (c & 7)) * 32) + (c >> 3); } else uidx = i * G + c;
        if (uidx >= nunits) return false;
        const int rt = uidx >> NPN_LOG2; u.pn = uidx & ((1 << NPN_LOG2) - 1);
        u.e = __builtin_amdgcn_readfirstlane(ld_i32_agent(tab + 4 * rt)); u.pm = __builtin_amdgcn_readfirstlane(ld_i32_agent(tab + 4 * rt + 1));
        u.rowbase = __builtin_amdgcn_readfirstlane(ld_i32_agent(tab + 4 * rt + 2)); u.nvalid = __builtin_amdgcn_readfirstlane(ld_i32_agent(tab + 4 * rt + 3));
        u.bptr = Wt + (size_t)u.e * estride + (size_t)u.pn * 256 * KB * 2; return true;
    }
    __device__ unsigned aoff(const Unit& u, int r) const {
        if (GATHER) { int tok; if (u.e < NEXP) { const int rr = r < u.nvalid ? r : u.nvalid - 1; tok = ld_i32_agent(rowtok + u.rowbase + rr); } else tok = u.rowbase - AROWS + r; return (unsigned)tok * (unsigned)(KB * 2); }
        return (unsigned)(u.rowbase + r) * (unsigned)(KB * 2);
    }
    __device__ size_t abase(const Unit& u) const { return (size_t)u.rowbase * (size_t)(KB * 2); }
};

typedef f32x4 Acc[2][2][4][2];
__device__ __forceinline__ u32x4 pack8(const f32x4 a, const f32x4 b) { u32x4 w; w.x = cvtpk(a[0], a[1]); w.y = cvtpk(a[2], a[3]); w.z = cvtpk(b[0], b[1]); w.w = cvtpk(b[2], b[3]); return w; }

struct EpiInProj {
    static constexpr bool PERM = true; bf16* proj; const float* cs;
    __device__ __forceinline__ void operator()(const Acc& acc, const Unit& u, int wr, int wc, int fr, int fq) const {
#pragma unroll
        for (int ai = 0; ai < 2; ++ai)
#pragma unroll
            for (int m = 0; m < 4; ++m) { const int row = u.pm * 256 + ai * 128 + wr * 64 + m * 16 + fr;
#pragma unroll
                for (int bj = 0; bj < 2; ++bj) { const int c0 = u.pn * 256 + bj * 128 + wc * 32 + 8 * fq; const int seg = c0 >> 9;
                    f32x4 v0 = acc[ai][bj][m][0], v1 = acc[ai][bj][m][1];
                    if (seg != 2 && seg != 5) {
                        if ((c0 & 63) < 16) { const int j0 = (c0 & 63) >> 1; const f32x4 ca = *(const f32x4*)(cs + (size_t)row * 16 + 2 * j0), cb = *(const f32x4*)(cs + (size_t)row * 16 + 2 * j0 + 4);
                            { const float t1 = v0[0], t2 = v0[1]; v0[0] = t1 * ca[0] - t2 * ca[1]; v0[1] = t2 * ca[0] + t1 * ca[1]; }
                            { const float t1 = v0[2], t2 = v0[3]; v0[2] = t1 * ca[2] - t2 * ca[3]; v0[3] = t2 * ca[2] + t1 * ca[3]; }
                            { const float t1 = v1[0], t2 = v1[1]; v1[0] = t1 * cb[0] - t2 * cb[1]; v1[1] = t2 * cb[0] + t1 * cb[1]; }
                            { const float t1 = v1[2], t2 = v1[3]; v1[2] = t1 * cb[2] - t2 * cb[3]; v1[3] = t2 * cb[2] + t1 * cb[3]; } }
                        if (seg == 0 || seg == 3) { v0 = v0 * QSCALE64; v1 = v1 * QSCALE64; }
                    }
                    *(u32x4*)(proj + (size_t)row * INW + c0) = pack8(v0, v1); } }
    }
};
struct EpiOutProj {
    static constexpr bool PERM = true; bf16* y; const float* x;
    __device__ __forceinline__ void operator()(const Acc& acc, const Unit& u, int wr, int wc, int fr, int fq) const {
#pragma unroll
        for (int ai = 0; ai < 2; ++ai)
#pragma unroll
            for (int m = 0; m < 4; ++m) { const int row = u.pm * 256 + ai * 128 + wr * 64 + m * 16 + fr;
#pragma unroll
                for (int bj = 0; bj < 2; ++bj) { const int c0 = u.pn * 256 + bj * 128 + wc * 32 + 8 * fq;
                    const f32x4 x0 = *(const f32x4*)(x + (size_t)row * DM + c0), x1 = *(const f32x4*)(x + (size_t)row * DM + c0 + 4);
                    *(u32x4*)(y + (size_t)row * DM + c0) = pack8(x0 * DN_ALPHA + acc[ai][bj][m][0], x1 * DN_ALPHA + acc[ai][bj][m][1]); } }
    }
};
struct EpiScale {
    static constexpr bool PERM = true; bf16* o; int ldc; float sc;
    __device__ __forceinline__ void operator()(const Acc& acc, const Unit& u, int wr, int wc, int fr, int fq) const {
#pragma unroll
        for (int ai = 0; ai < 2; ++ai)
#pragma unroll
            for (int m = 0; m < 4; ++m) { const int row = u.pm * 256 + ai * 128 + wr * 64 + m * 16 + fr;
#pragma unroll
                for (int bj = 0; bj < 2; ++bj) { const int c0 = u.pn * 256 + bj * 128 + wc * 32 + 8 * fq;
                    *(u32x4*)(o + (size_t)row * ldc + c0) = pack8(acc[ai][bj][m][0] * sc, acc[ai][bj][m][1] * sc); } }
    }
};
struct EpiWo {
    static constexpr bool PERM = true; bf16* y; const bf16* h1;
    __device__ __forceinline__ void operator()(const Acc& acc, const Unit& u, int wr, int wc, int fr, int fq) const {
#pragma unroll
        for (int ai = 0; ai < 2; ++ai)
#pragma unroll
            for (int m = 0; m < 4; ++m) { const int row = u.pm * 256 + ai * 128 + wr * 64 + m * 16 + fr;
#pragma unroll
                for (int bj = 0; bj < 2; ++bj) { const int c0 = u.pn * 256 + bj * 128 + wc * 32 + 8 * fq;
                    const u32x4 hv = *(const u32x4*)(h1 + (size_t)row * DM + c0);
                    f32x4 a, b; a[0] = __uint_as_float(hv.x << 16); a[1] = __uint_as_float(hv.x & 0xffff0000u); a[2] = __uint_as_float(hv.y << 16); a[3] = __uint_as_float(hv.y & 0xffff0000u);
                    b[0] = __uint_as_float(hv.z << 16); b[1] = __uint_as_float(hv.z & 0xffff0000u); b[2] = __uint_as_float(hv.w << 16); b[3] = __uint_as_float(hv.w & 0xffff0000u);
                    *(u32x4*)(y + (size_t)row * DM + c0) = pack8(a * DN_ALPHA + acc[ai][bj][m][0], b * DN_ALPHA + acc[ai][bj][m][1]); } }
    }
};
struct EpiF32 {
    static constexpr bool PERM = false; float* C; int ldc;
    __device__ __forceinline__ void operator()(const Acc& acc, const Unit& u, int wr, int wc, int fr, int fq) const {
#pragma unroll
        for (int ai = 0; ai < 2; ++ai)
#pragma unroll
            for (int m = 0; m < 4; ++m) { const int row = u.pm * 256 + ai * 128 + wr * 64 + m * 16 + fr;
#pragma unroll
                for (int bj = 0; bj < 2; ++bj)
#pragma unroll
                    for (int n = 0; n < 2; ++n) *(f32x4*)(C + (size_t)row * ldc + u.pn * 256 + bj * 128 + wc * 32 + n * 16 + 4 * fq) = acc[ai][bj][m][n]; }
    }
};
__device__ __forceinline__ float silu_mul(float g, float uu) { return g * fast_rcp(1.f + fast_exp2(-g * LOG2E)) * uu; }
struct EpiMoe1 {
    static constexpr bool PERM = true; bf16* H;
    __device__ __forceinline__ void operator()(const Acc& acc, const Unit& u, int wr, int wc, int fr, int fq) const {
#pragma unroll
        for (int ai = 0; ai < 2; ++ai)
#pragma unroll
            for (int m = 0; m < 4; ++m) { const int rl = ai * 128 + wr * 64 + m * 16 + fr;
                if (rl < u.nvalid) { const f32x4 g0 = acc[ai][0][m][0], g1 = acc[ai][0][m][1], u0 = acc[ai][1][m][0], u1 = acc[ai][1][m][1]; f32x4 h0, h1;
#pragma unroll
                    for (int q = 0; q < 4; ++q) { h0[q] = silu_mul(g0[q], u0[q]); h1[q] = silu_mul(g1[q], u1[q]); }
                    *(u32x4*)(H + (size_t)(u.rowbase + rl) * EDIM + u.pn * 128 + wc * 32 + 8 * fq) = pack8(h0, h1); } }
    }
};
struct EpiMoe2 {
    static constexpr bool PERM = true; bf16* Y; const float* roww;
    __device__ __forceinline__ void operator()(const Acc& acc, const Unit& u, int wr, int wc, int fr, int fq) const {
#pragma unroll
        for (int ai = 0; ai < 2; ++ai)
#pragma unroll
            for (int m = 0; m < 4; ++m) { const int rl = ai * 128 + wr * 64 + m * 16 + fr;
                if (rl < u.nvalid) { const size_t row = (size_t)(u.rowbase + rl); const float w = u.e < NEXP ? __hip_atomic_load(roww + row, __ATOMIC_RELAXED, __HIP_MEMORY_SCOPE_AGENT) : 1.f;
#pragma unroll
                    for (int bj = 0; bj < 2; ++bj) *(u32x4*)(Y + row * DM + u.pn * 256 + bj * 128 + wc * 32 + 8 * fq) = pack8(acc[ai][bj][m][0] * w, acc[ai][bj][m][1] * w); } }
    }
};

template <class Epi, class Sched>
__device__ __forceinline__ void gemm_phase(LAS unsigned char* lds, const char* Abase, const int K, const Sched& S, const Epi& E) {
    const int tid = threadIdx.x, wid = __builtin_amdgcn_readfirstlane(tid >> 6), lane = tid & 63, wr = wid >> 2, wc = wid & 3, fr = lane & 15, fq = lane >> 4;
    const int nt = K / BK;
    int Rr[2]; unsigned Cb[2], voffB[2];
#pragma unroll
    for (int i = 0; i < 2; ++i) { int R, C; stage_rc(tid * 16 + i * 8192, R, C); const int Rb = Epi::PERM ? ((R & ~31) + perm32(R & 31)) : R; Rr[i] = R; Cb[i] = (unsigned)C * 2u; voffB[i] = (unsigned)(Rb * K + C) * 2u; }
    const size_t kstep = (size_t)(BK * 2);
    const size_t hstep = (size_t)HALF * K * 2;
    const unsigned ldsw = (unsigned)wid * 1024u;
    const int aoff = lds_byte(wr * 64 + fr, fq * 8), boff = lds_byte(wc * 32 + fr, fq * 8);
#define G_SA(b, h) (((b) * 2 + (h)) * HTB)
#define G_SB(b, h) ((4 + (b) * 2 + (h)) * HTB)
#define G_STAGE(bufoff, gbase, voff) do { _Pragma("unroll") for (int _i = 0; _i < 2; ++_i) \
        __builtin_amdgcn_global_load_lds((const unsigned*)((const char*)(gbase) + (voff)[_i]), (LAS unsigned*)(lds + (bufoff) + ldsw + _i * 8192), 16, 0, 0); } while (0)
#define G_LDA(dst, b, h) do { _Pragma("unroll") for (int m = 0; m < 4; ++m) _Pragma("unroll") for (int k = 0; k < 2; ++k) dst[m][k] = *(const LAS bf16x8*)(lds + G_SA(b, h) + aoff + m * 2048 + k * 1024); } while (0)
#define G_LDB(dst, b, h) do { _Pragma("unroll") for (int n = 0; n < 2; ++n) _Pragma("unroll") for (int k = 0; k < 2; ++k) dst[n][k] = *(const LAS bf16x8*)(lds + G_SB(b, h) + boff + n * 2048 + k * 1024); } while (0)
#define G_MMA(ai, bj, At, Bt) do { __builtin_amdgcn_s_setprio(1); _Pragma("unroll") for (int m = 0; m < 4; ++m) _Pragma("unroll") for (int n = 0; n < 2; ++n) _Pragma("unroll") for (int k = 0; k < 2; ++k) \
        acc[ai][bj][m][n] = __builtin_amdgcn_mfma_f32_16x16x32_bf16(Bt[n][k], At[m][k], acc[ai][bj][m][n], 0, 0, 0); __builtin_amdgcn_s_setprio(0); } while (0)
#define G_WAIT_V(n) asm volatile("s_waitcnt vmcnt(" #n ")" ::: "memory")
#define G_WAIT_L(n) asm volatile("s_waitcnt lgkmcnt(" #n ")" ::: "memory")
#define G_BAR __builtin_amdgcn_s_barrier()
#define G_SCHED __builtin_amdgcn_sched_barrier(0)
    Unit cur, nxt; int ui = 0;
    if (!S.next(0, cur)) return;
    Acc acc;
#pragma unroll
    for (int a = 0; a < 2; ++a)
#pragma unroll
        for (int b = 0; b < 2; ++b)
#pragma unroll
            for (int m = 0; m < 4; ++m)
#pragma unroll
                for (int n = 0; n < 2; ++n) acc[a][b][m][n] = (f32x4){0.f, 0.f, 0.f, 0.f};
    bf16x8 At[4][2], B0[2][2], B1[2][2];
    constexpr bool GA = Sched::GATHER_A;
    unsigned vAc0[2], vAc1[2], vAn0[2], vAn1[2];
    const char* cA = Abase; const char* nA = Abase;
#pragma unroll
    for (int i = 0; i < 2; ++i) {
        if constexpr (GA) { vAc0[i] = S.aoff(cur, Rr[i]) + Cb[i]; vAc1[i] = S.aoff(cur, 128 + Rr[i]) + Cb[i]; }
        else { vAc0[i] = (unsigned)Rr[i] * (unsigned)(K * 2) + Cb[i]; vAc1[i] = (unsigned)(128 + Rr[i]) * (unsigned)(K * 2) + Cb[i]; vAn0[i] = vAc0[i]; vAn1[i] = vAc1[i]; }
    }
    if constexpr (!GA) cA = Abase + S.abase(cur);
    const char* cB = cur.bptr;
    G_STAGE(G_SB(0, 0), cB, voffB); G_STAGE(G_SB(0, 1), cB + hstep, voffB); G_STAGE(G_SA(0, 0), cA, vAc0); G_STAGE(G_SA(0, 1), cA, vAc1);
    if (wr == 1) G_BAR;
    G_WAIT_V(2); G_BAR;
    G_STAGE(G_SB(1, 0), cB + kstep, voffB); G_STAGE(G_SA(1, 0), cA + kstep, vAc0); G_STAGE(G_SB(1, 1), cB + hstep + kstep, voffB);
    G_WAIT_V(6); G_BAR;
    for (;;) {
        const bool has_next = S.next(ui + 1, nxt);
        const char* nB = has_next ? nxt.bptr : cB;
        if constexpr (GA) {
#pragma unroll
            for (int i = 0; i < 2; ++i) { vAn0[i] = has_next ? S.aoff(nxt, Rr[i]) + Cb[i] : vAc0[i]; vAn1[i] = has_next ? S.aoff(nxt, 128 + Rr[i]) + Cb[i] : vAc1[i]; }
        } else { nA = has_next ? Abase + S.abase(nxt) : cA; }
#pragma unroll 1
        for (int t = 0; t < nt; t += 2) {
            const bool last = (t == nt - 2);
            const char* a1 = cA + (size_t)(t + 1) * kstep;
            const char* a2 = last ? nA : cA + (size_t)(t + 2) * kstep; const char* b2 = last ? nB : cB + (size_t)(t + 2) * kstep;
            const char* a3 = a2 + kstep; const char* b3 = b2 + kstep;
            unsigned v20[2], v21[2];
#pragma unroll
            for (int i = 0; i < 2; ++i) { if constexpr (GA) { v20[i] = last ? vAn0[i] : vAc0[i]; v21[i] = last ? vAn1[i] : vAc1[i]; } else { v20[i] = vAc0[i]; v21[i] = vAc1[i]; } }
            G_LDB(B0, 0, 0); G_LDB(B1, 0, 1); G_SCHED; G_LDA(At, 0, 0); G_STAGE(G_SA(1, 1), a1, vAc1);
            G_WAIT_V(8); G_WAIT_L(0); G_BAR; G_MMA(0, 0, At, B0); G_MMA(0, 1, At, B1); G_BAR; G_SCHED;
            G_LDA(At, 0, 1); G_STAGE(G_SB(0, 0), b2, voffB); G_STAGE(G_SB(0, 1), b2 + hstep, voffB); G_STAGE(G_SA(0, 0), a2, v20);
            G_WAIT_V(8); G_WAIT_L(0); G_BAR; G_MMA(1, 0, At, B0); G_MMA(1, 1, At, B1); G_BAR; G_SCHED;
            G_LDB(B0, 1, 0); G_LDB(B1, 1, 1); G_SCHED; G_LDA(At, 1, 0); G_STAGE(G_SA(0, 1), a2, v21);
            G_WAIT_V(8); G_WAIT_L(0); G_BAR; G_MMA(0, 0, At, B0); G_MMA(0, 1, At, B1); G_BAR; G_SCHED;
            G_LDA(At, 1, 1); G_STAGE(G_SB(1, 0), b3, voffB); G_STAGE(G_SB(1, 1), b3 + hstep, voffB); G_STAGE(G_SA(1, 0), a3, v20);
            G_WAIT_V(8); G_WAIT_L(0); G_BAR; G_MMA(1, 0, At, B0); G_MMA(1, 1, At, B1); G_BAR; G_SCHED;
        }
        if (wr == 0) G_BAR;
        E(acc, cur, wr, wc, fr, fq);
        if (!has_next) break;
#pragma unroll
        for (int a = 0; a < 2; ++a)
#pragma unroll
            for (int b = 0; b < 2; ++b)
#pragma unroll
                for (int m = 0; m < 4; ++m)
#pragma unroll
                    for (int n = 0; n < 2; ++n) acc[a][b][m][n] = (f32x4){0.f, 0.f, 0.f, 0.f};
        cur = nxt; cB = nB; ++ui;
        if constexpr (GA) {
#pragma unroll
            for (int i = 0; i < 2; ++i) { vAc0[i] = vAn0[i]; vAc1[i] = vAn1[i]; }
        } else cA = nA;
        if (wr == 1) G_BAR;
    }
    G_WAIT_V(0);
    G_BAR;
#undef G_SA
#undef G_SB
#undef G_STAGE
#undef G_LDA
#undef G_LDB
#undef G_MMA
#undef G_WAIT_V
#undef G_WAIT_L
#undef G_BAR
#undef G_SCHED
}
}

namespace fa {
__device__ __forceinline__ int crow(int r, int hi) { return (r & 3) + 8 * (r >> 2) + 4 * hi; }
typedef short v4i16_t __attribute__((ext_vector_type(4)));
__device__ __forceinline__ s16x4 vtr(const LAS char* p) { return __builtin_bit_cast(s16x4, __builtin_amdgcn_ds_read_tr16_b64_v4i16((LAS v4i16_t*)p)); }
__device__ __forceinline__ float halfmax(float m) { auto rr = __builtin_amdgcn_permlane32_swap(__float_as_uint(m), __float_as_uint(m), false, false); return fmaxf(__uint_as_float(rr[0]), __uint_as_float(rr[1])); }
__device__ __forceinline__ float halfsum(float m) { auto rr = __builtin_amdgcn_permlane32_swap(__float_as_uint(m), __float_as_uint(m), false, false); return __uint_as_float(rr[0]) + __uint_as_float(rr[1]); }

template <int NQ, int KSTR> __device__ __forceinline__ f32x16 qk(const LAS char* Kl, int j, const bf16x8 (&qf)[NQ], int lane) {
    f32x16 s = {0.f, 0.f, 0.f, 0.f, 0.f, 0.f, 0.f, 0.f, 0.f, 0.f, 0.f, 0.f, 0.f, 0.f, 0.f, 0.f};
    const LAS char* kp = Kl + (32 * j + (lane & 31)) * KSTR + (lane >> 5) * 16;
#pragma unroll
    for (int ds = 0; ds < NQ; ++ds) { const bf16x8 kf = *(const LAS bf16x8*)(kp + ds * 32); s = __builtin_amdgcn_mfma_f32_32x32x16_bf16(kf, qf[ds], s, 0, 0, 0); }
    return s;
}
template <int NO> __device__ __forceinline__ void softmax_step(f32x16& p0, f32x16& p1, float& m, float& l, f32x16 (&o)[NO], bf16x8 (&pf)[4]) {
    float mx = fmaxf(p0[0], p1[0]);
#pragma unroll
    for (int r = 1; r < 16; ++r) mx = fmaxf(mx, fmaxf(p0[r], p1[r]));
    mx = halfmax(mx);
    const float mn = fmaxf(m, mx), mu = (mn == -INFINITY) ? 0.f : mn;
    const float al = fast_exp2(m - mu);
    float sum = 0.f;
#pragma unroll
    for (int r = 0; r < 16; ++r) { p0[r] = fast_exp2(p0[r] - mu); p1[r] = fast_exp2(p1[r] - mu); sum += p0[r] + p1[r]; }
    l = l * al + sum; m = mn;
#pragma unroll
    for (int d = 0; d < NO; ++d)
#pragma unroll
        for (int r = 0; r < 16; ++r) o[d][r] *= al;
#pragma unroll
    for (int s = 0; s < 2; ++s) {
        u32x4 a, b;
        a.x = cvtpk(p0[8 * s], p0[8 * s + 1]); a.y = cvtpk(p0[8 * s + 2], p0[8 * s + 3]); a.z = cvtpk(p0[8 * s + 4], p0[8 * s + 5]); a.w = cvtpk(p0[8 * s + 6], p0[8 * s + 7]);
        b.x = cvtpk(p1[8 * s], p1[8 * s + 1]); b.y = cvtpk(p1[8 * s + 2], p1[8 * s + 3]); b.z = cvtpk(p1[8 * s + 4], p1[8 * s + 5]); b.w = cvtpk(p1[8 * s + 6], p1[8 * s + 7]);
        pf[s] = __builtin_bit_cast(bf16x8, a); pf[2 + s] = __builtin_bit_cast(bf16x8, b);
    }
}
template <int NO, int VSTR> __device__ __forceinline__ void pv(f32x16 (&o)[NO], const LAS char* Vl, const bf16x8 (&pf)[4], int lane) {
    const LAS char* vb = Vl + (4 * (lane >> 5) + ((lane & 15) >> 2)) * VSTR + (16 * ((lane >> 4) & 1) + 4 * (lane & 3)) * 2;
#pragma unroll
    for (int d = 0; d < NO; ++d)
#pragma unroll
        for (int ks = 0; ks < 4; ++ks) {
            const s16x4 lo = vtr(vb + (16 * ks) * VSTR + d * 64), hi = vtr(vb + (16 * ks + 8) * VSTR + d * 64);
            const bf16x8 vf = (bf16x8){lo[0], lo[1], lo[2], lo[3], hi[0], hi[1], hi[2], hi[3]};
            o[d] = __builtin_amdgcn_mfma_f32_32x32x16_bf16(vf, pf[ks], o[d], 0, 0, 0);
        }
}
template <int NO> __device__ __forceinline__ void store_o(const f32x16 (&o)[NO], float inv, bf16* rowp, int hi) {
#pragma unroll
    for (int d = 0; d < NO; ++d)
#pragma unroll
        for (int g = 0; g < 4; ++g) { u32x2 w; w.x = cvtpk(o[d][4 * g] * inv, o[d][4 * g + 1] * inv); w.y = cvtpk(o[d][4 * g + 2] * inv, o[d][4 * g + 3] * inv);
            *(u32x2*)(rowp + 32 * d + 8 * g + 4 * hi) = w; }
}
}

__device__ __forceinline__ void diff_unit(const P& p, int b, int h, int qb, LAS unsigned char* ldsu, float lam) {
    constexpr int KSTR = 144, VSTR = 320, KB = 64 * KSTR, VB = 64 * VSTR, BUF = 2 * KB + VB;
    LAS char* lds = (LAS char*)ldsu;
    const int tid = threadIdx.x, lane = tid & 63, wid = __builtin_amdgcn_readfirstlane(tid >> 6), hi = lane >> 5;
    const int comp = wid >> 2, w4 = wid & 3;
    const bf16* proj = (const bf16*)(p.ws + WS_PROJ);
    const size_t rb = (size_t)b * SEQ;
    const int q0 = qb * 128, qmin = q0 + 32 * w4, qpos = qmin + (lane & 31);
    bf16x8 qf[4];
#pragma unroll
    for (int ds = 0; ds < 4; ++ds) qf[ds] = *(const bf16x8*)(proj + (rb + qpos) * INW + 1536 + h * 128 + comp * 64 + ds * 16 + hi * 8);
    const int ntiles = 2 * qb + 2;
    const int krow = tid >> 3, kch = tid & 7;
    const bf16* ksrc = proj + (rb + krow) * INW + 2048 + h * 128 + kch * 8;
    const int vrow0 = tid >> 4, vch = tid & 15;
    const bf16* vsrc = proj + (rb + vrow0) * INW + 2560 + h * 128 + vch * 8;
    const int kdst = krow * KSTR + kch * 16, vdst = 2 * KB + vrow0 * VSTR + vch * 16;
    u32x4 rk0, rk1, rv0, rv1;
    { rk0 = *(const u32x4*)(ksrc); rk1 = *(const u32x4*)(ksrc + 64); rv0 = *(const u32x4*)(vsrc); rv1 = *(const u32x4*)(vsrc + (size_t)32 * INW); }
    *(LAS u32x4*)(lds + kdst) = rk0; *(LAS u32x4*)(lds + KB + kdst) = rk1; *(LAS u32x4*)(lds + vdst) = rv0; *(LAS u32x4*)(lds + vdst + 32 * VSTR) = rv1;
    __syncthreads();
    float m = -INFINITY, l = 0.f; f32x16 o[4];
#pragma unroll
    for (int d = 0; d < 4; ++d)
#pragma unroll
        for (int r = 0; r < 16; ++r) o[d][r] = 0.f;
    for (int kt = 0; kt < ntiles; ++kt) {
        const bool more = kt + 1 < ntiles;
        if (more) { const size_t off = (size_t)(kt + 1) * 64 * INW; rk0 = *(const u32x4*)(ksrc + off); rk1 = *(const u32x4*)(ksrc + off + 64); rv0 = *(const u32x4*)(vsrc + off); rv1 = *(const u32x4*)(vsrc + off + (size_t)32 * INW); }
        const LAS char* buf = lds + (kt & 1) * BUF;
        const int k0 = kt * 64;
        if (k0 <= qmin + 31) {
            const LAS char* Kl = buf + comp * KB;
            f32x16 p0 = fa::qk<4, KSTR>(Kl, 0, qf, lane), p1 = fa::qk<4, KSTR>(Kl, 1, qf, lane);
            if (k0 + 63 > qmin) {
#pragma unroll
                for (int r = 0; r < 16; ++r) { const int key = k0 + fa::crow(r, hi); if (key > qpos) p0[r] = -INFINITY; if (key + 32 > qpos) p1[r] = -INFINITY; }
            }
            bf16x8 pf[4];
            fa::softmax_step<4>(p0, p1, m, l, o, pf);
            fa::pv<4, VSTR>(o, buf + 2 * KB, pf, lane);
        }
        if (more) { LAS char* nb = lds + ((kt + 1) & 1) * BUF; *(LAS u32x4*)(nb + kdst) = rk0; *(LAS u32x4*)(nb + KB + kdst) = rk1; *(LAS u32x4*)(nb + vdst) = rv0; *(LAS u32x4*)(nb + vdst + 32 * VSTR) = rv1; }
        __syncthreads();
    }
    l = fa::halfsum(l);
    const float inv = fast_rcp(l);
    LAS float* ex = (LAS float*)lds + w4 * 4096;
    if (comp == 1) {
#pragma unroll
        for (int d = 0; d < 4; ++d)
#pragma unroll
            for (int r = 0; r < 16; ++r) ex[(d * 16 + r) * 64 + lane] = o[d][r] * inv;
    }
    __syncthreads();
    if (comp == 0) {
        float ss = 0.f;
#pragma unroll
        for (int d = 0; d < 4; ++d)
#pragma unroll
            for (int r = 0; r < 16; ++r) { const float v = o[d][r] * inv - lam * ex[(d * 16 + r) * 64 + lane]; o[d][r] = v; ss += v * v; }
        ss = fa::halfsum(ss);
        const float rs = rsqrtf(ss * (1.f / 128.f) + SUBLN_EPS) * (1.f - LAMBDA_INIT);
        bf16* rowp = (bf16*)(p.ws + WS_MIXIN) + (rb + qpos) * DM + 512 + h * 128;
#pragma unroll
        for (int d = 0; d < 4; ++d)
#pragma unroll
            for (int g = 0; g < 4; ++g) { const int dd = 32 * d + 8 * g + 4 * hi; const f32x4 gg = *(const f32x4*)(p.subln_g + dd);
                u32x2 w; w.x = cvtpk(o[d][4 * g] * rs * gg[0], o[d][4 * g + 1] * rs * gg[1]); w.y = cvtpk(o[d][4 * g + 2] * rs * gg[2], o[d][4 * g + 3] * rs * gg[3]);
                *(u32x2*)(rowp + dd) = w; }
    }
    __syncthreads();
}

__device__ __forceinline__ void dil_unit(const P& p, int b, int h, int br, int grp, LAS unsigned char* ldsu) {
    constexpr int KSTR = 144, VSTR = 192, KALL = 384 * KSTR;
    LAS char* lds = (LAS char*)ldsu;
    const int tid = threadIdx.x, lane = tid & 63, wid = __builtin_amdgcn_readfirstlane(tid >> 6), hi = lane >> 5;
    const int dil = br == 0 ? 1 : (br == 1 ? 4 : 16), ngr = 16 / dil, res = grp / ngr, i0 = 256 * (grp % ngr);
    const bf16* proj = (const bf16*)(p.ws + WS_PROJ);
    const size_t rb = (size_t)b * SEQ;
#pragma unroll
    for (int i = 0; i < 6; ++i) { const int pidx = tid + 512 * i, row = pidx >> 3, ch = pidx & 7; int kidx = i0 - 128 + row; if (kidx < 0) kidx = 0;
        const bf16* src = proj + (rb + (size_t)kidx * dil + res) * INW + h * 64 + ch * 8;
        const u32x4 kv = *(const u32x4*)(src + 512), vv = *(const u32x4*)(src + 1024);
        *(LAS u32x4*)(lds + row * KSTR + ch * 16) = kv; *(LAS u32x4*)(lds + KALL + row * VSTR + ch * 16) = vv; }
    const int qi = i0 + 32 * wid + (lane & 31);
    const size_t qrow = rb + (size_t)qi * dil + res;
    bf16x8 qf[4];
#pragma unroll
    for (int ds = 0; ds < 4; ++ds) qf[ds] = *(const bf16x8*)(proj + qrow * INW + h * 64 + ds * 16 + hi * 8);
    __syncthreads();
    float m = -INFINITY, l = 0.f; f32x16 o[2];
#pragma unroll
    for (int d = 0; d < 2; ++d)
#pragma unroll
        for (int r = 0; r < 16; ++r) o[d][r] = 0.f;
#pragma unroll 1
    for (int kk = 0; kk < 3; ++kk) {
        const int kt = (wid >> 1) + kk;
        const LAS char* Kl = lds + kt * 64 * KSTR;
        f32x16 p0 = fa::qk<4, KSTR>(Kl, 0, qf, lane), p1 = fa::qk<4, KSTR>(Kl, 1, qf, lane);
        const int kb = i0 - 128 + 64 * kt;
#pragma unroll
        for (int r = 0; r < 16; ++r) { const int k0i = kb + fa::crow(r, hi), k1i = k0i + 32;
            if (k0i < 0 || k0i > qi || qi - k0i > 128) p0[r] = -INFINITY;
            if (k1i < 0 || k1i > qi || qi - k1i > 128) p1[r] = -INFINITY; }
        bf16x8 pf[4];
        fa::softmax_step<2>(p0, p1, m, l, o, pf);
        fa::pv<2, VSTR>(o, lds + KALL + kt * 64 * VSTR, pf, lane);
    }
    l = fa::halfsum(l);
    const float inv = fast_rcp(l);
    fa::store_o<2>(o, inv, (bf16*)(p.ws + WS_PARTA) + ((size_t)br * T + qrow) * 512 + h * 64, hi);
    if (hi == 0) ((float*)(p.ws + WS_LSEA))[((size_t)br * T + qrow) * 8 + h] = m + log2f(l);
    __syncthreads();
}

__device__ __forceinline__ void mem_unit(const P& p, int b, int h, int qblk, LAS unsigned char* ldsu) {
    constexpr int KSTR = 528, VSTR = 192, KB = 64 * KSTR, VB = 64 * VSTR, BUF = KB + VB;
    LAS char* lds = (LAS char*)ldsu;
    const int tid = threadIdx.x, lane = tid & 63, wid = __builtin_amdgcn_readfirstlane(tid >> 6), hi = lane >> 5;
    const bf16* qm = (const bf16*)(p.ws + WS_QM); const bf16* kvm = (const bf16*)(p.ws + WS_KVM);
    const size_t qrow = (size_t)b * SEQ + qblk * 256 + 32 * wid + (lane & 31);
    bf16x8 qf[16];
#pragma unroll
    for (int ds = 0; ds < 16; ++ds) qf[ds] = *(const bf16x8*)(qm + qrow * DM + h * 256 + ds * 16 + hi * 8);
    const bf16* kbase = kvm + (size_t)(b * MEML) * 2048 + h * 256;
#pragma unroll 1
    for (int quarter = 0; quarter < 4; ++quarter) {
        const bf16* vbase = kvm + (size_t)(b * MEML) * 2048 + 1024 + h * 256 + quarter * 64;
        u32x4 rk[4], rv;
#define MEM_LOAD(kt) do { _Pragma("unroll") for (int i = 0; i < 4; ++i) { const int pidx = tid + 512 * i, row = pidx >> 5, ch = pidx & 31; rk[i] = *(const u32x4*)(kbase + (size_t)((kt) * 64 + row) * 2048 + ch * 8); } \
        { const int row = tid >> 3, ch = tid & 7; rv = *(const u32x4*)(vbase + (size_t)((kt) * 64 + row) * 2048 + ch * 8); } } while (0)
#define MEM_WRITE(bufp) do { _Pragma("unroll") for (int i = 0; i < 4; ++i) { const int pidx = tid + 512 * i, row = pidx >> 5, ch = pidx & 31; *(LAS u32x4*)((bufp) + row * KSTR + ch * 16) = rk[i]; } \
        { const int row = tid >> 3, ch = tid & 7; *(LAS u32x4*)((bufp) + KB + row * VSTR + ch * 16) = rv; } } while (0)
        MEM_LOAD(0); MEM_WRITE(lds);
        __syncthreads();
        float m = -INFINITY, l = 0.f; f32x16 o[2];
#pragma unroll
        for (int d = 0; d < 2; ++d)
#pragma unroll
            for (int r = 0; r < 16; ++r) o[d][r] = 0.f;
#pragma unroll 1
        for (int kt = 0; kt < 4; ++kt) {
            const bool more = kt < 3;
            if (more) MEM_LOAD(kt + 1);
            const LAS char* buf = lds + (kt & 1) * BUF;
            f32x16 p0 = fa::qk<16, KSTR>(buf, 0, qf, lane), p1 = fa::qk<16, KSTR>(buf, 1, qf, lane);
            bf16x8 pf[4];
            fa::softmax_step<2>(p0, p1, m, l, o, pf);
            fa::pv<2, VSTR>(o, buf + KB, pf, lane);
            if (more) { LAS char* nb = lds + ((kt + 1) & 1) * BUF; MEM_WRITE(nb); }
            __syncthreads();
        }
#undef MEM_LOAD
#undef MEM_WRITE
        l = fa::halfsum(l);
        fa::store_o<2>(o, fast_rcp(l), (bf16*)(p.ws + WS_MO) + qrow * DM + h * 256 + quarter * 64, hi);
    }
}

struct Ctx { int tid, lane, wave, G, vcu, gw, ngw; LAS unsigned char* lds; };

template <class RowMap> __device__ __forceinline__ void transpose_tile(const float* W, int N, int k0, int n0, bf16* dst, int dstK, LAS float* scr, int lane, const RowMap& rm) {
    f32x4 v[16];
#pragma unroll
    for (int i = 0; i < 16; ++i) v[i] = *(const f32x4*)(W + (size_t)(k0 + 4 * i + (lane >> 4)) * N + n0 + (lane & 15) * 4);
#pragma unroll
    for (int i = 0; i < 16; ++i) { LAS float* s = scr + (4 * i + (lane >> 4)) * 65 + (lane & 15) * 4; s[0] = v[i][0]; s[1] = v[i][1]; s[2] = v[i][2]; s[3] = v[i][3]; }
    asm volatile("s_waitcnt lgkmcnt(0)" ::: "memory");
    const int c = lane & 7;
#pragma unroll
    for (int j = 0; j < 8; ++j) { const int n = (lane >> 3) + 8 * j; const LAS float* s = scr + (8 * c) * 65 + n;
        u32x4 w; w.x = cvtpk(s[0], s[65]); w.y = cvtpk(s[2 * 65], s[3 * 65]); w.z = cvtpk(s[4 * 65], s[5 * 65]); w.w = cvtpk(s[6 * 65], s[7 * 65]);
        *(u32x4*)(dst + (size_t)rm(n0 + n) * dstK + k0 + 8 * c) = w; }
    asm volatile("s_waitcnt lgkmcnt(0)" ::: "memory");
}
struct RmId { __device__ int operator()(int n) const { return n; } };
struct RmInProj { __device__ int operator()(int n) const { const int seg = n >> 9; if (seg == 2 || seg == 5) return n; const int d = n & 63; return (n & ~63) | (d < 16 ? 2 * (d & 7) + (d >> 3) : d); } };
struct RmGU { int up; __device__ int operator()(int n) const { return (n >> 7) * 256 + up * 128 + (n & 127); } };

__device__ __forceinline__ void phase_prologue(const P& p, const Ctx& c) {
    LAS float* scr = (LAS float*)(c.lds + c.wave * 16640);
    unsigned char* ws = p.ws;
    constexpr int I_IN = 16 * 48, I_SQ = 16 * 16, I_KV = 16 * 32, I_R = 16 * 4, I_E = 64;
    constexpr int ND = I_IN + 3 * I_SQ + I_KV + I_R;
    const int NIT = ND + 3 * I_E * (NEXP + 1);
    for (int it = c.gw; it < NIT; it += c.ngw) {
        int r = it;
        if (r < I_IN) { transpose_tile(p.w_in, INW, (r / 48) * 64, (r % 48) * 64, (bf16*)(ws + WS_WINT), DM, scr, c.lane, RmInProj{}); continue; } r -= I_IN;
        if (r < I_SQ) { transpose_tile(p.w_out, DM, (r / 16) * 64, (r % 16) * 64, (bf16*)(ws + WS_WOUTT), DM, scr, c.lane, RmId{}); continue; } r -= I_SQ;
        if (r < I_SQ) { transpose_tile(p.wq, DM, (r / 16) * 64, (r % 16) * 64, (bf16*)(ws + WS_WQT), DM, scr, c.lane, RmId{}); continue; } r -= I_SQ;
        if (r < I_KV) { transpose_tile(p.wkv, 2048, (r / 32) * 64, (r % 32) * 64, (bf16*)(ws + WS_WKVT), DM, scr, c.lane, RmId{}); continue; } r -= I_KV;
        if (r < I_SQ) { transpose_tile(p.wo, DM, (r / 16) * 64, (r % 16) * 64, (bf16*)(ws + WS_WOT), DM, scr, c.lane, RmId{}); continue; } r -= I_SQ;
        if (r < I_R) { transpose_tile(p.w_router, NEXP, (r / 4) * 64, (r % 4) * 64, (bf16*)(ws + WS_WRT), DM, scr, c.lane, RmId{}); continue; } r -= I_R;
        const int e = r / (3 * I_E), q = r % (3 * I_E), which = q / I_E, ti = q % I_E;
        if (which == 0) { const float* W = e < NEXP ? p.w_gate + (size_t)e * DM * EDIM : p.ws_gate; transpose_tile(W, EDIM, (ti / 4) * 64, (ti % 4) * 64, (bf16*)(ws + WS_WTGU) + (size_t)e * 512 * DM, DM, scr, c.lane, RmGU{0}); }
        else if (which == 1) { const float* W = e < NEXP ? p.w_up + (size_t)e * DM * EDIM : p.ws_up; transpose_tile(W, EDIM, (ti / 4) * 64, (ti % 4) * 64, (bf16*)(ws + WS_WTGU) + (size_t)e * 512 * DM, DM, scr, c.lane, RmGU{1}); }
        else { const float* W = e < NEXP ? p.w_down + (size_t)e * EDIM * DM : p.ws_down; transpose_tile(W, DM, (ti / 16) * 64, (ti % 16) * 64, (bf16*)(ws + WS_WTD) + (size_t)e * DM * EDIM, EDIM, scr, c.lane, RmId{}); }
    }
    const int gt = c.vcu * NTHR + c.tid, ngt = c.G * NTHR;
    for (int i = gt; i < T * DM / 8; i += ngt) { const f32x4 a = *(const f32x4*)(p.x + (size_t)i * 8), b = *(const f32x4*)(p.x + (size_t)i * 8 + 4); *(u32x4*)((bf16*)(ws + WS_XB) + (size_t)i * 8) = gm::pack8(a, b); }
    for (int i = gt; i < BATCH * MEML * DM / 8; i += ngt) { const f32x4 a = *(const f32x4*)(p.mem + (size_t)i * 8), b = *(const f32x4*)(p.mem + (size_t)i * 8 + 4); *(u32x4*)((bf16*)(ws + WS_MEMB) + (size_t)i * 8) = gm::pack8(a, b); }
    for (int i = gt; i < T * 8; i += ngt) { const int t = i >> 3, j = i & 7; const float inv = powf(500000.0f, -(float)(2 * j) / 16.0f); const float ang = (float)p.pos[t] * inv;
        ((float2*)(ws + WS_CS))[i] = make_float2(cosf(ang), sinf(ang)); }
    if (gt < 256) ((int*)(ws + WS_CNT))[gt] = 0;
    if (gt == 0) { float a = 0.f, b = 0.f; for (int k = 0; k < 64; ++k) { a += p.lq1[k] * p.lk1[k]; b += p.lq2[k] * p.lk2[k]; } ((float*)(ws + WS_SCAL))[0] = expf(a) - expf(b) + LAMBDA_INIT; }
}

__device__ __forceinline__ void unpack8(const u32x4 u, float (&v)[8]) {
    v[0] = __uint_as_float(u.x << 16); v[1] = __uint_as_float(u.x & 0xffff0000u); v[2] = __uint_as_float(u.y << 16); v[3] = __uint_as_float(u.y & 0xffff0000u);
    v[4] = __uint_as_float(u.z << 16); v[5] = __uint_as_float(u.z & 0xffff0000u); v[6] = __uint_as_float(u.w << 16); v[7] = __uint_as_float(u.w & 0xffff0000u);
}
__device__ __forceinline__ void phase_merge(const P& p, const Ctx& c) {
    const int gt = c.vcu * NTHR + c.tid, ngt = c.G * NTHR;
    const float* lse = (const float*)(p.ws + WS_LSEA); const bf16* pa = (const bf16*)(p.ws + WS_PARTA); bf16* mx = (bf16*)(p.ws + WS_MIXIN);
    for (int i = gt; i < T * 64; i += ngt) {
        const int t = i >> 6, c8 = (i & 63) * 8, h = c8 >> 6;
        const float l0 = lse[(size_t)t * 8 + h], l1 = lse[((size_t)T + t) * 8 + h], l2 = lse[((size_t)2 * T + t) * 8 + h];
        const float mxl = fmaxf(l0, fmaxf(l1, l2));
        float w0 = fast_exp2(l0 - mxl), w1 = fast_exp2(l1 - mxl), w2 = fast_exp2(l2 - mxl); const float inv = 1.f / (w0 + w1 + w2); w0 *= inv; w1 *= inv; w2 *= inv;
        float a[8], b[8], d[8];
        unpack8(*(const u32x4*)(pa + (size_t)t * 512 + c8), a); unpack8(*(const u32x4*)(pa + ((size_t)T + t) * 512 + c8), b); unpack8(*(const u32x4*)(pa + ((size_t)2 * T + t) * 512 + c8), d);
        u32x4 o; o.x = cvtpk(w0 * a[0] + w1 * b[0] + w2 * d[0], w0 * a[1] + w1 * b[1] + w2 * d[1]); o.y = cvtpk(w0 * a[2] + w1 * b[2] + w2 * d[2], w0 * a[3] + w1 * b[3] + w2 * d[3]);
        o.z = cvtpk(w0 * a[4] + w1 * b[4] + w2 * d[4], w0 * a[5] + w1 * b[5] + w2 * d[5]); o.w = cvtpk(w0 * a[6] + w1 * b[6] + w2 * d[6], w0 * a[7] + w1 * b[7] + w2 * d[7]);
        *(u32x4*)(mx + (size_t)t * DM + c8) = o;
    }
}
__device__ __forceinline__ void phase_ln(const bf16* in, bf16* outp, const float* g, const float* bb_, const Ctx& c) {
    for (int w = c.gw; w < T; w += c.ngw) {
        const bf16* r = in + (size_t)w * DM; float v[16]; float s = 0.f;
#pragma unroll
        for (int j = 0; j < 4; ++j) { const u32x2 u = *(const u32x2*)(r + j * 256 + c.lane * 4);
            v[4 * j] = __uint_as_float(u.x << 16); v[4 * j + 1] = __uint_as_float(u.x & 0xffff0000u); v[4 * j + 2] = __uint_as_float(u.y << 16); v[4 * j + 3] = __uint_as_float(u.y & 0xffff0000u); }
#pragma unroll
        for (int j = 0; j < 16; ++j) s += v[j];
#pragma unroll
        for (int o = 1; o < 64; o <<= 1) s += __shfl_xor(s, o);
        const float mu = s * (1.f / DM); float q = 0.f;
#pragma unroll
        for (int j = 0; j < 16; ++j) { v[j] -= mu; q += v[j] * v[j]; }
#pragma unroll
        for (int o = 1; o < 64; o <<= 1) q += __shfl_xor(q, o);
        const float rs = rsqrtf(q * (1.f / DM) + LN_EPS);
#pragma unroll
        for (int j = 0; j < 4; ++j) { const int cc = j * 256 + c.lane * 4; const f32x4 gg = *(const f32x4*)(g + cc), bb = *(const f32x4*)(bb_ + cc);
            u32x2 u; u.x = cvtpk(v[4 * j] * rs * gg[0] + bb[0], v[4 * j + 1] * rs * gg[1] + bb[1]); u.y = cvtpk(v[4 * j + 2] * rs * gg[2] + bb[2], v[4 * j + 3] * rs * gg[3] + bb[3]);
            *(u32x2*)(outp + (size_t)w * DM + cc) = u; }
    }
}
__device__ __forceinline__ void phase_route(const P& p, const Ctx& c) {
    const int lane = c.lane;
    for (int w = c.gw; w < T; w += c.ngw) {
        const f32x4 lg = *(const f32x4*)((const float*)(p.ws + WS_LOGITS) + (size_t)w * NEXP + lane * 4);
        const f32x4 eb = *(const f32x4*)(p.e_bias + lane * 4);
        float sc[4], bs[4];
#pragma unroll
        for (int j = 0; j < 4; ++j) { sc[j] = 1.f / (1.f + expf(-lg[j])); bs[j] = sc[j] + eb[j]; }
        float m1 = fmaxf(bs[0], bs[1]), m2 = fminf(bs[0], bs[1]);
        { const float cc = bs[2]; const float n1 = fmaxf(m1, cc); m2 = fmaxf(m2, fminf(m1, cc)); m1 = n1; }
        { const float cc = bs[3]; const float n1 = fmaxf(m1, cc); m2 = fmaxf(m2, fminf(m1, cc)); m1 = n1; }
#pragma unroll
        for (int o = 1; o < 8; o <<= 1) { const float b1 = __shfl_xor(m1, o), b2 = __shfl_xor(m2, o); const float n1 = fmaxf(m1, b1); m2 = fmaxf(fminf(m1, b1), fmaxf(m2, b2)); m1 = n1; }
        const float gs = m1 + m2; const int grp = lane >> 3; int rank = 0;
#pragma unroll
        for (int g2 = 0; g2 < 8; ++g2) { const float o = __shfl(gs, g2 * 8); rank += (o > gs || (o == gs && g2 < grp)) ? 1 : 0; }
        const bool sel = rank < 4;
        float cand[4];
#pragma unroll
        for (int j = 0; j < 4; ++j) cand[j] = sel ? bs[j] : -INFINITY;
        int myidx = 0; float myw = 0.f, wsum = 0.f;
#pragma unroll 1
        for (int k = 0; k < TOPK; ++k) {
            float bv = cand[0]; int bi = lane * 4;
#pragma unroll
            for (int j = 1; j < 4; ++j) if (cand[j] > bv) { bv = cand[j]; bi = lane * 4 + j; }
#pragma unroll
            for (int o = 1; o < 64; o <<= 1) { const float ov = __shfl_xor(bv, o); const int oi = __shfl_xor(bi, o); if (ov > bv || (ov == bv && oi < bi)) { bv = ov; bi = oi; } }
            const int own = bi >> 2, el = bi & 3;
            const float sv = el == 0 ? sc[0] : (el == 1 ? sc[1] : (el == 2 ? sc[2] : sc[3]));
            const float wv = __shfl(sv, own);
            if (lane == own) { if (el == 0) cand[0] = -INFINITY; else if (el == 1) cand[1] = -INFINITY; else if (el == 2) cand[2] = -INFINITY; else cand[3] = -INFINITY; }
            wsum += wv;
            if (lane == k) { myidx = bi; myw = wv; }
        }
        if (lane < TOPK) {
            const int rk = atomicAdd((int*)(p.ws + WS_CNT) + myidx, 1);
            ((int*)(p.ws + WS_RIDX))[(size_t)w * 8 + lane] = myidx;
            ((float*)(p.ws + WS_RW))[(size_t)w * 8 + lane] = myw / wsum * ROUTED_SCALE;
            ((int*)(p.ws + WS_RRANK))[(size_t)w * 8 + lane] = rk;
        }
    }
}
__device__ __forceinline__ void phase_scatter(const P& p, const Ctx& c) {
    LAS int* sh = (LAS int*)c.lds;
    const int tid = c.tid;
    int cnt = 0;
    if (tid < 256) { cnt = ld_i32_agent((const int*)(p.ws + WS_CNT) + tid); sh[tid] = cnt; sh[256 + tid] = (cnt + 255) >> 8; }
    __syncthreads();
    for (int o = 1; o < 256; o <<= 1) { int v = 0, v2 = 0; if (tid < 256 && tid >= o) { v = sh[tid - o]; v2 = sh[256 + tid - o]; } __syncthreads(); if (tid < 256) { sh[tid] += v; sh[256 + tid] += v2; } __syncthreads(); }
    if (blockIdx.x == 0) {
        int* st = (int*)(p.ws + WS_START); int* tab = (int*)(p.ws + WS_TILETAB);
        if (tid < 256) { const int st_e = sh[tid] - cnt; st[tid + 1] = sh[tid]; if (tid == 0) st[0] = 0;
            const int nte = (cnt + 255) >> 8, tb = sh[256 + tid] - nte;
            for (int ti = 0; ti < nte; ++ti) { int* q = tab + 4 * (tb + ti); q[0] = tid; q[1] = ti; q[2] = st_e + 256 * ti; q[3] = min(256, cnt - 256 * ti); } }
        const int nrt_r = sh[511];
        if (tid < 128) { int* q = tab + 4 * (nrt_r + tid); q[0] = NEXP; q[1] = tid; q[2] = AROWS + 256 * tid; q[3] = 256; }
        if (tid == 0) ((int*)(p.ws + WS_NRT))[0] = nrt_r + 128;
    }
    const int gt = c.vcu * NTHR + tid, ngt = c.G * NTHR;
    for (int i = gt; i < T * 8; i += ngt) {
        const int e = ((const int*)(p.ws + WS_RIDX))[i], rk = ((const int*)(p.ws + WS_RRANK))[i];
        const int pos = (e == 0 ? 0 : sh[e - 1]) + rk;
        ((int*)(p.ws + WS_ROWTOK))[pos] = i >> 3;
        ((float*)(p.ws + WS_ROWW))[pos] = ((const float*)(p.ws + WS_RW))[i];
        ((int*)(p.ws + WS_POS))[i] = pos;
    }
    __syncthreads();
}
__device__ __forceinline__ void phase_combine(const P& p, const Ctx& c) {
    const int lane = c.lane;
    const bf16* Y = (const bf16*)(p.ws + WS_Y);
    for (int w = c.gw; w < T; w += c.ngw) {
        const bf16* h2 = (const bf16*)(p.ws + WS_H2) + (size_t)w * DM;
        const int* pos = (const int*)(p.ws + WS_POS) + (size_t)w * 8;
        float v[16];
#pragma unroll
        for (int j = 0; j < 4; ++j) { const u32x2 u = *(const u32x2*)(h2 + j * 256 + lane * 4);
            v[4 * j] = DN_ALPHA * __uint_as_float(u.x << 16); v[4 * j + 1] = DN_ALPHA * __uint_as_float(u.x & 0xffff0000u); v[4 * j + 2] = DN_ALPHA * __uint_as_float(u.y << 16); v[4 * j + 3] = DN_ALPHA * __uint_as_float(u.y & 0xffff0000u); }
#pragma unroll
        for (int k = 0; k < 9; ++k) {
            const size_t row = k < 8 ? (size_t)pos[k < 8 ? k : 0] : (size_t)AROWS + w;
            const bf16* yr = Y + row * DM;
#pragma unroll
            for (int j = 0; j < 4; ++j) { const u32x2 u = *(const u32x2*)(yr + j * 256 + lane * 4);
                v[4 * j] += __uint_as_float(u.x << 16); v[4 * j + 1] += __uint_as_float(u.x & 0xffff0000u); v[4 * j + 2] += __uint_as_float(u.y << 16); v[4 * j + 3] += __uint_as_float(u.y & 0xffff0000u); }
        }
        float s = 0.f;
#pragma unroll
        for (int j = 0; j < 16; ++j) s += v[j];
#pragma unroll
        for (int o = 1; o < 64; o <<= 1) s += __shfl_xor(s, o);
        const float mu = s * (1.f / DM); float q = 0.f;
#pragma unroll
        for (int j = 0; j < 16; ++j) { v[j] -= mu; q += v[j] * v[j]; }
#pragma unroll
        for (int o = 1; o < 64; o <<= 1) q += __shfl_xor(q, o);
        const float rs = rsqrtf(q * (1.f / DM) + LN_EPS);
#pragma unroll
        for (int j = 0; j < 4; ++j) { const int cc = j * 256 + lane * 4; const f32x4 gg = *(const f32x4*)(p.ln3_g + cc), bb = *(const f32x4*)(p.ln3_b + cc);
            f32x4 o; o[0] = v[4 * j] * rs * gg[0] + bb[0]; o[1] = v[4 * j + 1] * rs * gg[1] + bb[1]; o[2] = v[4 * j + 2] * rs * gg[2] + bb[2]; o[3] = v[4 * j + 3] * rs * gg[3] + bb[3];
            *(f32x4*)(p.out + (size_t)w * DM + cc) = o; }
    }
}


#define XB_TMO      128
#define XB_XCNT(j)  (256  + 64 * (j))
#define XB_XSUB(j)  (1280 + 64 * (j))
#define XB_XGEN(j)  (2304 + 64 * (j))
#define XB_TOP      3328
#define XB_TOPGEN   3392
#define XCD_BAR_WORDS 3456
#define XB_SPIN_CAP (1u << 18)
__device__ __forceinline__ unsigned xb_ld(unsigned* p)              { return __hip_atomic_load(p, __ATOMIC_RELAXED, __HIP_MEMORY_SCOPE_AGENT); }
__device__ __forceinline__ unsigned xb_add(unsigned* p, unsigned v) { return __hip_atomic_fetch_add(p, v, __ATOMIC_RELAXED, __HIP_MEMORY_SCOPE_AGENT); }
__device__ __forceinline__ unsigned xb_xcc_id() { return (unsigned)__builtin_amdgcn_s_getreg((3 << 11) | 20) & 0xFu; }
#define XB_SPIN(cond, bar) do { unsigned _sp = 0; while (cond) { __builtin_amdgcn_s_sleep(1); \
    if ((++_sp & 255u) == 0u) { if (xb_ld(&(bar)[XB_TMO])) break; if (_sp > XB_SPIN_CAP) { atomicAdd(&(bar)[XB_TMO], 1u); break; } } } } while (0)
struct XcdBarrier { unsigned* bar; unsigned x; volatile LAS unsigned* st; };
__device__ __forceinline__ XcdBarrier xcd_barrier_post(unsigned* bar, volatile LAS unsigned* st) {
    XcdBarrier b; b.bar = bar; b.x = xb_xcc_id(); b.st = st;
    if (threadIdx.x == 0) (void)xb_add(&bar[XB_XCNT(b.x)], 1u);
    return b;
}
__device__ __forceinline__ void xcd_barrier_complete(unsigned* bar, unsigned x, unsigned& nloc, unsigned& nx) {
    const unsigned G = gridDim.x * gridDim.y * gridDim.z;
    unsigned sum, cnt, mine, sp = 0u;
    for (;;) {
        sum = 0u; cnt = 0u; mine = 0u;
#pragma unroll
        for (unsigned j = 0; j < 16; ++j) { const unsigned c = xb_ld(&bar[XB_XCNT(j)]); sum += c; cnt += (c > 0u) ? 1u : 0u; mine = (j == x) ? c : mine; }
        if (sum == G) break;
        __builtin_amdgcn_s_sleep(1);
        if ((++sp & 255u) == 0u) { if (xb_ld(&bar[XB_TMO])) break; if (sp > XB_SPIN_CAP) { atomicAdd(&bar[XB_TMO], 1u); break; } }
    }
    nloc = mine > 0u ? mine : 1u; nx = cnt > 0u ? cnt : 1u;
}
__device__ __forceinline__ void xcd_barrier(const XcdBarrier& b) {
    asm volatile("s_waitcnt vmcnt(0)" ::: "memory");
    __syncthreads();
    if (threadIdx.x == 0) {
        unsigned* bar = b.bar;
        __builtin_amdgcn_s_waitcnt(0);
        unsigned nloc = b.st[0], nx = b.st[1];
        if (nloc == 0u) { xcd_barrier_complete(bar, b.x, nloc, nx); b.st[0] = nloc; b.st[1] = nx; }
        const unsigned old = xb_add(&bar[XB_XSUB(b.x)], 1u);
        const unsigned gen = old / nloc;
        if (old + 1u == (gen + 1u) * nloc) {
            __builtin_amdgcn_fence(__ATOMIC_RELEASE, "agent");
            asm volatile("s_waitcnt vmcnt(0)" ::: "memory");
            const unsigned og = xb_add(&bar[XB_TOP], 1u);
            const unsigned tg = og / nx;
            if (og + 1u == (tg + 1u) * nx) xb_add(&bar[XB_TOPGEN], 1u);
            else XB_SPIN(xb_ld(&bar[XB_TOPGEN]) == tg, bar);
            __builtin_amdgcn_fence(__ATOMIC_ACQUIRE, "agent");
            xb_add(&bar[XB_XGEN(b.x)], 1u);
            asm volatile("s_waitcnt vmcnt(0)" ::: "memory");
        } else {
            XB_SPIN(xb_ld(&bar[XB_XGEN(b.x)]) == gen, bar);
            __builtin_amdgcn_fence(__ATOMIC_ACQUIRE, "agent");
            asm volatile("s_waitcnt vmcnt(0)" ::: "memory");
        }
    }
    __syncthreads();
}

enum Phase { PH_PROLOGUE = 0, PH_INPROJ, PH_ATTN, PH_MERGE, PH_OUTPROJ, PH_LN1, PH_QMEM, PH_MEMATTN, PH_WO, PH_LN2, PH_ROUTER, PH_ROUTE, PH_SCATTER, PH_MOE1, PH_MOE2, PH_COMBINE, PH_COUNT };
struct MKArgs { P p; int ph_lo, ph_hi; };

__global__ void __launch_bounds__(NTHR, 2) mk_fwd(MKArgs a) {
    extern __shared__ __attribute__((aligned(16))) unsigned char lds_raw[];
    LAS unsigned char* lds = (LAS unsigned char*)lds_raw;
    const P& p = a.p;
    Ctx c; c.tid = threadIdx.x; c.lane = c.tid & 63; c.wave = __builtin_amdgcn_readfirstlane(c.tid >> 6); c.G = gridDim.x;
    { const int bx = blockIdx.x; c.vcu = (c.G % 8 == 0) ? (bx % 8) * (c.G / 8) + bx / 8 : bx; }
    c.gw = c.vcu * NWAVES + c.wave; c.ngw = c.G * NWAVES; c.lds = lds;
    unsigned char* ws = p.ws;
    const int lo = a.ph_lo, hi = a.ph_hi;
#ifdef ONLY_PH
#define IN(k) ((k) == ONLY_PH)
#else
#define IN(k) (lo <= (k) && (k) < hi)
#endif
#ifndef USE_CG_SYNC
#define USE_CG_SYNC 0
#endif
    volatile LAS unsigned* MISC = (volatile LAS unsigned*)(lds + LDS_BYTES - 64);
    if (c.tid == 0) { MISC[0] = 0u; MISC[1] = 0u; }
    __syncthreads();
    XcdBarrier gbar; gbar.bar = (unsigned*)(ws + WS_BAR); gbar.x = 0; gbar.st = MISC;
    if (!USE_CG_SYNC && hi - lo > 1) gbar = xcd_barrier_post((unsigned*)(ws + WS_BAR), MISC);
#define SEAM(k) do { if (IN(k) && IN((k) + 1)) { if (USE_CG_SYNC) cg::this_grid().sync(); else xcd_barrier(gbar); } } while (0)

    if (IN(PH_PROLOGUE)) { phase_prologue(p, c); SEAM(PH_PROLOGUE); }

    if (IN(PH_INPROJ)) {
        { gm::DenseSched S; S.init(T, INW, DM, ws + WS_WINT, c.G, (int)blockIdx.x);
          gm::EpiInProj E{(bf16*)(ws + WS_PROJ), (const float*)(ws + WS_CS)};
          gm::gemm_phase(lds, (const char*)(ws + WS_XB), DM, S, E); }
        { gm::DenseSched S; S.init(BATCH * MEML, 2048, DM, ws + WS_WKVT, c.G, (int)blockIdx.x);
          gm::EpiScale E{(bf16*)(ws + WS_KVM), 2048, 1.f};
          gm::gemm_phase(lds, (const char*)(ws + WS_MEMB), DM, S, E); }
        SEAM(PH_INPROJ);
    }

    if (IN(PH_ATTN)) {
        const float lam = __hip_atomic_load((const float*)(ws + WS_SCAL), __ATOMIC_RELAXED, __HIP_MEMORY_SCOPE_AGENT);
        if (c.G == 256) { const int bh = c.vcu >> 3, s = c.vcu & 7;
            for (int i = 0; i < 4; ++i) { const int qb = (i == 0) ? s : (i == 1) ? 15 - s : (i == 2) ? 16 + s : 31 - s; diff_unit(p, bh >> 2, bh & 3, qb, lds, lam); } }
        else { for (int u = blockIdx.x; u < 1024; u += c.G) diff_unit(p, u >> 7, (u >> 5) & 3, u & 31, lds, lam); }
        for (int u = c.vcu; u < 3072; u += c.G) { const int grp = u & 15, t3 = u >> 4, br = t3 % 3, bh = t3 / 3; dil_unit(p, bh >> 3, bh & 7, br, grp, lds); }
        SEAM(PH_ATTN);
    }

    if (IN(PH_MERGE)) { phase_merge(p, c); SEAM(PH_MERGE); }

    if (IN(PH_OUTPROJ)) {
        gm::DenseSched S; S.init(T, DM, DM, ws + WS_WOUTT, c.G, (int)blockIdx.x);
        gm::EpiOutProj E{(bf16*)(ws + WS_Y1), p.x};
        gm::gemm_phase(lds, (const char*)(ws + WS_MIXIN), DM, S, E);
        SEAM(PH_OUTPROJ);
    }
    if (IN(PH_LN1)) { phase_ln((const bf16*)(ws + WS_Y1), (bf16*)(ws + WS_H1), p.ln1_g, p.ln1_b, c); SEAM(PH_LN1); }

    if (IN(PH_QMEM)) {
        gm::DenseSched S; S.init(T, DM, DM, ws + WS_WQT, c.G, (int)blockIdx.x);
        gm::EpiScale E{(bf16*)(ws + WS_QM), DM, QSCALE256};
        gm::gemm_phase(lds, (const char*)(ws + WS_H1), DM, S, E);
        SEAM(PH_QMEM);
    }
    if (IN(PH_MEMATTN)) {
        for (int u = c.vcu; u < 512; u += c.G) { const int qblk = u & 15, bh = u >> 4; mem_unit(p, bh >> 2, bh & 3, qblk, lds); }
        SEAM(PH_MEMATTN);
    }
    if (IN(PH_WO)) {
        gm::DenseSched S; S.init(T, DM, DM, ws + WS_WOT, c.G, (int)blockIdx.x);
        gm::EpiWo E{(bf16*)(ws + WS_Y2), (const bf16*)(ws + WS_H1)};
        gm::gemm_phase(lds, (const char*)(ws + WS_MO), DM, S, E);
        SEAM(PH_WO);
    }
    if (IN(PH_LN2)) { phase_ln((const bf16*)(ws + WS_Y2), (bf16*)(ws + WS_H2), p.ln2_g, p.ln2_b, c); SEAM(PH_LN2); }

    if (IN(PH_ROUTER)) {
        gm::DenseSched S; S.init(T, NEXP, DM, ws + WS_WRT, c.G, (int)blockIdx.x);
        gm::EpiF32 E{(float*)(ws + WS_LOGITS), NEXP};
        gm::gemm_phase(lds, (const char*)(ws + WS_H2), DM, S, E);
        SEAM(PH_ROUTER);
    }
    if (IN(PH_ROUTE)) { phase_route(p, c); SEAM(PH_ROUTE); }
    if (IN(PH_SCATTER)) { phase_scatter(p, c); SEAM(PH_SCATTER); }

    if (IN(PH_MOE1)) {
        const int nrt = __builtin_amdgcn_readfirstlane(ld_i32_agent((const int*)(ws + WS_NRT)));
        gm::MoeSched<1, DM, true> S{(const int*)(ws + WS_TILETAB), nrt * 2, c.G, (int)blockIdx.x, (const char*)(ws + WS_WTGU), (size_t)512 * DM * 2, (const int*)(ws + WS_ROWTOK)};
        gm::EpiMoe1 E{(bf16*)(ws + WS_HB)};
        gm::gemm_phase(lds, (const char*)(ws + WS_H2), DM, S, E);
        SEAM(PH_MOE1);
    }
    if (IN(PH_MOE2)) {
        const int nrt = __builtin_amdgcn_readfirstlane(ld_i32_agent((const int*)(ws + WS_NRT)));
        gm::MoeSched<2, EDIM, false> S{(const int*)(ws + WS_TILETAB), nrt * 4, c.G, (int)blockIdx.x, (const char*)(ws + WS_WTD), (size_t)DM * EDIM * 2, nullptr};
        gm::EpiMoe2 E{(bf16*)(ws + WS_Y), (const float*)(ws + WS_ROWW)};
        gm::gemm_phase(lds, (const char*)(ws + WS_HB), EDIM, S, E);
        SEAM(PH_MOE2);
    }
    if (IN(PH_COMBINE)) { phase_combine(p, c); }
#undef IN
#undef SEAM
}

#ifndef MK_MODE
#define MK_MODE 1
#endif
#ifndef NAIVE_MASK
#define NAIVE_MASK 0
#endif

static void fill_params(P& p, void* const* d_in, void* d_out, void* d_ws) {
    p.x = (const float*)d_in[0]; p.mem = (const float*)d_in[1]; p.pos = (const int*)d_in[2];
    p.w_in = (const float*)d_in[3]; p.w_out = (const float*)d_in[4]; p.lq1 = (const float*)d_in[5]; p.lk1 = (const float*)d_in[6]; p.lq2 = (const float*)d_in[7]; p.lk2 = (const float*)d_in[8];
    p.subln_g = (const float*)d_in[9]; p.ln1_g = (const float*)d_in[10]; p.ln1_b = (const float*)d_in[11];
    p.wq = (const float*)d_in[12]; p.wkv = (const float*)d_in[13]; p.wo = (const float*)d_in[14]; p.ln2_g = (const float*)d_in[15]; p.ln2_b = (const float*)d_in[16];
    p.w_router = (const float*)d_in[17]; p.e_bias = (const float*)d_in[18]; p.w_gate = (const float*)d_in[19]; p.w_up = (const float*)d_in[20]; p.w_down = (const float*)d_in[21];
    p.ws_gate = (const float*)d_in[22]; p.ws_up = (const float*)d_in[23]; p.ws_down = (const float*)d_in[24]; p.ln3_g = (const float*)d_in[25]; p.ln3_b = (const float*)d_in[26];
    p.out = (float*)d_out; p.ws = (unsigned char*)d_ws;
}

extern "C" void kernel_launch(void* const* d_in, const int* in_sizes, int n_in, void* d_out, int out_size, void* d_ws, size_t ws_size, hipStream_t stream) {
    static int grid = 0;
    if (grid == 0) {
        if (n_in != 27 || out_size != T * DM || ws_size < WS_END) { fprintf(stderr, "kernel_launch: unexpected shapes: n_in %d out %d ws %zu (need %zu)\n", n_in, out_size, ws_size, (size_t)WS_END); grid = -1; return; }
        int dev = 0, cus = 0, per_cu = 0;
        (void)hipGetDevice(&dev); (void)hipDeviceGetAttribute(&cus, hipDeviceAttributeMultiprocessorCount, dev);
        if (hipFuncSetAttribute((const void*)mk_fwd, hipFuncAttributeMaxDynamicSharedMemorySize, LDS_BYTES) != hipSuccess) { fprintf(stderr, "kernel_launch: hipFuncSetAttribute failed\n"); grid = -1; return; }
        if (hipOccupancyMaxActiveBlocksPerMultiprocessor(&per_cu, (const void*)mk_fwd, NTHR, LDS_BYTES) != hipSuccess || per_cu < 1) { fprintf(stderr, "kernel_launch: occupancy query says %d blocks/CU\n", per_cu); per_cu = 1; }
        (void)hipGetLastError();
        grid = cus;
        fprintf(stderr, "kernel_launch: cus %d per_cu %d grid %d\n", cus, per_cu, grid);
    }
    if (grid < 0) return;
    MKArgs a{};
    fill_params(a.p, d_in, d_out, d_ws);
    P p = a.p; unsigned char* ws = p.ws;
#if MK_MODE == 1
    a.ph_lo = 0; a.ph_hi = PH_COUNT;
    if (hipMemsetAsync(ws + WS_BAR, 0, 16384, stream) != hipSuccess) { fprintf(stderr, "kernel_launch: memset failed\n"); return; }
    void* args[] = {&a};
    hipError_t e = hipLaunchCooperativeKernel((const void*)mk_fwd, dim3(grid), dim3(NTHR), args, LDS_BYTES, stream);
    if (e != hipSuccess) fprintf(stderr, "cooperative launch failed: %s (grid %d)\n", hipGetErrorString(e), grid);
#elif MK_MODE == 2
    auto run = [&](int lo, int hi) { a.ph_lo = lo; a.ph_hi = hi; hipLaunchKernelGGL(mk_fwd, dim3(grid), dim3(NTHR), LDS_BYTES, stream, a); };
    auto nv = [&](int k) { return ((NAIVE_MASK >> k) & 1) != 0; };
    run(PH_PROLOGUE, PH_PROLOGUE + 1);
    if (nv(PH_INPROJ)) { ngemm<FInProj><<<dim3(T / 64, INW / 64, 1), 256, 0, stream>>>(FInProj{p}); ngemm<FKV><<<dim3(BATCH * MEML / 64, 2048 / 64, 1), 256, 0, stream>>>(FKV{p}); } else run(PH_INPROJ, PH_INPROJ + 1);
    if (nv(PH_ATTN)) { nattnA<<<3 * 8 * T / 256, 256, 0, stream>>>(p); nattnB<<<16 * T / 256, 256, 0, stream>>>(p); sublnB<<<T * 4 / 4, 256, 0, stream>>>(p); } else run(PH_ATTN, PH_ATTN + 1);
    if (nv(PH_MERGE)) mergeA<<<T * 512 / 256, 256, 0, stream>>>(p); else run(PH_MERGE, PH_MERGE + 1);
    if (nv(PH_OUTPROJ)) ngemm<FOutProj><<<dim3(T / 64, DM / 64, 1), 256, 0, stream>>>(FOutProj{p}); else run(PH_OUTPROJ, PH_OUTPROJ + 1);
    if (nv(PH_LN1)) ln_pass<<<T / 4, 256, 0, stream>>>((const bf16*)(ws + WS_Y1), (bf16*)(ws + WS_H1), p.ln1_g, p.ln1_b); else run(PH_LN1, PH_LN1 + 1);
    if (nv(PH_QMEM)) ngemm<FQMem><<<dim3(T / 64, DM / 64, 1), 256, 0, stream>>>(FQMem{p}); else run(PH_QMEM, PH_QMEM + 1);
    if (nv(PH_MEMATTN)) { ngemm<FMemS><<<dim3(T / 64, 256 / 64, 4), 256, 0, stream>>>(FMemS{p}); softmaxM<<<T * 4 / 4, 256, 0, stream>>>(p); ngemm<FMemO><<<dim3(T / 64, 256 / 64, 4), 256, 0, stream>>>(FMemO{p}); } else run(PH_MEMATTN, PH_MEMATTN + 1);
    if (nv(PH_WO)) ngemm<FWo><<<dim3(T / 64, DM / 64, 1), 256, 0, stream>>>(FWo{p}); else run(PH_WO, PH_WO + 1);
    if (nv(PH_LN2)) ln_pass<<<T / 4, 256, 0, stream>>>((const bf16*)(ws + WS_Y2), (bf16*)(ws + WS_H2), p.ln2_g, p.ln2_b); else run(PH_LN2, PH_LN2 + 1);
    if (nv(PH_ROUTER)) ngemm<FRouter><<<dim3(T / 64, NEXP / 64, 1), 256, 0, stream>>>(FRouter{p}); else run(PH_ROUTER, PH_ROUTER + 1);
    if (nv(PH_ROUTE)) route_pass<<<T / 4, 256, 0, stream>>>(p); else run(PH_ROUTE, PH_ROUTE + 1);
    run(PH_SCATTER, PH_SCATTER + 1);
    if (nv(PH_MOE1)) ngemm<FMoe1><<<dim3(T / 64, 512 / 64, NEXP + 1), 256, 0, stream>>>(FMoe1{p}); else run(PH_MOE1, PH_MOE1 + 1);
    if (nv(PH_MOE2)) ngemm<FMoe2><<<dim3(T / 64, DM / 64, NEXP + 1), 256, 0, stream>>>(FMoe2{p}); else run(PH_MOE2, PH_MOE2 + 1);
    if (nv(PH_COMBINE)) combine_pass<<<T / 4, 256, 0, stream>>>(p); else run(PH_COMBINE, PH_COMBINE + 1);
#else
    prep_kernel<<<T * 8 / 256, 256, 0, stream>>>(p);
    ngemm<FInProj><<<dim3(T / 64, INW / 64, 1), 256, 0, stream>>>(FInProj{p});
    nattnA<<<3 * 8 * T / 256, 256, 0, stream>>>(p);
    mergeA<<<T * 512 / 256, 256, 0, stream>>>(p);
    nattnB<<<16 * T / 256, 256, 0, stream>>>(p);
    sublnB<<<T * 4 / 4, 256, 0, stream>>>(p);
    ngemm<FOutProj><<<dim3(T / 64, DM / 64, 1), 256, 0, stream>>>(FOutProj{p});
    ln_pass<<<T / 4, 256, 0, stream>>>((const bf16*)(ws + WS_Y1), (bf16*)(ws + WS_H1), p.ln1_g, p.ln1_b);
    ngemm<FQMem><<<dim3(T / 64, DM / 64, 1), 256, 0, stream>>>(FQMem{p});
    ngemm<FKV><<<dim3(BATCH * MEML / 64, 2048 / 64, 1), 256, 0, stream>>>(FKV{p});
    ngemm<FMemS><<<dim3(T / 64, 256 / 64, 4), 256, 0, stream>>>(FMemS{p});
    softmaxM<<<T * 4 / 4, 256, 0, stream>>>(p);
    ngemm<FMemO><<<dim3(T / 64, 256 / 64, 4), 256, 0, stream>>>(FMemO{p});
    ngemm<FWo><<<dim3(T / 64, DM / 64, 1), 256, 0, stream>>>(FWo{p});
    ln_pass<<<T / 4, 256, 0, stream>>>((const bf16*)(ws + WS_Y2), (bf16*)(ws + WS_H2), p.ln2_g, p.ln2_b);
    ngemm<FRouter><<<dim3(T / 64, NEXP / 64, 1), 256, 0, stream>>>(FRouter{p});
    route_pass<<<T / 4, 256, 0, stream>>>(p);
    scan_pass<<<1, 256, 0, stream>>>(p);
    scatter_pass<<<T * 8 / 256, 256, 0, stream>>>(p);
    ngemm<FMoe1><<<dim3(T / 64, 512 / 64, NEXP + 1), 256, 0, stream>>>(FMoe1{p});
    ngemm<FMoe2><<<dim3(T / 64, DM / 64, NEXP + 1), 256, 0, stream>>>(FMoe2{p});
    combine_pass<<<T / 4, 256, 0, stream>>>(p);
#endif
}
```

```cpp
#define MK_MODE 1
#define NAIVE_MASK 0
#define REP_MASK 0
#include <hip/hip_runtime.h>
#include <hip/hip_cooperative_groups.h>
#include <cstdio>
#include <cstdint>
#include <cmath>
namespace cg = cooperative_groups;

constexpr int BATCH = 8, SEQ = 4096, DM = 1024, T = BATCH * SEQ;
constexpr int MEML = 256;
constexpr int INW = 3072;
constexpr int NEXP = 256, TOPK = 8, EDIM = 256;
constexpr int AROWS = T * TOPK;
constexpr float LN_EPS = 1e-5f, SUBLN_EPS = 1e-5f;
constexpr float DN_ALPHA = 1.189207115002721f;
constexpr float LOG2E = 1.4426950408889634f;
constexpr float QSCALE64 = 0.125f * LOG2E;
constexpr float QSCALE256 = 0.0625f * LOG2E;
constexpr float LAMBDA_INIT = 0.2f;
constexpr float ROUTED_SCALE = 2.5f;

constexpr size_t MiB = 1u << 20;
constexpr size_t WS_CNT = 0;
constexpr size_t WS_START = 4096;
constexpr size_t WS_SCAL = 8192;
constexpr size_t WS_NRT = 12288;
constexpr size_t WS_TILETAB = 16384;
constexpr size_t WS_BAR = 65536;
constexpr size_t WS_CS = 1 * MiB;
constexpr size_t WS_RIDX = 4 * MiB, WS_RW = 5 * MiB, WS_RRANK = 6 * MiB, WS_POS = 7 * MiB;
constexpr size_t WS_ROWTOK = 8 * MiB, WS_ROWW = 10 * MiB;
constexpr size_t WS_LSEA = 12 * MiB;
constexpr size_t WS_KVM = 16 * MiB;
constexpr size_t WS_MEMB = 24 * MiB;
constexpr size_t WS_WINT = 32 * MiB;
constexpr size_t WS_WOUTT = 38 * MiB;
constexpr size_t WS_WQT = 40 * MiB;
constexpr size_t WS_WKVT = 42 * MiB;
constexpr size_t WS_WOT = 46 * MiB;
constexpr size_t WS_WRT = 48 * MiB;
constexpr size_t WS_WTD = 64 * MiB;
constexpr size_t WS_H2 = 193 * MiB;
constexpr size_t WS_MIXIN = 193 * MiB;
constexpr size_t WS_Y1 = 257 * MiB;
constexpr size_t WS_DD = 257 * MiB;
constexpr size_t WS_H1 = 321 * MiB;
constexpr size_t WS_HB = 257 * MiB;
constexpr size_t WS_WTGU = 401 * MiB;
constexpr size_t WS_Y = 448 * MiB;
constexpr size_t WS_PROJ = 658 * MiB;
constexpr size_t WS_QM = 658 * MiB;
constexpr size_t WS_MO = 722 * MiB;
constexpr size_t WS_Y2 = 786 * MiB;
constexpr size_t WS_PARTA = 850 * MiB;
constexpr size_t WS_LOGITS = 850 * MiB;
constexpr size_t WS_SS = 850 * MiB;
constexpr size_t WS_XB = 946 * MiB;
constexpr size_t WS_END = 1024 * MiB;

typedef unsigned short bf16;
__device__ __forceinline__ float bf2f(bf16 v) { return __uint_as_float(((unsigned)v) << 16); }
__device__ __forceinline__ bf16 f2bf(float f) { unsigned u = __float_as_uint(f); return (bf16)((u + 0x7fffu + ((u >> 16) & 1u)) >> 16); }

struct P {
    const float *x, *mem; const int* pos;
    const float *w_in, *w_out, *lq1, *lk1, *lq2, *lk2, *subln_g, *ln1_g, *ln1_b;
    const float *wq, *wkv, *wo, *ln2_g, *ln2_b, *w_router, *e_bias, *w_gate, *w_up, *w_down;
    const float *ws_gate, *ws_up, *ws_down, *ln3_g, *ln3_b;
    float* out; unsigned char* ws;
};

__host__ __device__ __forceinline__ int sigma_dim(int p) { return p < 16 ? (p >> 1) + 8 * (p & 1) : p; }
__device__ __forceinline__ int proj_src_col(int c) {
    const int seg = c >> 9;
    if (seg == 2 || seg == 5) return c;
    return (c & ~63) | sigma_dim(c & 63);
}

__global__ void prep_kernel(P p) {
    const int i = blockIdx.x * blockDim.x + threadIdx.x;
    if (i < T * 8) {
        const int t = i >> 3, j = i & 7;
        const float inv = powf(500000.0f, -(float)(2 * j) / 16.0f);
        const float ang = (float)p.pos[t] * inv;
        float2* cs = (float2*)(p.ws + WS_CS);
        cs[i] = make_float2(cosf(ang), sinf(ang));
    }
    if (i < 256) ((int*)(p.ws + WS_CNT))[i] = 0;
    if (i == 0) {
        float a = 0.f, b = 0.f;
        for (int k = 0; k < 64; ++k) { a += p.lq1[k] * p.lk1[k]; b += p.lq2[k] * p.lk2[k]; }
        ((float*)(p.ws + WS_SCAL))[0] = expf(a) - expf(b) + LAMBDA_INIT;
    }
}

template <class F> __global__ void __launch_bounds__(256) ngemm(F f) {
    __shared__ float As[16][65], Bs[16][65];
    const int g = blockIdx.z, M = f.rows(g);
    const int m0 = blockIdx.x * 64, n0 = blockIdx.y * 64;
    if (m0 >= M) return;
    const int K = f.kdim();
    const int tid = threadIdx.x, tx = tid & 15, ty = tid >> 4;
    float acc[4][4];
#pragma unroll
    for (int i = 0; i < 4; ++i)
#pragma unroll
        for (int j = 0; j < 4; ++j) acc[i][j] = 0.f;
    for (int k0 = 0; k0 < K; k0 += 16) {
#pragma unroll
        for (int i = 0; i < 4; ++i) {
            const int idx = tid + i * 256;
            { const int k = idx & 15, r = idx >> 4; As[k][r] = (m0 + r < M) ? f.a(g, m0 + r, k0 + k) : 0.f; }
            { const int c = idx & 63, k = idx >> 6; Bs[k][c] = f.b(g, k0 + k, n0 + c); }
        }
        __syncthreads();
#pragma unroll
        for (int k = 0; k < 16; ++k) {
            float av[4], bv[4];
#pragma unroll
            for (int i = 0; i < 4; ++i) { av[i] = As[k][ty * 4 + i]; bv[i] = Bs[k][tx * 4 + i]; }
#pragma unroll
            for (int i = 0; i < 4; ++i)
#pragma unroll
                for (int j = 0; j < 4; ++j) acc[i][j] += av[i] * bv[j];
        }
        __syncthreads();
    }
#pragma unroll
    for (int i = 0; i < 4; ++i) { const int r = m0 + ty * 4 + i; if (r < M) f.epi(g, r, n0 + tx * 4, acc[i]); }
}

struct FInProj {
    P p;
    __device__ int rows(int) const { return T; }
    __device__ int kdim() const { return DM; }
    __device__ float a(int, int r, int k) const { return bf2f(f2bf(p.x[(size_t)r * DM + k])); }
    __device__ float b(int, int k, int c) const { return bf2f(f2bf(p.w_in[(size_t)k * INW + proj_src_col(c)])); }
    __device__ void epi(int, int r, int c0, const float (&v)[4]) const {
        bf16* proj = (bf16*)(p.ws + WS_PROJ);
        const int seg = c0 >> 9; float o[4] = {v[0], v[1], v[2], v[3]};
        if (seg != 2 && seg != 5) {
            const int pp = c0 & 63;
            if (pp < 16) {
                const float2* cs = (const float2*)(p.ws + WS_CS) + (size_t)r * 8;
#pragma unroll
                for (int q = 0; q < 2; ++q) { const float2 c = cs[(pp >> 1) + q]; const float t1 = v[2 * q], t2 = v[2 * q + 1]; o[2 * q] = t1 * c.x - t2 * c.y; o[2 * q + 1] = t2 * c.x + t1 * c.y; }
            }
            if (seg == 0 || seg == 3) {
#pragma unroll
                for (int q = 0; q < 4; ++q) o[q] *= QSCALE64;
            }
        }
#pragma unroll
        for (int q = 0; q < 4; ++q) proj[(size_t)r * INW + c0 + q] = f2bf(o[q]);
    }
};
struct FOutProj {
    P p;
    __device__ int rows(int) const { return T; }
    __device__ int kdim() const { return DM; }
    __device__ float a(int, int r, int k) const { return bf2f(((const bf16*)(p.ws + WS_MIXIN))[(size_t)r * DM + k]); }
    __device__ float b(int, int k, int c) const { return bf2f(f2bf(p.w_out[(size_t)k * DM + c])); }
    __device__ void epi(int, int r, int c0, const float (&v)[4]) const {
        bf16* y = (bf16*)(p.ws + WS_Y1);
#pragma unroll
        for (int q = 0; q < 4; ++q) y[(size_t)r * DM + c0 + q] = f2bf(DN_ALPHA * p.x[(size_t)r * DM + c0 + q] + v[q]);
    }
};
struct FQMem {
    P p;
    __device__ int rows(int) const { return T; }
    __device__ int kdim() const { return DM; }
    __device__ float a(int, int r, int k) const { return bf2f(((const bf16*)(p.ws + WS_H1))[(size_t)r * DM + k]); }
    __device__ float b(int, int k, int c) const { return bf2f(f2bf(p.wq[(size_t)k * DM + c])); }
    __device__ void epi(int, int r, int c0, const float (&v)[4]) const {
        bf16* y = (bf16*)(p.ws + WS_QM);
#pragma unroll
        for (int q = 0; q < 4; ++q) y[(size_t)r * DM + c0 + q] = f2bf(v[q] * QSCALE256);
    }
};
struct FKV {
    P p;
    __device__ int rows(int) const { return BATCH * MEML; }
    __device__ int kdim() const { return DM; }
    __device__ float a(int, int r, int k) const { return bf2f(f2bf(p.mem[(size_t)r * DM + k])); }
    __device__ float b(int, int k, int c) const { return bf2f(f2bf(p.wkv[(size_t)k * 2048 + c])); }
    __device__ void epi(int, int r, int c0, const float (&v)[4]) const {
        bf16* y = (bf16*)(p.ws + WS_KVM);
#pragma unroll
        for (int q = 0; q < 4; ++q) y[(size_t)r * 2048 + c0 + q] = f2bf(v[q]);
    }
};
struct FMemS {
    P p;
    __device__ int rows(int) const { return T; }
    __device__ int kdim() const { return 256; }
    __device__ float a(int g, int r, int k) const { return bf2f(((const bf16*)(p.ws + WS_QM))[(size_t)r * DM + g * 256 + k]); }
    __device__ float b(int g, int k, int c) const { const int bb = (blockIdx.x * 64) / SEQ; return bf2f(((const bf16*)(p.ws + WS_KVM))[(size_t)(bb * MEML + c) * 2048 + g * 256 + k]); }
    __device__ void epi(int g, int r, int c0, const float (&v)[4]) const {
        float* s = (float*)(p.ws + WS_SS);
#pragma unroll
        for (int q = 0; q < 4; ++q) s[(size_t)r * DM + g * 256 + c0 + q] = v[q];
    }
};
struct FMemO {
    P p;
    __device__ int rows(int) const { return T; }
    __device__ int kdim() const { return 256; }
    __device__ float a(int g, int r, int k) const { return bf2f(f2bf(((const float*)(p.ws + WS_SS))[(size_t)r * DM + g * 256 + k])); }
    __device__ float b(int g, int k, int c) const { const int bb = (blockIdx.x * 64) / SEQ; return bf2f(((const bf16*)(p.ws + WS_KVM))[(size_t)(bb * MEML + k) * 2048 + 1024 + g * 256 + c]); }
    __device__ void epi(int g, int r, int c0, const float (&v)[4]) const {
        bf16* y = (bf16*)(p.ws + WS_MO);
#pragma unroll
        for (int q = 0; q < 4; ++q) y[(size_t)r * DM + g * 256 + c0 + q] = f2bf(v[q]);
    }
};
struct FWo {
    P p;
    __device__ int rows(int) const { return T; }
    __device__ int kdim() const { return DM; }
    __device__ float a(int, int r, int k) const { return bf2f(((const bf16*)(p.ws + WS_MO))[(size_t)r * DM + k]); }
    __device__ float b(int, int k, int c) const { return bf2f(f2bf(p.wo[(size_t)k * DM + c])); }
    __device__ void epi(int, int r, int c0, const float (&v)[4]) const {
        bf16* y = (bf16*)(p.ws + WS_Y2); const bf16* h1 = (const bf16*)(p.ws + WS_H1);
#pragma unroll
        for (int q = 0; q < 4; ++q) y[(size_t)r * DM + c0 + q] = f2bf(DN_ALPHA * bf2f(h1[(size_t)r * DM + c0 + q]) + v[q]);
    }
};
struct FRouter {
    P p;
    __device__ int rows(int) const { return T; }
    __device__ int kdim() const { return DM; }
    __device__ float a(int, int r, int k) const { return bf2f(((const bf16*)(p.ws + WS_H2))[(size_t)r * DM + k]); }
    __device__ float b(int, int k, int c) const { return bf2f(f2bf(p.w_router[(size_t)k * NEXP + c])); }
    __device__ void epi(int, int r, int c0, const float (&v)[4]) const {
        float* y = (float*)(p.ws + WS_LOGITS);
#pragma unroll
        for (int q = 0; q < 4; ++q) y[(size_t)r * NEXP + c0 + q] = v[q];
    }
};
struct FMoe1 {
    P p;
    __device__ int rows(int g) const { const int* st = (const int*)(p.ws + WS_START); return g < NEXP ? st[g + 1] - st[g] : T; }
    __device__ int kdim() const { return DM; }
    __device__ float a(int g, int r, int k) const {
        const int* st = (const int*)(p.ws + WS_START); const int* rt = (const int*)(p.ws + WS_ROWTOK);
        const int tok = g < NEXP ? rt[st[g] + r] : r;
        return bf2f(((const bf16*)(p.ws + WS_H2))[(size_t)tok * DM + k]);
    }
    __device__ float b(int g, int k, int c) const {
        const float* w = (c & 1) ? (g < NEXP ? p.w_up + (size_t)g * DM * EDIM : p.ws_up) : (g < NEXP ? p.w_gate + (size_t)g * DM * EDIM : p.ws_gate);
        return bf2f(f2bf(w[(size_t)k * EDIM + (c >> 1)]));
    }
    __device__ void epi(int g, int r, int c0, const float (&v)[4]) const {
        const int* st = (const int*)(p.ws + WS_START); bf16* H = (bf16*)(p.ws + WS_HB);
        const size_t row = g < NEXP ? (size_t)st[g] + r : (size_t)AROWS + r;
        const float w = g < NEXP ? ((const float*)(p.ws + WS_ROWW))[row] : 1.f;
#pragma unroll
        for (int q = 0; q < 2; ++q) { const float gg = v[2 * q], uu = v[2 * q + 1]; H[row * EDIM + (c0 >> 1) + q] = f2bf(gg / (1.f + expf(-gg)) * uu * w); }
    }
};
struct FMoe2 {
    P p;
    __device__ int rows(int g) const { const int* st = (const int*)(p.ws + WS_START); return g < NEXP ? st[g + 1] - st[g] : T; }
    __device__ int kdim() const { return EDIM; }
    __device__ float a(int g, int r, int k) const {
        const int* st = (const int*)(p.ws + WS_START); const bf16* H = (const bf16*)(p.ws + WS_HB);
        const size_t row = g < NEXP ? (size_t)st[g] + r : (size_t)AROWS + r;
        return bf2f(H[row * EDIM + k]);
    }
    __device__ float b(int g, int k, int c) const { const float* w = g < NEXP ? p.w_down + (size_t)g * EDIM * DM : p.ws_down; return bf2f(f2bf(w[(size_t)k * DM + c])); }
    __device__ void epi(int g, int r, int c0, const float (&v)[4]) const {
        const int* st = (const int*)(p.ws + WS_START); bf16* Y = (bf16*)(p.ws + WS_Y);
        const size_t row = g < NEXP ? (size_t)st[g] + r : (size_t)AROWS + r;
#pragma unroll
        for (int q = 0; q < 4; ++q) Y[row * DM + c0 + q] = f2bf(v[q]);
    }
};

__global__ void __launch_bounds__(256) nattnA(P p) {
    const int i = blockIdx.x * blockDim.x + threadIdx.x;
    if (i >= 3 * 8 * T) return;
    const int t = i % T, h = (i / T) & 7, br = i / (8 * T);
    const int dil = br == 0 ? 1 : (br == 1 ? 4 : 16);
    const int s = t % SEQ, b0 = t - s;
    const bf16* proj = (const bf16*)(p.ws + WS_PROJ);
    float q[64], o[64];
#pragma unroll
    for (int e = 0; e < 64; ++e) { q[e] = bf2f(proj[(size_t)t * INW + h * 64 + e]); o[e] = 0.f; }
    float m = -INFINITY, l = 0.f;
    for (int j = 0; j <= 128; ++j) {
        const int ks = s - j * dil; if (ks < 0) break;
        const bf16* kr = proj + (size_t)(b0 + ks) * INW + 512 + h * 64;
        const bf16* vr = proj + (size_t)(b0 + ks) * INW + 1024 + h * 64;
        float sc = 0.f;
#pragma unroll
        for (int e = 0; e < 64; ++e) sc += q[e] * bf2f(kr[e]);
        const float mn = fmaxf(m, sc), al = exp2f(m - mn), pe = exp2f(sc - mn);
        l = l * al + pe;
#pragma unroll
        for (int e = 0; e < 64; ++e) o[e] = o[e] * al + pe * bf2f(vr[e]);
        m = mn;
    }
    bf16* pa = (bf16*)(p.ws + WS_PARTA) + ((size_t)br * T + t) * 512 + h * 64;
    const float il = 1.f / l;
#pragma unroll
    for (int e = 0; e < 64; ++e) pa[e] = f2bf(o[e] * il);
    ((float*)(p.ws + WS_LSEA))[((size_t)br * T + t) * 8 + h] = m + log2f(l);
}
__global__ void mergeA(P p) {
    const int i = blockIdx.x * blockDim.x + threadIdx.x;
    if (i >= T * 512) return;
    const int t = i >> 9, c = i & 511, h = c >> 6;
    const float* lse = (const float*)(p.ws + WS_LSEA);
    const float l0 = lse[(size_t)t * 8 + h], l1 = lse[((size_t)T + t) * 8 + h], l2 = lse[((size_t)2 * T + t) * 8 + h];
    const float mx = fmaxf(l0, fmaxf(l1, l2));
    const float w0 = exp2f(l0 - mx), w1 = exp2f(l1 - mx), w2 = exp2f(l2 - mx), inv = 1.f / (w0 + w1 + w2);
    const bf16* pa = (const bf16*)(p.ws + WS_PARTA);
    const float v = (w0 * bf2f(pa[(size_t)t * 512 + c]) + w1 * bf2f(pa[((size_t)T + t) * 512 + c]) + w2 * bf2f(pa[((size_t)2 * T + t) * 512 + c])) * inv;
    ((bf16*)(p.ws + WS_MIXIN))[(size_t)t * DM + c] = f2bf(v);
}
__global__ void __launch_bounds__(256) nattnB(P p) {
    const int i = blockIdx.x * blockDim.x + threadIdx.x;
    if (i >= 16 * T) return;
    const int t = i % T, ch = (i / T) & 3, h = i / (4 * T);
    const int s = t % SEQ, b0 = t - s;
    const bf16* proj = (const bf16*)(p.ws + WS_PROJ);
    float q0[64], q1[64], o0[32], o1[32];
#pragma unroll
    for (int e = 0; e < 64; ++e) { q0[e] = bf2f(proj[(size_t)t * INW + 1536 + h * 128 + e]); q1[e] = bf2f(proj[(size_t)t * INW + 1536 + h * 128 + 64 + e]); }
#pragma unroll
    for (int e = 0; e < 32; ++e) { o0[e] = 0.f; o1[e] = 0.f; }
    float m0 = -INFINITY, l0 = 0.f, m1 = -INFINITY, l1 = 0.f;
    for (int ks = 0; ks <= s; ++ks) {
        const bf16* kr = proj + (size_t)(b0 + ks) * INW + 2048 + h * 128;
        const bf16* vr = proj + (size_t)(b0 + ks) * INW + 2560 + h * 128 + ch * 32;
        float s0 = 0.f, s1 = 0.f;
#pragma unroll
        for (int e = 0; e < 64; ++e) { s0 += q0[e] * bf2f(kr[e]); s1 += q1[e] * bf2f(kr[64 + e]); }
        const float mn0 = fmaxf(m0, s0), a0 = exp2f(m0 - mn0), p0 = exp2f(s0 - mn0);
        const float mn1 = fmaxf(m1, s1), a1 = exp2f(m1 - mn1), p1 = exp2f(s1 - mn1);
        l0 = l0 * a0 + p0; l1 = l1 * a1 + p1; m0 = mn0; m1 = mn1;
#pragma unroll
        for (int e = 0; e < 32; ++e) { const float v = bf2f(vr[e]); o0[e] = o0[e] * a0 + p0 * v; o1[e] = o1[e] * a1 + p1 * v; }
    }
    const float lam = ((const float*)(p.ws + WS_SCAL))[0];
    float* dd = (float*)(p.ws + WS_DD) + (size_t)t * 512 + h * 128 + ch * 32;
    const float i0 = 1.f / l0, i1 = 1.f / l1;
#pragma unroll
    for (int e = 0; e < 32; ++e) dd[e] = o0[e] * i0 - lam * o1[e] * i1;
}
__global__ void sublnB(P p) {
    const int w = (blockIdx.x * blockDim.x + threadIdx.x) >> 6, lane = threadIdx.x & 63;
    if (w >= T * 4) return;
    const int t = w >> 2, h = w & 3;
    const float* dd = (const float*)(p.ws + WS_DD) + (size_t)t * 512 + h * 128;
    const float a = dd[lane], b = dd[lane + 64];
    float ss = a * a + b * b;
    for (int o = 1; o < 64; o <<= 1) ss += __shfl_xor(ss, o);
    const float r = rsqrtf(ss * (1.f / 128.f) + SUBLN_EPS) * (1.f - LAMBDA_INIT);
    bf16* mx = (bf16*)(p.ws + WS_MIXIN) + (size_t)t * DM + 512 + h * 128;
    mx[lane] = f2bf(a * r * p.subln_g[lane]); mx[lane + 64] = f2bf(b * r * p.subln_g[lane + 64]);
}
__global__ void softmaxM(P p) {
    const int w = (blockIdx.x * blockDim.x + threadIdx.x) >> 6, lane = threadIdx.x & 63;
    if (w >= T * 4) return;
    float* s = (float*)(p.ws + WS_SS) + (size_t)w * 256;
    float v[4]; float mx = -INFINITY;
#pragma unroll
    for (int j = 0; j < 4; ++j) { v[j] = s[lane + 64 * j]; mx = fmaxf(mx, v[j]); }
    for (int o = 1; o < 64; o <<= 1) mx = fmaxf(mx, __shfl_xor(mx, o));
    float sum = 0.f;
#pragma unroll
    for (int j = 0; j < 4; ++j) { v[j] = exp2f(v[j] - mx); sum += v[j]; }
    for (int o = 1; o < 64; o <<= 1) sum += __shfl_xor(sum, o);
    const float inv = 1.f / sum;
#pragma unroll
    for (int j = 0; j < 4; ++j) s[lane + 64 * j] = v[j] * inv;
}

__global__ void __launch_bounds__(256) ln_pass(const bf16* __restrict__ in, bf16* __restrict__ outp, const float* __restrict__ g, const float* __restrict__ b) {
    const int w = (blockIdx.x * blockDim.x + threadIdx.x) >> 6, lane = threadIdx.x & 63;
    if (w >= T) return;
    const bf16* r = in + (size_t)w * DM;
    float v[16]; float s = 0.f;
#pragma unroll
    for (int j = 0; j < 4; ++j) { const uint2 u = *(const uint2*)(r + j * 256 + lane * 4);
        v[4 * j] = __uint_as_float(u.x << 16); v[4 * j + 1] = __uint_as_float(u.x & 0xffff0000u); v[4 * j + 2] = __uint_as_float(u.y << 16); v[4 * j + 3] = __uint_as_float(u.y & 0xffff0000u); }
#pragma unroll
    for (int j = 0; j < 16; ++j) s += v[j];
    for (int o = 1; o < 64; o <<= 1) s += __shfl_xor(s, o);
    const float mu = s * (1.f / DM); float q = 0.f;
#pragma unroll
    for (int j = 0; j < 16; ++j) { v[j] -= mu; q += v[j] * v[j]; }
    for (int o = 1; o < 64; o <<= 1) q += __shfl_xor(q, o);
    const float rs = rsqrtf(q * (1.f / DM) + LN_EPS);
#pragma unroll
    for (int j = 0; j < 4; ++j) { const int c = j * 256 + lane * 4; const float4 gg = *(const float4*)(g + c), bb = *(const float4*)(b + c);
        uint2 u; u.x = (unsigned)f2bf(v[4 * j] * rs * gg.x + bb.x) | ((unsigned)f2bf(v[4 * j + 1] * rs * gg.y + bb.y) << 16);
        u.y = (unsigned)f2bf(v[4 * j + 2] * rs * gg.z + bb.z) | ((unsigned)f2bf(v[4 * j + 3] * rs * gg.w + bb.w) << 16);
        *(uint2*)(outp + (size_t)w * DM + c) = u; }
}

__global__ void __launch_bounds__(256) route_pass(P p) {
    const int w = (blockIdx.x * blockDim.x + threadIdx.x) >> 6, lane = threadIdx.x & 63;
    if (w >= T) return;
    const float4 lg = *(const float4*)((const float*)(p.ws + WS_LOGITS) + (size_t)w * NEXP + lane * 4);
    const float4 eb = *(const float4*)(p.e_bias + lane * 4);
    float sc[4] = {1.f / (1.f + expf(-lg.x)), 1.f / (1.f + expf(-lg.y)), 1.f / (1.f + expf(-lg.z)), 1.f / (1.f + expf(-lg.w))};
    float bs[4] = {sc[0] + eb.x, sc[1] + eb.y, sc[2] + eb.z, sc[3] + eb.w};
    float m1 = fmaxf(bs[0], bs[1]), m2 = fminf(bs[0], bs[1]);
    { const float c = bs[2]; const float n1 = fmaxf(m1, c); m2 = fmaxf(m2, fminf(m1, c)); m1 = n1; }
    { const float c = bs[3]; const float n1 = fmaxf(m1, c); m2 = fmaxf(m2, fminf(m1, c)); m1 = n1; }
#pragma unroll
    for (int o = 1; o < 8; o <<= 1) { const float b1 = __shfl_xor(m1, o), b2 = __shfl_xor(m2, o); const float n1 = fmaxf(m1, b1); m2 = fmaxf(fminf(m1, b1), fmaxf(m2, b2)); m1 = n1; }
    const float gs = m1 + m2; const int grp = lane >> 3;
    int rank = 0;
#pragma unroll
    for (int g2 = 0; g2 < 8; ++g2) { const float o = __shfl(gs, g2 * 8); rank += (o > gs || (o == gs && g2 < grp)) ? 1 : 0; }
    const bool sel = rank < 4;
    float cand[4];
#pragma unroll
    for (int j = 0; j < 4; ++j) cand[j] = sel ? bs[j] : -INFINITY;
    int myidx = 0; float myw = 0.f; float wsum = 0.f;
    for (int k = 0; k < TOPK; ++k) {
        float bv = cand[0]; int bi = lane * 4;
#pragma unroll
        for (int j = 1; j < 4; ++j) if (cand[j] > bv) { bv = cand[j]; bi = lane * 4 + j; }
#pragma unroll
        for (int o = 1; o < 64; o <<= 1) { const float ov = __shfl_xor(bv, o); const int oi = __shfl_xor(bi, o); if (ov > bv || (ov == bv && oi < bi)) { bv = ov; bi = oi; } }
        const int own = bi >> 2, el = bi & 3;
        const float sv = el == 0 ? sc[0] : (el == 1 ? sc[1] : (el == 2 ? sc[2] : sc[3]));
        const float wv = __shfl(sv, own);
        if (lane == own) { if (el == 0) cand[0] = -INFINITY; else if (el == 1) cand[1] = -INFINITY; else if (el == 2) cand[2] = -INFINITY; else cand[3] = -INFINITY; }
        wsum += wv;
        if (lane == k) { myidx = bi; myw = wv; }
    }
    if (lane < TOPK) {
        const float wn = myw / wsum * ROUTED_SCALE;
        const int rk = atomicAdd((int*)(p.ws + WS_CNT) + myidx, 1);
        ((int*)(p.ws + WS_RIDX))[(size_t)w * 8 + lane] = myidx;
        ((float*)(p.ws + WS_RW))[(size_t)w * 8 + lane] = wn;
        ((int*)(p.ws + WS_RRANK))[(size_t)w * 8 + lane] = rk;
    }
}
__global__ void scan_pass(P p) {
    __shared__ int sh[256];
    const int i = threadIdx.x; const int c = ((const int*)(p.ws + WS_CNT))[i];
    sh[i] = c; __syncthreads();
    for (int o = 1; o < 256; o <<= 1) { const int v = i >= o ? sh[i - o] : 0; __syncthreads(); sh[i] += v; __syncthreads(); }
    int* st = (int*)(p.ws + WS_START);
    st[i + 1] = sh[i]; if (i == 0) st[0] = 0;
}
__global__ void scatter_pass(P p) {
    const int i = blockIdx.x * blockDim.x + threadIdx.x;
    if (i >= T * 8) return;
    const int e = ((const int*)(p.ws + WS_RIDX))[i], rk = ((const int*)(p.ws + WS_RRANK))[i];
    const int pos = ((const int*)(p.ws + WS_START))[e] + rk;
    ((int*)(p.ws + WS_ROWTOK))[pos] = i >> 3;
    ((float*)(p.ws + WS_ROWW))[pos] = ((const float*)(p.ws + WS_RW))[i];
    ((int*)(p.ws + WS_POS))[i] = pos;
}
__global__ void __launch_bounds__(256) combine_pass(P p) {
    const int w = (blockIdx.x * blockDim.x + threadIdx.x) >> 6, lane = threadIdx.x & 63;
    if (w >= T) return;
    const bf16* h2 = (const bf16*)(p.ws + WS_H2) + (size_t)w * DM;
    const bf16* Y = (const bf16*)(p.ws + WS_Y);
    const int* pos = (const int*)(p.ws + WS_POS) + (size_t)w * 8;
    float v[16];
#pragma unroll
    for (int j = 0; j < 4; ++j) { const uint2 u = *(const uint2*)(h2 + j * 256 + lane * 4);
        v[4 * j] = DN_ALPHA * __uint_as_float(u.x << 16); v[4 * j + 1] = DN_ALPHA * __uint_as_float(u.x & 0xffff0000u); v[4 * j + 2] = DN_ALPHA * __uint_as_float(u.y << 16); v[4 * j + 3] = DN_ALPHA * __uint_as_float(u.y & 0xffff0000u); }
#pragma unroll
    for (int k = 0; k < 9; ++k) {
        const size_t row = k < 8 ? (size_t)pos[k < 8 ? k : 0] : (size_t)AROWS + w;
        const bf16* yr = Y + row * DM;
#pragma unroll
        for (int j = 0; j < 4; ++j) { const uint2 u = *(const uint2*)(yr + j * 256 + lane * 4);
            v[4 * j] += __uint_as_float(u.x << 16); v[4 * j + 1] += __uint_as_float(u.x & 0xffff0000u); v[4 * j + 2] += __uint_as_float(u.y << 16); v[4 * j + 3] += __uint_as_float(u.y & 0xffff0000u); }
    }
    float s = 0.f;
#pragma unroll
    for (int j = 0; j < 16; ++j) s += v[j];
    for (int o = 1; o < 64; o <<= 1) s += __shfl_xor(s, o);
    const float mu = s * (1.f / DM); float q = 0.f;
#pragma unroll
    for (int j = 0; j < 16; ++j) { v[j] -= mu; q += v[j] * v[j]; }
    for (int o = 1; o < 64; o <<= 1) q += __shfl_xor(q, o);
    const float rs = rsqrtf(q * (1.f / DM) + LN_EPS);
#pragma unroll
    for (int j = 0; j < 4; ++j) { const int c = j * 256 + lane * 4; const float4 gg = *(const float4*)(p.ln3_g + c), bb = *(const float4*)(p.ln3_b + c);
        float4 o; o.x = v[4 * j] * rs * gg.x + bb.x; o.y = v[4 * j + 1] * rs * gg.y + bb.y; o.z = v[4 * j + 2] * rs * gg.z + bb.z; o.w = v[4 * j + 3] * rs * gg.w + bb.w;
        *(float4*)(p.out + (size_t)w * DM + c) = o; }
}

#define LAS __attribute__((address_space(3)))
typedef short bf16x8 __attribute__((ext_vector_type(8)));
typedef short s16x4 __attribute__((ext_vector_type(4)));
typedef float f32x2 __attribute__((ext_vector_type(2)));
typedef float f32x4 __attribute__((ext_vector_type(4)));
typedef float f32x16 __attribute__((ext_vector_type(16)));
typedef unsigned u32x2 __attribute__((ext_vector_type(2)));
typedef unsigned u32x4 __attribute__((ext_vector_type(4)));
typedef __bf16 bf16x2_t __attribute__((ext_vector_type(2)));

constexpr int NWAVES = 8, NTHR = 512;
constexpr int LDS_BYTES = 163840;
constexpr int LDS_XTRA = 131072;

__device__ __forceinline__ unsigned cvtpk(float lo, float hi) { f32x2 v = {lo, hi}; bf16x2_t b = __builtin_convertvector(v, bf16x2_t); return __builtin_bit_cast(unsigned, b); }
__device__ __forceinline__ int ld_i32_agent(const int* p) { return __hip_atomic_load(p, __ATOMIC_RELAXED, __HIP_MEMORY_SCOPE_AGENT); }
__device__ __forceinline__ float fast_exp2(float x) { return __builtin_amdgcn_exp2f(x); }
__device__ __forceinline__ float fast_rcp(float x) { return __builtin_amdgcn_rcpf(x); }

namespace gm {
constexpr int BM = 256, BK = 64, HALF = 128, HTB = HALF * BK * 2, STAGE_BYTES = 8 * HTB, NXCD = 8, WGM = 8;
__device__ __forceinline__ int lds_byte(int r, int c) { const int st = (r >> 4) * 2 + (c >> 5), rr = r & 15, cc = c & 31, ob = rr * 64 + cc * 2; return st * 1024 + (ob ^ (((ob >> 9) & 1) << 5)); }
__device__ __forceinline__ void stage_rc(int b, int& R, int& C) { const int st = b / 1024, sb = b % 1024, swz = sb ^ (((sb >> 9) & 1) << 5); R = (st >> 1) * 16 + swz / 64; C = (st & 1) * 32 + (swz % 64) / 2; }
__device__ __forceinline__ int perm32(int rho) { const int n = rho >> 4, i = rho & 15; return 8 * (i >> 2) + 4 * n + (i & 3); }

struct Unit { int pm, pn, e, nvalid, rowbase, slot; const char* bptr; };

struct DenseSched {
    static constexpr bool GATHER_A = false;
    int nM, nN, nwg, G, c, K; const char* Bt;
    __device__ void init(int M, int N, int K_, const void* Bt_, int G_, int c_) { nM = M / BM; nN = N / BM; nwg = nM * nN; G = G_; c = c_; K = K_; Bt = (const char*)Bt_; }
    __device__ bool next(int i, Unit& u) const {
        const long L = (long)i * G + c; if (L >= nwg) return false;
        int wgid = (int)L; { const int q = nwg / NXCD, r = nwg % NXCD, xcd = wgid % NXCD, off = wgid / NXCD; wgid = (xcd < r ? xcd * (q + 1) : r * (q + 1) + (xcd - r) * q) + off; }
        const int nig = WGM * nN, gid = wgid / nig, fm = gid * WGM, gsz = (nM - fm) < WGM ? (nM - fm) : WGM;
        u.pm = fm + ((wgid % nig) % gsz); u.pn = (wgid % nig) / gsz; u.e = 0; u.nvalid = 256; u.rowbase = u.pm * 256; u.slot = i;
        u.bptr = Bt + (size_t)u.pn * 256 * K * 2; return true;
    }
    __device__ unsigned aoff(const Unit& u, int r) const { return (unsigned)(u.rowbase + r) * (unsigned)(K * 2); }
    __device__ size_t abase(const Unit& u) const { return (size_t)u.rowbase * (size_t)(K * 2); }
};
__device__ __forceinline__ int moe_uidx(int i, int G, int c) { return (G == 256) ? ((i * 8 + (c & 7)) * 32) + (c >> 3) : i * G + c; }
template <int NPN_LOG2, int KB  , bool GATHER> struct MoeSched {
    static constexpr bool GATHER_A = GATHER;
    const LAS int* xd; const LAS int* xt; int n_my, G, c; const char* Wt; size_t estride;
    __device__ bool next(int i, Unit& u) const {
        if (i >= n_my) return false;
        const int uidx = moe_uidx(i, G, c); u.pn = uidx & ((1 << NPN_LOG2) - 1); u.slot = i;
        u.e = __builtin_amdgcn_readfirstlane(xd[4 * i]); u.pm = __builtin_amdgcn_readfirstlane(xd[4 * i + 1]);
        u.rowbase = __builtin_amdgcn_readfirstlane(xd[4 * i + 2]); u.nvalid = __builtin_amdgcn_readfirstlane(xd[4 * i + 3]);
        u.bptr = Wt + (size_t)u.e * estride + (size_t)u.pn * 256 * KB * 2; return true;
    }
    __device__ unsigned aoff(const Unit& u, int r) const { return (unsigned)xt[u.slot * 256 + r] * (unsigned)(KB * 2); }
    __device__ size_t abase(const Unit& u) const { return (size_t)u.rowbase * (size_t)(KB * 2); }
};
template <int NPN_LOG2, bool WITH_ROWS> __device__ __forceinline__ int moe_preload(LAS unsigned char* lds, const int* tab, int nunits, int G, int c, const int* rowtok, const float* roww) {
    LAS int* xd = (LAS int*)(lds + LDS_XTRA); LAS int* xt = xd + 128; LAS float* xw = (LAS float*)(xt + 11 * 256);
    int n_my = 0;
    while (n_my < 32 && moe_uidx(n_my, G, c) < nunits) ++n_my;
    const int tid = threadIdx.x;
    if (tid < n_my * 4) xd[tid] = ld_i32_agent(tab + 4 * (moe_uidx(tid >> 2, G, c) >> NPN_LOG2) + (tid & 3));
    if (WITH_ROWS) {
        for (int idx = tid; idx < n_my * 256; idx += NTHR) {
            const int slot = idx >> 8, r = idx & 255, rt = moe_uidx(slot, G, c) >> NPN_LOG2;
            const int e = ld_i32_agent(tab + 4 * rt), rowbase = ld_i32_agent(tab + 4 * rt + 2), nvalid = ld_i32_agent(tab + 4 * rt + 3);
            const int rr = r < nvalid ? r : nvalid - 1;
            int tok; float w;
            if (e < NEXP) { tok = ld_i32_agent(rowtok + rowbase + rr); w = __hip_atomic_load(roww + rowbase + rr, __ATOMIC_RELAXED, __HIP_MEMORY_SCOPE_AGENT); } else { tok = rowbase - AROWS + r; w = 1.f; }
            xt[idx] = tok; xw[idx] = w;
        }
    }
    __syncthreads();
    return n_my;
}

typedef f32x4 Acc[2][2][4][2];
__device__ __forceinline__ u32x4 pack8(const f32x4 a, const f32x4 b) { u32x4 w; w.x = cvtpk(a[0], a[1]); w.y = cvtpk(a[2], a[3]); w.z = cvtpk(b[0], b[1]); w.w = cvtpk(b[2], b[3]); return w; }

struct EpiInProj {
    static constexpr bool PERM = true; bf16* proj; const float* cs;
    __device__ __forceinline__ void operator()(const Acc& acc, const Unit& u, int wr, int wc, int fr, int fq) const {
#pragma unroll
        for (int ai = 0; ai < 2; ++ai)
#pragma unroll
            for (int m = 0; m < 4; ++m) { const int row = u.pm * 256 + ai * 128 + wr * 64 + m * 16 + fr;
#pragma unroll
                for (int bj = 0; bj < 2; ++bj) { const int c0 = u.pn * 256 + bj * 128 + wc * 32 + 8 * fq; const int seg = c0 >> 9;
                    f32x4 v0 = acc[ai][bj][m][0], v1 = acc[ai][bj][m][1];
                    if (seg != 2 && seg != 5) {
                        if ((c0 & 63) < 16) { const int j0 = (c0 & 63) >> 1; const f32x4 ca = *(const f32x4*)(cs + (size_t)row * 16 + 2 * j0), cb = *(const f32x4*)(cs + (size_t)row * 16 + 2 * j0 + 4);
                            { const float t1 = v0[0], t2 = v0[1]; v0[0] = t1 * ca[0] - t2 * ca[1]; v0[1] = t2 * ca[0] + t1 * ca[1]; }
                            { const float t1 = v0[2], t2 = v0[3]; v0[2] = t1 * ca[2] - t2 * ca[3]; v0[3] = t2 * ca[2] + t1 * ca[3]; }
                            { const float t1 = v1[0], t2 = v1[1]; v1[0] = t1 * cb[0] - t2 * cb[1]; v1[1] = t2 * cb[0] + t1 * cb[1]; }
                            { const float t1 = v1[2], t2 = v1[3]; v1[2] = t1 * cb[2] - t2 * cb[3]; v1[3] = t2 * cb[2] + t1 * cb[3]; } }
                        if (seg == 0 || seg == 3) { v0 = v0 * QSCALE64; v1 = v1 * QSCALE64; }
                    }
                    *(u32x4*)(proj + (size_t)row * INW + c0) = pack8(v0, v1); } }
    }
};
struct EpiOutProj {
    static constexpr bool PERM = true; bf16* y; const float* x;
    __device__ __forceinline__ void operator()(const Acc& acc, const Unit& u, int wr, int wc, int fr, int fq) const {
#pragma unroll
        for (int ai = 0; ai < 2; ++ai)
#pragma unroll
            for (int m = 0; m < 4; ++m) { const int row = u.pm * 256 + ai * 128 + wr * 64 + m * 16 + fr;
#pragma unroll
                for (int bj = 0; bj < 2; ++bj) { const int c0 = u.pn * 256 + bj * 128 + wc * 32 + 8 * fq;
                    const f32x4 x0 = *(const f32x4*)(x + (size_t)row * DM + c0), x1 = *(const f32x4*)(x + (size_t)row * DM + c0 + 4);
                    *(u32x4*)(y + (size_t)row * DM + c0) = pack8(x0 * DN_ALPHA + acc[ai][bj][m][0], x1 * DN_ALPHA + acc[ai][bj][m][1]); } }
    }
};
struct EpiScale {
    static constexpr bool PERM = true; bf16* o; int ldc; float sc;
    __device__ __forceinline__ void operator()(const Acc& acc, const Unit& u, int wr, int wc, int fr, int fq) const {
#pragma unroll
        for (int ai = 0; ai < 2; ++ai)
#pragma unroll
            for (int m = 0; m < 4; ++m) { const int row = u.pm * 256 + ai * 128 + wr * 64 + m * 16 + fr;
#pragma unroll
                for (int bj = 0; bj < 2; ++bj) { const int c0 = u.pn * 256 + bj * 128 + wc * 32 + 8 * fq;
                    *(u32x4*)(o + (size_t)row * ldc + c0) = pack8(acc[ai][bj][m][0] * sc, acc[ai][bj][m][1] * sc); } }
    }
};
struct EpiWo {
    static constexpr bool PERM = true; bf16* y; const bf16* h1;
    __device__ __forceinline__ void operator()(const Acc& acc, const Unit& u, int wr, int wc, int fr, int fq) const {
#pragma unroll
        for (int ai = 0; ai < 2; ++ai)
#pragma unroll
            for (int m = 0; m < 4; ++m) { const int row = u.pm * 256 + ai * 128 + wr * 64 + m * 16 + fr;
#pragma unroll
                for (int bj = 0; bj < 2; ++bj) { const int c0 = u.pn * 256 + bj * 128 + wc * 32 + 8 * fq;
                    const u32x4 hv = *(const u32x4*)(h1 + (size_t)row * DM + c0);
                    f32x4 a, b; a[0] = __uint_as_float(hv.x << 16); a[1] = __uint_as_float(hv.x & 0xffff0000u); a[2] = __uint_as_float(hv.y << 16); a[3] = __uint_as_float(hv.y & 0xffff0000u);
                    b[0] = __uint_as_float(hv.z << 16); b[1] = __uint_as_float(hv.z & 0xffff0000u); b[2] = __uint_as_float(hv.w << 16); b[3] = __uint_as_float(hv.w & 0xffff0000u);
                    *(u32x4*)(y + (size_t)row * DM + c0) = pack8(a * DN_ALPHA + acc[ai][bj][m][0], b * DN_ALPHA + acc[ai][bj][m][1]); } }
    }
};
struct EpiF32 {
    static constexpr bool PERM = false; float* C; int ldc;
    __device__ __forceinline__ void operator()(const Acc& acc, const Unit& u, int wr, int wc, int fr, int fq) const {
#pragma unroll
        for (int ai = 0; ai < 2; ++ai)
#pragma unroll
            for (int m = 0; m < 4; ++m) { const int row = u.pm * 256 + ai * 128 + wr * 64 + m * 16 + fr;
#pragma unroll
                for (int bj = 0; bj < 2; ++bj)
#pragma unroll
                    for (int n = 0; n < 2; ++n) *(f32x4*)(C + (size_t)row * ldc + u.pn * 256 + bj * 128 + wc * 32 + n * 16 + 4 * fq) = acc[ai][bj][m][n]; }
    }
};
__device__ __forceinline__ float silu_mul(float g, float uu) { return g * fast_rcp(1.f + fast_exp2(-g * LOG2E)) * uu; }
struct EpiMoe1 {
    static constexpr bool PERM = true; bf16* H; const LAS float* xw;
    __device__ __forceinline__ void operator()(const Acc& acc, const Unit& u, int wr, int wc, int fr, int fq) const {
#pragma unroll
        for (int ai = 0; ai < 2; ++ai)
#pragma unroll
            for (int m = 0; m < 4; ++m) { const int rl = ai * 128 + wr * 64 + m * 16 + fr;
                if (rl < u.nvalid) { const f32x4 g0 = acc[ai][0][m][0], g1 = acc[ai][0][m][1], u0 = acc[ai][1][m][0], u1 = acc[ai][1][m][1]; f32x4 h0, h1; const float w = xw[u.slot * 256 + rl];
#pragma unroll
                    for (int q = 0; q < 4; ++q) { h0[q] = silu_mul(g0[q], u0[q]) * w; h1[q] = silu_mul(g1[q], u1[q]) * w; }
                    *(u32x4*)(H + (size_t)(u.rowbase + rl) * EDIM + u.pn * 128 + wc * 32 + 8 * fq) = pack8(h0, h1); } }
    }
};
struct EpiMoe2 {
    static constexpr bool PERM = true; bf16* Y;
    __device__ __forceinline__ void operator()(const Acc& acc, const Unit& u, int wr, int wc, int fr, int fq) const {
#pragma unroll
        for (int ai = 0; ai < 2; ++ai)
#pragma unroll
            for (int m = 0; m < 4; ++m) { const int rl = ai * 128 + wr * 64 + m * 16 + fr;
                if (rl < u.nvalid) { const size_t row = (size_t)(u.rowbase + rl);
#pragma unroll
                    for (int bj = 0; bj < 2; ++bj) *(u32x4*)(Y + row * DM + u.pn * 256 + bj * 128 + wc * 32 + 8 * fq) = pack8(acc[ai][bj][m][0], acc[ai][bj][m][1]); } }
    }
};

template <class Epi, class Sched>
__device__ __forceinline__ void gemm_phase(LAS unsigned char* lds, const char* Abase, const int K, const Sched& S, const Epi& E) {
    const int tid = threadIdx.x, wid = __builtin_amdgcn_readfirstlane(tid >> 6), lane = tid & 63, wr = wid >> 2, wc = wid & 3, fr = lane & 15, fq = lane >> 4;
    const int nt = K / BK;
    int Rr[2]; unsigned Cb[2], voffB[2];
#pragma unroll
    for (int i = 0; i < 2; ++i) { int R, C; stage_rc(tid * 16 + i * 8192, R, C); const int Rb = Epi::PERM ? ((R & ~31) + perm32(R & 31)) : R; Rr[i] = R; Cb[i] = (unsigned)C * 2u; voffB[i] = (unsigned)(Rb * K + C) * 2u; }
    const size_t kstep = (size_t)(BK * 2);
    const size_t hstep = (size_t)HALF * K * 2;
    const unsigned ldsw = (unsigned)wid * 1024u;
    const int aoff = lds_byte(wr * 64 + fr, fq * 8), boff = lds_byte(wc * 32 + fr, fq * 8);
#define G_SA(b, h) (((b) * 2 + (h)) * HTB)
#define G_SB(b, h) ((4 + (b) * 2 + (h)) * HTB)
#define G_STAGE(bufoff, gbase, voff) do { _Pragma("unroll") for (int _i = 0; _i < 2; ++_i) \
        __builtin_amdgcn_global_load_lds((const unsigned*)((const char*)(gbase) + (voff)[_i]), (LAS unsigned*)(lds + (bufoff) + ldsw + _i * 8192), 16, 0, 0); } while (0)
#define G_LDA(dst, b, h) do { _Pragma("unroll") for (int m = 0; m < 4; ++m) _Pragma("unroll") for (int k = 0; k < 2; ++k) dst[m][k] = *(const LAS bf16x8*)(lds + G_SA(b, h) + aoff + m * 2048 + k * 1024); } while (0)
#define G_LDB(dst, b, h) do { _Pragma("unroll") for (int n = 0; n < 2; ++n) _Pragma("unroll") for (int k = 0; k < 2; ++k) dst[n][k] = *(const LAS bf16x8*)(lds + G_SB(b, h) + boff + n * 2048 + k * 1024); } while (0)
#define G_MMA(ai, bj, At, Bt) do { __builtin_amdgcn_s_setprio(1); _Pragma("unroll") for (int m = 0; m < 4; ++m) _Pragma("unroll") for (int n = 0; n < 2; ++n) _Pragma("unroll") for (int k = 0; k < 2; ++k) \
        acc[ai][bj][m][n] = __builtin_amdgcn_mfma_f32_16x16x32_bf16(Bt[n][k], At[m][k], acc[ai][bj][m][n], 0, 0, 0); __builtin_amdgcn_s_setprio(0); } while (0)
#define G_WAIT_V(n) asm volatile("s_waitcnt vmcnt(" #n ")" ::: "memory")
#define G_WAIT_L(n) asm volatile("s_waitcnt lgkmcnt(" #n ")" ::: "memory")
#define G_BAR __builtin_amdgcn_s_barrier()
#define G_SCHED __builtin_amdgcn_sched_barrier(0)
    Unit cur, nxt; int ui = 0;
    if (!S.next(0, cur)) return;
    Acc acc;
#pragma unroll
    for (int a = 0; a < 2; ++a)
#pragma unroll
        for (int b = 0; b < 2; ++b)
#pragma unroll
            for (int m = 0; m < 4; ++m)
#pragma unroll
                for (int n = 0; n < 2; ++n) acc[a][b][m][n] = (f32x4){0.f, 0.f, 0.f, 0.f};
    bf16x8 At[4][2], B0[2][2], B1[2][2];
    constexpr bool GA = Sched::GATHER_A;
    unsigned vAc0[2], vAc1[2], vAn0[2], vAn1[2];
    const char* cA = Abase; const char* nA = Abase;
#pragma unroll
    for (int i = 0; i < 2; ++i) {
        if constexpr (GA) { vAc0[i] = S.aoff(cur, Rr[i]) + Cb[i]; vAc1[i] = S.aoff(cur, 128 + Rr[i]) + Cb[i]; }
        else { vAc0[i] = (unsigned)Rr[i] * (unsigned)(K * 2) + Cb[i]; vAc1[i] = (unsigned)(128 + Rr[i]) * (unsigned)(K * 2) + Cb[i]; vAn0[i] = vAc0[i]; vAn1[i] = vAc1[i]; }
    }
    if constexpr (!GA) cA = Abase + S.abase(cur);
    const char* cB = cur.bptr;
    G_STAGE(G_SB(0, 0), cB, voffB); G_STAGE(G_SB(0, 1), cB + hstep, voffB); G_STAGE(G_SA(0, 0), cA, vAc0); G_STAGE(G_SA(0, 1), cA, vAc1);
    if (wr == 1) G_BAR;
    G_WAIT_V(2); G_BAR;
    G_STAGE(G_SB(1, 0), cB + kstep, voffB); G_STAGE(G_SA(1, 0), cA + kstep, vAc0); G_STAGE(G_SB(1, 1), cB + hstep + kstep, voffB);
    G_WAIT_V(6); G_BAR;
    for (;;) {
        const bool has_next = S.next(ui + 1, nxt);
        const char* nB = has_next ? nxt.bptr : cB;
        if constexpr (GA) {
#pragma unroll
            for (int i = 0; i < 2; ++i) { vAn0[i] = has_next ? S.aoff(nxt, Rr[i]) + Cb[i] : vAc0[i]; vAn1[i] = has_next ? S.aoff(nxt, 128 + Rr[i]) + Cb[i] : vAc1[i]; }
        } else { nA = has_next ? Abase + S.abase(nxt) : cA; }
#pragma unroll 1
        for (int t = 0; t < nt; t += 2) {
            const bool last = (t == nt - 2);
            const char* a1 = cA + (size_t)(t + 1) * kstep;
            const char* a2 = last ? nA : cA + (size_t)(t + 2) * kstep; const char* b2 = last ? nB : cB + (size_t)(t + 2) * kstep;
            const char* a3 = a2 + kstep; const char* b3 = b2 + kstep;
            unsigned v20[2], v21[2];
#pragma unroll
            for (int i = 0; i < 2; ++i) { if constexpr (GA) { v20[i] = last ? vAn0[i] : vAc0[i]; v21[i] = last ? vAn1[i] : vAc1[i]; } else { v20[i] = vAc0[i]; v21[i] = vAc1[i]; } }
            G_LDB(B0, 0, 0); G_LDB(B1, 0, 1); G_SCHED; G_LDA(At, 0, 0); G_STAGE(G_SA(1, 1), a1, vAc1);
            G_WAIT_V(8); G_WAIT_L(0); G_BAR; G_MMA(0, 0, At, B0); G_MMA(0, 1, At, B1); G_BAR; G_SCHED;
            G_LDA(At, 0, 1); G_STAGE(G_SB(0, 0), b2, voffB); G_STAGE(G_SB(0, 1), b2 + hstep, voffB); G_STAGE(G_SA(0, 0), a2, v20);
            G_WAIT_V(8); G_WAIT_L(0); G_BAR; G_MMA(1, 0, At, B0); G_MMA(1, 1, At, B1); G_BAR; G_SCHED;
            G_LDB(B0, 1, 0); G_LDB(B1, 1, 1); G_SCHED; G_LDA(At, 1, 0); G_STAGE(G_SA(0, 1), a2, v21);
            G_WAIT_V(8); G_WAIT_L(0); G_BAR; G_MMA(0, 0, At, B0); G_MMA(0, 1, At, B1); G_BAR; G_SCHED;
            G_LDA(At, 1, 1); G_STAGE(G_SB(1, 0), b3, voffB); G_STAGE(G_SB(1, 1), b3 + hstep, voffB); G_STAGE(G_SA(1, 0), a3, v20);
            G_WAIT_V(8); G_WAIT_L(0); G_BAR; G_MMA(1, 0, At, B0); G_MMA(1, 1, At, B1); G_BAR; G_SCHED;
        }
        if (wr == 0) G_BAR;
        E(acc, cur, wr, wc, fr, fq);
        if (!has_next) break;
#pragma unroll
        for (int a = 0; a < 2; ++a)
#pragma unroll
            for (int b = 0; b < 2; ++b)
#pragma unroll
                for (int m = 0; m < 4; ++m)
#pragma unroll
                    for (int n = 0; n < 2; ++n) acc[a][b][m][n] = (f32x4){0.f, 0.f, 0.f, 0.f};
        cur = nxt; cB = nB; ++ui;
        if constexpr (GA) {
#pragma unroll
            for (int i = 0; i < 2; ++i) { vAc0[i] = vAn0[i]; vAc1[i] = vAn1[i]; }
        } else cA = nA;
        if (wr == 1) G_BAR;
    }
    G_WAIT_V(0);
    G_BAR;
#undef G_SA
#undef G_SB
#undef G_STAGE
#undef G_LDA
#undef G_LDB
#undef G_MMA
#undef G_WAIT_V
#undef G_WAIT_L
#undef G_BAR
#undef G_SCHED
}
}

namespace fa {
__device__ __forceinline__ int crow(int r, int hi) { return (r & 3) + 8 * (r >> 2) + 4 * hi; }
typedef short v4i16_t __attribute__((ext_vector_type(4)));
__device__ __forceinline__ s16x4 vtr(const LAS char* p) { return __builtin_bit_cast(s16x4, __builtin_amdgcn_ds_read_tr16_b64_v4i16((LAS v4i16_t*)p)); }
__device__ __forceinline__ float halfmax(float m) { auto rr = __builtin_amdgcn_permlane32_swap(__float_as_uint(m), __float_as_uint(m), false, false); return fmaxf(__uint_as_float(rr[0]), __uint_as_float(rr[1])); }
__device__ __forceinline__ float halfsum(float m) { auto rr = __builtin_amdgcn_permlane32_swap(__float_as_uint(m), __float_as_uint(m), false, false); return __uint_as_float(rr[0]) + __uint_as_float(rr[1]); }

template <int NQ, int KSTR> __device__ __forceinline__ f32x16 qk(const LAS char* Kl, int j, const bf16x8 (&qf)[NQ], int lane) {
    f32x16 s = {0.f, 0.f, 0.f, 0.f, 0.f, 0.f, 0.f, 0.f, 0.f, 0.f, 0.f, 0.f, 0.f, 0.f, 0.f, 0.f};
    const LAS char* kp = Kl + (32 * j + (lane & 31)) * KSTR + (lane >> 5) * 16;
#pragma unroll
    for (int ds = 0; ds < NQ; ++ds) { const bf16x8 kf = *(const LAS bf16x8*)(kp + ds * 32); s = __builtin_amdgcn_mfma_f32_32x32x16_bf16(kf, qf[ds], s, 0, 0, 0); }
    return s;
}
template <int NO> __device__ __forceinline__ void softmax_step(f32x16& p0, f32x16& p1, float& m, float& l, f32x16 (&o)[NO], bf16x8 (&pf)[4]) {
    float mx = fmaxf(p0[0], p1[0]);
#pragma unroll
    for (int r = 1; r < 16; ++r) mx = fmaxf(mx, fmaxf(p0[r], p1[r]));
    mx = halfmax(mx);
    const float mn = fmaxf(m, mx), mu = (mn == -INFINITY) ? 0.f : mn;
    const float al = fast_exp2(m - mu);
    float sum = 0.f;
#pragma unroll
    for (int r = 0; r < 16; ++r) { p0[r] = fast_exp2(p0[r] - mu); p1[r] = fast_exp2(p1[r] - mu); sum += p0[r] + p1[r]; }
    l = l * al + sum; m = mn;
#pragma unroll
    for (int d = 0; d < NO; ++d)
#pragma unroll
        for (int r = 0; r < 16; ++r) o[d][r] *= al;
#pragma unroll
    for (int s = 0; s < 2; ++s) {
        u32x4 a, b;
        a.x = cvtpk(p0[8 * s], p0[8 * s + 1]); a.y = cvtpk(p0[8 * s + 2], p0[8 * s + 3]); a.z = cvtpk(p0[8 * s + 4], p0[8 * s + 5]); a.w = cvtpk(p0[8 * s + 6], p0[8 * s + 7]);
        b.x = cvtpk(p1[8 * s], p1[8 * s + 1]); b.y = cvtpk(p1[8 * s + 2], p1[8 * s + 3]); b.z = cvtpk(p1[8 * s + 4], p1[8 * s + 5]); b.w = cvtpk(p1[8 * s + 6], p1[8 * s + 7]);
        pf[s] = __builtin_bit_cast(bf16x8, a); pf[2 + s] = __builtin_bit_cast(bf16x8, b);
    }
}
template <int NO, int VSTR> __device__ __forceinline__ void pv(f32x16 (&o)[NO], const LAS char* Vl, const bf16x8 (&pf)[4], int lane) {
    const LAS char* vb = Vl + (4 * (lane >> 5) + ((lane & 15) >> 2)) * VSTR + (16 * ((lane >> 4) & 1) + 4 * (lane & 3)) * 2;
#pragma unroll
    for (int d = 0; d < NO; ++d)
#pragma unroll
        for (int ks = 0; ks < 4; ++ks) {
            const s16x4 lo = vtr(vb + (16 * ks) * VSTR + d * 64), hi = vtr(vb + (16 * ks + 8) * VSTR + d * 64);
            const bf16x8 vf = (bf16x8){lo[0], lo[1], lo[2], lo[3], hi[0], hi[1], hi[2], hi[3]};
            o[d] = __builtin_amdgcn_mfma_f32_32x32x16_bf16(vf, pf[ks], o[d], 0, 0, 0);
        }
}
template <int NO> __device__ __forceinline__ void store_o(const f32x16 (&o)[NO], float inv, bf16* rowp, int hi) {
#pragma unroll
    for (int d = 0; d < NO; ++d)
#pragma unroll
        for (int g = 0; g < 4; ++g) { u32x2 w; w.x = cvtpk(o[d][4 * g] * inv, o[d][4 * g + 1] * inv); w.y = cvtpk(o[d][4 * g + 2] * inv, o[d][4 * g + 3] * inv);
            *(u32x2*)(rowp + 32 * d + 8 * g + 4 * hi) = w; }
}
}

__device__ __forceinline__ void diff_unit(const P& p, int b, int h, int qb, LAS unsigned char* ldsu, float lam) {
    constexpr int KSTR = 144, VSTR = 320, KB = 64 * KSTR, VB = 64 * VSTR, BUF = 2 * KB + VB;
    LAS char* lds = (LAS char*)ldsu;
    const int tid = threadIdx.x, lane = tid & 63, wid = __builtin_amdgcn_readfirstlane(tid >> 6), hi = lane >> 5;
    const int comp = wid >> 2, w4 = wid & 3;
    const bf16* proj = (const bf16*)(p.ws + WS_PROJ);
    const size_t rb = (size_t)b * SEQ;
    const int q0 = qb * 128, qmin = q0 + 32 * w4, qpos = qmin + (lane & 31);
    bf16x8 qf[4];
#pragma unroll
    for (int ds = 0; ds < 4; ++ds) qf[ds] = *(const bf16x8*)(proj + (rb + qpos) * INW + 1536 + h * 128 + comp * 64 + ds * 16 + hi * 8);
    const int ntiles = 2 * qb + 2;
    const int krow = tid >> 3, kch = tid & 7;
    const bf16* ksrc = proj + (rb + krow) * INW + 2048 + h * 128 + kch * 8;
    const int vrow0 = tid >> 4, vch = tid & 15;
    const bf16* vsrc = proj + (rb + vrow0) * INW + 2560 + h * 128 + vch * 8;
    const int kdst = krow * KSTR + kch * 16, vdst = 2 * KB + vrow0 * VSTR + vch * 16;
    u32x4 rk0, rk1, rv0, rv1;
    { rk0 = *(const u32x4*)(ksrc); rk1 = *(const u32x4*)(ksrc + 64); rv0 = *(const u32x4*)(vsrc); rv1 = *(const u32x4*)(vsrc + (size_t)32 * INW); }
    *(LAS u32x4*)(lds + kdst) = rk0; *(LAS u32x4*)(lds + KB + kdst) = rk1; *(LAS u32x4*)(lds + vdst) = rv0; *(LAS u32x4*)(lds + vdst + 32 * VSTR) = rv1;
    __syncthreads();
    float m = -INFINITY, l = 0.f; f32x16 o[4];
#pragma unroll
    for (int d = 0; d < 4; ++d)
#pragma unroll
        for (int r = 0; r < 16; ++r) o[d][r] = 0.f;
    for (int kt = 0; kt < ntiles; ++kt) {
        const bool more = kt + 1 < ntiles;
        if (more) { const size_t off = (size_t)(kt + 1) * 64 * INW; rk0 = *(const u32x4*)(ksrc + off); rk1 = *(const u32x4*)(ksrc + off + 64); rv0 = *(const u32x4*)(vsrc + off); rv1 = *(const u32x4*)(vsrc + off + (size_t)32 * INW); }
        const LAS char* buf = lds + (kt & 1) * BUF;
        const int k0 = kt * 64;
        if (k0 <= qmin + 31) {
            const LAS char* Kl = buf + comp * KB;
            f32x16 p0 = fa::qk<4, KSTR>(Kl, 0, qf, lane), p1 = fa::qk<4, KSTR>(Kl, 1, qf, lane);
            if (k0 + 63 > qmin) {
#pragma unroll
                for (int r = 0; r < 16; ++r) { const int key = k0 + fa::crow(r, hi); if (key > qpos) p0[r] = -INFINITY; if (key + 32 > qpos) p1[r] = -INFINITY; }
            }
            bf16x8 pf[4];
            fa::softmax_step<4>(p0, p1, m, l, o, pf);
            fa::pv<4, VSTR>(o, buf + 2 * KB, pf, lane);
        }
        if (more) { LAS char* nb = lds + ((kt + 1) & 1) * BUF; *(LAS u32x4*)(nb + kdst) = rk0; *(LAS u32x4*)(nb + KB + kdst) = rk1; *(LAS u32x4*)(nb + vdst) = rv0; *(LAS u32x4*)(nb + vdst + 32 * VSTR) = rv1; }
        __syncthreads();
    }
    l = fa::halfsum(l);
    const float inv = fast_rcp(l);
    LAS float* ex = (LAS float*)lds + w4 * 4096;
    if (comp == 1) {
#pragma unroll
        for (int d = 0; d < 4; ++d)
#pragma unroll
            for (int r = 0; r < 16; ++r) ex[(d * 16 + r) * 64 + lane] = o[d][r] * inv;
    }
    __syncthreads();
    if (comp == 0) {
        float ss = 0.f;
#pragma unroll
        for (int d = 0; d < 4; ++d)
#pragma unroll
            for (int r = 0; r < 16; ++r) { const float v = o[d][r] * inv - lam * ex[(d * 16 + r) * 64 + lane]; o[d][r] = v; ss += v * v; }
        ss = fa::halfsum(ss);
        const float rs = rsqrtf(ss * (1.f / 128.f) + SUBLN_EPS) * (1.f - LAMBDA_INIT);
        bf16* rowp = (bf16*)(p.ws + WS_MIXIN) + (rb + qpos) * DM + 512 + h * 128;
#pragma unroll
        for (int d = 0; d < 4; ++d)
#pragma unroll
            for (int g = 0; g < 4; ++g) { const int dd = 32 * d + 8 * g + 4 * hi; const f32x4 gg = *(const f32x4*)(p.subln_g + dd);
                u32x2 w; w.x = cvtpk(o[d][4 * g] * rs * gg[0], o[d][4 * g + 1] * rs * gg[1]); w.y = cvtpk(o[d][4 * g + 2] * rs * gg[2], o[d][4 * g + 3] * rs * gg[3]);
                *(u32x2*)(rowp + dd) = w; }
    }
    __syncthreads();
}

__device__ __forceinline__ void dil_unit(const P& p, int b, int h, int br, int grp, LAS unsigned char* ldsu) {
    constexpr int KSTR = 144, VSTR = 192, KALL = 384 * KSTR;
    LAS char* lds = (LAS char*)ldsu;
    const int tid = threadIdx.x, lane = tid & 63, wid = __builtin_amdgcn_readfirstlane(tid >> 6), hi = lane >> 5;
    const int dil = br == 0 ? 1 : (br == 1 ? 4 : 16), ngr = 16 / dil, res = grp / ngr, i0 = 256 * (grp % ngr);
    const bf16* proj = (const bf16*)(p.ws + WS_PROJ);
    const size_t rb = (size_t)b * SEQ;
#pragma unroll
    for (int i = 0; i < 6; ++i) { const int pidx = tid + 512 * i, row = pidx >> 3, ch = pidx & 7; int kidx = i0 - 128 + row; if (kidx < 0) kidx = 0;
        const bf16* src = proj + (rb + (size_t)kidx * dil + res) * INW + h * 64 + ch * 8;
        const u32x4 kv = *(const u32x4*)(src + 512), vv = *(const u32x4*)(src + 1024);
        *(LAS u32x4*)(lds + row * KSTR + ch * 16) = kv; *(LAS u32x4*)(lds + KALL + row * VSTR + ch * 16) = vv; }
    const int qi = i0 + 32 * wid + (lane & 31);
    const size_t qrow = rb + (size_t)qi * dil + res;
    bf16x8 qf[4];
#pragma unroll
    for (int ds = 0; ds < 4; ++ds) qf[ds] = *(const bf16x8*)(proj + qrow * INW + h * 64 + ds * 16 + hi * 8);
    __syncthreads();
    float m = -INFINITY, l = 0.f; f32x16 o[2];
#pragma unroll
    for (int d = 0; d < 2; ++d)
#pragma unroll
        for (int r = 0; r < 16; ++r) o[d][r] = 0.f;
#pragma unroll 1
    for (int kk = 0; kk < 3; ++kk) {
        const int kt = (wid >> 1) + kk;
        const LAS char* Kl = lds + kt * 64 * KSTR;
        f32x16 p0 = fa::qk<4, KSTR>(Kl, 0, qf, lane), p1 = fa::qk<4, KSTR>(Kl, 1, qf, lane);
        const int kb = i0 - 128 + 64 * kt;
#pragma unroll
        for (int r = 0; r < 16; ++r) { const int k0i = kb + fa::crow(r, hi), k1i = k0i + 32;
            if (k0i < 0 || k0i > qi || qi - k0i > 128) p0[r] = -INFINITY;
            if (k1i < 0 || k1i > qi || qi - k1i > 128) p1[r] = -INFINITY; }
        bf16x8 pf[4];
        fa::softmax_step<2>(p0, p1, m, l, o, pf);
        fa::pv<2, VSTR>(o, lds + KALL + kt * 64 * VSTR, pf, lane);
    }
    l = fa::halfsum(l);
    const float inv = fast_rcp(l);
    fa::store_o<2>(o, inv, (bf16*)(p.ws + WS_PARTA) + ((size_t)br * T + qrow) * 512 + h * 64, hi);
    if (hi == 0) ((float*)(p.ws + WS_LSEA))[((size_t)br * T + qrow) * 8 + h] = m + log2f(l);
    __syncthreads();
}

__device__ __forceinline__ void mem_unit(const P& p, int b, int h, int qblk, LAS unsigned char* ldsu) {
    constexpr int KSTR = 528, VSTR = 192, KB = 64 * KSTR, VB = 64 * VSTR, BUF = KB + VB;
    LAS char* lds = (LAS char*)ldsu;
    const int tid = threadIdx.x, lane = tid & 63, wid = __builtin_amdgcn_readfirstlane(tid >> 6), hi = lane >> 5;
    const bf16* qm = (const bf16*)(p.ws + WS_QM); const bf16* kvm = (const bf16*)(p.ws + WS_KVM);
    const size_t qrow = (size_t)b * SEQ + qblk * 256 + 32 * wid + (lane & 31);
    bf16x8 qf[16];
#pragma unroll
    for (int ds = 0; ds < 16; ++ds) qf[ds] = *(const bf16x8*)(qm + qrow * DM + h * 256 + ds * 16 + hi * 8);
    const bf16* kbase = kvm + (size_t)(b * MEML) * 2048 + h * 256;
#pragma unroll 1
    for (int quarter = 0; quarter < 4; ++quarter) {
        const bf16* vbase = kvm + (size_t)(b * MEML) * 2048 + 1024 + h * 256 + quarter * 64;
        u32x4 rk[4], rv;
#define MEM_LOAD(kt) do { _Pragma("unroll") for (int i = 0; i < 4; ++i) { const int pidx = tid + 512 * i, row = pidx >> 5, ch = pidx & 31; rk[i] = *(const u32x4*)(kbase + (size_t)((kt) * 64 + row) * 2048 + ch * 8); } \
        { const int row = tid >> 3, ch = tid & 7; rv = *(const u32x4*)(vbase + (size_t)((kt) * 64 + row) * 2048 + ch * 8); } } while (0)
#define MEM_WRITE(bufp) do { _Pragma("unroll") for (int i = 0; i < 4; ++i) { const int pidx = tid + 512 * i, row = pidx >> 5, ch = pidx & 31; *(LAS u32x4*)((bufp) + row * KSTR + ch * 16) = rk[i]; } \
        { const int row = tid >> 3, ch = tid & 7; *(LAS u32x4*)((bufp) + KB + row * VSTR + ch * 16) = rv; } } while (0)
        MEM_LOAD(0); MEM_WRITE(lds);
        __syncthreads();
        float m = -INFINITY, l = 0.f; f32x16 o[2];
#pragma unroll
        for (int d = 0; d < 2; ++d)
#pragma unroll
            for (int r = 0; r < 16; ++r) o[d][r] = 0.f;
#pragma unroll 1
        for (int kt = 0; kt < 4; ++kt) {
            const bool more = kt < 3;
            if (more) MEM_LOAD(kt + 1);
            const LAS char* buf = lds + (kt & 1) * BUF;
            f32x16 p0 = fa::qk<16, KSTR>(buf, 0, qf, lane), p1 = fa::qk<16, KSTR>(buf, 1, qf, lane);
            bf16x8 pf[4];
            fa::softmax_step<2>(p0, p1, m, l, o, pf);
            fa::pv<2, VSTR>(o, buf + KB, pf, lane);
            if (more) { LAS char* nb = lds + ((kt + 1) & 1) * BUF; MEM_WRITE(nb); }
            __syncthreads();
        }
#undef MEM_LOAD
#undef MEM_WRITE
        l = fa::halfsum(l);
        fa::store_o<2>(o, fast_rcp(l), (bf16*)(p.ws + WS_MO) + qrow * DM + h * 256 + quarter * 64, hi);
    }
}

struct Ctx { int tid, lane, wave, G, vcu, gw, ngw; LAS unsigned char* lds; };

template <class RowMap> __device__ __forceinline__ void transpose_tile(const float* W, int N, int k0, int n0, bf16* dst, int dstK, LAS float* scr, int lane, const RowMap& rm) {
    f32x4 v[16];
#pragma unroll
    for (int i = 0; i < 16; ++i) v[i] = *(const f32x4*)(W + (size_t)(k0 + 4 * i + (lane >> 4)) * N + n0 + (lane & 15) * 4);
#pragma unroll
    for (int i = 0; i < 16; ++i) { LAS float* s = scr + (4 * i + (lane >> 4)) * 65 + (lane & 15) * 4; s[0] = v[i][0]; s[1] = v[i][1]; s[2] = v[i][2]; s[3] = v[i][3]; }
    asm volatile("s_waitcnt lgkmcnt(0)" ::: "memory");
    const int c = lane & 7;
#pragma unroll
    for (int j = 0; j < 8; ++j) { const int n = (lane >> 3) + 8 * j; const LAS float* s = scr + (8 * c) * 65 + n;
        u32x4 w; w.x = cvtpk(s[0], s[65]); w.y = cvtpk(s[2 * 65], s[3 * 65]); w.z = cvtpk(s[4 * 65], s[5 * 65]); w.w = cvtpk(s[6 * 65], s[7 * 65]);
        *(u32x4*)(dst + (size_t)rm(n0 + n) * dstK + k0 + 8 * c) = w; }
    asm volatile("s_waitcnt lgkmcnt(0)" ::: "memory");
}
struct RmId { __device__ int operator()(int n) const { return n; } };
struct RmInProj { __device__ int operator()(int n) const { const int seg = n >> 9; if (seg == 2 || seg == 5) return n; const int d = n & 63; return (n & ~63) | (d < 16 ? 2 * (d & 7) + (d >> 3) : d); } };
struct RmGU { int up; __device__ int operator()(int n) const { return (n >> 7) * 256 + up * 128 + (n & 127); } };

__device__ __forceinline__ void phase_prologue(const P& p, const Ctx& c) {
    LAS float* scr = (LAS float*)(c.lds + c.wave * 16640);
    unsigned char* ws = p.ws;
    constexpr int I_IN = 16 * 48, I_SQ = 16 * 16, I_KV = 16 * 32, I_R = 16 * 4, I_E = 64;
    constexpr int ND = I_IN + 3 * I_SQ + I_KV + I_R;
    const int NIT = ND + 3 * I_E * (NEXP + 1);
    for (int it = c.gw; it < NIT; it += c.ngw) {
        int r = it;
        if (r < I_IN) { transpose_tile(p.w_in, INW, (r / 48) * 64, (r % 48) * 64, (bf16*)(ws + WS_WINT), DM, scr, c.lane, RmInProj{}); continue; } r -= I_IN;
        if (r < I_SQ) { transpose_tile(p.w_out, DM, (r / 16) * 64, (r % 16) * 64, (bf16*)(ws + WS_WOUTT), DM, scr, c.lane, RmId{}); continue; } r -= I_SQ;
        if (r < I_SQ) { transpose_tile(p.wq, DM, (r / 16) * 64, (r % 16) * 64, (bf16*)(ws + WS_WQT), DM, scr, c.lane, RmId{}); continue; } r -= I_SQ;
        if (r < I_KV) { transpose_tile(p.wkv, 2048, (r / 32) * 64, (r % 32) * 64, (bf16*)(ws + WS_WKVT), DM, scr, c.lane, RmId{}); continue; } r -= I_KV;
        if (r < I_SQ) { transpose_tile(p.wo, DM, (r / 16) * 64, (r % 16) * 64, (bf16*)(ws + WS_WOT), DM, scr, c.lane, RmId{}); continue; } r -= I_SQ;
        if (r < I_R) { transpose_tile(p.w_router, NEXP, (r / 4) * 64, (r % 4) * 64, (bf16*)(ws + WS_WRT), DM, scr, c.lane, RmId{}); continue; } r -= I_R;
        const int e = r / (3 * I_E), q = r % (3 * I_E), which = q / I_E, ti = q % I_E;
        if (which == 0) { const float* W = e < NEXP ? p.w_gate + (size_t)e * DM * EDIM : p.ws_gate; transpose_tile(W, EDIM, (ti / 4) * 64, (ti % 4) * 64, (bf16*)(ws + WS_WTGU) + (size_t)e * 512 * DM, DM, scr, c.lane, RmGU{0}); }
        else if (which == 1) { const float* W = e < NEXP ? p.w_up + (size_t)e * DM * EDIM : p.ws_up; transpose_tile(W, EDIM, (ti / 4) * 64, (ti % 4) * 64, (bf16*)(ws + WS_WTGU) + (size_t)e * 512 * DM, DM, scr, c.lane, RmGU{1}); }
        else { const float* W = e < NEXP ? p.w_down + (size_t)e * EDIM * DM : p.ws_down; transpose_tile(W, DM, (ti / 16) * 64, (ti % 16) * 64, (bf16*)(ws + WS_WTD) + (size_t)e * DM * EDIM, EDIM, scr, c.lane, RmId{}); }
    }
    const int gt = c.vcu * NTHR + c.tid, ngt = c.G * NTHR;
    for (int i = gt; i < T * DM / 8; i += ngt) { const f32x4 a = *(const f32x4*)(p.x + (size_t)i * 8), b = *(const f32x4*)(p.x + (size_t)i * 8 + 4); *(u32x4*)((bf16*)(ws + WS_XB) + (size_t)i * 8) = gm::pack8(a, b); }
    for (int i = gt; i < BATCH * MEML * DM / 8; i += ngt) { const f32x4 a = *(const f32x4*)(p.mem + (size_t)i * 8), b = *(const f32x4*)(p.mem + (size_t)i * 8 + 4); *(u32x4*)((bf16*)(ws + WS_MEMB) + (size_t)i * 8) = gm::pack8(a, b); }
    for (int i = gt; i < T * 8; i += ngt) { const int t = i >> 3, j = i & 7; const float inv = powf(500000.0f, -(float)(2 * j) / 16.0f); const float ang = (float)p.pos[t] * inv;
        ((float2*)(ws + WS_CS))[i] = make_float2(cosf(ang), sinf(ang)); }
    if (gt < 256) ((int*)(ws + WS_CNT))[gt] = 0;
    if (gt == 0) { float a = 0.f, b = 0.f; for (int k = 0; k < 64; ++k) { a += p.lq1[k] * p.lk1[k]; b += p.lq2[k] * p.lk2[k]; } ((float*)(ws + WS_SCAL))[0] = expf(a) - expf(b) + LAMBDA_INIT; }
}

__device__ __forceinline__ void unpack8(const u32x4 u, float (&v)[8]) {
    v[0] = __uint_as_float(u.x << 16); v[1] = __uint_as_float(u.x & 0xffff0000u); v[2] = __uint_as_float(u.y << 16); v[3] = __uint_as_float(u.y & 0xffff0000u);
    v[4] = __uint_as_float(u.z << 16); v[5] = __uint_as_float(u.z & 0xffff0000u); v[6] = __uint_as_float(u.w << 16); v[7] = __uint_as_float(u.w & 0xffff0000u);
}
__device__ __forceinline__ void phase_merge(const P& p, const Ctx& c) {
    const int gt = c.vcu * NTHR + c.tid, ngt = c.G * NTHR;
    const float* lse = (const float*)(p.ws + WS_LSEA); const bf16* pa = (const bf16*)(p.ws + WS_PARTA); bf16* mx = (bf16*)(p.ws + WS_MIXIN);
    for (int i = gt; i < T * 64; i += ngt) {
        const int t = i >> 6, c8 = (i & 63) * 8, h = c8 >> 6;
        const float l0 = lse[(size_t)t * 8 + h], l1 = lse[((size_t)T + t) * 8 + h], l2 = lse[((size_t)2 * T + t) * 8 + h];
        const float mxl = fmaxf(l0, fmaxf(l1, l2));
        float w0 = fast_exp2(l0 - mxl), w1 = fast_exp2(l1 - mxl), w2 = fast_exp2(l2 - mxl); const float inv = 1.f / (w0 + w1 + w2); w0 *= inv; w1 *= inv; w2 *= inv;
        float a[8], b[8], d[8];
        unpack8(*(const u32x4*)(pa + (size_t)t * 512 + c8), a); unpack8(*(const u32x4*)(pa + ((size_t)T + t) * 512 + c8), b); unpack8(*(const u32x4*)(pa + ((size_t)2 * T + t) * 512 + c8), d);
        u32x4 o; o.x = cvtpk(w0 * a[0] + w1 * b[0] + w2 * d[0], w0 * a[1] + w1 * b[1] + w2 * d[1]); o.y = cvtpk(w0 * a[2] + w1 * b[2] + w2 * d[2], w0 * a[3] + w1 * b[3] + w2 * d[3]);
        o.z = cvtpk(w0 * a[4] + w1 * b[4] + w2 * d[4], w0 * a[5] + w1 * b[5] + w2 * d[5]); o.w = cvtpk(w0 * a[6] + w1 * b[6] + w2 * d[6], w0 * a[7] + w1 * b[7] + w2 * d[7]);
        *(u32x4*)(mx + (size_t)t * DM + c8) = o;
    }
}
__device__ __forceinline__ void phase_ln(const bf16* in, bf16* outp, const float* g, const float* bb_, const Ctx& c) {
    for (int w = c.gw; w < T; w += c.ngw) {
        const bf16* r = in + (size_t)w * DM; float v[16]; float s = 0.f;
#pragma unroll
        for (int j = 0; j < 4; ++j) { const u32x2 u = *(const u32x2*)(r + j * 256 + c.lane * 4);
            v[4 * j] = __uint_as_float(u.x << 16); v[4 * j + 1] = __uint_as_float(u.x & 0xffff0000u); v[4 * j + 2] = __uint_as_float(u.y << 16); v[4 * j + 3] = __uint_as_float(u.y & 0xffff0000u); }
#pragma unroll
        for (int j = 0; j < 16; ++j) s += v[j];
#pragma unroll
        for (int o = 1; o < 64; o <<= 1) s += __shfl_xor(s, o);
        const float mu = s * (1.f / DM); float q = 0.f;
#pragma unroll
        for (int j = 0; j < 16; ++j) { v[j] -= mu; q += v[j] * v[j]; }
#pragma unroll
        for (int o = 1; o < 64; o <<= 1) q += __shfl_xor(q, o);
        const float rs = rsqrtf(q * (1.f / DM) + LN_EPS);
#pragma unroll
        for (int j = 0; j < 4; ++j) { const int cc = j * 256 + c.lane * 4; const f32x4 gg = *(const f32x4*)(g + cc), bb = *(const f32x4*)(bb_ + cc);
            u32x2 u; u.x = cvtpk(v[4 * j] * rs * gg[0] + bb[0], v[4 * j + 1] * rs * gg[1] + bb[1]); u.y = cvtpk(v[4 * j + 2] * rs * gg[2] + bb[2], v[4 * j + 3] * rs * gg[3] + bb[3]);
            *(u32x2*)(outp + (size_t)w * DM + cc) = u; }
    }
}
__device__ __forceinline__ void phase_route(const P& p, const Ctx& c) {
    const int lane = c.lane;
    for (int w = c.gw; w < T; w += c.ngw) {
        const f32x4 lg = *(const f32x4*)((const float*)(p.ws + WS_LOGITS) + (size_t)w * NEXP + lane * 4);
        const f32x4 eb = *(const f32x4*)(p.e_bias + lane * 4);
        float sc[4], bs[4];
#pragma unroll
        for (int j = 0; j < 4; ++j) { sc[j] = 1.f / (1.f + expf(-lg[j])); bs[j] = sc[j] + eb[j]; }
        float m1 = fmaxf(bs[0], bs[1]), m2 = fminf(bs[0], bs[1]);
        { const float cc = bs[2]; const float n1 = fmaxf(m1, cc); m2 = fmaxf(m2, fminf(m1, cc)); m1 = n1; }
        { const float cc = bs[3]; const float n1 = fmaxf(m1, cc); m2 = fmaxf(m2, fminf(m1, cc)); m1 = n1; }
#pragma unroll
        for (int o = 1; o < 8; o <<= 1) { const float b1 = __shfl_xor(m1, o), b2 = __shfl_xor(m2, o); const float n1 = fmaxf(m1, b1); m2 = fmaxf(fminf(m1, b1), fmaxf(m2, b2)); m1 = n1; }
        const float gs = m1 + m2; const int grp = lane >> 3; int rank = 0;
#pragma unroll
        for (int g2 = 0; g2 < 8; ++g2) { const float o = __shfl(gs, g2 * 8); rank += (o > gs || (o == gs && g2 < grp)) ? 1 : 0; }
        const bool sel = rank < 4;
        float cand[4];
#pragma unroll
        for (int j = 0; j < 4; ++j) cand[j] = sel ? bs[j] : -INFINITY;
        int myidx = 0; float myw = 0.f, wsum = 0.f;
#pragma unroll 1
        for (int k = 0; k < TOPK; ++k) {
            float bv = cand[0]; int bi = lane * 4;
#pragma unroll
            for (int j = 1; j < 4; ++j) if (cand[j] > bv) { bv = cand[j]; bi = lane * 4 + j; }
#pragma unroll
            for (int o = 1; o < 64; o <<= 1) { const float ov = __shfl_xor(bv, o); const int oi = __shfl_xor(bi, o); if (ov > bv || (ov == bv && oi < bi)) { bv = ov; bi = oi; } }
            const int own = bi >> 2, el = bi & 3;
            const float sv = el == 0 ? sc[0] : (el == 1 ? sc[1] : (el == 2 ? sc[2] : sc[3]));
            const float wv = __shfl(sv, own);
            if (lane == own) { if (el == 0) cand[0] = -INFINITY; else if (el == 1) cand[1] = -INFINITY; else if (el == 2) cand[2] = -INFINITY; else cand[3] = -INFINITY; }
            wsum += wv;
            if (lane == k) { myidx = bi; myw = wv; }
        }
        if (lane < TOPK) {
            const int rk = atomicAdd((int*)(p.ws + WS_CNT) + myidx, 1);
            ((int*)(p.ws + WS_RIDX))[(size_t)w * 8 + lane] = myidx;
            ((float*)(p.ws + WS_RW))[(size_t)w * 8 + lane] = myw / wsum * ROUTED_SCALE;
            ((int*)(p.ws + WS_RRANK))[(size_t)w * 8 + lane] = rk;
        }
    }
}
__device__ __forceinline__ void phase_scatter(const P& p, const Ctx& c) {
    LAS int* sh = (LAS int*)c.lds;
    const int tid = c.tid;
    int cnt = 0;
    if (tid < 256) { cnt = ld_i32_agent((const int*)(p.ws + WS_CNT) + tid); sh[tid] = cnt; sh[256 + tid] = (cnt + 255) >> 8; }
    __syncthreads();
    for (int o = 1; o < 256; o <<= 1) { int v = 0, v2 = 0; if (tid < 256 && tid >= o) { v = sh[tid - o]; v2 = sh[256 + tid - o]; } __syncthreads(); if (tid < 256) { sh[tid] += v; sh[256 + tid] += v2; } __syncthreads(); }
    if (blockIdx.x == 0) {
        int* st = (int*)(p.ws + WS_START); int* tab = (int*)(p.ws + WS_TILETAB);
        if (tid < 256) { const int st_e = sh[tid] - cnt; st[tid + 1] = sh[tid]; if (tid == 0) st[0] = 0;
            const int nte = (cnt + 255) >> 8, tb = sh[256 + tid] - nte;
            for (int ti = 0; ti < nte; ++ti) { int* q = tab + 4 * (tb + ti); q[0] = tid; q[1] = ti; q[2] = st_e + 256 * ti; q[3] = min(256, cnt - 256 * ti); } }
        const int nrt_r = sh[511];
        if (tid < 128) { int* q = tab + 4 * (nrt_r + tid); q[0] = NEXP; q[1] = tid; q[2] = AROWS + 256 * tid; q[3] = 256; }
        if (tid == 0) ((int*)(p.ws + WS_NRT))[0] = nrt_r + 128;
    }
    const int gt = c.vcu * NTHR + tid, ngt = c.G * NTHR;
    for (int i = gt; i < T * 8; i += ngt) {
        const int e = ((const int*)(p.ws + WS_RIDX))[i], rk = ((const int*)(p.ws + WS_RRANK))[i];
        const int pos = (e == 0 ? 0 : sh[e - 1]) + rk;
        ((int*)(p.ws + WS_ROWTOK))[pos] = i >> 3;
        ((float*)(p.ws + WS_ROWW))[pos] = ((const float*)(p.ws + WS_RW))[i];
        ((int*)(p.ws + WS_POS))[i] = pos;
    }
    __syncthreads();
}
__device__ __forceinline__ void phase_combine(const P& p, const Ctx& c) {
    const int lane = c.lane;
    const bf16* Y = (const bf16*)(p.ws + WS_Y);
    for (int w = c.gw; w < T; w += c.ngw) {
        const bf16* h2 = (const bf16*)(p.ws + WS_H2) + (size_t)w * DM;
        const int* pos = (const int*)(p.ws + WS_POS) + (size_t)w * 8;
        float v[16];
#pragma unroll
        for (int j = 0; j < 4; ++j) { const u32x2 u = *(const u32x2*)(h2 + j * 256 + lane * 4);
            v[4 * j] = DN_ALPHA * __uint_as_float(u.x << 16); v[4 * j + 1] = DN_ALPHA * __uint_as_float(u.x & 0xffff0000u); v[4 * j + 2] = DN_ALPHA * __uint_as_float(u.y << 16); v[4 * j + 3] = DN_ALPHA * __uint_as_float(u.y & 0xffff0000u); }
#pragma unroll
        for (int k = 0; k < 9; ++k) {
            const size_t row = k < 8 ? (size_t)pos[k < 8 ? k : 0] : (size_t)AROWS + w;
            const bf16* yr = Y + row * DM;
#pragma unroll
            for (int j = 0; j < 4; ++j) { const u32x2 u = *(const u32x2*)(yr + j * 256 + lane * 4);
                v[4 * j] += __uint_as_float(u.x << 16); v[4 * j + 1] += __uint_as_float(u.x & 0xffff0000u); v[4 * j + 2] += __uint_as_float(u.y << 16); v[4 * j + 3] += __uint_as_float(u.y & 0xffff0000u); }
        }
        float s = 0.f;
#pragma unroll
        for (int j = 0; j < 16; ++j) s += v[j];
#pragma unroll
        for (int o = 1; o < 64; o <<= 1) s += __shfl_xor(s, o);
        const float mu = s * (1.f / DM); float q = 0.f;
#pragma unroll
        for (int j = 0; j < 16; ++j) { v[j] -= mu; q += v[j] * v[j]; }
#pragma unroll
        for (int o = 1; o < 64; o <<= 1) q += __shfl_xor(q, o);
        const float rs = rsqrtf(q * (1.f / DM) + LN_EPS);
#pragma unroll
        for (int j = 0; j < 4; ++j) { const int cc = j * 256 + lane * 4; const f32x4 gg = *(const f32x4*)(p.ln3_g + cc), bb = *(const f32x4*)(p.ln3_b + cc);
            f32x4 o; o[0] = v[4 * j] * rs * gg[0] + bb[0]; o[1] = v[4 * j + 1] * rs * gg[1] + bb[1]; o[2] = v[4 * j + 2] * rs * gg[2] + bb[2]; o[3] = v[4 * j + 3] * rs * gg[3] + bb[3];
            *(f32x4*)(p.out + (size_t)w * DM + cc) = o; }
    }
}


#define XB_TMO      128
#define XB_XCNT(j)  (256  + 64 * (j))
#define XB_XSUB(j)  (1280 + 64 * (j))
#define XB_XGEN(j)  (2304 + 64 * (j))
#define XB_TOP      3328
#define XB_TOPGEN   3392
#define XCD_BAR_WORDS 3456
#define XB_SPIN_CAP (1u << 18)
__device__ __forceinline__ unsigned xb_ld(unsigned* p)              { return __hip_atomic_load(p, __ATOMIC_RELAXED, __HIP_MEMORY_SCOPE_AGENT); }
__device__ __forceinline__ unsigned xb_add(unsigned* p, unsigned v) { return __hip_atomic_fetch_add(p, v, __ATOMIC_RELAXED, __HIP_MEMORY_SCOPE_AGENT); }
__device__ __forceinline__ unsigned xb_xcc_id() { return (unsigned)__builtin_amdgcn_s_getreg((3 << 11) | 20) & 0xFu; }
#define XB_SPIN(cond, bar) do { unsigned _sp = 0; while (cond) { __builtin_amdgcn_s_sleep(1); \
    if ((++_sp & 255u) == 0u) { if (xb_ld(&(bar)[XB_TMO])) break; if (_sp > XB_SPIN_CAP) { atomicAdd(&(bar)[XB_TMO], 1u); break; } } } } while (0)
struct XcdBarrier { unsigned* bar; unsigned x; volatile LAS unsigned* st; };
__device__ __forceinline__ XcdBarrier xcd_barrier_post(unsigned* bar, volatile LAS unsigned* st) {
    XcdBarrier b; b.bar = bar; b.x = xb_xcc_id(); b.st = st;
    if (threadIdx.x == 0) (void)xb_add(&bar[XB_XCNT(b.x)], 1u);
    return b;
}
__device__ __forceinline__ void xcd_barrier_complete(unsigned* bar, unsigned x, unsigned& nloc, unsigned& nx) {
    const unsigned G = gridDim.x * gridDim.y * gridDim.z;
    unsigned sum, cnt, mine, sp = 0u;
    for (;;) {
        sum = 0u; cnt = 0u; mine = 0u;
#pragma unroll
        for (unsigned j = 0; j < 16; ++j) { const unsigned c = xb_ld(&bar[XB_XCNT(j)]); sum += c; cnt += (c > 0u) ? 1u : 0u; mine = (j == x) ? c : mine; }
        if (sum == G) break;
        __builtin_amdgcn_s_sleep(1);
        if ((++sp & 255u) == 0u) { if (xb_ld(&bar[XB_TMO])) break; if (sp > XB_SPIN_CAP) { atomicAdd(&bar[XB_TMO], 1u); break; } }
    }
    nloc = mine > 0u ? mine : 1u; nx = cnt > 0u ? cnt : 1u;
}
__device__ __forceinline__ void xcd_barrier(const XcdBarrier& b) {
    asm volatile("s_waitcnt vmcnt(0)" ::: "memory");
    __syncthreads();
    if (threadIdx.x == 0) {
        unsigned* bar = b.bar;
        __builtin_amdgcn_s_waitcnt(0);
        unsigned nloc = b.st[0], nx = b.st[1];
        if (nloc == 0u) { xcd_barrier_complete(bar, b.x, nloc, nx); b.st[0] = nloc; b.st[1] = nx; }
        const unsigned old = xb_add(&bar[XB_XSUB(b.x)], 1u);
        const unsigned gen = old / nloc;
        if (old + 1u == (gen + 1u) * nloc) {
            __builtin_amdgcn_fence(__ATOMIC_RELEASE, "agent");
            asm volatile("s_waitcnt vmcnt(0)" ::: "memory");
            const unsigned og = xb_add(&bar[XB_TOP], 1u);
            const unsigned tg = og / nx;
            if (og + 1u == (tg + 1u) * nx) xb_add(&bar[XB_TOPGEN], 1u);
            else XB_SPIN(xb_ld(&bar[XB_TOPGEN]) == tg, bar);
            __builtin_amdgcn_fence(__ATOMIC_ACQUIRE, "agent");
            xb_add(&bar[XB_XGEN(b.x)], 1u);
            asm volatile("s_waitcnt vmcnt(0)" ::: "memory");
        } else {
            XB_SPIN(xb_ld(&bar[XB_XGEN(b.x)]) == gen, bar);
            __builtin_amdgcn_fence(__ATOMIC_ACQUIRE, "agent");
            asm volatile("s_waitcnt vmcnt(0)" ::: "memory");
        }
    }
    __syncthreads();
}

enum Phase { PH_PROLOGUE = 0, PH_INPROJ, PH_ATTN, PH_MERGE, PH_OUTPROJ, PH_LN1, PH_QMEM, PH_MEMATTN, PH_WO, PH_LN2, PH_ROUTER, PH_ROUTE, PH_SCATTER, PH_MOE1, PH_MOE2, PH_COMBINE, PH_COUNT };
struct MKArgs { P p; int ph_lo, ph_hi; };

__global__ void __launch_bounds__(NTHR, 2) mk_fwd(MKArgs a) {
    extern __shared__ __attribute__((aligned(16))) unsigned char lds_raw[];
    LAS unsigned char* lds = (LAS unsigned char*)lds_raw;
    const P& p = a.p;
    Ctx c; c.tid = threadIdx.x; c.lane = c.tid & 63; c.wave = __builtin_amdgcn_readfirstlane(c.tid >> 6); c.G = gridDim.x;
    { const int bx = blockIdx.x; c.vcu = (c.G % 8 == 0) ? (bx % 8) * (c.G / 8) + bx / 8 : bx; }
    c.gw = c.vcu * NWAVES + c.wave; c.ngw = c.G * NWAVES; c.lds = lds;
    unsigned char* ws = p.ws;
    const int lo = a.ph_lo, hi = a.ph_hi;
#ifdef ONLY_PH
#define IN(k) ((k) == ONLY_PH)
#else
#define IN(k) (lo <= (k) && (k) < hi)
#endif
#ifndef USE_CG_SYNC
#define USE_CG_SYNC 0
#endif
    volatile LAS unsigned* MISC = (volatile LAS unsigned*)(lds + LDS_BYTES - 64);
    if (c.tid == 0) { MISC[0] = 0u; MISC[1] = 0u; }
    __syncthreads();
    XcdBarrier gbar; gbar.bar = (unsigned*)(ws + WS_BAR); gbar.x = 0; gbar.st = MISC;
    if (!USE_CG_SYNC && hi - lo > 1) gbar = xcd_barrier_post((unsigned*)(ws + WS_BAR), MISC);
#ifndef REP_MASK
#define REP_MASK 0
#endif
#define REPS(k) (1 + ((REP_MASK >> (k)) & 1))
#define SEAM(k) do { if (IN(k) && IN((k) + 1)) { if (USE_CG_SYNC) cg::this_grid().sync(); else xcd_barrier(gbar); } } while (0)

    if (IN(PH_PROLOGUE)) { for (int rep = 0; rep < REPS(PH_PROLOGUE); ++rep) phase_prologue(p, c); SEAM(PH_PROLOGUE); }

    if (IN(PH_INPROJ)) {
        for (int rep = 0; rep < REPS(PH_INPROJ); ++rep)
        { gm::DenseSched S; S.init(T, INW, DM, ws + WS_WINT, c.G, (int)blockIdx.x);
          gm::EpiInProj E{(bf16*)(ws + WS_PROJ), (const float*)(ws + WS_CS)};
          gm::gemm_phase(lds, (const char*)(ws + WS_XB), DM, S, E); }
        { gm::DenseSched S; S.init(BATCH * MEML, 2048, DM, ws + WS_WKVT, c.G, (int)blockIdx.x);
          gm::EpiScale E{(bf16*)(ws + WS_KVM), 2048, 1.f};
          gm::gemm_phase(lds, (const char*)(ws + WS_MEMB), DM, S, E); }
        SEAM(PH_INPROJ);
    }

    if (IN(PH_ATTN)) {
        const float lam = __hip_atomic_load((const float*)(ws + WS_SCAL), __ATOMIC_RELAXED, __HIP_MEMORY_SCOPE_AGENT);
        for (int rep = 0; rep < REPS(16); ++rep)
        if (c.G == 256) { const int bh = c.vcu >> 3, s = c.vcu & 7;
            for (int i = 0; i < 4; ++i) { const int qb = (i == 0) ? s : (i == 1) ? 15 - s : (i == 2) ? 16 + s : 31 - s; diff_unit(p, bh >> 2, bh & 3, qb, lds, lam); } }
        else { for (int u = blockIdx.x; u < 1024; u += c.G) diff_unit(p, u >> 7, (u >> 5) & 3, u & 31, lds, lam); }
        for (int rep = 0; rep < REPS(17); ++rep)
        for (int u = c.vcu; u < 3072; u += c.G) { const int grp = u & 15, t3 = u >> 4, br = t3 % 3, bh = t3 / 3; dil_unit(p, bh >> 3, bh & 7, br, grp, lds); }
        SEAM(PH_ATTN);
    }

    if (IN(PH_MERGE)) { for (int rep = 0; rep < REPS(PH_MERGE); ++rep) phase_merge(p, c); SEAM(PH_MERGE); }

    if (IN(PH_OUTPROJ)) {
        for (int rep = 0; rep < REPS(PH_OUTPROJ); ++rep) {
        gm::DenseSched S; S.init(T, DM, DM, ws + WS_WOUTT, c.G, (int)blockIdx.x);
        gm::EpiOutProj E{(bf16*)(ws + WS_Y1), p.x};
        gm::gemm_phase(lds, (const char*)(ws + WS_MIXIN), DM, S, E);
        }
        SEAM(PH_OUTPROJ);
    }
    if (IN(PH_LN1)) { for (int rep = 0; rep < REPS(PH_LN1); ++rep) phase_ln((const bf16*)(ws + WS_Y1), (bf16*)(ws + WS_H1), p.ln1_g, p.ln1_b, c); SEAM(PH_LN1); }

    if (IN(PH_QMEM)) {
        for (int rep = 0; rep < REPS(PH_QMEM); ++rep) {
        gm::DenseSched S; S.init(T, DM, DM, ws + WS_WQT, c.G, (int)blockIdx.x);
        gm::EpiScale E{(bf16*)(ws + WS_QM), DM, QSCALE256};
        gm::gemm_phase(lds, (const char*)(ws + WS_H1), DM, S, E);
        }
        SEAM(PH_QMEM);
    }
    if (IN(PH_MEMATTN)) {
        for (int rep = 0; rep < REPS(PH_MEMATTN); ++rep)
        for (int u = c.vcu; u < 512; u += c.G) { const int qblk = u & 15, bh = u >> 4; mem_unit(p, bh >> 2, bh & 3, qblk, lds); }
        SEAM(PH_MEMATTN);
    }
    if (IN(PH_WO)) {
        for (int rep = 0; rep < REPS(PH_WO); ++rep) {
        gm::DenseSched S; S.init(T, DM, DM, ws + WS_WOT, c.G, (int)blockIdx.x);
        gm::EpiWo E{(bf16*)(ws + WS_Y2), (const bf16*)(ws + WS_H1)};
        gm::gemm_phase(lds, (const char*)(ws + WS_MO), DM, S, E);
        }
        SEAM(PH_WO);
    }
    if (IN(PH_LN2)) { for (int rep = 0; rep < REPS(PH_LN2); ++rep) phase_ln((const bf16*)(ws + WS_Y2), (bf16*)(ws + WS_H2), p.ln2_g, p.ln2_b, c); SEAM(PH_LN2); }

    if (IN(PH_ROUTER)) {
        for (int rep = 0; rep < REPS(PH_ROUTER); ++rep) {
        gm::DenseSched S; S.init(T, NEXP, DM, ws + WS_WRT, c.G, (int)blockIdx.x);
        gm::EpiF32 E{(float*)(ws + WS_LOGITS), NEXP};
        gm::gemm_phase(lds, (const char*)(ws + WS_H2), DM, S, E);
        }
        SEAM(PH_ROUTER);
    }
    if (IN(PH_ROUTE)) { phase_route(p, c); SEAM(PH_ROUTE); }
    if (IN(PH_SCATTER)) { phase_scatter(p, c); SEAM(PH_SCATTER); }

    if (IN(PH_MOE1)) {
        for (int rep = 0; rep < REPS(PH_MOE1); ++rep) {
        const int nrt = __builtin_amdgcn_readfirstlane(ld_i32_agent((const int*)(ws + WS_NRT)));
        const int n_my = gm::moe_preload<1, true>(lds, (const int*)(ws + WS_TILETAB), nrt * 2, c.G, (int)blockIdx.x, (const int*)(ws + WS_ROWTOK), (const float*)(ws + WS_ROWW));
        const LAS int* xd = (const LAS int*)(lds + LDS_XTRA);
        gm::MoeSched<1, DM, true> S{xd, xd + 128, n_my, c.G, (int)blockIdx.x, (const char*)(ws + WS_WTGU), (size_t)512 * DM * 2};
        gm::EpiMoe1 E{(bf16*)(ws + WS_HB), (const LAS float*)(xd + 128 + 11 * 256)};
        gm::gemm_phase(lds, (const char*)(ws + WS_H2), DM, S, E);
        }
        SEAM(PH_MOE1);
    }
    if (IN(PH_MOE2)) {
        for (int rep = 0; rep < REPS(PH_MOE2); ++rep) {
        const int nrt = __builtin_amdgcn_readfirstlane(ld_i32_agent((const int*)(ws + WS_NRT)));
        const int n_my = gm::moe_preload<2, false>(lds, (const int*)(ws + WS_TILETAB), nrt * 4, c.G, (int)blockIdx.x, nullptr, nullptr);
        const LAS int* xd = (const LAS int*)(lds + LDS_XTRA);
        gm::MoeSched<2, EDIM, false> S{xd, xd + 128, n_my, c.G, (int)blockIdx.x, (const char*)(ws + WS_WTD), (size_t)DM * EDIM * 2};
        gm::EpiMoe2 E{(bf16*)(ws + WS_Y)};
        gm::gemm_phase(lds, (const char*)(ws + WS_HB), EDIM, S, E);
        }
        SEAM(PH_MOE2);
    }
    if (IN(PH_COMBINE)) { for (int rep = 0; rep < REPS(PH_COMBINE); ++rep) phase_combine(p, c); }
#undef IN
#undef SEAM
}

#ifndef MK_MODE
#define MK_MODE 1
#endif
#ifndef NAIVE_MASK
#define NAIVE_MASK 0
#endif

static void fill_params(P& p, void* const* d_in, void* d_out, void* d_ws) {
    p.x = (const float*)d_in[0]; p.mem = (const float*)d_in[1]; p.pos = (const int*)d_in[2];
    p.w_in = (const float*)d_in[3]; p.w_out = (const float*)d_in[4]; p.lq1 = (const float*)d_in[5]; p.lk1 = (const float*)d_in[6]; p.lq2 = (const float*)d_in[7]; p.lk2 = (const float*)d_in[8];
    p.subln_g = (const float*)d_in[9]; p.ln1_g = (const float*)d_in[10]; p.ln1_b = (const float*)d_in[11];
    p.wq = (const float*)d_in[12]; p.wkv = (const float*)d_in[13]; p.wo = (const float*)d_in[14]; p.ln2_g = (const float*)d_in[15]; p.ln2_b = (const float*)d_in[16];
    p.w_router = (const float*)d_in[17]; p.e_bias = (const float*)d_in[18]; p.w_gate = (const float*)d_in[19]; p.w_up = (const float*)d_in[20]; p.w_down = (const float*)d_in[21];
    p.ws_gate = (const float*)d_in[22]; p.ws_up = (const float*)d_in[23]; p.ws_down = (const float*)d_in[24]; p.ln3_g = (const float*)d_in[25]; p.ln3_b = (const float*)d_in[26];
    p.out = (float*)d_out; p.ws = (unsigned char*)d_ws;
}

extern "C" void kernel_launch(void* const* d_in, const int* in_sizes, int n_in, void* d_out, int out_size, void* d_ws, size_t ws_size, hipStream_t stream) {
    static int grid = 0;
    if (grid == 0) {
        if (n_in != 27 || out_size != T * DM || ws_size < WS_END) { fprintf(stderr, "kernel_launch: unexpected shapes: n_in %d out %d ws %zu (need %zu)\n", n_in, out_size, ws_size, (size_t)WS_END); grid = -1; return; }
        int dev = 0, cus = 0, per_cu = 0;
        (void)hipGetDevice(&dev); (void)hipDeviceGetAttribute(&cus, hipDeviceAttributeMultiprocessorCount, dev);
        if (hipFuncSetAttribute((const void*)mk_fwd, hipFuncAttributeMaxDynamicSharedMemorySize, LDS_BYTES) != hipSuccess) { fprintf(stderr, "kernel_launch: hipFuncSetAttribute failed\n"); grid = -1; return; }
        if (hipOccupancyMaxActiveBlocksPerMultiprocessor(&per_cu, (const void*)mk_fwd, NTHR, LDS_BYTES) != hipSuccess || per_cu < 1) { fprintf(stderr, "kernel_launch: occupancy query says %d blocks/CU\n", per_cu); per_cu = 1; }
        (void)hipGetLastError();
        grid = cus;
        fprintf(stderr, "kernel_launch: cus %d per_cu %d grid %d\n", cus, per_cu, grid);
    }
    if (grid < 0) return;
    MKArgs a{};
    fill_params(a.p, d_in, d_out, d_ws);
    P p = a.p; unsigned char* ws = p.ws;
#if MK_MODE == 1
    a.ph_lo = 0; a.ph_hi = PH_COUNT;
    if (hipMemsetAsync(ws + WS_BAR, 0, 16384, stream) != hipSuccess) { fprintf(stderr, "kernel_launch: memset failed\n"); return; }
    void* args[] = {&a};
    hipError_t e = hipLaunchCooperativeKernel((const void*)mk_fwd, dim3(grid), dim3(NTHR), args, LDS_BYTES, stream);
    if (e != hipSuccess) fprintf(stderr, "cooperative launch failed: %s (grid %d)\n", hipGetErrorString(e), grid);
#elif MK_MODE == 2
    auto run = [&](int lo, int hi) { a.ph_lo = lo; a.ph_hi = hi; hipLaunchKernelGGL(mk_fwd, dim3(grid), dim3(NTHR), LDS_BYTES, stream, a); };
    auto nv = [&](int k) { return ((NAIVE_MASK >> k) & 1) != 0; };
    run(PH_PROLOGUE, PH_PROLOGUE + 1);
    if (nv(PH_INPROJ)) { ngemm<FInProj><<<dim3(T / 64, INW / 64, 1), 256, 0, stream>>>(FInProj{p}); ngemm<FKV><<<dim3(BATCH * MEML / 64, 2048 / 64, 1), 256, 0, stream>>>(FKV{p}); } else run(PH_INPROJ, PH_INPROJ + 1);
    if (nv(PH_ATTN)) { nattnA<<<3 * 8 * T / 256, 256, 0, stream>>>(p); nattnB<<<16 * T / 256, 256, 0, stream>>>(p); sublnB<<<T * 4 / 4, 256, 0, stream>>>(p); } else run(PH_ATTN, PH_ATTN + 1);
    if (nv(PH_MERGE)) mergeA<<<T * 512 / 256, 256, 0, stream>>>(p); else run(PH_MERGE, PH_MERGE + 1);
    if (nv(PH_OUTPROJ)) ngemm<FOutProj><<<dim3(T / 64, DM / 64, 1), 256, 0, stream>>>(FOutProj{p}); else run(PH_OUTPROJ, PH_OUTPROJ + 1);
    if (nv(PH_LN1)) ln_pass<<<T / 4, 256, 0, stream>>>((const bf16*)(ws + WS_Y1), (bf16*)(ws + WS_H1), p.ln1_g, p.ln1_b); else run(PH_LN1, PH_LN1 + 1);
    if (nv(PH_QMEM)) ngemm<FQMem><<<dim3(T / 64, DM / 64, 1), 256, 0, stream>>>(FQMem{p}); else run(PH_QMEM, PH_QMEM + 1);
    if (nv(PH_MEMATTN)) { ngemm<FMemS><<<dim3(T / 64, 256 / 64, 4), 256, 0, stream>>>(FMemS{p}); softmaxM<<<T * 4 / 4, 256, 0, stream>>>(p); ngemm<FMemO><<<dim3(T / 64, 256 / 64, 4), 256, 0, stream>>>(FMemO{p}); } else run(PH_MEMATTN, PH_MEMATTN + 1);
    if (nv(PH_WO)) ngemm<FWo><<<dim3(T / 64, DM / 64, 1), 256, 0, stream>>>(FWo{p}); else run(PH_WO, PH_WO + 1);
    if (nv(PH_LN2)) ln_pass<<<T / 4, 256, 0, stream>>>((const bf16*)(ws + WS_Y2), (bf16*)(ws + WS_H2), p.ln2_g, p.ln2_b); else run(PH_LN2, PH_LN2 + 1);
    if (nv(PH_ROUTER)) ngemm<FRouter><<<dim3(T / 64, NEXP / 64, 1), 256, 0, stream>>>(FRouter{p}); else run(PH_ROUTER, PH_ROUTER + 1);
    if (nv(PH_ROUTE)) route_pass<<<T / 4, 256, 0, stream>>>(p); else run(PH_ROUTE, PH_ROUTE + 1);
    run(PH_SCATTER, PH_SCATTER + 1);
    if (nv(PH_MOE1)) ngemm<FMoe1><<<dim3(T / 64, 512 / 64, NEXP + 1), 256, 0, stream>>>(FMoe1{p}); else run(PH_MOE1, PH_MOE1 + 1);
    if (nv(PH_MOE2)) ngemm<FMoe2><<<dim3(T / 64, DM / 64, NEXP + 1), 256, 0, stream>>>(FMoe2{p}); else run(PH_MOE2, PH_MOE2 + 1);
    if (nv(PH_COMBINE)) combine_pass<<<T / 4, 256, 0, stream>>>(p); else run(PH_COMBINE, PH_COMBINE + 1);
#else
    prep_kernel<<<T * 8 / 256, 256, 0, stream>>>(p);
    ngemm<FInProj><<<dim3(T / 64, INW / 64, 1), 256, 0, stream>>>(FInProj{p});
    nattnA<<<3 * 8 * T / 256, 256, 0, stream>>>(p);
    mergeA<<<T * 512 / 256, 256, 0, stream>>>(p);
    nattnB<<<16 * T / 256, 256, 0, stream>>>(p);
    sublnB<<<T * 4 / 4, 256, 0, stream>>>(p);
    ngemm<FOutProj><<<dim3(T / 64, DM / 64, 1), 256, 0, stream>>>(FOutProj{p});
    ln_pass<<<T / 4, 256, 0, stream>>>((const bf16*)(ws + WS_Y1), (bf16*)(ws + WS_H1), p.ln1_g, p.ln1_b);
    ngemm<FQMem><<<dim3(T / 64, DM / 64, 1), 256, 0, stream>>>(FQMem{p});
    ngemm<FKV><<<dim3(BATCH * MEML / 64, 2048 / 64, 1), 256, 0, stream>>>(FKV{p});
    ngemm<FMemS><<<dim3(T / 64, 256 / 64, 4), 256, 0, stream>>>(FMemS{p});
    softmaxM<<<T * 4 / 4, 256, 0, stream>>>(p);
    ngemm<FMemO><<<dim3(T / 64, 256 / 64, 4), 256, 0, stream>>>(FMemO{p});
    ngemm<FWo><<<dim3(T / 64, DM / 64, 1), 256, 0, stream>>>(FWo{p});
    ln_pass<<<T / 4, 256, 0, stream>>>((const bf16*)(ws + WS_Y2), (bf16*)(ws + WS_H2), p.ln2_g, p.ln2_b);
    ngemm<FRouter><<<dim3(T / 64, NEXP / 64, 1), 256, 0, stream>>>(FRouter{p});
    route_pass<<<T / 4, 256, 0, stream>>>(p);
    scan_pass<<<1, 256, 0, stream>>>(p);
    scatter_pass<<<T * 8 / 256, 256, 0, stream>>>(p);
    ngemm<FMoe1><<<dim3(T / 64, 512 / 64, NEXP + 1), 256, 0, stream>>>(FMoe1{p});
    ngemm<FMoe2><<<dim3(T / 64, DM / 64, NEXP + 1), 256, 0, stream>>>(FMoe2{p});
    combine_pass<<<T / 4, 256, 0, stream>>>(p);
#endif
}
```

```cpp
#define MK_MODE 1
#define NAIVE_MASK 0
#define REP_MASK 0
#include <hip/hip_runtime.h>
#include <hip/hip_cooperative_groups.h>
#include <cstdio>
#include <cstdint>
#include <cmath>
namespace cg = cooperative_groups;

constexpr int BATCH = 8, SEQ = 4096, DM = 1024, T = BATCH * SEQ;
constexpr int MEML = 256;
constexpr int INW = 3072;
constexpr int NEXP = 256, TOPK = 8, EDIM = 256;
constexpr int AROWS = T * TOPK;
constexpr float LN_EPS = 1e-5f, SUBLN_EPS = 1e-5f;
constexpr float DN_ALPHA = 1.189207115002721f;
constexpr float LOG2E = 1.4426950408889634f;
constexpr float QSCALE64 = 0.125f * LOG2E;
constexpr float QSCALE256 = 0.0625f * LOG2E;
constexpr float LAMBDA_INIT = 0.2f;
constexpr float ROUTED_SCALE = 2.5f;

constexpr size_t MiB = 1u << 20;
constexpr size_t WS_CNT = 0;
constexpr size_t WS_START = 4096;
constexpr size_t WS_SCAL = 8192;
constexpr size_t WS_NRT = 12288;
constexpr size_t WS_TILETAB = 16384;
constexpr size_t WS_BAR = 65536;
constexpr size_t WS_SN = 81920;
constexpr size_t WS_CN = 86016;
constexpr size_t WS_ECTR = 90112;
constexpr size_t WS_LCTR = 90240;
constexpr size_t WS_SN2 = 94208;
constexpr size_t WS_CN2 = 95232;
constexpr size_t WS_STATS1 = 131072;
constexpr size_t WS_STATS2 = 131072 + 262144;
constexpr size_t WS_ZERO_END = 131072 + 2 * 262144;
constexpr size_t WS_CS = 1 * MiB;
constexpr size_t WS_RIDX = 4 * MiB, WS_RW = 5 * MiB, WS_RRANK = 6 * MiB, WS_POS = 7 * MiB;
constexpr size_t WS_ROWTOK = 8 * MiB, WS_ROWW = 10 * MiB;
constexpr size_t WS_LSEA = 12 * MiB;
constexpr size_t WS_KVM = 16 * MiB;
constexpr size_t WS_MEMB = 24 * MiB;
constexpr size_t WS_WINT = 32 * MiB;
constexpr size_t WS_WOUTT = 38 * MiB;
constexpr size_t WS_WQT = 40 * MiB;
constexpr size_t WS_WKVT = 42 * MiB;
constexpr size_t WS_WOT = 46 * MiB;
constexpr size_t WS_WRT = 48 * MiB;
constexpr size_t WS_WTD = 64 * MiB;
constexpr size_t WS_H2Q = 129 * MiB;
constexpr size_t WS_H2 = 193 * MiB;
constexpr size_t WS_MIXIN = 193 * MiB;
constexpr size_t WS_Y1 = 257 * MiB;
constexpr size_t WS_DD = 257 * MiB;
constexpr size_t WS_H1 = 321 * MiB;
constexpr size_t WS_SLOTTOK = 321 * MiB;
constexpr size_t WS_SLOTW = 353 * MiB;
constexpr size_t WS_HB = 257 * MiB;
constexpr size_t WS_WTGU = 401 * MiB;
constexpr size_t WS_Y = 448 * MiB;
constexpr size_t WS_PROJ = 658 * MiB;
constexpr size_t WS_QM = 658 * MiB;
constexpr size_t WS_MO = 722 * MiB;
constexpr size_t WS_Y2 = 786 * MiB;
constexpr size_t WS_PARTA = 850 * MiB;
constexpr size_t WS_LOGITS = 850 * MiB;
constexpr size_t WS_SS = 850 * MiB;
constexpr size_t WS_XB = 946 * MiB;
constexpr size_t WS_END = 1024 * MiB;

typedef unsigned short bf16;
__device__ __forceinline__ float bf2f(bf16 v) { return __uint_as_float(((unsigned)v) << 16); }
__device__ __forceinline__ bf16 f2bf(float f) { unsigned u = __float_as_uint(f); return (bf16)((u + 0x7fffu + ((u >> 16) & 1u)) >> 16); }

struct P {
    const float *x, *mem; const int* pos;
    const float *w_in, *w_out, *lq1, *lk1, *lq2, *lk2, *subln_g, *ln1_g, *ln1_b;
    const float *wq, *wkv, *wo, *ln2_g, *ln2_b, *w_router, *e_bias, *w_gate, *w_up, *w_down;
    const float *ws_gate, *ws_up, *ws_down, *ln3_g, *ln3_b;
    float* out; unsigned char* ws;
};

__host__ __device__ __forceinline__ int sigma_dim(int p) { return p < 16 ? (p >> 1) + 8 * (p & 1) : p; }
__device__ __forceinline__ int proj_src_col(int c) {
    const int seg = c >> 9;
    if (seg == 2 || seg == 5) return c;
    return (c & ~63) | sigma_dim(c & 63);
}

__global__ void prep_kernel(P p) {
    const int i = blockIdx.x * blockDim.x + threadIdx.x;
    if (i < T * 8) {
        const int t = i >> 3, j = i & 7;
        const float inv = powf(500000.0f, -(float)(2 * j) / 16.0f);
        const float ang = (float)p.pos[t] * inv;
        float2* cs = (float2*)(p.ws + WS_CS);
        cs[i] = make_float2(cosf(ang), sinf(ang));
    }
    if (i < 256) ((int*)(p.ws + WS_CNT))[i] = 0;
    if (i == 0) {
        float a = 0.f, b = 0.f;
        for (int k = 0; k < 64; ++k) { a += p.lq1[k] * p.lk1[k]; b += p.lq2[k] * p.lk2[k]; }
        ((float*)(p.ws + WS_SCAL))[0] = expf(a) - expf(b) + LAMBDA_INIT;
    }
}

template <class F> __global__ void __launch_bounds__(256) ngemm(F f) {
    __shared__ float As[16][65], Bs[16][65];
    const int g = blockIdx.z, M = f.rows(g);
    const int m0 = blockIdx.x * 64, n0 = blockIdx.y * 64;
    if (m0 >= M) return;
    const int K = f.kdim();
    const int tid = threadIdx.x, tx = tid & 15, ty = tid >> 4;
    float acc[4][4];
#pragma unroll
    for (int i = 0; i < 4; ++i)
#pragma unroll
        for (int j = 0; j < 4; ++j) acc[i][j] = 0.f;
    for (int k0 = 0; k0 < K; k0 += 16) {
#pragma unroll
        for (int i = 0; i < 4; ++i) {
            const int idx = tid + i * 256;
            { const int k = idx & 15, r = idx >> 4; As[k][r] = (m0 + r < M) ? f.a(g, m0 + r, k0 + k) : 0.f; }
            { const int c = idx & 63, k = idx >> 6; Bs[k][c] = f.b(g, k0 + k, n0 + c); }
        }
        __syncthreads();
#pragma unroll
        for (int k = 0; k < 16; ++k) {
            float av[4], bv[4];
#pragma unroll
            for (int i = 0; i < 4; ++i) { av[i] = As[k][ty * 4 + i]; bv[i] = Bs[k][tx * 4 + i]; }
#pragma unroll
            for (int i = 0; i < 4; ++i)
#pragma unroll
                for (int j = 0; j < 4; ++j) acc[i][j] += av[i] * bv[j];
        }
        __syncthreads();
    }
#pragma unroll
    for (int i = 0; i < 4; ++i) { const int r = m0 + ty * 4 + i; if (r < M) f.epi(g, r, n0 + tx * 4, acc[i]); }
}

struct FInProj {
    P p;
    __device__ int rows(int) const { return T; }
    __device__ int kdim() const { return DM; }
    __device__ float a(int, int r, int k) const { return bf2f(f2bf(p.x[(size_t)r * DM + k])); }
    __device__ float b(int, int k, int c) const { return bf2f(f2bf(p.w_in[(size_t)k * INW + proj_src_col(c)])); }
    __device__ void epi(int, int r, int c0, const float (&v)[4]) const {
        bf16* proj = (bf16*)(p.ws + WS_PROJ);
        const int seg = c0 >> 9; float o[4] = {v[0], v[1], v[2], v[3]};
        if (seg != 2 && seg != 5) {
            const int pp = c0 & 63;
            if (pp < 16) {
                const float2* cs = (const float2*)(p.ws + WS_CS) + (size_t)r * 8;
#pragma unroll
                for (int q = 0; q < 2; ++q) { const float2 c = cs[(pp >> 1) + q]; const float t1 = v[2 * q], t2 = v[2 * q + 1]; o[2 * q] = t1 * c.x - t2 * c.y; o[2 * q + 1] = t2 * c.x + t1 * c.y; }
            }
            if (seg == 0 || seg == 3) {
#pragma unroll
                for (int q = 0; q < 4; ++q) o[q] *= QSCALE64;
            }
        }
#pragma unroll
        for (int q = 0; q < 4; ++q) proj[(size_t)r * INW + c0 + q] = f2bf(o[q]);
    }
};
struct FOutProj {
    P p;
    __device__ int rows(int) const { return T; }
    __device__ int kdim() const { return DM; }
    __device__ float a(int, int r, int k) const { return bf2f(((const bf16*)(p.ws + WS_MIXIN))[(size_t)r * DM + k]); }
    __device__ float b(int, int k, int c) const { return bf2f(f2bf(p.w_out[(size_t)k * DM + c])); }
    __device__ void epi(int, int r, int c0, const float (&v)[4]) const {
        bf16* y = (bf16*)(p.ws + WS_Y1);
#pragma unroll
        for (int q = 0; q < 4; ++q) y[(size_t)r * DM + c0 + q] = f2bf(DN_ALPHA * p.x[(size_t)r * DM + c0 + q] + v[q]);
    }
};
struct FQMem {
    P p;
    __device__ int rows(int) const { return T; }
    __device__ int kdim() const { return DM; }
    __device__ float a(int, int r, int k) const { return bf2f(((const bf16*)(p.ws + WS_H1))[(size_t)r * DM + k]); }
    __device__ float b(int, int k, int c) const { return bf2f(f2bf(p.wq[(size_t)k * DM + c])); }
    __device__ void epi(int, int r, int c0, const float (&v)[4]) const {
        bf16* y = (bf16*)(p.ws + WS_QM);
#pragma unroll
        for (int q = 0; q < 4; ++q) y[(size_t)r * DM + c0 + q] = f2bf(v[q] * QSCALE256);
    }
};
struct FKV {
    P p;
    __device__ int rows(int) const { return BATCH * MEML; }
    __device__ int kdim() const { return DM; }
    __device__ float a(int, int r, int k) const { return bf2f(f2bf(p.mem[(size_t)r * DM + k])); }
    __device__ float b(int, int k, int c) const { return bf2f(f2bf(p.wkv[(size_t)k * 2048 + c])); }
    __device__ void epi(int, int r, int c0, const float (&v)[4]) const {
        bf16* y = (bf16*)(p.ws + WS_KVM);
#pragma unroll
        for (int q = 0; q < 4; ++q) y[(size_t)r * 2048 + c0 + q] = f2bf(v[q]);
    }
};
struct FMemS {
    P p;
    __device__ int rows(int) const { return T; }
    __device__ int kdim() const { return 256; }
    __device__ float a(int g, int r, int k) const { return bf2f(((const bf16*)(p.ws + WS_QM))[(size_t)r * DM + g * 256 + k]); }
    __device__ float b(int g, int k, int c) const { const int bb = (blockIdx.x * 64) / SEQ; return bf2f(((const bf16*)(p.ws + WS_KVM))[(size_t)(bb * MEML + c) * 2048 + g * 256 + k]); }
    __device__ void epi(int g, int r, int c0, const float (&v)[4]) const {
        float* s = (float*)(p.ws + WS_SS);
#pragma unroll
        for (int q = 0; q < 4; ++q) s[(size_t)r * DM + g * 256 + c0 + q] = v[q];
    }
};
struct FMemO {
    P p;
    __device__ int rows(int) const { return T; }
    __device__ int kdim() const { return 256; }
    __device__ float a(int g, int r, int k) const { return bf2f(f2bf(((const float*)(p.ws + WS_SS))[(size_t)r * DM + g * 256 + k])); }
    __device__ float b(int g, int k, int c) const { const int bb = (blockIdx.x * 64) / SEQ; return bf2f(((const bf16*)(p.ws + WS_KVM))[(size_t)(bb * MEML + k) * 2048 + 1024 + g * 256 + c]); }
    __device__ void epi(int g, int r, int c0, const float (&v)[4]) const {
        bf16* y = (bf16*)(p.ws + WS_MO);
#pragma unroll
        for (int q = 0; q < 4; ++q) y[(size_t)r * DM + g * 256 + c0 + q] = f2bf(v[q]);
    }
};
struct FWo {
    P p;
    __device__ int rows(int) const { return T; }
    __device__ int kdim() const { return DM; }
    __device__ float a(int, int r, int k) const { return bf2f(((const bf16*)(p.ws + WS_MO))[(size_t)r * DM + k]); }
    __device__ float b(int, int k, int c) const { return bf2f(f2bf(p.wo[(size_t)k * DM + c])); }
    __device__ void epi(int, int r, int c0, const float (&v)[4]) const {
        bf16* y = (bf16*)(p.ws + WS_Y2); const bf16* h1 = (const bf16*)(p.ws + WS_H1);
#pragma unroll
        for (int q = 0; q < 4; ++q) y[(size_t)r * DM + c0 + q] = f2bf(DN_ALPHA * bf2f(h1[(size_t)r * DM + c0 + q]) + v[q]);
    }
};
struct FRouter {
    P p;
    __device__ int rows(int) const { return T; }
    __device__ int kdim() const { return DM; }
    __device__ float a(int, int r, int k) const { return bf2f(((const bf16*)(p.ws + WS_H2))[(size_t)r * DM + k]); }
    __device__ float b(int, int k, int c) const { return bf2f(f2bf(p.w_router[(size_t)k * NEXP + c])); }
    __device__ void epi(int, int r, int c0, const float (&v)[4]) const {
        float* y = (float*)(p.ws + WS_LOGITS);
#pragma unroll
        for (int q = 0; q < 4; ++q) y[(size_t)r * NEXP + c0 + q] = v[q];
    }
};
struct FMoe1 {
    P p;
    __device__ int rows(int g) const { const int* st = (const int*)(p.ws + WS_START); return g < NEXP ? st[g + 1] - st[g] : T; }
    __device__ int kdim() const { return DM; }
    __device__ float a(int g, int r, int k) const {
        const int* st = (const int*)(p.ws + WS_START); const int* rt = (const int*)(p.ws + WS_ROWTOK);
        const int tok = g < NEXP ? rt[st[g] + r] : r;
        return bf2f(((const bf16*)(p.ws + WS_H2))[(size_t)tok * DM + k]);
    }
    __device__ float b(int g, int k, int c) const {
        const float* w = (c & 1) ? (g < NEXP ? p.w_up + (size_t)g * DM * EDIM : p.ws_up) : (g < NEXP ? p.w_gate + (size_t)g * DM * EDIM : p.ws_gate);
        return bf2f(f2bf(w[(size_t)k * EDIM + (c >> 1)]));
    }
    __device__ void epi(int g, int r, int c0, const float (&v)[4]) const {
        const int* st = (const int*)(p.ws + WS_START); bf16* H = (bf16*)(p.ws + WS_HB);
        const size_t row = g < NEXP ? (size_t)st[g] + r : (size_t)AROWS + r;
        const float w = g < NEXP ? ((const float*)(p.ws + WS_ROWW))[row] : 1.f;
#pragma unroll
        for (int q = 0; q < 2; ++q) { const float gg = v[2 * q], uu = v[2 * q + 1]; H[row * EDIM + (c0 >> 1) + q] = f2bf(gg / (1.f + expf(-gg)) * uu * w); }
    }
};
struct FMoe2 {
    P p;
    __device__ int rows(int g) const { const int* st = (const int*)(p.ws + WS_START); return g < NEXP ? st[g + 1] - st[g] : T; }
    __device__ int kdim() const { return EDIM; }
    __device__ float a(int g, int r, int k) const {
        const int* st = (const int*)(p.ws + WS_START); const bf16* H = (const bf16*)(p.ws + WS_HB);
        const size_t row = g < NEXP ? (size_t)st[g] + r : (size_t)AROWS + r;
        return bf2f(H[row * EDIM + k]);
    }
    __device__ float b(int g, int k, int c) const { const float* w = g < NEXP ? p.w_down + (size_t)g * EDIM * DM : p.ws_down; return bf2f(f2bf(w[(size_t)k * DM + c])); }
    __device__ void epi(int g, int r, int c0, const float (&v)[4]) const {
        const int* st = (const int*)(p.ws + WS_START); bf16* Y = (bf16*)(p.ws + WS_Y);
        const size_t row = g < NEXP ? (size_t)st[g] + r : (size_t)AROWS + r;
#pragma unroll
        for (int q = 0; q < 4; ++q) Y[row * DM + c0 + q] = f2bf(v[q]);
    }
};

__global__ void __launch_bounds__(256) nattnA(P p) {
    const int i = blockIdx.x * blockDim.x + threadIdx.x;
    if (i >= 3 * 8 * T) return;
    const int t = i % T, h = (i / T) & 7, br = i / (8 * T);
    const int dil = br == 0 ? 1 : (br == 1 ? 4 : 16);
    const int s = t % SEQ, b0 = t - s;
    const bf16* proj = (const bf16*)(p.ws + WS_PROJ);
    float q[64], o[64];
#pragma unroll
    for (int e = 0; e < 64; ++e) { q[e] = bf2f(proj[(size_t)t * INW + h * 64 + e]); o[e] = 0.f; }
    float m = -INFINITY, l = 0.f;
    for (int j = 0; j <= 128; ++j) {
        const int ks = s - j * dil; if (ks < 0) break;
        const bf16* kr = proj + (size_t)(b0 + ks) * INW + 512 + h * 64;
        const bf16* vr = proj + (size_t)(b0 + ks) * INW + 1024 + h * 64;
        float sc = 0.f;
#pragma unroll
        for (int e = 0; e < 64; ++e) sc += q[e] * bf2f(kr[e]);
        const float mn = fmaxf(m, sc), al = exp2f(m - mn), pe = exp2f(sc - mn);
        l = l * al + pe;
#pragma unroll
        for (int e = 0; e < 64; ++e) o[e] = o[e] * al + pe * bf2f(vr[e]);
        m = mn;
    }
    bf16* pa = (bf16*)(p.ws + WS_PARTA) + ((size_t)br * T + t) * 512 + h * 64;
    const float il = 1.f / l;
#pragma unroll
    for (int e = 0; e < 64; ++e) pa[e] = f2bf(o[e] * il);
    ((float*)(p.ws + WS_LSEA))[((size_t)br * T + t) * 8 + h] = m + log2f(l);
}
__global__ void mergeA(P p) {
    const int i = blockIdx.x * blockDim.x + threadIdx.x;
    if (i >= T * 512) return;
    const int t = i >> 9, c = i & 511, h = c >> 6;
    const float* lse = (const float*)(p.ws + WS_LSEA);
    const float l0 = lse[(size_t)t * 8 + h], l1 = lse[((size_t)T + t) * 8 + h], l2 = lse[((size_t)2 * T + t) * 8 + h];
    const float mx = fmaxf(l0, fmaxf(l1, l2));
    const float w0 = exp2f(l0 - mx), w1 = exp2f(l1 - mx), w2 = exp2f(l2 - mx), inv = 1.f / (w0 + w1 + w2);
    const bf16* pa = (const bf16*)(p.ws + WS_PARTA);
    const float v = (w0 * bf2f(pa[(size_t)t * 512 + c]) + w1 * bf2f(pa[((size_t)T + t) * 512 + c]) + w2 * bf2f(pa[((size_t)2 * T + t) * 512 + c])) * inv;
    ((bf16*)(p.ws + WS_MIXIN))[(size_t)t * DM + c] = f2bf(v);
}
__global__ void __launch_bounds__(256) nattnB(P p) {
    const int i = blockIdx.x * blockDim.x + threadIdx.x;
    if (i >= 16 * T) return;
    const int t = i % T, ch = (i / T) & 3, h = i / (4 * T);
    const int s = t % SEQ, b0 = t - s;
    const bf16* proj = (const bf16*)(p.ws + WS_PROJ);
    float q0[64], q1[64], o0[32], o1[32];
#pragma unroll
    for (int e = 0; e < 64; ++e) { q0[e] = bf2f(proj[(size_t)t * INW + 1536 + h * 128 + e]); q1[e] = bf2f(proj[(size_t)t * INW + 1536 + h * 128 + 64 + e]); }
#pragma unroll
    for (int e = 0; e < 32; ++e) { o0[e] = 0.f; o1[e] = 0.f; }
    float m0 = -INFINITY, l0 = 0.f, m1 = -INFINITY, l1 = 0.f;
    for (int ks = 0; ks <= s; ++ks) {
        const bf16* kr = proj + (size_t)(b0 + ks) * INW + 2048 + h * 128;
        const bf16* vr = proj + (size_t)(b0 + ks) * INW + 2560 + h * 128 + ch * 32;
        float s0 = 0.f, s1 = 0.f;
#pragma unroll
        for (int e = 0; e < 64; ++e) { s0 += q0[e] * bf2f(kr[e]); s1 += q1[e] * bf2f(kr[64 + e]); }
        const float mn0 = fmaxf(m0, s0), a0 = exp2f(m0 - mn0), p0 = exp2f(s0 - mn0);
        const float mn1 = fmaxf(m1, s1), a1 = exp2f(m1 - mn1), p1 = exp2f(s1 - mn1);
        l0 = l0 * a0 + p0; l1 = l1 * a1 + p1; m0 = mn0; m1 = mn1;
#pragma unroll
        for (int e = 0; e < 32; ++e) { const float v = bf2f(vr[e]); o0[e] = o0[e] * a0 + p0 * v; o1[e] = o1[e] * a1 + p1 * v; }
    }
    const float lam = ((const float*)(p.ws + WS_SCAL))[0];
    float* dd = (float*)(p.ws + WS_DD) + (size_t)t * 512 + h * 128 + ch * 32;
    const float i0 = 1.f / l0, i1 = 1.f / l1;
#pragma unroll
    for (int e = 0; e < 32; ++e) dd[e] = o0[e] * i0 - lam * o1[e] * i1;
}
__global__ void sublnB(P p) {
    const int w = (blockIdx.x * blockDim.x + threadIdx.x) >> 6, lane = threadIdx.x & 63;
    if (w >= T * 4) return;
    const int t = w >> 2, h = w & 3;
    const float* dd = (const float*)(p.ws + WS_DD) + (size_t)t * 512 + h * 128;
    const float a = dd[lane], b = dd[lane + 64];
    float ss = a * a + b * b;
    for (int o = 1; o < 64; o <<= 1) ss += __shfl_xor(ss, o);
    const float r = rsqrtf(ss * (1.f / 128.f) + SUBLN_EPS) * (1.f - LAMBDA_INIT);
    bf16* mx = (bf16*)(p.ws + WS_MIXIN) + (size_t)t * DM + 512 + h * 128;
    mx[lane] = f2bf(a * r * p.subln_g[lane]); mx[lane + 64] = f2bf(b * r * p.subln_g[lane + 64]);
}
__global__ void softmaxM(P p) {
    const int w = (blockIdx.x * blockDim.x + threadIdx.x) >> 6, lane = threadIdx.x & 63;
    if (w >= T * 4) return;
    float* s = (float*)(p.ws + WS_SS) + (size_t)w * 256;
    float v[4]; float mx = -INFINITY;
#pragma unroll
    for (int j = 0; j < 4; ++j) { v[j] = s[lane + 64 * j]; mx = fmaxf(mx, v[j]); }
    for (int o = 1; o < 64; o <<= 1) mx = fmaxf(mx, __shfl_xor(mx, o));
    float sum = 0.f;
#pragma unroll
    for (int j = 0; j < 4; ++j) { v[j] = exp2f(v[j] - mx); sum += v[j]; }
    for (int o = 1; o < 64; o <<= 1) sum += __shfl_xor(sum, o);
    const float inv = 1.f / sum;
#pragma unroll
    for (int j = 0; j < 4; ++j) s[lane + 64 * j] = v[j] * inv;
}

__global__ void __launch_bounds__(256) ln_pass(const bf16* __restrict__ in, bf16* __restrict__ outp, const float* __restrict__ g, const float* __restrict__ b) {
    const int w = (blockIdx.x * blockDim.x + threadIdx.x) >> 6, lane = threadIdx.x & 63;
    if (w >= T) return;
    const bf16* r = in + (size_t)w * DM;
    float v[16]; float s = 0.f;
#pragma unroll
    for (int j = 0; j < 4; ++j) { const uint2 u = *(const uint2*)(r + j * 256 + lane * 4);
        v[4 * j] = __uint_as_float(u.x << 16); v[4 * j + 1] = __uint_as_float(u.x & 0xffff0000u); v[4 * j + 2] = __uint_as_float(u.y << 16); v[4 * j + 3] = __uint_as_float(u.y & 0xffff0000u); }
#pragma unroll
    for (int j = 0; j < 16; ++j) s += v[j];
    for (int o = 1; o < 64; o <<= 1) s += __shfl_xor(s, o);
    const float mu = s * (1.f / DM); float q = 0.f;
#pragma unroll
    for (int j = 0; j < 16; ++j) { v[j] -= mu; q += v[j] * v[j]; }
    for (int o = 1; o < 64; o <<= 1) q += __shfl_xor(q, o);
    const float rs = rsqrtf(q * (1.f / DM) + LN_EPS);
#pragma unroll
    for (int j = 0; j < 4; ++j) { const int c = j * 256 + lane * 4; const float4 gg = *(const float4*)(g + c), bb = *(const float4*)(b + c);
        uint2 u; u.x = (unsigned)f2bf(v[4 * j] * rs * gg.x + bb.x) | ((unsigned)f2bf(v[4 * j + 1] * rs * gg.y + bb.y) << 16);
        u.y = (unsigned)f2bf(v[4 * j + 2] * rs * gg.z + bb.z) | ((unsigned)f2bf(v[4 * j + 3] * rs * gg.w + bb.w) << 16);
        *(uint2*)(outp + (size_t)w * DM + c) = u; }
}

__global__ void __launch_bounds__(256) route_pass(P p) {
    const int w = (blockIdx.x * blockDim.x + threadIdx.x) >> 6, lane = threadIdx.x & 63;
    if (w >= T) return;
    const float4 lg = *(const float4*)((const float*)(p.ws + WS_LOGITS) + (size_t)w * NEXP + lane * 4);
    const float4 eb = *(const float4*)(p.e_bias + lane * 4);
    float sc[4] = {1.f / (1.f + expf(-lg.x)), 1.f / (1.f + expf(-lg.y)), 1.f / (1.f + expf(-lg.z)), 1.f / (1.f + expf(-lg.w))};
    float bs[4] = {sc[0] + eb.x, sc[1] + eb.y, sc[2] + eb.z, sc[3] + eb.w};
    float m1 = fmaxf(bs[0], bs[1]), m2 = fminf(bs[0], bs[1]);
    { const float c = bs[2]; const float n1 = fmaxf(m1, c); m2 = fmaxf(m2, fminf(m1, c)); m1 = n1; }
    { const float c = bs[3]; const float n1 = fmaxf(m1, c); m2 = fmaxf(m2, fminf(m1, c)); m1 = n1; }
#pragma unroll
    for (int o = 1; o < 8; o <<= 1) { const float b1 = __shfl_xor(m1, o), b2 = __shfl_xor(m2, o); const float n1 = fmaxf(m1, b1); m2 = fmaxf(fminf(m1, b1), fmaxf(m2, b2)); m1 = n1; }
    const float gs = m1 + m2; const int grp = lane >> 3;
    int rank = 0;
#pragma unroll
    for (int g2 = 0; g2 < 8; ++g2) { const float o = __shfl(gs, g2 * 8); rank += (o > gs || (o == gs && g2 < grp)) ? 1 : 0; }
    const bool sel = rank < 4;
    float cand[4];
#pragma unroll
    for (int j = 0; j < 4; ++j) cand[j] = sel ? bs[j] : -INFINITY;
    int myidx = 0; float myw = 0.f; float wsum = 0.f;
    for (int k = 0; k < TOPK; ++k) {
        float bv = cand[0]; int bi = lane * 4;
#pragma unroll
        for (int j = 1; j < 4; ++j) if (cand[j] > bv) { bv = cand[j]; bi = lane * 4 + j; }
#pragma unroll
        for (int o = 1; o < 64; o <<= 1) { const float ov = __shfl_xor(bv, o); const int oi = __shfl_xor(bi, o); if (ov > bv || (ov == bv && oi < bi)) { bv = ov; bi = oi; } }
        const int own = bi >> 2, el = bi & 3;
        const float sv = el == 0 ? sc[0] : (el == 1 ? sc[1] : (el == 2 ? sc[2] : sc[3]));
        const float wv = __shfl(sv, own);
        if (lane == own) { if (el == 0) cand[0] = -INFINITY; else if (el == 1) cand[1] = -INFINITY; else if (el == 2) cand[2] = -INFINITY; else cand[3] = -INFINITY; }
        wsum += wv;
        if (lane == k) { myidx = bi; myw = wv; }
    }
    if (lane < TOPK) {
        const float wn = myw / wsum * ROUTED_SCALE;
        const int rk = atomicAdd((int*)(p.ws + WS_CNT) + myidx, 1);
        ((int*)(p.ws + WS_RIDX))[(size_t)w * 8 + lane] = myidx;
        ((float*)(p.ws + WS_RW))[(size_t)w * 8 + lane] = wn;
        ((int*)(p.ws + WS_RRANK))[(size_t)w * 8 + lane] = rk;
    }
}
__global__ void scan_pass(P p) {
    __shared__ int sh[256];
    const int i = threadIdx.x; const int c = ((const int*)(p.ws + WS_CNT))[i];
    sh[i] = c; __syncthreads();
    for (int o = 1; o < 256; o <<= 1) { const int v = i >= o ? sh[i - o] : 0; __syncthreads(); sh[i] += v; __syncthreads(); }
    int* st = (int*)(p.ws + WS_START);
    st[i + 1] = sh[i]; if (i == 0) st[0] = 0;
}
__global__ void scatter_pass(P p) {
    const int i = blockIdx.x * blockDim.x + threadIdx.x;
    if (i >= T * 8) return;
    const int e = ((const int*)(p.ws + WS_RIDX))[i], rk = ((const int*)(p.ws + WS_RRANK))[i];
    const int pos = ((const int*)(p.ws + WS_START))[e] + rk;
    ((int*)(p.ws + WS_ROWTOK))[pos] = i >> 3;
    ((float*)(p.ws + WS_ROWW))[pos] = ((const float*)(p.ws + WS_RW))[i];
    ((int*)(p.ws + WS_POS))[i] = pos;
}
__global__ void __launch_bounds__(256) combine_pass(P p) {
    const int w = (blockIdx.x * blockDim.x + threadIdx.x) >> 6, lane = threadIdx.x & 63;
    if (w >= T) return;
    const bf16* h2 = (const bf16*)(p.ws + WS_H2) + (size_t)w * DM;
    const bf16* Y = (const bf16*)(p.ws + WS_Y);
    const int* pos = (const int*)(p.ws + WS_POS) + (size_t)w * 8;
    float v[16];
#pragma unroll
    for (int j = 0; j < 4; ++j) { const uint2 u = *(const uint2*)(h2 + j * 256 + lane * 4);
        v[4 * j] = DN_ALPHA * __uint_as_float(u.x << 16); v[4 * j + 1] = DN_ALPHA * __uint_as_float(u.x & 0xffff0000u); v[4 * j + 2] = DN_ALPHA * __uint_as_float(u.y << 16); v[4 * j + 3] = DN_ALPHA * __uint_as_float(u.y & 0xffff0000u); }
#pragma unroll
    for (int k = 0; k < 9; ++k) {
        const size_t row = k < 8 ? (size_t)pos[k < 8 ? k : 0] : (size_t)AROWS + w;
        const bf16* yr = Y + row * DM;
#pragma unroll
        for (int j = 0; j < 4; ++j) { const uint2 u = *(const uint2*)(yr + j * 256 + lane * 4);
            v[4 * j] += __uint_as_float(u.x << 16); v[4 * j + 1] += __uint_as_float(u.x & 0xffff0000u); v[4 * j + 2] += __uint_as_float(u.y << 16); v[4 * j + 3] += __uint_as_float(u.y & 0xffff0000u); }
    }
    float s = 0.f;
#pragma unroll
    for (int j = 0; j < 16; ++j) s += v[j];
    for (int o = 1; o < 64; o <<= 1) s += __shfl_xor(s, o);
    const float mu = s * (1.f / DM); float q = 0.f;
#pragma unroll
    for (int j = 0; j < 16; ++j) { v[j] -= mu; q += v[j] * v[j]; }
    for (int o = 1; o < 64; o <<= 1) q += __shfl_xor(q, o);
    const float rs = rsqrtf(q * (1.f / DM) + LN_EPS);
#pragma unroll
    for (int j = 0; j < 4; ++j) { const int c = j * 256 + lane * 4; const float4 gg = *(const float4*)(p.ln3_g + c), bb = *(const float4*)(p.ln3_b + c);
        float4 o; o.x = v[4 * j] * rs * gg.x + bb.x; o.y = v[4 * j + 1] * rs * gg.y + bb.y; o.z = v[4 * j + 2] * rs * gg.z + bb.z; o.w = v[4 * j + 3] * rs * gg.w + bb.w;
        *(float4*)(p.out + (size_t)w * DM + c) = o; }
}

#define LAS __attribute__((address_space(3)))
typedef short bf16x8 __attribute__((ext_vector_type(8)));
typedef short s16x4 __attribute__((ext_vector_type(4)));
typedef float f32x2 __attribute__((ext_vector_type(2)));
typedef float f32x4 __attribute__((ext_vector_type(4)));
typedef float f32x16 __attribute__((ext_vector_type(16)));
typedef unsigned u32x2 __attribute__((ext_vector_type(2)));
typedef unsigned u32x4 __attribute__((ext_vector_type(4)));
typedef __bf16 bf16x2_t __attribute__((ext_vector_type(2)));

constexpr int NWAVES = 8, NTHR = 512;
constexpr int LDS_BYTES = 163840;
constexpr int LDS_XTRA = 131072;
#ifndef MOE_ROWS_DEF
#define MOE_ROWS_DEF 256
#endif
#ifndef LN2_SPLIT
#define LN2_SPLIT 24576
#endif
#ifndef LN2_FOLD
#define LN2_FOLD 1
#endif
#ifndef WO_STATS
#define WO_STATS LN2_FOLD
#endif
#ifndef ECHUNK_CFG
#define ECHUNK_CFG 8
#endif
#ifndef NT_OUT
#define NT_OUT 0
#endif
#if NT_OUT
#define OUT_ST16(ptr, val) __builtin_nontemporal_store((val), (u32x4*)(ptr))
#define OUT_AUX 2
#else
#define OUT_ST16(ptr, val) (*(u32x4*)(ptr) = (val))
#define OUT_AUX 0
#endif
#ifndef ROUTER_FUSE
#define ROUTER_FUSE 0
#endif
#ifndef XB_FLAT_WAIT
#define XB_FLAT_WAIT 1
#endif
#ifndef NO_SCATTER
#define NO_SCATTER 0
#endif
#ifndef QMEM_FUSE
#define QMEM_FUSE 1
#endif
#ifndef MOE2_FLIP
#define MOE2_FLIP 1
#endif
#ifndef NDC_CFG
#define NDC_CFG 0
#endif
#ifndef CONV_SPLIT
#define CONV_SPLIT 3600
#endif
#ifndef INPROJ_NU
#define INPROJ_NU 0
#endif
#ifndef NCJ_CFG
#define NCJ_CFG 12
#endif
constexpr int MOE_ROWS = MOE_ROWS_DEF;
constexpr int MOE_RSH = MOE_ROWS == 256 ? 8 : 7; constexpr bool MOE_HALFM = MOE_ROWS == 128;

__device__ __forceinline__ unsigned cvtpk(float lo, float hi) { f32x2 v = {lo, hi}; bf16x2_t b = __builtin_convertvector(v, bf16x2_t); return __builtin_bit_cast(unsigned, b); }
__device__ __forceinline__ int ld_i32_agent(const int* p) { return __hip_atomic_load(p, __ATOMIC_RELAXED, __HIP_MEMORY_SCOPE_AGENT); }
__device__ __forceinline__ float fast_exp2(float x) { return __builtin_amdgcn_exp2f(x); }
__device__ __forceinline__ float fast_rcp(float x) { return __builtin_amdgcn_rcpf(x); }

namespace gm {
constexpr int BM = 256, BK = 64, HALF = 128, HTB = HALF * BK * 2, STAGE_BYTES = 8 * HTB, NXCD = 8, WGM = 8;
__device__ __forceinline__ int lds_byte(int r, int c) { const int st = (r >> 4) * 2 + (c >> 5), rr = r & 15, cc = c & 31, ob = rr * 64 + cc * 2; return st * 1024 + (ob ^ (((ob >> 9) & 1) << 5)); }
__device__ __forceinline__ void stage_rc(int b, int& R, int& C) { const int st = b / 1024, sb = b % 1024, swz = sb ^ (((sb >> 9) & 1) << 5); R = (st >> 1) * 16 + swz / 64; C = (st & 1) * 32 + (swz % 64) / 2; }
__device__ __forceinline__ int perm32(int rho) { const int n = rho >> 4, i = rho & 15; return 8 * (i >> 2) + 4 * n + (i & 3); }

struct Unit { int pm, pn, e, nvalid, rowbase, slot; unsigned boff; };

struct DenseSched {
    static constexpr bool GATHER_A = false;
    int nM, nN, nwg, G, c, K; const char* Bt; int i_lo = 0, i_cnt = 1 << 30;
    __device__ __forceinline__ void init(int M, int N, int K_, const void* Bt_, int G_, int c_) { nM = M / BM; nN = N / BM; nwg = nM * nN; G = G_; c = c_; K = K_; Bt = (const char*)Bt_; }
    __device__ __forceinline__ bool next(int i, Unit& u) const {
        if (i >= i_cnt) return false;
        const long L = (long)(i + i_lo) * G + c; if (L >= nwg) return false;
        int wgid = (int)L; { const int q = nwg / NXCD, r = nwg % NXCD, xcd = wgid % NXCD, off = wgid / NXCD; wgid = (xcd < r ? xcd * (q + 1) : r * (q + 1) + (xcd - r) * q) + off; }
        const int nig = WGM * nN, gid = wgid / nig, fm = gid * WGM, gsz = (nM - fm) < WGM ? (nM - fm) : WGM;
        u.pm = fm + ((wgid % nig) % gsz); u.pn = (wgid % nig) / gsz; u.e = 0; u.nvalid = 256; u.rowbase = u.pm * 256; u.slot = i;
        u.boff = (unsigned)u.pn * 256u * (unsigned)(K * 2); return true;
    }
    __device__ __forceinline__ unsigned aoff(const Unit& u, int r) const { return (unsigned)(u.rowbase + r) * (unsigned)(K * 2); }
    __device__ __forceinline__ unsigned abase(const Unit& u) const { return (unsigned)u.rowbase * (unsigned)(K * 2); }
    __device__ __forceinline__ const char* bbase() const { return Bt; }
};
struct DenseSchedH {
    static constexpr bool GATHER_A = false;
    int nM, G, c, K; const char* Bt;
    __device__ __forceinline__ void init(int M, int K_, const void* Bt_, int G_, int c_) { nM = M / 128; G = G_; c = c_; K = K_; Bt = (const char*)Bt_; }
    __device__ __forceinline__ bool next(int i, Unit& u) const {
        const long L = (long)i * G + c; if (L >= nM) return false;
        u.pm = (int)L; u.pn = 0; u.e = 0; u.nvalid = 128; u.rowbase = u.pm * 128; u.slot = i; u.boff = 0u; return true;
    }
    __device__ __forceinline__ unsigned abase(const Unit& u) const { return (unsigned)u.rowbase * (unsigned)(K * 2); }
    __device__ __forceinline__ const char* bbase() const { return Bt; }
};
__device__ __forceinline__ int moe_uidx(int i, int G, int c) { return (G == 256) ? ((i * 8 + (c & 7)) * 32) + (c >> 3) : i * G + c; }
template <int NPN_LOG2, int KB  , bool GATHER> struct MoeSched {
    static constexpr bool GATHER_A = GATHER;
    const LAS int* xd; const LAS int* xt; int n_my, G, c; const char* Wt; size_t estride;
    __device__ bool next(int i, Unit& u) const {
        if (i >= n_my) return false;
        const int uidx = moe_uidx(i, G, c); u.pn = uidx & ((1 << NPN_LOG2) - 1); u.slot = i;
        u.e = __builtin_amdgcn_readfirstlane(xd[4 * i]); u.pm = __builtin_amdgcn_readfirstlane(xd[4 * i + 1]);
        u.rowbase = __builtin_amdgcn_readfirstlane(xd[4 * i + 2]); u.nvalid = __builtin_amdgcn_readfirstlane(xd[4 * i + 3]);
        u.boff = (unsigned)u.e * (unsigned)estride + (unsigned)u.pn * 256u * (unsigned)(KB * 2); return true;
    }
    __device__ unsigned aoff(const Unit& u, int r) const { return (unsigned)xt[u.slot * MOE_ROWS + (r & (MOE_ROWS - 1))] * (unsigned)(KB * 2); }
    __device__ unsigned abase(const Unit& u) const { return (unsigned)u.rowbase * (unsigned)(KB * 2); }
    __device__ const char* bbase() const { return Wt; }
};
template <int NPN_LOG2, int KB> struct MoeSchedFlip {
    static constexpr bool GATHER_A = false;
    const LAS int* xd; int n_my, G, c; const char* Hb; size_t estride;
    __device__ bool next(int i, Unit& u) const {
        if (i >= n_my) return false;
        const int uidx = moe_uidx(i, G, c); u.pn = uidx & ((1 << NPN_LOG2) - 1); u.slot = i;
        u.e = __builtin_amdgcn_readfirstlane(xd[4 * i]); u.pm = __builtin_amdgcn_readfirstlane(xd[4 * i + 1]);
        u.rowbase = __builtin_amdgcn_readfirstlane(xd[4 * i + 2]); u.nvalid = __builtin_amdgcn_readfirstlane(xd[4 * i + 3]);
        u.boff = (unsigned)u.rowbase * (unsigned)(KB * 2); return true;
    }
    __device__ unsigned abase(const Unit& u) const { return (unsigned)u.e * (unsigned)estride + (unsigned)u.pn * 256u * (unsigned)(KB * 2); }
    __device__ const char* bbase() const { return Hb; }
};
constexpr int XD_INTS = 256, XT_SLOTS = MOE_ROWS == 256 ? 11 : 22;
template <int NPN_LOG2, bool WITH_ROWS> __device__ __forceinline__ int moe_preload(LAS unsigned char* lds, const int* tab, int nunits, int G, int c, const int* rowtok, const float* roww) {
    LAS int* xd = (LAS int*)(lds + LDS_XTRA); LAS int* xt = xd + XD_INTS; LAS float* xw = (LAS float*)(xt + XT_SLOTS * MOE_ROWS);
    int n_my = 0;
    while (n_my < (WITH_ROWS ? XT_SLOTS : 64) && moe_uidx(n_my, G, c) < nunits) ++n_my;
    const int tid = threadIdx.x;
    if (tid < n_my * 4) xd[tid] = ld_i32_agent(tab + 4 * (moe_uidx(tid >> 2, G, c) >> NPN_LOG2) + (tid & 3));
    if (WITH_ROWS) {
        for (int idx = tid; idx < n_my * MOE_ROWS; idx += NTHR) {
            const int slot = idx >> MOE_RSH, r = idx & (MOE_ROWS - 1), rt = moe_uidx(slot, G, c) >> NPN_LOG2;
            const int e = ld_i32_agent(tab + 4 * rt), rowbase = ld_i32_agent(tab + 4 * rt + 2), nvalid = ld_i32_agent(tab + 4 * rt + 3);
            const int rr = r < nvalid ? r : nvalid - 1;
            int tok; float w;
            if (e < NEXP) { tok = ld_i32_agent(rowtok + rowbase + rr); w = __hip_atomic_load(roww + rowbase + rr, __ATOMIC_RELAXED, __HIP_MEMORY_SCOPE_AGENT); } else { tok = rowbase - AROWS + r; w = 1.f; }
            xt[idx] = tok; xw[idx] = w;
        }
    }
    __syncthreads();
    return n_my;
}
template <int NPN_LOG2> __device__ __forceinline__ int moe_preload_scan(LAS unsigned char* lds, const LAS int* sh, int G, int c, const int* slottok, const float* slotw) {
    LAS int* xd = (LAS int*)(lds + LDS_XTRA); LAS int* xt = xd + XD_INTS; LAS float* xw = (LAS float*)(xt + XT_SLOTS * MOE_ROWS);
    const int nrt_r = sh[511], nunits = (nrt_r + T / MOE_ROWS) << NPN_LOG2;
    int n_my = 0;
    while (n_my < XT_SLOTS && moe_uidx(n_my, G, c) < nunits) ++n_my;
    const int tid = threadIdx.x;
    if (tid < n_my) {
        const int rt = moe_uidx(tid, G, c) >> NPN_LOG2; int e, ti, rowbase, nvalid;
        if (rt >= nrt_r) { e = NEXP; ti = rt - nrt_r; rowbase = AROWS + MOE_ROWS * ti; nvalid = MOE_ROWS; }
        else { int lo = 0, hi = NEXP - 1; while (lo < hi) { const int mid = (lo + hi) >> 1; if (sh[256 + mid] > rt) hi = mid; else lo = mid + 1; }
            e = lo; ti = rt - (e ? sh[256 + e - 1] : 0); const int st_e = e ? sh[e - 1] : 0; rowbase = st_e + MOE_ROWS * ti; nvalid = min(MOE_ROWS, sh[e] - st_e - MOE_ROWS * ti); }
        xd[4 * tid] = e; xd[4 * tid + 1] = ti; xd[4 * tid + 2] = rowbase; xd[4 * tid + 3] = nvalid;
    }
    __syncthreads();
    for (int idx = tid; idx < n_my * MOE_ROWS; idx += NTHR) {
        const int slot = idx >> MOE_RSH, r = idx & (MOE_ROWS - 1);
        const int e = xd[4 * slot], ti = xd[4 * slot + 1], nvalid = xd[4 * slot + 3];
        const int rr = r < nvalid ? r : nvalid - 1;
        int tok; float w;
        if (e < NEXP) { const size_t q = (size_t)e * T + ti * MOE_ROWS + rr; tok = ld_i32_agent(slottok + q); w = __hip_atomic_load(slotw + q, __ATOMIC_RELAXED, __HIP_MEMORY_SCOPE_AGENT); } else { tok = ti * MOE_ROWS + r; w = 1.f; }
        xt[idx] = tok; xw[idx] = w;
    }
    __syncthreads();
    return n_my;
}

typedef f32x4 Acc[2][2][4][2];
__device__ __forceinline__ u32x4 pack8(const f32x4 a, const f32x4 b) { u32x4 w; w.x = cvtpk(a[0], a[1]); w.y = cvtpk(a[2], a[3]); w.z = cvtpk(b[0], b[1]); w.w = cvtpk(b[2], b[3]); return w; }

struct EpiInProj {
    static constexpr bool PERM = true; static constexpr bool FLIP = false; static constexpr int NSTORE = 0; bf16* proj; const float* cs;
    __device__ __forceinline__ void operator()(const Acc& acc, const Unit& u, int wr, int wc, int fr, int fq, const __amdgpu_buffer_rsrc_t rs, const unsigned char* wsbase) const {
#pragma unroll
        for (int ai = 0; ai < 2; ++ai)
#pragma unroll
            for (int m = 0; m < 4; ++m) { const int row = u.pm * 256 + ai * 128 + wr * 64 + m * 16 + fr;
#pragma unroll
                for (int bj = 0; bj < 2; ++bj) { const int c0 = u.pn * 256 + wc * 64 + fq * 16 + bj * 8; const int seg = c0 >> 9;
                    f32x4 v0 = acc[ai][bj][m][0], v1 = acc[ai][bj][m][1];
                    if (seg != 2 && seg != 5) {
                        if ((c0 & 63) < 16) { const int j0 = (c0 & 63) >> 1; const f32x4 ca = *(const f32x4*)(cs + (size_t)row * 16 + 2 * j0), cb = *(const f32x4*)(cs + (size_t)row * 16 + 2 * j0 + 4);
                            { const float t1 = v0[0], t2 = v0[1]; v0[0] = t1 * ca[0] - t2 * ca[1]; v0[1] = t2 * ca[0] + t1 * ca[1]; }
                            { const float t1 = v0[2], t2 = v0[3]; v0[2] = t1 * ca[2] - t2 * ca[3]; v0[3] = t2 * ca[2] + t1 * ca[3]; }
                            { const float t1 = v1[0], t2 = v1[1]; v1[0] = t1 * cb[0] - t2 * cb[1]; v1[1] = t2 * cb[0] + t1 * cb[1]; }
                            { const float t1 = v1[2], t2 = v1[3]; v1[2] = t1 * cb[2] - t2 * cb[3]; v1[3] = t2 * cb[2] + t1 * cb[3]; } }
                        if (seg == 0 || seg == 3) { v0 = v0 * QSCALE64; v1 = v1 * QSCALE64; }
                    }
                    OUT_ST16(proj + (size_t)row * INW + c0, pack8(v0, v1)); } }
    }
};
__device__ __forceinline__ void stats_flush(LAS float* red, float* dst) {
    asm volatile("s_waitcnt lgkmcnt(0)" ::: "memory"); __builtin_amdgcn_s_barrier();
    const int t = threadIdx.x;
    const float v = (red[t] + red[512 + t]) + (red[1024 + t] + red[1536 + t]);
    atomicAdd(dst + t, v);
}
struct EpiOutProj {
    static constexpr bool PERM = true; static constexpr bool FLIP = false; static constexpr int NSTORE = 0; bf16* y; const float* x; float* stats; LAS float* red;
    __device__ __forceinline__ void operator()(const Acc& acc, const Unit& u, int wr, int wc, int fr, int fq, const __amdgpu_buffer_rsrc_t rs, const unsigned char* wsbase) const {
        const int cb = u.pn * 256 + wc * 64 + fq * 16;
#pragma unroll
        for (int ai = 0; ai < 2; ++ai) {
            f32x4 xv[4][4];
#pragma unroll
            for (int m = 0; m < 4; ++m) { const float* xr = x + (size_t)(u.pm * 256 + ai * 128 + wr * 64 + m * 16 + fr) * DM + cb;
#pragma unroll
                for (int q = 0; q < 4; ++q) xv[m][q] = *(const f32x4*)(xr + 4 * q); }
#pragma unroll
            for (int m = 0; m < 4; ++m) { const int lrow = ai * 128 + wr * 64 + m * 16 + fr, row = u.pm * 256 + lrow; float s1 = 0.f, s2 = 0.f;
#pragma unroll
                for (int bj = 0; bj < 2; ++bj) {
                    const f32x4 v0 = xv[m][2 * bj] * DN_ALPHA + acc[ai][bj][m][0], v1 = xv[m][2 * bj + 1] * DN_ALPHA + acc[ai][bj][m][1];
                    OUT_ST16(y + (size_t)row * DM + cb + bj * 8, pack8(v0, v1));
                    s1 += (v0[0] + v0[1]) + (v0[2] + v0[3]) + (v1[0] + v1[1]) + (v1[2] + v1[3]);
                    s2 += (v0[0] * v0[0] + v0[1] * v0[1]) + (v0[2] * v0[2] + v0[3] * v0[3]) + (v1[0] * v1[0] + v1[1] * v1[1]) + (v1[2] * v1[2] + v1[3] * v1[3]); }
                s1 += __shfl_xor(s1, 16); s2 += __shfl_xor(s2, 16); s1 += __shfl_xor(s1, 32); s2 += __shfl_xor(s2, 32);
                if (fq == 0) { f32x2 sv2 = {s1, s2}; *(LAS f32x2*)(red + (wc * 256 + lrow) * 2) = sv2; } }
        }
        stats_flush(red, stats + (size_t)u.pm * 512);
    }
};
struct EpiQMemLN {
    static constexpr bool PERM = true; static constexpr bool FLIP = false; static constexpr int NSTORE = 0; bf16* o; const float* stats; const float* sn; const float* cn; float sc;
    __device__ __forceinline__ void operator()(const Acc& acc, const Unit& u, int wr, int wc, int fr, int fq, const __amdgpu_buffer_rsrc_t rs, const unsigned char* wsbase) const {
        f32x4 sv[2][2], cv[2][2];
#pragma unroll
        for (int bj = 0; bj < 2; ++bj) { const int c0 = u.pn * 256 + wc * 64 + fq * 16 + bj * 8;
            sv[bj][0] = *(const f32x4*)(sn + c0); sv[bj][1] = *(const f32x4*)(sn + c0 + 4); cv[bj][0] = *(const f32x4*)(cn + c0); cv[bj][1] = *(const f32x4*)(cn + c0 + 4); }
        f32x2 stv[2][4];
#pragma unroll
        for (int ai = 0; ai < 2; ++ai)
#pragma unroll
            for (int m = 0; m < 4; ++m) stv[ai][m] = *(const f32x2*)(stats + (size_t)(u.pm * 256 + ai * 128 + wr * 64 + m * 16 + fr) * 2);
#pragma unroll
        for (int ai = 0; ai < 2; ++ai)
#pragma unroll
            for (int m = 0; m < 4; ++m) { const int row = u.pm * 256 + ai * 128 + wr * 64 + m * 16 + fr;
                const f32x2 st = stv[ai][m]; const float mu = st[0] * (1.f / DM), rstd = rsqrtf(st[1] * (1.f / DM) - mu * mu + LN_EPS);
#pragma unroll
                for (int bj = 0; bj < 2; ++bj) { const int c0 = u.pn * 256 + wc * 64 + fq * 16 + bj * 8;
                    const f32x4 v0 = ((acc[ai][bj][m][0] - sv[bj][0] * mu) * rstd + cv[bj][0]) * sc, v1 = ((acc[ai][bj][m][1] - sv[bj][1] * mu) * rstd + cv[bj][1]) * sc;
                    OUT_ST16(o + (size_t)row * DM + c0, pack8(v0, v1)); } }
    }
};
struct EpiScale {
    static constexpr bool PERM = true; static constexpr bool FLIP = false; static constexpr int NSTORE = 16; bf16* o; int ldc; float sc;
    __device__ __forceinline__ void operator()(const Acc& acc, const Unit& u, int wr, int wc, int fr, int fq, const __amdgpu_buffer_rsrc_t rs, const unsigned char* wsbase) const {
#pragma unroll
        for (int ai = 0; ai < 2; ++ai)
#pragma unroll
            for (int m = 0; m < 4; ++m) { const int row = u.pm * 256 + ai * 128 + wr * 64 + m * 16 + fr;
#pragma unroll
                for (int bj = 0; bj < 2; ++bj) { const int c0 = u.pn * 256 + wc * 64 + fq * 16 + bj * 8;
                    OUT_ST16(o + (size_t)row * ldc + c0, pack8(acc[ai][bj][m][0] * sc, acc[ai][bj][m][1] * sc)); } }
    }
};
struct EpiWo {
    static constexpr bool PERM = true; static constexpr bool FLIP = false; static constexpr int NSTORE = 0; bf16* y; const bf16* y1; const float* stats; const float* g; const float* b; float* stats2; LAS float* red;
    __device__ __forceinline__ void operator()(const Acc& acc, const Unit& u, int wr, int wc, int fr, int fq, const __amdgpu_buffer_rsrc_t rs, const unsigned char* wsbase) const {
        f32x4 gv[2][2], bv[2][2];
#pragma unroll
        for (int bj = 0; bj < 2; ++bj) { const int c0 = u.pn * 256 + wc * 64 + fq * 16 + bj * 8;
            gv[bj][0] = *(const f32x4*)(g + c0); gv[bj][1] = *(const f32x4*)(g + c0 + 4); bv[bj][0] = *(const f32x4*)(b + c0); bv[bj][1] = *(const f32x4*)(b + c0 + 4); }
#pragma unroll
        for (int ai = 0; ai < 2; ++ai) {
            u32x4 hvv[4][2]; f32x2 stv[4];
#pragma unroll
            for (int m = 0; m < 4; ++m) { const int row = u.pm * 256 + ai * 128 + wr * 64 + m * 16 + fr; stv[m] = *(const f32x2*)(stats + (size_t)row * 2);
#pragma unroll
                for (int bj = 0; bj < 2; ++bj) hvv[m][bj] = *(const u32x4*)(y1 + (size_t)row * DM + u.pn * 256 + wc * 64 + fq * 16 + bj * 8); }
#pragma unroll
            for (int m = 0; m < 4; ++m) { const int lrow = ai * 128 + wr * 64 + m * 16 + fr, row = u.pm * 256 + lrow;
                const f32x2 st = stv[m]; const float mu = st[0] * (1.f / DM), rstd = rsqrtf(st[1] * (1.f / DM) - mu * mu + LN_EPS); float s1 = 0.f, s2 = 0.f;
#pragma unroll
                for (int bj = 0; bj < 2; ++bj) { const int c0 = u.pn * 256 + wc * 64 + fq * 16 + bj * 8;
                    const u32x4 hv = hvv[m][bj];
                    f32x4 a, bb; a[0] = __uint_as_float(hv.x << 16); a[1] = __uint_as_float(hv.x & 0xffff0000u); a[2] = __uint_as_float(hv.y << 16); a[3] = __uint_as_float(hv.y & 0xffff0000u);
                    bb[0] = __uint_as_float(hv.z << 16); bb[1] = __uint_as_float(hv.z & 0xffff0000u); bb[2] = __uint_as_float(hv.w << 16); bb[3] = __uint_as_float(hv.w & 0xffff0000u);
                    const f32x4 h0 = (a - mu) * rstd * gv[bj][0] + bv[bj][0], h1 = (bb - mu) * rstd * gv[bj][1] + bv[bj][1];
                    const f32x4 v0 = h0 * DN_ALPHA + acc[ai][bj][m][0], v1 = h1 * DN_ALPHA + acc[ai][bj][m][1];
                    OUT_ST16(y + (size_t)row * DM + c0, pack8(v0, v1));
                    s1 += (v0[0] + v0[1]) + (v0[2] + v0[3]) + (v1[0] + v1[1]) + (v1[2] + v1[3]);
                    s2 += (v0[0] * v0[0] + v0[1] * v0[1]) + (v0[2] * v0[2] + v0[3] * v0[3]) + (v1[0] * v1[0] + v1[1] * v1[1]) + (v1[2] * v1[2] + v1[3] * v1[3]); }
                if (WO_STATS) { s1 += __shfl_xor(s1, 16); s2 += __shfl_xor(s2, 16); s1 += __shfl_xor(s1, 32); s2 += __shfl_xor(s2, 32);
                    if (fq == 0) { f32x2 sv2 = {s1, s2}; *(LAS f32x2*)(red + (wc * 256 + lrow) * 2) = sv2; } } }
        }
        if (WO_STATS) stats_flush(red, stats2 + (size_t)u.pm * 512);
    }
};
struct EpiRouterLN {
    static constexpr bool PERM = false; static constexpr bool FLIP = false; static constexpr int NSTORE = 0; float* C; int ldc; const float* stats; const float* sn; const float* cn;
    __device__ __forceinline__ void operator()(const Acc& acc, const Unit& u, int wr, int wc, int fr, int fq, const __amdgpu_buffer_rsrc_t rs, const unsigned char* wsbase) const {
        f32x4 sv[2][2], cv[2][2];
#pragma unroll
        for (int bj = 0; bj < 2; ++bj)
#pragma unroll
            for (int n = 0; n < 2; ++n) { const int c0 = u.pn * 256 + bj * 128 + wc * 32 + n * 16 + 4 * fq; sv[bj][n] = *(const f32x4*)(sn + c0); cv[bj][n] = *(const f32x4*)(cn + c0); }
        f32x2 stv[2][4];
#pragma unroll
        for (int ai = 0; ai < 2; ++ai)
#pragma unroll
            for (int m = 0; m < 4; ++m) stv[ai][m] = *(const f32x2*)(stats + (size_t)(u.pm * 256 + ai * 128 + wr * 64 + m * 16 + fr) * 2);
#pragma unroll
        for (int ai = 0; ai < 2; ++ai)
#pragma unroll
            for (int m = 0; m < 4; ++m) { const int row = u.pm * 256 + ai * 128 + wr * 64 + m * 16 + fr;
                const f32x2 st = stv[ai][m]; const float mu = st[0] * (1.f / DM), rstd = rsqrtf(st[1] * (1.f / DM) - mu * mu + LN_EPS);
#pragma unroll
                for (int bj = 0; bj < 2; ++bj)
#pragma unroll
                    for (int n = 0; n < 2; ++n) *(f32x4*)(C + (size_t)row * ldc + u.pn * 256 + bj * 128 + wc * 32 + n * 16 + 4 * fq) = (acc[ai][bj][m][n] - sv[bj][n] * mu) * rstd + cv[bj][n]; }
    }
};
struct EpiRouterLNH {
    static constexpr bool PERM = false; static constexpr bool FLIP = false; static constexpr int NSTORE = 0; float* C; int ldc; const float* stats; const float* sn; const float* cn;
    __device__ __forceinline__ void operator()(const Acc& acc, const Unit& u, int wr, int wc, int fr, int fq, const __amdgpu_buffer_rsrc_t rs, const unsigned char* wsbase) const {
        f32x4 sv[2][2], cv[2][2];
#pragma unroll
        for (int bj = 0; bj < 2; ++bj)
#pragma unroll
            for (int n = 0; n < 2; ++n) { const int c0 = bj * 128 + wc * 32 + n * 16 + 4 * fq; sv[bj][n] = *(const f32x4*)(sn + c0); cv[bj][n] = *(const f32x4*)(cn + c0); }
        f32x2 stv[4];
#pragma unroll
        for (int m = 0; m < 4; ++m) stv[m] = *(const f32x2*)(stats + (size_t)(u.rowbase + wr * 64 + m * 16 + fr) * 2);
#pragma unroll
        for (int m = 0; m < 4; ++m) { const int row = u.rowbase + wr * 64 + m * 16 + fr;
            const f32x2 st = stv[m]; const float mu = st[0] * (1.f / DM), rstd = rsqrtf(st[1] * (1.f / DM) - mu * mu + LN_EPS);
#pragma unroll
            for (int bj = 0; bj < 2; ++bj)
#pragma unroll
                for (int n = 0; n < 2; ++n) *(f32x4*)(C + (size_t)row * ldc + bj * 128 + wc * 32 + n * 16 + 4 * fq) = (acc[0][bj][m][n] - sv[bj][n] * mu) * rstd + cv[bj][n]; }
    }
};
struct EpiF32 {
    static constexpr bool PERM = false; static constexpr bool FLIP = false; static constexpr int NSTORE = 0; float* C; int ldc;
    __device__ __forceinline__ void operator()(const Acc& acc, const Unit& u, int wr, int wc, int fr, int fq, const __amdgpu_buffer_rsrc_t rs, const unsigned char* wsbase) const {
#pragma unroll
        for (int ai = 0; ai < 2; ++ai)
#pragma unroll
            for (int m = 0; m < 4; ++m) { const int row = u.pm * 256 + ai * 128 + wr * 64 + m * 16 + fr;
#pragma unroll
                for (int bj = 0; bj < 2; ++bj)
#pragma unroll
                    for (int n = 0; n < 2; ++n) *(f32x4*)(C + (size_t)row * ldc + u.pn * 256 + bj * 128 + wc * 32 + n * 16 + 4 * fq) = acc[ai][bj][m][n]; }
    }
};
__device__ __forceinline__ float silu_mul(float g, float uu) { return g * fast_rcp(1.f + fast_exp2(-g * LOG2E)) * uu; }
constexpr float H8_SCALE = 8.f, W8_SCALE = 16.f, WD8_SCALE = 32.f, X8_SCALE = 4.f;
struct EpiMoe1 {
    static constexpr bool PERM = true; static constexpr bool FLIP = false; static constexpr int NSTORE = MOE_ROWS / 32; unsigned char* H; const LAS float* xw;
    __device__ __forceinline__ void operator()(const Acc& acc, const Unit& u, int wr, int wc, int fr, int fq, const __amdgpu_buffer_rsrc_t rs, const unsigned char* wsbase) const {
        const unsigned base = (unsigned)(H - wsbase) + (unsigned)u.rowbase * (unsigned)EDIM + (unsigned)(u.pn * 128 + wc * 32 + 8 * fq);
#pragma unroll
        for (int ai = 0; ai < MOE_ROWS / 128; ++ai)
#pragma unroll
            for (int m = 0; m < 4; ++m) { const int rl = ai * 128 + wr * 64 + m * 16 + fr;
                const f32x4 g0 = acc[ai][0][m][0], g1 = acc[ai][0][m][1], u0 = acc[ai][1][m][0], u1 = acc[ai][1][m][1]; f32x4 h0, h1; const float w = xw[u.slot * MOE_ROWS + rl] * H8_SCALE;
#pragma unroll
                for (int q = 0; q < 4; ++q) { h0[q] = silu_mul(g0[q], u0[q]) * w; h1[q] = silu_mul(g1[q], u1[q]) * w; }
                int t0 = 0, t1 = 0;
                t0 = __builtin_amdgcn_cvt_pk_fp8_f32(h0[0], h0[1], t0, false); t0 = __builtin_amdgcn_cvt_pk_fp8_f32(h0[2], h0[3], t0, true);
                t1 = __builtin_amdgcn_cvt_pk_fp8_f32(h1[0], h1[1], t1, false); t1 = __builtin_amdgcn_cvt_pk_fp8_f32(h1[2], h1[3], t1, true);
                u32x2 w8; w8.x = (unsigned)t0; w8.y = (unsigned)t1;
                const unsigned voff = (rl < u.nvalid) ? base + (unsigned)rl * (unsigned)EDIM : 0xffffffffu;
                __builtin_amdgcn_raw_buffer_store_b64(w8, rs, (int)voff, 0, OUT_AUX);
                asm volatile("" ::: "memory"); __builtin_amdgcn_sched_barrier(0); }
    }
};
constexpr float Y8_SCALE = 16.f, Y8_INV = 1.f / 16.f;
struct EpiMoe2 {
    static constexpr bool PERM = true; static constexpr bool FLIP = false; static constexpr int NSTORE = MOE_ROWS / 32; unsigned char* Y;
    __device__ __forceinline__ void operator()(const Acc& acc, const Unit& u, int wr, int wc, int fr, int fq, const __amdgpu_buffer_rsrc_t rs, const unsigned char* wsbase) const {
        const unsigned base = (unsigned)(Y - wsbase) + (unsigned)u.rowbase * (unsigned)DM + (unsigned)(u.pn * 256 + wc * 64 + fq * 16);
#pragma unroll
        for (int ai = 0; ai < MOE_ROWS / 128; ++ai)
#pragma unroll
            for (int m = 0; m < 4; ++m) { const int rl = ai * 128 + wr * 64 + m * 16 + fr; u32x4 w;
#pragma unroll
                for (int bj = 0; bj < 2; ++bj) {
                    const f32x4 a = acc[ai][bj][m][0] * Y8_SCALE, b = acc[ai][bj][m][1] * Y8_SCALE; int t0 = 0, t1 = 0;
                    t0 = __builtin_amdgcn_cvt_pk_fp8_f32(a[0], a[1], t0, false); t0 = __builtin_amdgcn_cvt_pk_fp8_f32(a[2], a[3], t0, true);
                    t1 = __builtin_amdgcn_cvt_pk_fp8_f32(b[0], b[1], t1, false); t1 = __builtin_amdgcn_cvt_pk_fp8_f32(b[2], b[3], t1, true);
                    if (bj == 0) { w.x = (unsigned)t0; w.y = (unsigned)t1; } else { w.z = (unsigned)t0; w.w = (unsigned)t1; } }
                const unsigned voff = (rl < u.nvalid) ? base + (unsigned)rl * (unsigned)DM : 0xffffffffu;
                __builtin_amdgcn_raw_buffer_store_b128(w, rs, (int)voff, 0, OUT_AUX);
                asm volatile("" ::: "memory"); __builtin_amdgcn_sched_barrier(0); }
    }
};
struct EpiMoe2F {
    static constexpr bool PERM = false; static constexpr bool FLIP = true; static constexpr int NSTORE = 8; unsigned char* Y;
    __device__ __forceinline__ void operator()(const Acc& acc, const Unit& u, int wr, int wc, int fr, int fq, const __amdgpu_buffer_rsrc_t rs, const unsigned char* wsbase) const {
        unsigned ones_ = ~0u; asm volatile("" : "+s"(ones_));
        const int t_ = (int)__builtin_amdgcn_mbcnt_hi(ones_, __builtin_amdgcn_mbcnt_lo(ones_, 0u));
        const int fr_ = t_ & 15, fq_ = (t_ >> 4) & 3;
        const bool odd = (fr_ & 1) != 0;
        const unsigned base = (unsigned)(Y - wsbase) + (unsigned)u.rowbase * (unsigned)DM + (unsigned)(u.pn * 256 + wr * 128 + fq_ * 32 + (odd ? 16 : 0)) + (unsigned)(wc * 32 + (fr_ & ~1)) * (unsigned)DM;
#pragma unroll
        for (int bj = 0; bj < 2; ++bj)
#pragma unroll
            for (int n = 0; n < 2; ++n) {
                u32x4 s1, s2;
#pragma unroll
                for (int m = 0; m < 4; ++m) {
                    const f32x4 a = acc[0][bj][m][n] * Y8_SCALE, b = acc[1][bj][m][n] * Y8_SCALE; int t0 = 0, t1 = 0;
                    t0 = __builtin_amdgcn_cvt_pk_fp8_f32(a[0], a[1], t0, false); t0 = __builtin_amdgcn_cvt_pk_fp8_f32(a[2], a[3], t0, true);
                    t1 = __builtin_amdgcn_cvt_pk_fp8_f32(b[0], b[1], t1, false); t1 = __builtin_amdgcn_cvt_pk_fp8_f32(b[2], b[3], t1, true);
                    const int give = odd ? t0 : t1;
                    const int got = __builtin_amdgcn_mov_dpp(give, 0xB1, 0xf, 0xf, true);
                    s1[m] = (unsigned)(odd ? got : t0); s2[m] = (unsigned)(odd ? t1 : got); }
                const int re = bj * 128 + wc * 32 + n * 16 + (fr_ & ~1);
                const unsigned v1 = (re < u.nvalid) ? base + (unsigned)(bj * 128 + n * 16) * (unsigned)DM : 0xffffffffu, v2 = (re + 1 < u.nvalid) ? base + (unsigned)(bj * 128 + n * 16 + 1) * (unsigned)DM : 0xffffffffu;
                __builtin_amdgcn_raw_buffer_store_b128(s1, rs, (int)v1, 0, OUT_AUX);
                asm volatile("" ::: "memory"); __builtin_amdgcn_sched_barrier(0);
                __builtin_amdgcn_raw_buffer_store_b128(s2, rs, (int)v2, 0, OUT_AUX);
                asm volatile("" ::: "memory"); __builtin_amdgcn_sched_barrier(0); }
    }
};

typedef int v8i32 __attribute__((ext_vector_type(8)));
typedef int v4i32 __attribute__((ext_vector_type(4)));
template <class Epi, class Sched, bool FP8 = false, int SCW = 0x7F7F7F7F, bool HALFM = false, bool PIN_ACC = false>
__device__ __forceinline__ void gemm_phase(LAS unsigned char* lds, const unsigned char* wsbase, const char* Abase, const int K, const Sched& S, const Epi& E) {
    int tid_ = threadIdx.x; asm volatile("" : "+v"(tid_));
    const int tid = tid_, wid = __builtin_amdgcn_readfirstlane(tid >> 6), lane = tid & 63, wr = wid >> 2, wc = wid & 3, fr = lane & 15, fq = lane >> 4;
    const int nt = K / BK;
    constexpr bool GA = Sched::GATHER_A;
    int Rr[2]; unsigned Cb[2]; unsigned vB, vA;
#pragma unroll
    for (int i = 0; i < 2; ++i) { int R, C; stage_rc(tid * 16 + i * 8192, R, C); Rr[i] = R; Cb[i] = (unsigned)C * 2u; }
    { const int R = Rr[0]; const int Rb = Epi::PERM ? (64 * (R >> 5) + 16 * ((R >> 2) & 3) + 4 * ((R >> 4) & 1) + (R & 3)) : R; vB = (unsigned)Rb * (unsigned)(K * 2) + Cb[0];
      const int Ra = Epi::FLIP ? (32 * ((R >> 2) & 3) + 4 * ((R >> 4) & 3) + (R & 3)) : R; vA = (unsigned)Ra * (unsigned)(K * 2) + Cb[0]; }
    const unsigned p1step = (Epi::FLIP ? 128u : 64u) * (unsigned)(K * 2), p1stepB = (Epi::PERM ? 128u : 64u) * (unsigned)(K * 2), hstepB = (Epi::PERM ? 8u : 128u) * (unsigned)(K * 2);
    const unsigned kstep = (unsigned)(BK * 2);
    const unsigned hstep = (Epi::FLIP ? 16u : (unsigned)HALF) * (unsigned)K * 2u;
    const unsigned ldsw = (unsigned)wid * 1024u;
    const int aoff = lds_byte(wr * 64 + fr, fq * 8), boff = lds_byte(wc * 32 + fr, fq * 8);
    const __amdgpu_buffer_rsrc_t rsA = __builtin_amdgcn_make_buffer_rsrc((void*)wsbase, 0, 0x7ffff000, 0x00020000);
#define rsB rsA
    const unsigned offA = (unsigned)((const char*)Abase - (const char*)wsbase), offB = (unsigned)((const char*)S.bbase() - (const char*)wsbase);
#define G_SA(b, h) (((b) * 2 + (h)) * HTB)
#define G_SB(b, h) ((4 + (b) * 2 + (h)) * HTB)
#define G_STAGE(bufoff, rs, soff, voff) do { _Pragma("unroll") for (int _i = 0; _i < 2; ++_i) \
        __builtin_amdgcn_raw_ptr_buffer_load_lds(rs, (LAS unsigned*)(lds + (bufoff) + ldsw + _i * 8192), 16, (int)(voff)[_i], (int)(soff), 0, 0); } while (0)
#define G_STAGE1(bufoff, rs, soff, v0) do { _Pragma("unroll") for (int _i = 0; _i < 2; ++_i) \
        __builtin_amdgcn_raw_ptr_buffer_load_lds(rs, (LAS unsigned*)(lds + (bufoff) + ldsw + _i * 8192), 16, (int)(v0), (int)((soff) + _i * p1step), 0, 0); } while (0)
#define G_STAGE_B(bufoff, soff) do { _Pragma("unroll") for (int _i = 0; _i < 2; ++_i) \
        __builtin_amdgcn_raw_ptr_buffer_load_lds(rsB, (LAS unsigned*)(lds + (bufoff) + ldsw + _i * 8192), 16, (int)(vB), (int)((soff) + _i * p1stepB), 0, 0); } while (0)
#define G_STAGE_A(bufoff, soff, h, vg) do { if constexpr (GA) { G_STAGE(bufoff, rsA, soff, vg); } else { G_STAGE1(bufoff, rsA, (soff) + (h) * hstep, vA); } } while (0)
#define G_LD32(p) __builtin_shufflevector(*(const LAS v4i32*)(p), *(const LAS v4i32*)((p) + 1024), 0, 1, 2, 3, 4, 5, 6, 7)
#define G_LDA(dst, b, h) do { if constexpr (FP8) { _Pragma("unroll") for (int m = 0; m < 4; ++m) dst##8[m] = G_LD32(lds + G_SA(b, h) + aoff + m * 2048); } \
        else { _Pragma("unroll") for (int m = 0; m < 4; ++m) _Pragma("unroll") for (int k = 0; k < 2; ++k) dst[m][k] = *(const LAS bf16x8*)(lds + G_SA(b, h) + aoff + m * 2048 + k * 1024); } } while (0)
#define G_LDB(dst, b, h) do { if constexpr (FP8) { _Pragma("unroll") for (int n = 0; n < 2; ++n) dst##8[n] = G_LD32(lds + G_SB(b, h) + boff + n * 2048); } \
        else { _Pragma("unroll") for (int n = 0; n < 2; ++n) _Pragma("unroll") for (int k = 0; k < 2; ++k) dst[n][k] = *(const LAS bf16x8*)(lds + G_SB(b, h) + boff + n * 2048 + k * 1024); } } while (0)
#define G_MMA(ai, bj, At, Bt) do { __builtin_amdgcn_s_setprio(1); _Pragma("unroll") for (int m = 0; m < 4; ++m) _Pragma("unroll") for (int n = 0; n < 2; ++n) { \
        if constexpr (FP8 && Epi::FLIP) { acc[ai][bj][m][n] = __builtin_amdgcn_mfma_scale_f32_16x16x128_f8f6f4(At##8[m], Bt##8[n], acc[ai][bj][m][n], 0, 0, 0, SCW, 0, SCW); } \
        else if constexpr (FP8) { acc[ai][bj][m][n] = __builtin_amdgcn_mfma_scale_f32_16x16x128_f8f6f4(Bt##8[n], At##8[m], acc[ai][bj][m][n], 0, 0, 0, SCW, 0, SCW); } \
        else { _Pragma("unroll") for (int k = 0; k < 2; ++k) acc[ai][bj][m][n] = __builtin_amdgcn_mfma_f32_16x16x32_bf16(Bt[n][k], At[m][k], acc[ai][bj][m][n], 0, 0, 0); } } \
        __builtin_amdgcn_s_setprio(0); \
        if constexpr (PIN_ACC) { asm volatile("" : "+v"(acc[ai][bj][0][0]), "+v"(acc[ai][bj][0][1]), "+v"(acc[ai][bj][1][0]), "+v"(acc[ai][bj][1][1]), \
                                                   "+v"(acc[ai][bj][2][0]), "+v"(acc[ai][bj][2][1]), "+v"(acc[ai][bj][3][0]), "+v"(acc[ai][bj][3][1])); } } while (0)
#define G_WAIT_V(n) asm volatile("s_waitcnt vmcnt(" #n ")" ::: "memory")
#define G_WAIT_V8S() do { if (Epi::NSTORE == 0 || !post_epi) { asm volatile("s_waitcnt vmcnt(8)" ::: "memory"); } else if (Epi::NSTORE == 4) { asm volatile("s_waitcnt vmcnt(12)" ::: "memory"); } else if (Epi::NSTORE == 8) { asm volatile("s_waitcnt vmcnt(16)" ::: "memory"); } else { static_assert(Epi::NSTORE == 0 || Epi::NSTORE == 4 || Epi::NSTORE == 8 || Epi::NSTORE == 16, "NSTORE"); asm volatile("s_waitcnt vmcnt(24)" ::: "memory"); } } while (0)
#define G_WAIT_L(n) asm volatile("s_waitcnt lgkmcnt(" #n ")" ::: "memory")
#define G_WAIT_V6S() do { if (Epi::NSTORE == 0 || !post_epi) { asm volatile("s_waitcnt vmcnt(6)" ::: "memory"); } else if (Epi::NSTORE == 4) { asm volatile("s_waitcnt vmcnt(10)" ::: "memory"); } else { static_assert(Epi::NSTORE == 0 || Epi::NSTORE == 4 || Epi::NSTORE == 8, "NSTORE"); asm volatile("s_waitcnt vmcnt(14)" ::: "memory"); } } while (0)
#define G_BAR __builtin_amdgcn_s_barrier()
#define G_SCHED __builtin_amdgcn_sched_barrier(0)
    Unit cur, nxt; int ui = 0;
    if (!S.next(0, cur)) return;
    Acc acc;
#pragma unroll
    for (int a = 0; a < 2; ++a)
#pragma unroll
        for (int b = 0; b < 2; ++b)
#pragma unroll
            for (int m = 0; m < 4; ++m)
#pragma unroll
                for (int n = 0; n < 2; ++n) acc[a][b][m][n] = (f32x4){0.f, 0.f, 0.f, 0.f};
    bf16x8 At[4][2], B0[2][2], B1[2][2]; v8i32 At8[4], B08[2], B18[2];
    unsigned vAc0[2], vAc1[2];
    unsigned cA = 0u, nA = 0u;
    if constexpr (GA) {
#pragma unroll
        for (int i = 0; i < 2; ++i) { vAc0[i] = S.aoff(cur, Rr[i]) + Cb[i]; vAc1[i] = S.aoff(cur, 128 + Rr[i]) + Cb[i]; }
    } else { cA = S.abase(cur); }
    cA += offA;
    unsigned cB = cur.boff + offB;
    if constexpr (HALFM) {
        G_STAGE_B(G_SB(0, 0), cB); G_STAGE_B(G_SB(0, 1), cB + hstepB); G_STAGE_A(G_SA(0, 0), cA, 0, vAc0);
        if (wr == 1) G_BAR;
        G_STAGE_B(G_SB(1, 0), cB + kstep); G_STAGE_B(G_SB(1, 1), cB + hstepB + kstep); G_STAGE_A(G_SA(1, 0), cA + kstep, 0, vAc0);
        G_WAIT_V(6); G_BAR; G_BAR;
    } else {
    G_STAGE_B(G_SB(0, 0), cB); G_STAGE_B(G_SB(0, 1), cB + hstepB); G_STAGE_A(G_SA(0, 0), cA, 0, vAc0); G_STAGE_A(G_SA(0, 1), cA, 1, vAc1);
    if (wr == 1) G_BAR;
    G_WAIT_V(2); G_BAR;
    G_STAGE_B(G_SB(1, 0), cB + kstep); G_STAGE_A(G_SA(1, 0), cA + kstep, 0, vAc0); G_STAGE_B(G_SB(1, 1), cB + hstepB + kstep);
    G_WAIT_V(6); G_BAR;
    }
    for (;;) {
        const bool has_next = S.next(ui + 1, nxt);
        const unsigned nB = has_next ? nxt.boff + offB : cB;
        if constexpr (!GA) { nA = has_next ? S.abase(nxt) + offA : cA; } else { nA = cA; }
#pragma unroll 1
        for (int t = 0; t < nt; t += 2) {
            const bool last = (t == nt - 2);
            const unsigned a1 = cA + (unsigned)(t + 1) * kstep;
            const unsigned a2 = last ? nA : cA + (unsigned)(t + 2) * kstep; const unsigned b2 = last ? nB : cB + (unsigned)(t + 2) * kstep;
            const unsigned a3 = a2 + kstep; const unsigned b3 = b2 + kstep;
            unsigned v20[2], v21[2];
#pragma unroll
            for (int i = 0; i < 2; ++i) { if constexpr (GA) { v20[i] = vAc0[i]; v21[i] = vAc1[i]; } else { v20[i] = 0u; v21[i] = 0u; } }
            if constexpr (GA) { if (last && has_next) { int t_ = threadIdx.x; asm volatile("" : "+v"(t_));
#pragma unroll
                for (int i = 0; i < 2; ++i) { int R_, C_; stage_rc(t_ * 16 + i * 8192, R_, C_); v20[i] = S.aoff(nxt, R_) + (unsigned)C_ * 2u; v21[i] = S.aoff(nxt, 128 + R_) + (unsigned)C_ * 2u; } } }
            const bool post_epi = (t == 0) && (ui > 0);
            if constexpr (HALFM) {
            G_LDB(B0, 0, 0); G_LDB(B1, 0, 1); G_SCHED; G_LDA(At, 0, 0);
            G_WAIT_L(0); G_BAR; G_MMA(0, 0, At, B0); G_MMA(0, 1, At, B1); G_BAR; G_SCHED;
            G_STAGE_B(G_SB(0, 0), b2); G_STAGE_B(G_SB(0, 1), b2 + hstepB); G_STAGE_A(G_SA(0, 0), a2, 0, v20);
            G_WAIT_V6S(); G_BAR; G_BAR; G_SCHED;
            G_LDB(B0, 1, 0); G_LDB(B1, 1, 1); G_SCHED; G_LDA(At, 1, 0);
            G_WAIT_L(0); G_BAR; G_MMA(0, 0, At, B0); G_MMA(0, 1, At, B1); G_BAR; G_SCHED;
            G_STAGE_B(G_SB(1, 0), b3); G_STAGE_B(G_SB(1, 1), b3 + hstepB); G_STAGE_A(G_SA(1, 0), a3, 0, v20);
            G_WAIT_V(6); G_BAR; G_BAR; G_SCHED;
            } else {
            G_LDB(B0, 0, 0); G_LDB(B1, 0, 1); G_SCHED; G_LDA(At, 0, 0); G_STAGE_A(G_SA(1, 1), a1, 1, vAc1);
            G_WAIT_V8S(); G_WAIT_L(0); G_BAR; G_MMA(0, 0, At, B0); G_MMA(0, 1, At, B1); G_BAR; G_SCHED;
            G_LDA(At, 0, 1); G_STAGE_B(G_SB(0, 0), b2); G_STAGE_B(G_SB(0, 1), b2 + hstepB); G_STAGE_A(G_SA(0, 0), a2, 0, v20);
            G_WAIT_V8S(); G_WAIT_L(0); G_BAR; G_MMA(1, 0, At, B0); G_MMA(1, 1, At, B1); G_BAR; G_SCHED;
            G_LDB(B0, 1, 0); G_LDB(B1, 1, 1); G_SCHED; G_LDA(At, 1, 0); G_STAGE_A(G_SA(0, 1), a2, 1, v21);
            G_WAIT_V(8); G_WAIT_L(0); G_BAR; G_MMA(0, 0, At, B0); G_MMA(0, 1, At, B1); G_BAR; G_SCHED;
            G_LDA(At, 1, 1); G_STAGE_B(G_SB(1, 0), b3); G_STAGE_B(G_SB(1, 1), b3 + hstepB); G_STAGE_A(G_SA(1, 0), a3, 0, v20);
            G_WAIT_V(8); G_WAIT_L(0); G_BAR; G_MMA(1, 0, At, B0); G_MMA(1, 1, At, B1); G_BAR; G_SCHED;
            }
        }
        if (wr == 0) G_BAR;
        E(acc, cur, wr, wc, fr, fq, rsA, wsbase);
        G_SCHED;
        if (!has_next) break;
#pragma unroll
        for (int a = 0; a < 2; ++a)
#pragma unroll
            for (int b = 0; b < 2; ++b)
#pragma unroll
                for (int m = 0; m < 4; ++m)
#pragma unroll
                    for (int n = 0; n < 2; ++n) acc[a][b][m][n] = (f32x4){0.f, 0.f, 0.f, 0.f};
        cur = nxt; cB = nB; ++ui;
        if constexpr (GA) { int t_ = threadIdx.x; asm volatile("" : "+v"(t_));
#pragma unroll
            for (int i = 0; i < 2; ++i) { int R_, C_; stage_rc(t_ * 16 + i * 8192, R_, C_); vAc0[i] = S.aoff(cur, R_) + (unsigned)C_ * 2u; vAc1[i] = S.aoff(cur, 128 + R_) + (unsigned)C_ * 2u; }
        } else cA = nA;
        if (wr == 1) G_BAR;
    }
    G_WAIT_V(0);
    G_BAR;
#undef G_SA
#undef G_SB
#undef rsB
#undef G_STAGE
#undef G_STAGE1
#undef G_STAGE_A
#undef G_STAGE_B
#undef G_LDA
#undef G_LDB
#undef G_MMA
#undef G_LD32
#undef G_WAIT_V
#undef G_WAIT_V8S
#undef G_WAIT_V6S
#undef G_WAIT_L
#undef G_BAR
#undef G_SCHED
}
}

namespace fa {
__device__ __forceinline__ int crow(int r, int hi) { return (r & 3) + 8 * (r >> 2) + 4 * hi; }
typedef short v4i16_t __attribute__((ext_vector_type(4)));
__device__ __forceinline__ s16x4 vtr(const LAS char* p) { return __builtin_bit_cast(s16x4, __builtin_amdgcn_ds_read_tr16_b64_v4i16((LAS v4i16_t*)p)); }
__device__ __forceinline__ float max3f(float a, float b, float c) { float r; asm("v_max3_f32 %0, %1, %2, %3" : "=v"(r) : "v"(a), "v"(b), "v"(c)); return r; }
__device__ __forceinline__ float max2f(float a, float b) { float r; asm("v_max_f32_e32 %0, %1, %2" : "=v"(r) : "v"(a), "v"(b)); return r; }
__device__ __forceinline__ float rowmax32(const f32x16& p0, const f32x16& p1) {
    float a = max3f(p0[0], p0[1], p1[0]), b = max3f(p0[2], p0[3], p1[1]); a = max3f(a, p1[2], p1[3]);
#pragma unroll
    for (int r = 4; r < 16; r += 4) { a = max3f(a, p0[r], p0[r + 1]); b = max3f(b, p0[r + 2], p0[r + 3]); a = max3f(a, p1[r], p1[r + 1]); b = max3f(b, p1[r + 2], p1[r + 3]); }
    return max2f(a, b);
}
__device__ __forceinline__ float halfmax(float m) { auto rr = __builtin_amdgcn_permlane32_swap(__float_as_uint(m), __float_as_uint(m), false, false); return fmaxf(__uint_as_float(rr[0]), __uint_as_float(rr[1])); }
__device__ __forceinline__ float halfsum(float m) { auto rr = __builtin_amdgcn_permlane32_swap(__float_as_uint(m), __float_as_uint(m), false, false); return __uint_as_float(rr[0]) + __uint_as_float(rr[1]); }

template <int NQ, int KSTR> __device__ __forceinline__ f32x16 qk(const LAS char* Kl, int j, const bf16x8 (&qf)[NQ], int lane) {
    f32x16 s = {0.f, 0.f, 0.f, 0.f, 0.f, 0.f, 0.f, 0.f, 0.f, 0.f, 0.f, 0.f, 0.f, 0.f, 0.f, 0.f};
    const LAS char* kp = Kl + (32 * j + (lane & 31)) * KSTR + (lane >> 5) * 16;
#pragma unroll
    for (int ds = 0; ds < NQ; ++ds) { const bf16x8 kf = *(const LAS bf16x8*)(kp + ds * 32); s = __builtin_amdgcn_mfma_f32_32x32x16_bf16(kf, qf[ds], s, 0, 0, 0); }
    return s;
}
template <int NQ, int KSTR> __device__ __forceinline__ f32x16 qk_c(const LAS char* Kl, int j, const bf16x8 (&qf)[NQ], int lane, const f32x16& c0) {
    f32x16 s = c0;
    const LAS char* kp = Kl + (32 * j + (lane & 31)) * KSTR + (lane >> 5) * 16;
#pragma unroll
    for (int ds = 0; ds < NQ; ++ds) { const bf16x8 kf = *(const LAS bf16x8*)(kp + ds * 32); s = __builtin_amdgcn_mfma_f32_32x32x16_bf16(kf, qf[ds], s, 0, 0, 0); }
    return s;
}
template <int NO> __device__ __forceinline__ void softmax_step_dm(f32x16& p0, f32x16& p1, float& mref, f32x16& negm, float& l, f32x16 (&o)[NO], bf16x8 (&pf)[4]) {
    constexpr float THR = 8.f;
    float mx = halfmax(rowmax32(p0, p1));
    if (__any(mx > THR)) {
        const float dl = fmaxf(mx, 0.f), al = fast_exp2(-dl);
        mref += dl; l *= al;
#pragma unroll
        for (int r = 0; r < 16; ++r) { p0[r] -= dl; p1[r] -= dl; negm[r] = -mref; }
#pragma unroll
        for (int d = 0; d < NO; ++d)
#pragma unroll
            for (int r = 0; r < 16; ++r) o[d][r] *= al;
    }
    float sum = 0.f;
#pragma unroll
    for (int r = 0; r < 16; ++r) { p0[r] = fast_exp2(p0[r]); p1[r] = fast_exp2(p1[r]); sum += p0[r] + p1[r]; }
    l += sum;
#pragma unroll
    for (int s = 0; s < 2; ++s) {
        u32x4 a, b;
        a.x = cvtpk(p0[8 * s], p0[8 * s + 1]); a.y = cvtpk(p0[8 * s + 2], p0[8 * s + 3]); a.z = cvtpk(p0[8 * s + 4], p0[8 * s + 5]); a.w = cvtpk(p0[8 * s + 6], p0[8 * s + 7]);
        b.x = cvtpk(p1[8 * s], p1[8 * s + 1]); b.y = cvtpk(p1[8 * s + 2], p1[8 * s + 3]); b.z = cvtpk(p1[8 * s + 4], p1[8 * s + 5]); b.w = cvtpk(p1[8 * s + 6], p1[8 * s + 7]);
        pf[s] = __builtin_bit_cast(bf16x8, a); pf[2 + s] = __builtin_bit_cast(bf16x8, b);
    }
}
template <int NO> __device__ __forceinline__ void softmax_step_dm2(f32x16& p0, f32x16& p1, float& mref, float& l, f32x16 (&o)[NO], bf16x8 (&pf)[4]) {
    constexpr float THR = 8.f;
    float mx = halfmax(rowmax32(p0, p1)) - mref;
    if (__any(mx > THR)) {
        const float dl = fmaxf(mx, 0.f), al = fast_exp2(-dl);
        mref += dl; l *= al;
#pragma unroll
        for (int d = 0; d < NO; ++d)
#pragma unroll
            for (int r = 0; r < 16; ++r) o[d][r] *= al;
    }
    float sum = 0.f;
#pragma unroll
    for (int r = 0; r < 16; ++r) { p0[r] = fast_exp2(p0[r] - mref); p1[r] = fast_exp2(p1[r] - mref); sum += p0[r] + p1[r]; }
    l += sum;
#pragma unroll
    for (int s = 0; s < 2; ++s) {
        u32x4 a, b;
        a.x = cvtpk(p0[8 * s], p0[8 * s + 1]); a.y = cvtpk(p0[8 * s + 2], p0[8 * s + 3]); a.z = cvtpk(p0[8 * s + 4], p0[8 * s + 5]); a.w = cvtpk(p0[8 * s + 6], p0[8 * s + 7]);
        b.x = cvtpk(p1[8 * s], p1[8 * s + 1]); b.y = cvtpk(p1[8 * s + 2], p1[8 * s + 3]); b.z = cvtpk(p1[8 * s + 4], p1[8 * s + 5]); b.w = cvtpk(p1[8 * s + 6], p1[8 * s + 7]);
        pf[s] = __builtin_bit_cast(bf16x8, a); pf[2 + s] = __builtin_bit_cast(bf16x8, b);
    }
}
template <int NO> __device__ __forceinline__ void softmax_step(f32x16& p0, f32x16& p1, float& m, float& l, f32x16 (&o)[NO], bf16x8 (&pf)[4]) {
    float mx = halfmax(rowmax32(p0, p1));
    const float mn = fmaxf(m, mx), mu = (mn == -INFINITY) ? 0.f : mn;
    const float al = fast_exp2(m - mu);
    float sum = 0.f;
#pragma unroll
    for (int r = 0; r < 16; ++r) { p0[r] = fast_exp2(p0[r] - mu); p1[r] = fast_exp2(p1[r] - mu); sum += p0[r] + p1[r]; }
    l = l * al + sum; m = mn;
#pragma unroll
    for (int d = 0; d < NO; ++d)
#pragma unroll
        for (int r = 0; r < 16; ++r) o[d][r] *= al;
#pragma unroll
    for (int s = 0; s < 2; ++s) {
        u32x4 a, b;
        a.x = cvtpk(p0[8 * s], p0[8 * s + 1]); a.y = cvtpk(p0[8 * s + 2], p0[8 * s + 3]); a.z = cvtpk(p0[8 * s + 4], p0[8 * s + 5]); a.w = cvtpk(p0[8 * s + 6], p0[8 * s + 7]);
        b.x = cvtpk(p1[8 * s], p1[8 * s + 1]); b.y = cvtpk(p1[8 * s + 2], p1[8 * s + 3]); b.z = cvtpk(p1[8 * s + 4], p1[8 * s + 5]); b.w = cvtpk(p1[8 * s + 6], p1[8 * s + 7]);
        pf[s] = __builtin_bit_cast(bf16x8, a); pf[2 + s] = __builtin_bit_cast(bf16x8, b);
    }
}
template <int NO, int VSTR> __device__ __forceinline__ void pv(f32x16 (&o)[NO], const LAS char* Vl, const bf16x8 (&pf)[4], int lane) {
    const LAS char* vb = Vl + (4 * (lane >> 5) + ((lane & 15) >> 2)) * VSTR + (16 * ((lane >> 4) & 1) + 4 * (lane & 3)) * 2;
#pragma unroll
    for (int d = 0; d < NO; ++d)
#pragma unroll
        for (int ks = 0; ks < 4; ++ks) {
            const s16x4 lo = vtr(vb + (16 * ks) * VSTR + d * 64), hi = vtr(vb + (16 * ks + 8) * VSTR + d * 64);
            const bf16x8 vf = (bf16x8){lo[0], lo[1], lo[2], lo[3], hi[0], hi[1], hi[2], hi[3]};
            o[d] = __builtin_amdgcn_mfma_f32_32x32x16_bf16(vf, pf[ks], o[d], 0, 0, 0);
        }
}
template <int NO, int VSTR, int KS0, int KS1> __device__ __forceinline__ void pv_ks(f32x16 (&o)[NO], const LAS char* Vl, const bf16x8 (&pf)[4], int lane) {
    const LAS char* vb = Vl + (4 * (lane >> 5) + ((lane & 15) >> 2)) * VSTR + (16 * ((lane >> 4) & 1) + 4 * (lane & 3)) * 2;
#pragma unroll
    for (int d = 0; d < NO; ++d)
#pragma unroll
        for (int ks = KS0; ks < KS1; ++ks) {
            const s16x4 lo = vtr(vb + (16 * ks) * VSTR + d * 64), hi = vtr(vb + (16 * ks + 8) * VSTR + d * 64);
            const bf16x8 vf = (bf16x8){lo[0], lo[1], lo[2], lo[3], hi[0], hi[1], hi[2], hi[3]};
            o[d] = __builtin_amdgcn_mfma_f32_32x32x16_bf16(vf, pf[ks], o[d], 0, 0, 0);
        }
}
__device__ __forceinline__ float rowmax16(const f32x16& p) {
    float a = max3f(p[0], p[1], p[2]), b = max3f(p[3], p[4], p[5]);
    a = max3f(a, p[6], p[7]); b = max3f(b, p[8], p[9]); a = max3f(a, p[10], p[11]); b = max3f(b, p[12], p[13]); a = max3f(a, p[14], p[15]);
    return max2f(a, b);
}
template <int NO> __device__ __forceinline__ void store_o(const f32x16 (&o)[NO], float inv, bf16* rowp, int hi) {
#pragma unroll
    for (int d = 0; d < NO; ++d)
#pragma unroll
        for (int g = 0; g < 4; g += 2) {
            u32x2 a, b;
            a.x = cvtpk(o[d][4 * g] * inv, o[d][4 * g + 1] * inv); a.y = cvtpk(o[d][4 * g + 2] * inv, o[d][4 * g + 3] * inv);
            b.x = cvtpk(o[d][4 * g + 4] * inv, o[d][4 * g + 5] * inv); b.y = cvtpk(o[d][4 * g + 6] * inv, o[d][4 * g + 7] * inv);
            { auto r = __builtin_amdgcn_permlane32_swap(a.x, b.x, false, false); a.x = r[0]; b.x = r[1]; }
            { auto r = __builtin_amdgcn_permlane32_swap(a.y, b.y, false, false); a.y = r[0]; b.y = r[1]; }
            u32x4 w; w.x = a.x; w.y = a.y; w.z = b.x; w.w = b.y;
            OUT_ST16(rowp + 32 * d + 8 * g + 8 * hi, w); }
}
}

__device__ __forceinline__ void diff_unit(const P& p, int b, int h, int qb, LAS unsigned char* ldsu, float lam) {
    constexpr int KSTR = 144, VSTR = 320, KB = 64 * KSTR, VB = 64 * VSTR, BUF = 2 * KB + VB;
    LAS char* lds = (LAS char*)ldsu;
    const int tid = threadIdx.x, lane = tid & 63, wid = __builtin_amdgcn_readfirstlane(tid >> 6), hi = lane >> 5;
    const int comp = wid >> 2, w4 = wid & 3;
    const bf16* proj = (const bf16*)(p.ws + WS_PROJ);
    const size_t rb = (size_t)b * SEQ;
    const int q0 = qb * 128, qmin = q0 + 32 * w4, qpos = qmin + (lane & 31);
    bf16x8 qf[4];
#pragma unroll
    for (int ds = 0; ds < 4; ++ds) qf[ds] = *(const bf16x8*)(proj + (rb + qpos) * INW + 1536 + h * 128 + comp * 64 + ds * 16 + hi * 8);
    const int ntiles = 2 * qb + 2;
    const int krow = tid >> 3, kch = tid & 7;
    const bf16* ksrc = proj + (rb + krow) * INW + 2048 + h * 128 + kch * 8;
    const int vrow0 = tid >> 4, vch = tid & 15;
    const bf16* vsrc = proj + (rb + vrow0) * INW + 2560 + h * 128 + vch * 8;
    const int kdst = krow * KSTR + kch * 16, vdst = 2 * KB + vrow0 * VSTR + vch * 16;
    u32x4 rk0, rk1, rv0, rv1;
    { rk0 = *(const u32x4*)(ksrc); rk1 = *(const u32x4*)(ksrc + 64); rv0 = *(const u32x4*)(vsrc); rv1 = *(const u32x4*)(vsrc + (size_t)32 * INW); }
    *(LAS u32x4*)(lds + kdst) = rk0; *(LAS u32x4*)(lds + KB + kdst) = rk1; *(LAS u32x4*)(lds + vdst) = rv0; *(LAS u32x4*)(lds + vdst + 32 * VSTR) = rv1;
    __syncthreads();
    float mref = 0.f, l = 0.f; f32x16 o[4]; f32x16 negm;
#pragma unroll
    for (int r = 0; r < 16; ++r) negm[r] = 0.f;
#pragma unroll
    for (int d = 0; d < 4; ++d)
#pragma unroll
        for (int r = 0; r < 16; ++r) o[d][r] = 0.f;
    for (int kt = 0; kt < ntiles; ++kt) {
        const bool more = kt + 1 < ntiles;
        if (more) { const size_t off = (size_t)(kt + 1) * 64 * INW; rk0 = *(const u32x4*)(ksrc + off); rk1 = *(const u32x4*)(ksrc + off + 64); rv0 = *(const u32x4*)(vsrc + off); rv1 = *(const u32x4*)(vsrc + off + (size_t)32 * INW); }
        const LAS char* buf = lds + (kt & 1) * BUF;
        const int k0 = kt * 64;
        if (k0 <= qmin + 31) {
            const LAS char* Kl = buf + comp * KB;
            f32x16 p0 = fa::qk_c<4, KSTR>(Kl, 0, qf, lane, negm), p1 = fa::qk_c<4, KSTR>(Kl, 1, qf, lane, negm);
            if (k0 + 63 > qmin) {
#pragma unroll
                for (int r = 0; r < 16; ++r) { const int key = k0 + fa::crow(r, hi); if (key > qpos) p0[r] = -INFINITY; if (key + 32 > qpos) p1[r] = -INFINITY; }
            }
            bf16x8 pf[4];
            fa::softmax_step_dm<4>(p0, p1, mref, negm, l, o, pf);
            fa::pv<4, VSTR>(o, buf + 2 * KB, pf, lane);
        }
        if (more) { LAS char* nb = lds + ((kt + 1) & 1) * BUF; *(LAS u32x4*)(nb + kdst) = rk0; *(LAS u32x4*)(nb + KB + kdst) = rk1; *(LAS u32x4*)(nb + vdst) = rv0; *(LAS u32x4*)(nb + vdst + 32 * VSTR) = rv1; }
        __syncthreads();
    }
    l = fa::halfsum(l);
    const float inv = fast_rcp(l);
    LAS float* ex = (LAS float*)lds + w4 * 4096;
    if (comp == 1) {
#pragma unroll
        for (int d = 0; d < 4; ++d)
#pragma unroll
            for (int r = 0; r < 16; ++r) ex[(d * 16 + r) * 64 + lane] = o[d][r] * inv;
    }
    __syncthreads();
    if (comp == 0) {
        float ss = 0.f;
#pragma unroll
        for (int d = 0; d < 4; ++d)
#pragma unroll
            for (int r = 0; r < 16; ++r) { const float v = o[d][r] * inv - lam * ex[(d * 16 + r) * 64 + lane]; o[d][r] = v; ss += v * v; }
        ss = fa::halfsum(ss);
        const float rs = rsqrtf(ss * (1.f / 128.f) + SUBLN_EPS) * (1.f - LAMBDA_INIT);
        bf16* rowp = (bf16*)(p.ws + WS_MIXIN) + (rb + qpos) * DM + 512 + h * 128;
#pragma unroll
        for (int d = 0; d < 4; ++d)
#pragma unroll
            for (int g = 0; g < 4; ++g) { const int dd = 32 * d + 8 * g + 4 * hi; const f32x4 gg = *(const f32x4*)(p.subln_g + dd);
                u32x2 w; w.x = cvtpk(o[d][4 * g] * rs * gg[0], o[d][4 * g + 1] * rs * gg[1]); w.y = cvtpk(o[d][4 * g + 2] * rs * gg[2], o[d][4 * g + 3] * rs * gg[3]);
                *(u32x2*)(rowp + dd) = w; }
    }
    __syncthreads();
}

struct DilGeo { int b, h, br, dil, res, i0; };
__device__ __forceinline__ DilGeo dil_decode(int u) { DilGeo g; const int grp = u & 15, t3 = u >> 4; g.br = t3 % 3; const int bh = t3 / 3; g.b = bh >> 3; g.h = bh & 7;
    g.dil = g.br == 0 ? 1 : (g.br == 1 ? 4 : 16); const int ngr = 16 / g.dil; g.res = grp / ngr; g.i0 = 256 * (grp % ngr); return g; }
template <int SK, int KSTR, int VSTR, int KALL> __device__ __forceinline__ void dil_compute(const LAS char* lds, int kt0, int i0, int qi, const bf16x8 (&qf)[4], int lane, int hi, f32x16 (&o)[2], float& m, float& l) {
    f32x16 sc[6];
#pragma unroll
    for (int kk = 0; kk < 3; ++kk) {
        const LAS char* Kl = lds + (kt0 + kk) * 64 * KSTR;
        const int kb = i0 - 128 + 64 * (kt0 + kk);
#pragma unroll
        for (int j = 0; j < 2; ++j) {
            if (2 * kk + j == SK) continue;
            sc[2 * kk + j] = fa::qk<4, KSTR>(Kl, j, qf, lane);
            if (kk != 1 || kb < 0) {
#pragma unroll
                for (int r = 0; r < 16; ++r) { const int ki = kb + 32 * j + fa::crow(r, hi); if (ki < 0 || ki > qi || qi - ki > 128) sc[2 * kk + j][r] = -INFINITY; }
            }
        }
    }
    m = SK == 0 ? fa::max3f(fa::rowmax16(sc[1]), fa::rowmax32(sc[2], sc[3]), fa::rowmax32(sc[4], sc[5])) : fa::max3f(fa::rowmax32(sc[0], sc[1]), fa::rowmax32(sc[2], sc[3]), fa::rowmax16(sc[4]));
    m = fa::halfmax(m);
    l = 0.f;
#pragma unroll
    for (int t = 0; t < 6; ++t) { if (t == SK) continue;
#pragma unroll
        for (int r = 0; r < 16; ++r) { sc[t][r] = fast_exp2(sc[t][r] - m); l += sc[t][r]; } }
    l = fa::halfsum(l);
#pragma unroll
    for (int d = 0; d < 2; ++d)
#pragma unroll
        for (int r = 0; r < 16; ++r) o[d][r] = 0.f;
#pragma unroll
    for (int kk = 0; kk < 3; ++kk) {
        bf16x8 pf[4];
#pragma unroll
        for (int j = 0; j < 2; ++j) { if (2 * kk + j == SK) continue;
#pragma unroll
            for (int s2 = 0; s2 < 2; ++s2) { const f32x16& q = sc[2 * kk + j]; u32x4 a;
                a.x = cvtpk(q[8 * s2], q[8 * s2 + 1]); a.y = cvtpk(q[8 * s2 + 2], q[8 * s2 + 3]); a.z = cvtpk(q[8 * s2 + 4], q[8 * s2 + 5]); a.w = cvtpk(q[8 * s2 + 6], q[8 * s2 + 7]);
                pf[2 * j + s2] = __builtin_bit_cast(bf16x8, a); } }
        const LAS char* Vl = lds + KALL + (kt0 + kk) * 64 * VSTR;
        if (SK == 0 && kk == 0) fa::pv_ks<2, VSTR, 2, 4>(o, Vl, pf, lane);
        else if (SK == 5 && kk == 2) fa::pv_ks<2, VSTR, 0, 2>(o, Vl, pf, lane);
        else fa::pv<2, VSTR>(o, Vl, pf, lane);
    }
}
__device__ __forceinline__ void dil_phase(const P& p, int u0, int ustride, int nunits, LAS unsigned char* ldsu) {
    constexpr int KSTR = 144, VSTR = 192, KALL = 384 * KSTR;
    LAS char* lds = (LAS char*)ldsu;
    const int tid = threadIdx.x, lane = tid & 63, wid = __builtin_amdgcn_readfirstlane(tid >> 6), hi = lane >> 5;
    const bf16* proj = (const bf16*)(p.ws + WS_PROJ);
    int u = u0; if (u >= nunits) return;
    DilGeo g = dil_decode(u);
    u32x4 rk[6], rv[6]; bf16x8 qf[4], qn[4];
#define DIL_LOAD(G, QF) do { const size_t rb_ = (size_t)(G).b * SEQ; \
        _Pragma("unroll") for (int i = 0; i < 6; ++i) { const int pidx = tid + 512 * i, row = pidx >> 3, ch = pidx & 7; int kidx = (G).i0 - 128 + row; if (kidx < 0) kidx = 0; \
            const bf16* src = proj + (rb_ + (size_t)kidx * (G).dil + (G).res) * INW + (G).h * 64 + ch * 8; rk[i] = *(const u32x4*)(src + 512); rv[i] = *(const u32x4*)(src + 1024); } \
        { const size_t qrow_ = rb_ + (size_t)((G).i0 + 32 * wid + (lane & 31)) * (G).dil + (G).res; \
          _Pragma("unroll") for (int ds = 0; ds < 4; ++ds) QF[ds] = *(const bf16x8*)(proj + qrow_ * INW + (G).h * 64 + ds * 16 + hi * 8); } } while (0)
    DIL_LOAD(g, qf);
    for (;;) {
#pragma unroll
        for (int i = 0; i < 6; ++i) { const int pidx = tid + 512 * i, row = pidx >> 3, ch = pidx & 7; *(LAS u32x4*)(lds + row * KSTR + ch * 16) = rk[i]; *(LAS u32x4*)(lds + KALL + row * VSTR + ch * 16) = rv[i]; }
        __syncthreads();
        const int un = u + ustride; const bool more = un < nunits;
        DilGeo gn = g; if (more) { gn = dil_decode(un); DIL_LOAD(gn, qn); }
        const int qi = g.i0 + 32 * wid + (lane & 31);
        const size_t qrow = (size_t)g.b * SEQ + (size_t)qi * g.dil + g.res;
        f32x16 o[2]; float m, l;
        const int kt0 = wid >> 1;
        if (wid & 1) dil_compute<0, KSTR, VSTR, KALL>(lds, kt0, g.i0, qi, qf, lane, hi, o, m, l);
        else dil_compute<5, KSTR, VSTR, KALL>(lds, kt0, g.i0, qi, qf, lane, hi, o, m, l);
        const float inv = fast_rcp(l);
        fa::store_o<2>(o, inv, (bf16*)(p.ws + WS_PARTA) + ((size_t)g.br * T + qrow) * 512 + g.h * 64, hi);
        if (hi == 0) ((float*)(p.ws + WS_LSEA))[((size_t)g.br * T + qrow) * 8 + g.h] = m + log2f(l);
        __syncthreads();
        if (!more) break;
        u = un; g = gn;
#pragma unroll
        for (int ds = 0; ds < 4; ++ds) qf[ds] = qn[ds];
    }
#undef DIL_LOAD
}

__device__ __forceinline__ void mem_unit(const P& p, int b, int h, int qblk, LAS unsigned char* ldsu) {
    constexpr int KSTR = 528, VSTR = 320, KB = 64 * KSTR, VB = 64 * VSTR;
    LAS char* lds = (LAS char*)ldsu;
    int tid_ = threadIdx.x; asm volatile("" : "+v"(tid_));
    const int tid = tid_, lane = tid & 63, wid = __builtin_amdgcn_readfirstlane(tid >> 6), hi = lane >> 5;
    const bf16* qm = (const bf16*)(p.ws + WS_QM); const bf16* kvm = (const bf16*)(p.ws + WS_KVM);
    const size_t qrow = (size_t)b * SEQ + qblk * 256 + 32 * wid + (lane & 31);
    const bf16* kbase = kvm + (size_t)(b * MEML) * 2048 + h * 256;
    const bf16* vbase = kbase + 1024;
    u32x4 rr[4];
#define MEMK_LOAD(kt) do { _Pragma("unroll") for (int i = 0; i < 4; ++i) { const int pidx = tid + 512 * i, row = pidx >> 5, ch = pidx & 31; rr[i] = *(const u32x4*)(kbase + (size_t)((kt) * 64 + row) * 2048 + ch * 8); } } while (0)
#define MEMK_WRITE(bufp) do { _Pragma("unroll") for (int i = 0; i < 4; ++i) { const int pidx = tid + 512 * i, row = pidx >> 5, ch = pidx & 31; *(LAS u32x4*)((bufp) + row * KSTR + ch * 16) = rr[i]; } } while (0)
#define MEMV_LOAD(hf, kt) do { _Pragma("unroll") for (int i = 0; i < 2; ++i) { const int pidx = tid + 512 * i, row = pidx >> 4, ch = pidx & 15; rr[i] = *(const u32x4*)(vbase + (hf) * 128 + (size_t)((kt) * 64 + row) * 2048 + ch * 8); } } while (0)
#define MEMV_WRITE(bufp) do { _Pragma("unroll") for (int i = 0; i < 2; ++i) { const int pidx = tid + 512 * i, row = pidx >> 4, ch = pidx & 15; *(LAS u32x4*)((bufp) + row * VSTR + ch * 16) = rr[i]; } } while (0)
    bf16x8 pf[16];
    float l;
    {
        f32x16 sc[8];
#pragma unroll
        for (int t = 0; t < 8; ++t)
#pragma unroll
            for (int r = 0; r < 16; ++r) sc[t][r] = 0.f;
        MEMK_LOAD(0); MEMK_WRITE(lds);
        __syncthreads();
#pragma unroll
        for (int dh = 0; dh < 2; ++dh) {
            bf16x8 qf[8];
#pragma unroll
            for (int ds = 0; ds < 8; ++ds) qf[ds] = *(const bf16x8*)(qm + qrow * DM + h * 256 + dh * 128 + ds * 16 + hi * 8);
#pragma unroll
            for (int kt = 0; kt < 4; ++kt) {
                const int step = dh * 4 + kt;
                if (step < 7) MEMK_LOAD((step + 1) & 3);
                const LAS char* buf = lds + (step & 1) * KB + dh * 256;
                sc[2 * kt] = fa::qk_c<8, KSTR>(buf, 0, qf, lane, sc[2 * kt]); sc[2 * kt + 1] = fa::qk_c<8, KSTR>(buf, 1, qf, lane, sc[2 * kt + 1]);
                if (step < 7) { MEMK_WRITE(lds + ((step + 1) & 1) * KB); }
                __syncthreads();
            }
        }
        MEMV_LOAD(0, 0);
        float mx = fa::max2f(fa::max2f(fa::rowmax32(sc[0], sc[1]), fa::rowmax32(sc[2], sc[3])), fa::max2f(fa::rowmax32(sc[4], sc[5]), fa::rowmax32(sc[6], sc[7])));
        mx = fa::halfmax(mx);
        float sum = 0.f;
#pragma unroll
        for (int t = 0; t < 8; ++t)
#pragma unroll
            for (int r = 0; r < 16; ++r) { sc[t][r] = fast_exp2(sc[t][r] - mx); sum += sc[t][r]; }
        l = fa::halfsum(sum);
#pragma unroll
        for (int t = 0; t < 8; ++t)
#pragma unroll
            for (int s2 = 0; s2 < 2; ++s2) { u32x4 a;
                a.x = cvtpk(sc[t][8 * s2], sc[t][8 * s2 + 1]); a.y = cvtpk(sc[t][8 * s2 + 2], sc[t][8 * s2 + 3]); a.z = cvtpk(sc[t][8 * s2 + 4], sc[t][8 * s2 + 5]); a.w = cvtpk(sc[t][8 * s2 + 6], sc[t][8 * s2 + 7]);
                pf[2 * t + s2] = __builtin_bit_cast(bf16x8, a); }
    }
    const float inv = fast_rcp(l);
    MEMV_WRITE(lds);
    __syncthreads();
#pragma unroll
    for (int hf = 0; hf < 2; ++hf) {
        f32x16 o[4];
#pragma unroll
        for (int d = 0; d < 4; ++d)
#pragma unroll
            for (int r = 0; r < 16; ++r) o[d][r] = 0.f;
#pragma unroll
        for (int kt = 0; kt < 4; ++kt) {
            const int step = hf * 4 + kt;
            if (step < 7) MEMV_LOAD((step + 1) >> 2, (step + 1) & 3);
            const bf16x8 pk[4] = {pf[4 * kt], pf[4 * kt + 1], pf[4 * kt + 2], pf[4 * kt + 3]};
            fa::pv<4, VSTR>(o, lds + (step & 1) * VB, pk, lane);
            if (step < 7) { MEMV_WRITE(lds + ((step + 1) & 1) * VB); }
            __syncthreads();
        }
        fa::store_o<4>(o, inv, (bf16*)(p.ws + WS_MO) + qrow * DM + h * 256 + hf * 128, hi);
    }
#undef MEMK_LOAD
#undef MEMK_WRITE
#undef MEMV_LOAD
#undef MEMV_WRITE
}

struct Ctx { int tid, lane, wave, G, vcu, gw, ngw; LAS unsigned char* lds; };

template <class RowMap> __device__ __forceinline__ void transpose_tile(const float* W, int N, int k0, int n0, bf16* dst, int dstK, LAS float* scr, int lane, const RowMap& rm) {
    f32x4 v[16];
#pragma unroll
    for (int i = 0; i < 16; ++i) v[i] = *(const f32x4*)(W + (size_t)(k0 + 4 * i + (lane >> 4)) * N + n0 + (lane & 15) * 4);
#pragma unroll
    for (int i = 0; i < 16; ++i) { LAS float* s = scr + (4 * i + (lane >> 4)) * 65 + (lane & 15) * 4; s[0] = v[i][0]; s[1] = v[i][1]; s[2] = v[i][2]; s[3] = v[i][3]; }
    asm volatile("s_waitcnt lgkmcnt(0)" ::: "memory");
    const int c = lane & 7;
#pragma unroll
    for (int j = 0; j < 8; ++j) { const int n = (lane >> 3) + 8 * j; const LAS float* s = scr + (8 * c) * 65 + n;
        u32x4 w; w.x = cvtpk(s[0], s[65]); w.y = cvtpk(s[2 * 65], s[3 * 65]); w.z = cvtpk(s[4 * 65], s[5 * 65]); w.w = cvtpk(s[6 * 65], s[7 * 65]);
        *(u32x4*)(dst + (size_t)rm(n0 + n) * dstK + k0 + 8 * c) = w; }
    asm volatile("s_waitcnt lgkmcnt(0)" ::: "memory");
}
template <int N> __device__ __forceinline__ void tile_load_n(const float* W, int k0, int n0, int lane, f32x4 (&v)[16]) {
    const __amdgpu_buffer_rsrc_t rs = __builtin_amdgcn_make_buffer_rsrc((void*)W, 0, 0x7ffff000, 0x00020000);
    const int voff = ((64 * (lane >> 5)) * N + (lane & 31)) * 4, sbase = (k0 * N + n0) * 4;
#pragma unroll
    for (int i = 0; i < 64; ++i) v[i >> 2][i & 3] = __uint_as_float(__builtin_amdgcn_raw_buffer_load_b32(rs, voff, sbase + i * N * 4, 2));
}
__device__ __forceinline__ void tile_load(const float* W, int N, int k0, int n0, int lane, f32x4 (&v)[16]) {
    if (N == EDIM) tile_load_n<EDIM>(W, k0, n0, lane, v); else tile_load_n<DM>(W, k0, n0, lane, v);
}
__device__ __forceinline__ void tile_store8(const f32x4 (&v)[16], int k0, unsigned char* dstrow0, int dstK, int rowmul  , int rowadd, LAS float* scr, int lane, float sc) {
    LAS unsigned char* sb = (LAS unsigned char*)scr;
    LAS unsigned char* wp = sb + (lane & 31) * 144 + 64 * (lane >> 5);
#pragma unroll
    for (int q = 0; q < 4; ++q) { int t[4];
#pragma unroll
        for (int m = 0; m < 4; ++m) { const f32x4 x = v[4 * q + m]; int tt = 0; tt = __builtin_amdgcn_cvt_pk_fp8_f32(x[0] * sc, x[1] * sc, tt, false); tt = __builtin_amdgcn_cvt_pk_fp8_f32(x[2] * sc, x[3] * sc, tt, true); t[m] = tt; }
        u32x4 w; w.x = (unsigned)t[0]; w.y = (unsigned)t[1]; w.z = (unsigned)t[2]; w.w = (unsigned)t[3];
        *(LAS u32x4*)(wp + 16 * q) = w; }
    asm volatile("s_waitcnt lgkmcnt(0)" ::: "memory");
    const int c = lane & 7;
#pragma unroll
    for (int j = 0; j < 4; ++j) { const int n = (lane >> 3) + 8 * j;
        const u32x4 w = *(const LAS u32x4*)(sb + n * 144 + 16 * c);
        const int drow = rowadd + (rowmul ? n : 16 * (n >> 3) + (n & 7));
        __builtin_nontemporal_store(w, (u32x4*)(dstrow0 + (size_t)drow * dstK + k0 + 16 * c)); }
    asm volatile("s_waitcnt lgkmcnt(0)" ::: "memory");
}
struct EItem { const float* W; int N, k0, n0, dstK, rowadd, rowmul; unsigned char* dst; float sc; };
__device__ __forceinline__ EItem eitem_decode(const P& p, int r) {
    constexpr int I_E = 64; EItem it;
    const int e = r / (3 * I_E), q = r % (3 * I_E), which = q / I_E, ti = q % I_E;
    if (which == 0) { it.W = e < NEXP ? p.w_gate + (size_t)e * DM * EDIM : p.ws_gate; it.N = EDIM; it.k0 = (ti / 8) * 128; it.n0 = (ti % 8) * 32; it.dst = (unsigned char*)(p.ws + WS_WTGU) + (size_t)e * 512 * DM; it.dstK = DM;
        it.rowadd = (it.n0 >> 7) * 256 + 64 * ((it.n0 & 127) >> 5); it.rowmul = 0; it.sc = gm::W8_SCALE; }
    else if (which == 1) { it.W = e < NEXP ? p.w_up + (size_t)e * DM * EDIM : p.ws_up; it.N = EDIM; it.k0 = (ti / 8) * 128; it.n0 = (ti % 8) * 32; it.dst = (unsigned char*)(p.ws + WS_WTGU) + (size_t)e * 512 * DM; it.dstK = DM;
        it.rowadd = (it.n0 >> 7) * 256 + 64 * ((it.n0 & 127) >> 5) + 8; it.rowmul = 0; it.sc = gm::W8_SCALE; }
    else { it.W = e < NEXP ? p.w_down + (size_t)e * EDIM * DM : p.ws_down; it.N = DM; it.k0 = (ti / 32) * 128; it.n0 = (ti % 32) * 32; it.dst = (unsigned char*)(p.ws + WS_WTD) + (size_t)e * DM * EDIM; it.dstK = EDIM; it.rowadd = it.n0; it.rowmul = 1; it.sc = gm::WD8_SCALE; }
    return it;
}
__device__ __forceinline__ void transpose_tile_ln(const float* W, int N, int k0, int n0, bf16* dst, int dstK, LAS float* scr, int lane, const float* g, const float* b, float* sn, float* cn) {
    f32x4 v[16];
#pragma unroll
    for (int i = 0; i < 16; ++i) v[i] = *(const f32x4*)(W + (size_t)(k0 + 4 * i + (lane >> 4)) * N + n0 + (lane & 15) * 4);
#pragma unroll
    for (int i = 0; i < 16; ++i) { LAS float* s = scr + (4 * i + (lane >> 4)) * 65 + (lane & 15) * 4; s[0] = v[i][0]; s[1] = v[i][1]; s[2] = v[i][2]; s[3] = v[i][3]; }
    asm volatile("s_waitcnt lgkmcnt(0)" ::: "memory");
    const int c = lane & 7;
    float gk[8];
#pragma unroll
    for (int e = 0; e < 8; ++e) gk[e] = g[k0 + 8 * c + e];
#pragma unroll
    for (int j = 0; j < 8; ++j) { const int n = (lane >> 3) + 8 * j; const LAS float* s = scr + (8 * c) * 65 + n;
        u32x4 w; w.x = cvtpk(s[0] * gk[0], s[65] * gk[1]); w.y = cvtpk(s[2 * 65] * gk[2], s[3 * 65] * gk[3]); w.z = cvtpk(s[4 * 65] * gk[4], s[5 * 65] * gk[5]); w.w = cvtpk(s[6 * 65] * gk[6], s[7 * 65] * gk[7]);
        *(u32x4*)(dst + (size_t)(n0 + n) * dstK + k0 + 8 * c) = w; }
    float sa = 0.f, sb = 0.f;
#pragma unroll 8
    for (int k = 0; k < 64; ++k) { const float wv = scr[k * 65 + lane]; const float gw = wv * g[k0 + k]; sa += __uint_as_float((cvtpk(gw, 0.f) & 0xffffu) << 16); sb += wv * b[k0 + k]; }
    atomicAdd(sn + n0 + lane, sa); atomicAdd(cn + n0 + lane, sb);
    asm volatile("s_waitcnt lgkmcnt(0)" ::: "memory");
}
struct RmId { __device__ int operator()(int n) const { return n; } };
struct RmInProj { __device__ int operator()(int n) const { const int seg = n >> 9; if (seg == 2 || seg == 5) return n; const int d = n & 63; return (n & ~63) | (d < 16 ? 2 * (d & 7) + (d >> 3) : d); } };
struct RmGU { int up; __device__ int operator()(int n) const { return (n >> 7) * 256 + up * 128 + (n & 127); } };

__device__ __forceinline__ int etick(int* ctr, int lane) { int v = 0; if (lane == 0) v = __hip_atomic_fetch_add(ctr, 1, __ATOMIC_RELAXED, __HIP_MEMORY_SCOPE_AGENT); return __builtin_amdgcn_readfirstlane(v); }
constexpr int ECONV_NCH = 3 * 64 * (NEXP + 1) / ECHUNK_CFG;
__device__ __forceinline__ void prologue_experts(const P& p, const Ctx& c, int* ctr, const int ch_lo, const int NCH  ) {
    LAS float* scr = (LAS float*)(c.lds + c.wave * 16896);
    constexpr int NE = 3 * 64 * (NEXP + 1), CH = ECHUNK_CFG;
    static_assert(NE % CH == 0, "chunking");
    const int ch = ch_lo + etick(ctr, c.lane); f32x4 va[16], vb[16], vc[16]; EItem e0, e1, e2;
    if (ch >= NCH) return;
    int chn = ch_lo + etick(ctr, c.lane);
    int it = ch * CH, k = 0; bool have1 = true, have2 = true;
    auto advance = [&](bool& have) { if (++k == CH) { k = 0; have = chn < NCH; it = chn * CH; if (have) chn = ch_lo + etick(ctr, c.lane); } else ++it; };
    e0 = eitem_decode(p, it); tile_load(e0.W, e0.N, e0.k0, e0.n0, c.lane, va);
    advance(have1);
    if (have1) { e1 = eitem_decode(p, it); tile_load(e1.W, e1.N, e1.k0, e1.n0, c.lane, vb); }
    while (true) {
        have2 = have1;
        if (have1) { advance(have2); if (have2) { e2 = eitem_decode(p, it); tile_load(e2.W, e2.N, e2.k0, e2.n0, c.lane, vc); } }
        tile_store8(va, e0.k0, e0.dst, e0.dstK, e0.rowmul, e0.rowadd, scr, c.lane, e0.sc);
        if (!have1) break;
        e0 = e1; e1 = e2; have1 = have2;
#pragma unroll
        for (int i = 0; i < 16; ++i) { va[i] = vb[i]; vb[i] = vc[i]; }
    }
}
__device__ __forceinline__ void phase_prologue(const P& p, const Ctx& c) {
    LAS float* scr = (LAS float*)(c.lds + c.wave * 16896);
    unsigned char* ws = p.ws;
    constexpr int I_IN = 16 * 48, I_SQ = 16 * 16, I_KV = 16 * 32, I_R = 16 * 4, I_E = 64;
    constexpr int ND = I_IN + 3 * I_SQ + I_KV + I_R;
    for (int it = c.gw; it < ND; it += c.ngw) {
        int r = it;
        if (r < I_IN) { transpose_tile(p.w_in, INW, (r / 48) * 64, (r % 48) * 64, (bf16*)(ws + WS_WINT), DM, scr, c.lane, RmInProj{}); continue; } r -= I_IN;
        if (r < I_SQ) { transpose_tile(p.w_out, DM, (r / 16) * 64, (r % 16) * 64, (bf16*)(ws + WS_WOUTT), DM, scr, c.lane, RmId{}); continue; } r -= I_SQ;
        if (r < I_SQ) { transpose_tile_ln(p.wq, DM, (r / 16) * 64, (r % 16) * 64, (bf16*)(ws + WS_WQT), DM, scr, c.lane, p.ln1_g, p.ln1_b, (float*)(ws + WS_SN), (float*)(ws + WS_CN)); continue; } r -= I_SQ;
        if (r < I_KV) { transpose_tile(p.wkv, 2048, (r / 32) * 64, (r % 32) * 64, (bf16*)(ws + WS_WKVT), DM, scr, c.lane, RmId{}); continue; } r -= I_KV;
        if (r < I_SQ) { transpose_tile(p.wo, DM, (r / 16) * 64, (r % 16) * 64, (bf16*)(ws + WS_WOT), DM, scr, c.lane, RmId{}); continue; } r -= I_SQ;
        if (LN2_FOLD) transpose_tile_ln(p.w_router, NEXP, (r / 4) * 64, (r % 4) * 64, (bf16*)(ws + WS_WRT), DM, scr, c.lane, p.ln2_g, p.ln2_b, (float*)(ws + WS_SN2), (float*)(ws + WS_CN2));
        else transpose_tile(p.w_router, NEXP, (r / 4) * 64, (r % 4) * 64, (bf16*)(ws + WS_WRT), DM, scr, c.lane, RmId{});
    }
    const int gt = c.vcu * NTHR + c.tid, ngt = c.G * NTHR;
    for (int i0 = gt; i0 < T * DM / 8; i0 += ngt * 4) { f32x4 a[4], b[4];
#pragma unroll
        for (int q = 0; q < 4; ++q) { const size_t i = (size_t)i0 + (size_t)q * ngt; a[q] = __builtin_nontemporal_load((const f32x4*)(p.x + i * 8)); b[q] = __builtin_nontemporal_load((const f32x4*)(p.x + i * 8 + 4)); }
#pragma unroll
        for (int q = 0; q < 4; ++q) { const size_t i = (size_t)i0 + (size_t)q * ngt; *(u32x4*)((bf16*)(ws + WS_XB) + i * 8) = gm::pack8(a[q], b[q]); } }
    for (int i = gt; i < BATCH * MEML * DM / 8; i += ngt) { const f32x4 a = *(const f32x4*)(p.mem + (size_t)i * 8), b = *(const f32x4*)(p.mem + (size_t)i * 8 + 4); *(u32x4*)((bf16*)(ws + WS_MEMB) + (size_t)i * 8) = gm::pack8(a, b); }
    for (int i = gt; i < T * 8; i += ngt) { const int t = i >> 3, j = i & 7; const float inv = powf(500000.0f, -(float)(2 * j) / 16.0f); const float ang = (float)p.pos[t] * inv;
        ((float2*)(ws + WS_CS))[i] = make_float2(cosf(ang), sinf(ang)); }
    if (gt < 256) ((int*)(ws + WS_CNT))[gt] = 0;
    if (gt == 0) { float a = 0.f, b = 0.f; for (int k = 0; k < 64; ++k) { a += p.lq1[k] * p.lk1[k]; b += p.lq2[k] * p.lk2[k]; } ((float*)(ws + WS_SCAL))[0] = expf(a) - expf(b) + LAMBDA_INIT; }
}

__device__ __forceinline__ void unpack8(const u32x4 u, float (&v)[8]) {
    v[0] = __uint_as_float(u.x << 16); v[1] = __uint_as_float(u.x & 0xffff0000u); v[2] = __uint_as_float(u.y << 16); v[3] = __uint_as_float(u.y & 0xffff0000u);
    v[4] = __uint_as_float(u.z << 16); v[5] = __uint_as_float(u.z & 0xffff0000u); v[6] = __uint_as_float(u.w << 16); v[7] = __uint_as_float(u.w & 0xffff0000u);
}
__device__ __forceinline__ void phase_merge(const P& p, const Ctx& c, const int gt, const int ngt) {
    const float* lse = (const float*)(p.ws + WS_LSEA); const bf16* pa = (const bf16*)(p.ws + WS_PARTA); bf16* mx = (bf16*)(p.ws + WS_MIXIN);
    for (int i0 = gt; i0 < T * 64; i0 += ngt * 4) {
        u32x4 ua[4], ub[4], ud[4]; float l0[4], l1[4], l2[4];
#pragma unroll
        for (int q = 0; q < 4; ++q) { const int i = i0 + q * ngt; if (i < T * 64) { const int t = i >> 6, c8 = (i & 63) * 8, h = c8 >> 6;
            l0[q] = lse[(size_t)t * 8 + h]; l1[q] = lse[((size_t)T + t) * 8 + h]; l2[q] = lse[((size_t)2 * T + t) * 8 + h];
            ua[q] = *(const u32x4*)(pa + (size_t)t * 512 + c8); ub[q] = *(const u32x4*)(pa + ((size_t)T + t) * 512 + c8); ud[q] = *(const u32x4*)(pa + ((size_t)2 * T + t) * 512 + c8); } }
#pragma unroll
        for (int q = 0; q < 4; ++q) { const int i = i0 + q * ngt; if (i < T * 64) { const int t = i >> 6, c8 = (i & 63) * 8;
            const float mxl = fmaxf(l0[q], fmaxf(l1[q], l2[q]));
            float w0 = fast_exp2(l0[q] - mxl), w1 = fast_exp2(l1[q] - mxl), w2 = fast_exp2(l2[q] - mxl); const float inv = 1.f / (w0 + w1 + w2); w0 *= inv; w1 *= inv; w2 *= inv;
            float a[8], b[8], d[8]; unpack8(ua[q], a); unpack8(ub[q], b); unpack8(ud[q], d);
            u32x4 o; o.x = cvtpk(w0 * a[0] + w1 * b[0] + w2 * d[0], w0 * a[1] + w1 * b[1] + w2 * d[1]); o.y = cvtpk(w0 * a[2] + w1 * b[2] + w2 * d[2], w0 * a[3] + w1 * b[3] + w2 * d[3]);
            o.z = cvtpk(w0 * a[4] + w1 * b[4] + w2 * d[4], w0 * a[5] + w1 * b[5] + w2 * d[5]); o.w = cvtpk(w0 * a[6] + w1 * b[6] + w2 * d[6], w0 * a[7] + w1 * b[7] + w2 * d[7]);
            OUT_ST16(mx + (size_t)t * DM + c8, o); } }
    }
}
__device__ __forceinline__ void phase_ln(const bf16* in, bf16* outp, const float* g, const float* bb_, const Ctx& c, unsigned char* q8, int row_lo, int row_hi, int gw, int ngw) {
    constexpr int LNR = 4;
    u32x2 raw[LNR][4], nraw[LNR][4];
    int w = row_lo + gw * LNR;
    if (w < row_hi) {
#pragma unroll
        for (int rr = 0; rr < LNR; ++rr)
#pragma unroll
            for (int j = 0; j < 4; ++j) raw[rr][j] = *(const u32x2*)(in + (size_t)(w + rr) * DM + j * 256 + c.lane * 4); }
    for (; w < row_hi; w += ngw * LNR) {
        const int wn = w + ngw * LNR;
        if (wn < row_hi) {
#pragma unroll
            for (int rr = 0; rr < LNR; ++rr)
#pragma unroll
                for (int j = 0; j < 4; ++j) nraw[rr][j] = *(const u32x2*)(in + (size_t)(wn + rr) * DM + j * 256 + c.lane * 4); }
        float v[LNR][16]; float s[LNR], q[LNR];
#pragma unroll
        for (int rr = 0; rr < LNR; ++rr) {
#pragma unroll
            for (int j = 0; j < 4; ++j) { const u32x2 u = raw[rr][j];
                v[rr][4 * j] = __uint_as_float(u.x << 16); v[rr][4 * j + 1] = __uint_as_float(u.x & 0xffff0000u); v[rr][4 * j + 2] = __uint_as_float(u.y << 16); v[rr][4 * j + 3] = __uint_as_float(u.y & 0xffff0000u); } }
#pragma unroll
        for (int rr = 0; rr < LNR; ++rr) { s[rr] = 0.f;
#pragma unroll
            for (int j = 0; j < 16; ++j) s[rr] += v[rr][j]; }
#pragma unroll
        for (int o = 1; o < 64; o <<= 1) {
#pragma unroll
            for (int rr = 0; rr < LNR; ++rr) s[rr] += __shfl_xor(s[rr], o); }
#pragma unroll
        for (int rr = 0; rr < LNR; ++rr) { const float mu = s[rr] * (1.f / DM); q[rr] = 0.f;
#pragma unroll
            for (int j = 0; j < 16; ++j) { v[rr][j] -= mu; q[rr] += v[rr][j] * v[rr][j]; } }
#pragma unroll
        for (int o = 1; o < 64; o <<= 1) {
#pragma unroll
            for (int rr = 0; rr < LNR; ++rr) q[rr] += __shfl_xor(q[rr], o); }
#pragma unroll
        for (int rr = 0; rr < LNR; ++rr) { const float rs = rsqrtf(q[rr] * (1.f / DM) + LN_EPS);
#pragma unroll
            for (int j = 0; j < 4; ++j) { const int cc = j * 256 + c.lane * 4; const f32x4 gg = *(const f32x4*)(g + cc), bb = *(const f32x4*)(bb_ + cc);
                const float y0 = v[rr][4 * j] * rs * gg[0] + bb[0], y1 = v[rr][4 * j + 1] * rs * gg[1] + bb[1], y2 = v[rr][4 * j + 2] * rs * gg[2] + bb[2], y3 = v[rr][4 * j + 3] * rs * gg[3] + bb[3];
                u32x2 u; u.x = cvtpk(y0, y1); u.y = cvtpk(y2, y3);
                *(u32x2*)(outp + (size_t)(w + rr) * DM + cc) = u;
                if (q8) { int t8 = 0; t8 = __builtin_amdgcn_cvt_pk_fp8_f32(y0 * gm::X8_SCALE, y1 * gm::X8_SCALE, t8, false); t8 = __builtin_amdgcn_cvt_pk_fp8_f32(y2 * gm::X8_SCALE, y3 * gm::X8_SCALE, t8, true); *(int*)(q8 + (size_t)(w + rr) * DM + cc) = t8; } } }
#pragma unroll
        for (int rr = 0; rr < LNR; ++rr)
#pragma unroll
            for (int j = 0; j < 4; ++j) raw[rr][j] = nraw[rr][j];
    }
}
#define DPP_F(old, src, ctrl, rmask) __uint_as_float(__builtin_amdgcn_update_dpp(__float_as_uint(old), __float_as_uint(src), (ctrl), (rmask), 0xf, false))
__device__ __forceinline__ float wave_max_f32(float v) {
    v = fmaxf(v, DPP_F(v, v, 0x111, 0xf)); v = fmaxf(v, DPP_F(v, v, 0x112, 0xf)); v = fmaxf(v, DPP_F(v, v, 0x114, 0xf)); v = fmaxf(v, DPP_F(v, v, 0x118, 0xf));
    v = fmaxf(v, DPP_F(v, v, 0x142, 0xa)); v = fmaxf(v, DPP_F(v, v, 0x143, 0xc));
    return __uint_as_float(__builtin_amdgcn_readlane(__float_as_uint(v), 63));
}
__device__ __forceinline__ void phase_route(const P& p, const Ctx& c, int nrep, const int w_first, const int w_step, const int w_end) {
    const int lane = c.lane;
    for (int rep = 0; rep < nrep; ++rep)
    for (int w0 = w_first; w0 < w_end; w0 += w_step) {
        f32x4 lgs[8];
#pragma unroll
        for (int tt = 0; tt < 8; ++tt) lgs[tt] = *(const f32x4*)((const float*)(p.ws + WS_LOGITS) + (size_t)(w0 + tt) * NEXP + lane * 4);
        const f32x4 eb = *(const f32x4*)(p.e_bias + lane * 4);
        int myidx = 0; float myw = 0.f, mysum = 1.f;
#pragma unroll
        for (int tt = 0; tt < 8; ++tt) {
            const f32x4 lg = lgs[tt];
            float sc[4], bs[4];
#pragma unroll
            for (int j = 0; j < 4; ++j) { sc[j] = 1.f / (1.f + expf(-lg[j])); bs[j] = sc[j] + eb[j]; }
            float m1 = fmaxf(bs[0], bs[1]), m2 = fminf(bs[0], bs[1]);
            { const float cc = bs[2]; const float n1 = fmaxf(m1, cc); m2 = fmaxf(m2, fminf(m1, cc)); m1 = n1; }
            { const float cc = bs[3]; const float n1 = fmaxf(m1, cc); m2 = fmaxf(m2, fminf(m1, cc)); m1 = n1; }
            { const float b1 = DPP_F(m1, m1, 0xB1, 0xf), b2 = DPP_F(m2, m2, 0xB1, 0xf); const float n1 = fmaxf(m1, b1); m2 = fmaxf(fminf(m1, b1), fmaxf(m2, b2)); m1 = n1; }
            { const float b1 = DPP_F(m1, m1, 0x4E, 0xf), b2 = DPP_F(m2, m2, 0x4E, 0xf); const float n1 = fmaxf(m1, b1); m2 = fmaxf(fminf(m1, b1), fmaxf(m2, b2)); m1 = n1; }
            { const float b1 = DPP_F(m1, m1, 0x141, 0xf), b2 = DPP_F(m2, m2, 0x141, 0xf); const float n1 = fmaxf(m1, b1); m2 = fmaxf(fminf(m1, b1), fmaxf(m2, b2)); m1 = n1; }
            const float gs = m1 + m2; const int grp = lane >> 3; int rank = 0;
#pragma unroll
            for (int g2 = 0; g2 < 8; ++g2) { const float o = __uint_as_float(__builtin_amdgcn_readlane(__float_as_uint(gs), g2 * 8)); rank += (o > gs || (o == gs && g2 < grp)) ? 1 : 0; }
            const bool sel = rank < 4;
            float cand[4];
#pragma unroll
            for (int j = 0; j < 4; ++j) cand[j] = sel ? bs[j] : -INFINITY;
            float wsum = 0.f;
#pragma unroll
            for (int k = 0; k < TOPK; ++k) {
                const float lm = fmaxf(fmaxf(cand[0], cand[1]), fmaxf(cand[2], cand[3]));
                const float wm = wave_max_f32(lm);
                const unsigned long long bal = __ballot(lm == wm);
                const int own = __builtin_ctzll(bal);
                const int el = (cand[0] == wm) ? 0 : (cand[1] == wm) ? 1 : (cand[2] == wm) ? 2 : 3;
                const float sv = el == 0 ? sc[0] : (el == 1 ? sc[1] : (el == 2 ? sc[2] : sc[3]));
                const float wv = __uint_as_float(__builtin_amdgcn_readlane(__float_as_uint(sv), own));
                const int elo = __builtin_amdgcn_readlane(el, own);
                if (lane == own) { if (el == 0) cand[0] = -INFINITY; else if (el == 1) cand[1] = -INFINITY; else if (el == 2) cand[2] = -INFINITY; else cand[3] = -INFINITY; }
                wsum += wv;
                if (lane == tt * 8 + k) { myidx = own * 4 + elo; myw = wv; }
            }
            if ((lane >> 3) == tt) mysum = wsum;
        }
        if (rep == nrep - 1) {
            const int rk = atomicAdd((int*)(p.ws + WS_CNT) + myidx, 1);
            ((int*)(p.ws + WS_RIDX))[(size_t)w0 * 8 + lane] = myidx;
            ((float*)(p.ws + WS_RW))[(size_t)w0 * 8 + lane] = myw / mysum * ROUTED_SCALE;
            ((int*)(p.ws + WS_RRANK))[(size_t)w0 * 8 + lane] = rk;
#if NO_SCATTER
            ((int*)(p.ws + WS_SLOTTOK))[(size_t)myidx * T + rk] = w0 + (lane >> 3);
            ((float*)(p.ws + WS_SLOTW))[(size_t)myidx * T + rk] = myw / mysum * ROUTED_SCALE;
#endif
        }
    }
}
__device__ __forceinline__ void phase_scatter(const P& p, const Ctx& c) {
    LAS int* sh = (LAS int*)c.lds;
    const int tid = c.tid;
    int cnt = 0;
    if (tid < 256) { cnt = ld_i32_agent((const int*)(p.ws + WS_CNT) + tid); sh[tid] = cnt; sh[256 + tid] = (cnt + MOE_ROWS - 1) >> MOE_RSH; }
    __syncthreads();
    for (int o = 1; o < 256; o <<= 1) { int v = 0, v2 = 0; if (tid < 256 && tid >= o) { v = sh[tid - o]; v2 = sh[256 + tid - o]; } __syncthreads(); if (tid < 256) { sh[tid] += v; sh[256 + tid] += v2; } __syncthreads(); }
    if (blockIdx.x == 0) {
        int* st = (int*)(p.ws + WS_START); int* tab = (int*)(p.ws + WS_TILETAB);
        if (tid < 256) { const int st_e = sh[tid] - cnt; st[tid + 1] = sh[tid]; if (tid == 0) st[0] = 0;
            const int nte = (cnt + MOE_ROWS - 1) >> MOE_RSH, tb = sh[256 + tid] - nte;
            for (int ti = 0; ti < nte; ++ti) { int* q = tab + 4 * (tb + ti); q[0] = tid; q[1] = ti; q[2] = st_e + MOE_ROWS * ti; q[3] = min(MOE_ROWS, cnt - MOE_ROWS * ti); } }
        const int nrt_r = sh[511];
        if (tid < T / MOE_ROWS) { int* q = tab + 4 * (nrt_r + tid); q[0] = NEXP; q[1] = tid; q[2] = AROWS + MOE_ROWS * tid; q[3] = MOE_ROWS; }
        if (tid == 0) ((int*)(p.ws + WS_NRT))[0] = nrt_r + T / MOE_ROWS;
    }
    const int gt = c.vcu * NTHR + tid, ngt = c.G * NTHR;
    for (int i0 = gt; i0 < T * 8; i0 += ngt * 2) {
        int e[2], rk[2]; float wv[2];
#pragma unroll
        for (int q = 0; q < 2; ++q) { const int i = i0 + q * ngt; e[q] = ((const int*)(p.ws + WS_RIDX))[i]; rk[q] = ((const int*)(p.ws + WS_RRANK))[i]; wv[q] = ((const float*)(p.ws + WS_RW))[i]; }
#pragma unroll
        for (int q = 0; q < 2; ++q) { const int i = i0 + q * ngt; const int pos = (e[q] == 0 ? 0 : sh[e[q] - 1]) + rk[q];
            ((int*)(p.ws + WS_ROWTOK))[pos] = i >> 3; ((float*)(p.ws + WS_ROWW))[pos] = wv[q]; ((int*)(p.ws + WS_POS))[i] = pos; }
    }
    __syncthreads();
}
__device__ __forceinline__ void moe_scan_tables(const P& p, const Ctx& c) {
    LAS int* sh = (LAS int*)c.lds;
    const int tid = c.tid;
    int cnt = 0;
    if (tid < 256) { cnt = ld_i32_agent((const int*)(p.ws + WS_CNT) + tid); sh[tid] = cnt; sh[256 + tid] = (cnt + MOE_ROWS - 1) >> MOE_RSH; }
    __syncthreads();
    for (int o = 1; o < 256; o <<= 1) { int v = 0, v2 = 0; if (tid < 256 && tid >= o) { v = sh[tid - o]; v2 = sh[256 + tid - o]; } __syncthreads(); if (tid < 256) { sh[tid] += v; sh[256 + tid] += v2; } __syncthreads(); }
    if (blockIdx.x == 0) {
        int* st = (int*)(p.ws + WS_START); int* tab = (int*)(p.ws + WS_TILETAB);
        if (tid < 256) { const int st_e = sh[tid] - cnt; st[tid + 1] = sh[tid]; if (tid == 0) st[0] = 0;
            const int nte = (cnt + MOE_ROWS - 1) >> MOE_RSH, tb = sh[256 + tid] - nte;
            for (int ti = 0; ti < nte; ++ti) { int* q = tab + 4 * (tb + ti); q[0] = tid; q[1] = ti; q[2] = st_e + MOE_ROWS * ti; q[3] = min(MOE_ROWS, cnt - MOE_ROWS * ti); } }
        const int nrt_r = sh[511];
        if (tid < T / MOE_ROWS) { int* q = tab + 4 * (nrt_r + tid); q[0] = NEXP; q[1] = tid; q[2] = AROWS + MOE_ROWS * tid; q[3] = MOE_ROWS; }
        if (tid == 0) ((int*)(p.ws + WS_NRT))[0] = nrt_r + T / MOE_ROWS;
    }
    const int gt = c.vcu * NTHR + tid, ngt = c.G * NTHR;
    for (int i = gt; i < T * 8; i += ngt) { const int e = ((const int*)(p.ws + WS_RIDX))[i], rk = ((const int*)(p.ws + WS_RRANK))[i];
        ((int*)(p.ws + WS_POS))[i] = (e == 0 ? 0 : sh[e - 1]) + rk; }
}
__device__ __forceinline__ void phase_combine(const P& p, const Ctx& c) {
    const int lane = c.lane;
    const unsigned char* Y = (const unsigned char*)(p.ws + WS_Y);
    for (int w = c.gw; w < T; w += c.ngw) {
        const int pv = ((const int*)(p.ws + WS_POS))[(size_t)w * 8 + (lane & 7)];
        const bf16* h2 = (const bf16*)(p.ws + WS_H2) + (size_t)w * DM;
        float v[16]; u32x2 hu[4]; int yu[9][4];
#pragma unroll
        for (int j = 0; j < 4; ++j) hu[j] = *(const u32x2*)(h2 + j * 256 + lane * 4);
#pragma unroll
        for (int k = 0; k < 9; ++k) {
            const size_t row = k < 8 ? (size_t)__builtin_amdgcn_readlane(pv, k < 8 ? k : 0) : (size_t)AROWS + w;
#pragma unroll
            for (int j = 0; j < 4; ++j) yu[k][j] = *(const int*)(Y + row * DM + j * 256 + lane * 4);
        }
#pragma unroll
        for (int j = 0; j < 4; ++j) { const u32x2 u = hu[j];
            v[4 * j] = DN_ALPHA * __uint_as_float(u.x << 16); v[4 * j + 1] = DN_ALPHA * __uint_as_float(u.x & 0xffff0000u); v[4 * j + 2] = DN_ALPHA * __uint_as_float(u.y << 16); v[4 * j + 3] = DN_ALPHA * __uint_as_float(u.y & 0xffff0000u); }
#pragma unroll
        for (int j = 0; j < 4; ++j) { float a0 = 0.f, a1 = 0.f, a2 = 0.f, a3 = 0.f;
#pragma unroll
            for (int k = 0; k < 9; ++k) { const f32x2 lo = __builtin_amdgcn_cvt_pk_f32_fp8(yu[k][j], false), hi = __builtin_amdgcn_cvt_pk_f32_fp8(yu[k][j], true); a0 += lo[0]; a1 += lo[1]; a2 += hi[0]; a3 += hi[1]; }
            v[4 * j] += a0 * gm::Y8_INV; v[4 * j + 1] += a1 * gm::Y8_INV; v[4 * j + 2] += a2 * gm::Y8_INV; v[4 * j + 3] += a3 * gm::Y8_INV; }
        float s = 0.f;
#pragma unroll
        for (int j = 0; j < 16; ++j) s += v[j];
#pragma unroll
        for (int o = 1; o < 64; o <<= 1) s += __shfl_xor(s, o);
        const float mu = s * (1.f / DM); float q = 0.f;
#pragma unroll
        for (int j = 0; j < 16; ++j) { v[j] -= mu; q += v[j] * v[j]; }
#pragma unroll
        for (int o = 1; o < 64; o <<= 1) q += __shfl_xor(q, o);
        const float rs = rsqrtf(q * (1.f / DM) + LN_EPS);
#pragma unroll
        for (int j = 0; j < 4; ++j) { const int cc = j * 256 + lane * 4; const f32x4 gg = *(const f32x4*)(p.ln3_g + cc), bb = *(const f32x4*)(p.ln3_b + cc);
            f32x4 o; o[0] = v[4 * j] * rs * gg[0] + bb[0]; o[1] = v[4 * j + 1] * rs * gg[1] + bb[1]; o[2] = v[4 * j + 2] * rs * gg[2] + bb[2]; o[3] = v[4 * j + 3] * rs * gg[3] + bb[3];
            *(f32x4*)(p.out + (size_t)w * DM + cc) = o; }
    }
}

#define XB_TMO      128
#define XB_XCNT(j)  (256  + 64 * (j))
#define XB_XSUB(j)  (1280 + 64 * (j))
#define XB_XGEN(j)  (2304 + 64 * (j))
#define XB_TOP      3328
#define XB_TOPGEN   3392
#define XCD_BAR_WORDS 3456
#define XB_SPIN_CAP (1u << 18)
__device__ __forceinline__ unsigned xb_ld(unsigned* p)              { return __hip_atomic_load(p, __ATOMIC_RELAXED, __HIP_MEMORY_SCOPE_AGENT); }
__device__ __forceinline__ unsigned xb_add(unsigned* p, unsigned v) { return __hip_atomic_fetch_add(p, v, __ATOMIC_RELAXED, __HIP_MEMORY_SCOPE_AGENT); }
__device__ __forceinline__ unsigned xb_xcc_id() { return (unsigned)__builtin_amdgcn_s_getreg((3 << 11) | 20) & 0xFu; }
#define XB_SPIN(cond, bar) do { unsigned _sp = 0; while (cond) { __builtin_amdgcn_s_sleep(1); \
    if ((++_sp & 255u) == 0u) { if (xb_ld(&(bar)[XB_TMO])) break; if (_sp > XB_SPIN_CAP) { atomicAdd(&(bar)[XB_TMO], 1u); break; } } } } while (0)
struct XcdBarrier { unsigned* bar; unsigned x; volatile LAS unsigned* st; };
__device__ __forceinline__ XcdBarrier xcd_barrier_post(unsigned* bar, volatile LAS unsigned* st) {
    XcdBarrier b; b.bar = bar; b.x = xb_xcc_id(); b.st = st;
    if (threadIdx.x == 0) (void)xb_add(&bar[XB_XCNT(b.x)], 1u);
    return b;
}
__device__ __forceinline__ void xcd_barrier_complete(unsigned* bar, unsigned x, unsigned& nloc, unsigned& nx) {
    const unsigned G = gridDim.x * gridDim.y * gridDim.z;
    unsigned sum, cnt, mine, sp = 0u;
    for (;;) {
        sum = 0u; cnt = 0u; mine = 0u;
#pragma unroll
        for (unsigned j = 0; j < 16; ++j) { const unsigned c = xb_ld(&bar[XB_XCNT(j)]); sum += c; cnt += (c > 0u) ? 1u : 0u; mine = (j == x) ? c : mine; }
        if (sum == G) break;
        __builtin_amdgcn_s_sleep(1);
        if ((++sp & 255u) == 0u) { if (xb_ld(&bar[XB_TMO])) break; if (sp > XB_SPIN_CAP) { atomicAdd(&bar[XB_TMO], 1u); break; } }
    }
    nloc = mine > 0u ? mine : 1u; nx = cnt > 0u ? cnt : 1u;
}
__device__ __forceinline__ void xcd_barrier(const XcdBarrier& b) {
    asm volatile("s_waitcnt vmcnt(0)" ::: "memory");
    __syncthreads();
    if (threadIdx.x == 0) {
        unsigned* bar = b.bar;
        __builtin_amdgcn_s_waitcnt(0);
        unsigned nloc = b.st[0], nx = b.st[1];
        if (nloc == 0u) { xcd_barrier_complete(bar, b.x, nloc, nx); b.st[0] = nloc; b.st[1] = nx; }
        const unsigned old = xb_add(&bar[XB_XSUB(b.x)], 1u);
        const unsigned gen = old / nloc;
        if (old + 1u == (gen + 1u) * nloc) {
            __builtin_amdgcn_fence(__ATOMIC_RELEASE, "agent");
            asm volatile("s_waitcnt vmcnt(0)" ::: "memory");
            const unsigned og = xb_add(&bar[XB_TOP], 1u);
            const unsigned tg = og / nx;
            if (og + 1u == (tg + 1u) * nx) xb_add(&bar[XB_TOPGEN], 1u);
            else XB_SPIN(xb_ld(&bar[XB_TOPGEN]) == tg, bar);
            __builtin_amdgcn_fence(__ATOMIC_ACQUIRE, "agent");
#if !XB_FLAT_WAIT
            xb_add(&bar[XB_XGEN(b.x)], 1u);
#endif
            asm volatile("s_waitcnt vmcnt(0)" ::: "memory");
        } else {
#if XB_FLAT_WAIT
            XB_SPIN(xb_ld(&bar[XB_TOPGEN]) == gen, bar);
#else
            XB_SPIN(xb_ld(&bar[XB_XGEN(b.x)]) == gen, bar);
#endif
            __builtin_amdgcn_fence(__ATOMIC_ACQUIRE, "agent");
            asm volatile("s_waitcnt vmcnt(0)" ::: "memory");
        }
    }
    __syncthreads();
}

enum Phase { PH_PROLOGUE = 0, PH_INPROJ, PH_ATTN, PH_MERGE, PH_OUTPROJ, PH_LN1, PH_QMEM, PH_MEMATTN, PH_WO, PH_LN2, PH_ROUTER, PH_ROUTE, PH_SCATTER, PH_MOE1, PH_MOE2, PH_COMBINE, PH_COUNT };
struct MKArgs { P p; int ph_lo, ph_hi; };

__global__ void __launch_bounds__(NTHR, 2) mk_fwd(MKArgs a) {
    extern __shared__ __attribute__((aligned(16))) unsigned char lds_raw[];
    LAS unsigned char* lds = (LAS unsigned char*)lds_raw;
    typedef const __attribute__((address_space(4))) MKArgs* KArgP;
    const KArgP kargs = (KArgP)__builtin_amdgcn_kernarg_segment_ptr();
#define LDP_(field, idx) p.field = (decltype(p.field))(__attribute__((address_space(1))) char*)(src_[idx])
#define LOAD_P() KArgP kq_ = kargs; asm volatile("" : "+s"(kq_)); P p; { const __attribute__((address_space(4))) unsigned long long* src_ = (const __attribute__((address_space(4))) unsigned long long*)kq_; \
        LDP_(x, 0); LDP_(mem, 1); LDP_(pos, 2); LDP_(w_in, 3); LDP_(w_out, 4); LDP_(lq1, 5); LDP_(lk1, 6); LDP_(lq2, 7); LDP_(lk2, 8); LDP_(subln_g, 9); LDP_(ln1_g, 10); LDP_(ln1_b, 11); \
        LDP_(wq, 12); LDP_(wkv, 13); LDP_(wo, 14); LDP_(ln2_g, 15); LDP_(ln2_b, 16); LDP_(w_router, 17); LDP_(e_bias, 18); LDP_(w_gate, 19); LDP_(w_up, 20); LDP_(w_down, 21); \
        LDP_(ws_gate, 22); LDP_(ws_up, 23); LDP_(ws_down, 24); LDP_(ln3_g, 25); LDP_(ln3_b, 26); LDP_(out, 27); LDP_(ws, 28); } unsigned char* const ws = p.ws; \
        { int t_ = threadIdx.x; asm volatile("" : "+v"(t_)); c.tid = t_; c.lane = t_ & 63; }
    Ctx c; c.tid = threadIdx.x; c.lane = c.tid & 63; c.wave = __builtin_amdgcn_readfirstlane(c.tid >> 6); c.G = gridDim.x;
    { const int bx = blockIdx.x; c.vcu = (c.G % 8 == 0) ? (bx % 8) * (c.G / 8) + bx / 8 : bx; }
    c.gw = c.vcu * NWAVES + c.wave; c.ngw = c.G * NWAVES; c.lds = lds;
    const int lo = a.ph_lo, hi = a.ph_hi;
    unsigned char* const ws0 = a.p.ws;
#ifdef ONLY_PH
#define IN(k) ((k) == ONLY_PH)
#else
#define IN(k) (lo <= (k) && (k) < hi)
#endif
#ifndef USE_CG_SYNC
#define USE_CG_SYNC 0
#endif
    volatile LAS unsigned* MISC = (volatile LAS unsigned*)(lds + LDS_BYTES - 64);
    if (c.tid == 0) { MISC[0] = 0u; MISC[1] = 0u; }
    __syncthreads();
    XcdBarrier gbar; gbar.bar = (unsigned*)(ws0 + WS_BAR); gbar.x = 0; gbar.st = MISC;
    if (!USE_CG_SYNC && hi - lo > 1) gbar = xcd_barrier_post((unsigned*)(ws0 + WS_BAR), MISC);
#ifndef REP_MASK
#define REP_MASK 0
#endif
#define REPS(k) (1 + ((REP_MASK >> (k)) & 1))
#if REP_MASK == 0
#define REPLOOP(k)
#else
#define REPLOOP(k) for (int rep = 0; rep < REPS(k); ++rep)
#endif
#define SEAM(k) do { if (IN(k) && IN((k) + 1)) { if (USE_CG_SYNC) cg::this_grid().sync(); else { xcd_barrier(gbar); if ((REP_MASK >> 24) & 1) xcd_barrier(gbar); } } STAMP((k) + 1); } while (0)

#ifdef PROBE_A
    volatile LAS unsigned long long* stamps = (volatile LAS unsigned long long*)(lds + LDS_XTRA + 30720);
#define STAMP(k) do { if (blockIdx.x == 0 && c.tid == 0) stamps[(k)] = __builtin_amdgcn_s_memrealtime(); } while (0)
#else
#define STAMP(k) do {} while (0)
#endif
    STAMP(0);
    if (IN(PH_PROLOGUE)) { LOAD_P(); REPLOOP(PH_PROLOGUE) phase_prologue(p, c); SEAM(PH_PROLOGUE); }

    if (IN(PH_INPROJ)) { LOAD_P();
        constexpr int NCJ = NCJ_CFG;
        const int bx = (int)blockIdx.x, j = bx >> 3;
        const bool part = (c.G == 256) && NCJ > 0;
        const int cjlo = part ? (j * NCJ) / 32 : 0, cjhi = part ? ((j + 1) * NCJ) / 32 : 0;
        const bool conv = cjhi > cjlo;
        const int Gg = part ? 256 - 8 * NCJ : c.G, cg_ = part ? (j - cjlo) * 8 + (bx & 7) : bx;
        constexpr int NU = INPROJ_NU, NGc = 256 - 8 * NCJ, NCc = 8 * NCJ, NLEFT = NU > 0 ? (T / 256) * (INW / 256) - NU * NGc : 0;
        static_assert(NU == 0 || (NLEFT >= 0 && NLEFT + 64 <= NCc), "in-proj balance: leftover + K/V units must fit one per converter workgroup");
        const bool bal = part && NU > 0;
        if (!conv) {
        REPLOOP(PH_INPROJ)
        { gm::DenseSched S; S.init(T, INW, DM, ws + WS_WINT, Gg, cg_); if (bal) S.i_cnt = NU;
          gm::EpiInProj E{(bf16*)(ws + WS_PROJ), (const float*)(ws + WS_CS)};
          gm::gemm_phase(lds, ws, (const char*)(ws + WS_XB), DM, S, E); }
        if (!bal) {
          gm::DenseSched S; S.init(BATCH * MEML, 2048, DM, ws + WS_WKVT, Gg, cg_);
          gm::EpiScale E{(bf16*)(ws + WS_KVM), 2048, 1.f};
          gm::gemm_phase(lds, ws, (const char*)(ws + WS_MEMB), DM, S, E); }
        __syncthreads();
        }
        {
          const int nch_ = (c.G == 256 && NDC_CFG > 0) ? CONV_SPLIT : ECONV_NCH;
          if (c.tid == 0) MISC[2] = (unsigned)__hip_atomic_load((int*)(ws + WS_ECTR), __ATOMIC_RELAXED, __HIP_MEMORY_SCOPE_AGENT);
          __syncthreads();
          const int seen = (int)MISC[2];
          if (seen < nch_) prologue_experts(p, c, (int*)(ws + WS_ECTR), 0, nch_); }
        if (bal && conv) {
            const int ci = cjlo * 8 + (bx & 7);
            __syncthreads();
            if (ci < 64) { gm::DenseSched S; S.init(BATCH * MEML, 2048, DM, ws + WS_WKVT, 1 << 20, ci); S.i_cnt = 1;
                gm::EpiScale E{(bf16*)(ws + WS_KVM), 2048, 1.f};
                gm::gemm_phase(lds, ws, (const char*)(ws + WS_MEMB), DM, S, E); }
            else if (ci - 64 < NLEFT) { gm::DenseSched S; S.init(T, INW, DM, ws + WS_WINT, 1 << 20, NU * NGc + ci - 64); S.i_cnt = 1;
                gm::EpiInProj E{(bf16*)(ws + WS_PROJ), (const float*)(ws + WS_CS)};
                gm::gemm_phase(lds, ws, (const char*)(ws + WS_XB), DM, S, E); }
        }
        SEAM(PH_INPROJ);
    }

    if (IN(PH_ATTN)) { LOAD_P();
        const float lam = __hip_atomic_load((const float*)(ws + WS_SCAL), __ATOMIC_RELAXED, __HIP_MEMORY_SCOPE_AGENT);
        REPLOOP(16)
        if (c.G == 256) { const int bh = c.vcu >> 3, s = c.vcu & 7;
            for (int i = 0; i < 4; ++i) { const int qb = (i == 0) ? s : (i == 1) ? 15 - s : (i == 2) ? 16 + s : 31 - s; diff_unit(p, bh >> 2, bh & 3, qb, lds, lam); } }
        else { for (int u = blockIdx.x; u < 1024; u += c.G) diff_unit(p, u >> 7, (u >> 5) & 3, u & 31, lds, lam); }
        STAMP(20);
        REPLOOP(17)
        if (c.G == 256 && NDC_CFG > 0) {
            constexpr int NDC = NDC_CFG;
            const int bx = (int)blockIdx.x, j = bx >> 3, cjlo = (j * NDC) / 32, cjhi = ((j + 1) * NDC) / 32;
            if (cjhi == cjlo) dil_phase(p, (bx & 7) * (32 - NDC) + (j - cjlo), 256 - 8 * NDC, 3072, lds);
            __syncthreads();
            prologue_experts(p, c, (int*)(ws + WS_LCTR), CONV_SPLIT, ECONV_NCH);
        } else
        dil_phase(p, c.vcu, c.G, 3072, lds);
        SEAM(PH_ATTN);
    }

    if (IN(PH_MERGE)) { LOAD_P(); REPLOOP(PH_MERGE) phase_merge(p, c, c.vcu * NTHR + c.tid, c.G * NTHR); SEAM(PH_MERGE); }

    if (IN(PH_OUTPROJ)) { LOAD_P();
        REPLOOP(PH_OUTPROJ) {
        gm::DenseSched S; S.init(T, DM, DM, ws + WS_WOUTT, c.G, (int)blockIdx.x);
        gm::EpiOutProj E{(bf16*)(ws + WS_Y1), p.x, (float*)(ws + WS_STATS1), (LAS float*)(lds + LDS_XTRA)};
        gm::gemm_phase(lds, ws, (const char*)(ws + WS_MIXIN), DM, S, E);
        }
        SEAM(PH_OUTPROJ);
    }
#if QMEM_FUSE
    if (IN(PH_QMEM)) { LOAD_P();
        for (int k = 0; ; ++k) {
            gm::DenseSched S; S.init(T, DM, DM, ws + WS_WQT, c.G, (int)blockIdx.x); S.i_lo = k; S.i_cnt = 1;
            gm::Unit u0; if (!S.next(0, u0)) break;
            gm::EpiQMemLN E{(bf16*)(ws + WS_QM), (const float*)(ws + WS_STATS1), (const float*)(ws + WS_SN), (const float*)(ws + WS_CN), QSCALE256};
            gm::gemm_phase(lds, ws, (const char*)(ws + WS_Y1), DM, S, E);
            __syncthreads();
            mem_unit(p, u0.pm >> 4, u0.pn, u0.pm & 15, lds);
            __syncthreads();
        }
        SEAM(PH_QMEM);
    }
#else
    if (IN(PH_QMEM)) { LOAD_P();
        REPLOOP(PH_QMEM) {
        gm::DenseSched S; S.init(T, DM, DM, ws + WS_WQT, c.G, (int)blockIdx.x);
        gm::EpiQMemLN E{(bf16*)(ws + WS_QM), (const float*)(ws + WS_STATS1), (const float*)(ws + WS_SN), (const float*)(ws + WS_CN), QSCALE256};
        gm::gemm_phase(lds, ws, (const char*)(ws + WS_Y1), DM, S, E);
        }
        SEAM(PH_QMEM);
    }
    if (IN(PH_MEMATTN)) { LOAD_P();
        REPLOOP(PH_MEMATTN)
        for (int u = c.vcu; u < 512; u += c.G) { const int qblk = u & 15, bh = u >> 4; mem_unit(p, bh >> 2, bh & 3, qblk, lds); }
        SEAM(PH_MEMATTN);
    }
#endif
    if (IN(PH_WO)) { LOAD_P();
        REPLOOP(PH_WO) {
        gm::DenseSched S; S.init(T, DM, DM, ws + WS_WOT, c.G, (int)blockIdx.x);
        gm::EpiWo E{(bf16*)(ws + WS_Y2), (const bf16*)(ws + WS_Y1), (const float*)(ws + WS_STATS1), p.ln1_g, p.ln1_b, (float*)(ws + WS_STATS2), (LAS float*)(lds + LDS_XTRA)};
        gm::gemm_phase(lds, ws, (const char*)(ws + WS_MO), DM, S, E);
        }
        SEAM(PH_WO);
    }
#if LN2_FOLD
#if ROUTER_FUSE
    if (IN(PH_ROUTER)) { LOAD_P();
        if (c.G == 256) {
            gm::DenseSchedH S; S.init(T, DM, ws + WS_WRT, c.G, (int)blockIdx.x);
            gm::EpiRouterLNH E{(float*)(ws + WS_LOGITS), NEXP, (const float*)(ws + WS_STATS2), (const float*)(ws + WS_SN2), (const float*)(ws + WS_CN2)};
            gm::gemm_phase<gm::EpiRouterLNH, gm::DenseSchedH, false, 0x7F7F7F7F, true, false>(lds, ws, (const char*)(ws + WS_Y2), DM, S, E);
            __syncthreads();
            { const int r0 = (int)blockIdx.x * 128; phase_route(p, c, 1, r0 + c.wave * 8, 64, r0 + 128); }
        } else {
            gm::DenseSched S; S.init(T, NEXP, DM, ws + WS_WRT, c.G, (int)blockIdx.x);
            gm::EpiRouterLN E{(float*)(ws + WS_LOGITS), NEXP, (const float*)(ws + WS_STATS2), (const float*)(ws + WS_SN2), (const float*)(ws + WS_CN2)};
            gm::gemm_phase(lds, ws, (const char*)(ws + WS_Y2), DM, S, E);
        }
        phase_ln((const bf16*)(ws + WS_Y2), (bf16*)(ws + WS_H2), p.ln2_g, p.ln2_b, c, (unsigned char*)(ws + WS_H2Q), 0, T, c.gw, c.ngw);
        SEAM(PH_ROUTER);
    }
#else
    if (IN(PH_ROUTER)) { LOAD_P();
        REPLOOP(PH_ROUTER) {
        gm::DenseSched S; S.init(T, NEXP, DM, ws + WS_WRT, c.G, (int)blockIdx.x);
        gm::EpiRouterLN E{(float*)(ws + WS_LOGITS), NEXP, (const float*)(ws + WS_STATS2), (const float*)(ws + WS_SN2), (const float*)(ws + WS_CN2)};
        gm::gemm_phase(lds, ws, (const char*)(ws + WS_Y2), DM, S, E);
        }
        { const int bx = (int)blockIdx.x; const bool has_unit = bx < 128 && c.G == 256;
          if (c.G != 256) phase_ln((const bf16*)(ws + WS_Y2), (bf16*)(ws + WS_H2), p.ln2_g, p.ln2_b, c, (unsigned char*)(ws + WS_H2Q), 0, T, c.gw, c.ngw);
          else if (!has_unit) phase_ln((const bf16*)(ws + WS_Y2), (bf16*)(ws + WS_H2), p.ln2_g, p.ln2_b, c, (unsigned char*)(ws + WS_H2Q), 0, LN2_SPLIT, (bx - 128) * NWAVES + c.wave, 128 * NWAVES);
          else phase_ln((const bf16*)(ws + WS_Y2), (bf16*)(ws + WS_H2), p.ln2_g, p.ln2_b, c, (unsigned char*)(ws + WS_H2Q), LN2_SPLIT, T, bx * NWAVES + c.wave, 128 * NWAVES); }
        SEAM(PH_ROUTER);
    }
#endif
#else
    if (IN(PH_LN2)) { LOAD_P(); REPLOOP(PH_LN2) phase_ln((const bf16*)(ws + WS_Y2), (bf16*)(ws + WS_H2), p.ln2_g, p.ln2_b, c, (unsigned char*)(ws + WS_H2Q), 0, T, c.gw, c.ngw); SEAM(PH_LN2); }

    if (IN(PH_ROUTER)) { LOAD_P();
        REPLOOP(PH_ROUTER) {
        gm::DenseSched S; S.init(T, NEXP, DM, ws + WS_WRT, c.G, (int)blockIdx.x);
        gm::EpiF32 E{(float*)(ws + WS_LOGITS), NEXP};
        gm::gemm_phase(lds, ws, (const char*)(ws + WS_H2), DM, S, E);
        }
        SEAM(PH_ROUTER);
    }
#endif
#if ROUTER_FUSE
    if (IN(PH_ROUTE) && c.G != 256) { LOAD_P(); phase_route(p, c, 1, c.gw * 8, c.ngw * 8, T); SEAM(PH_ROUTE); }
#else
    if (IN(PH_ROUTE)) { LOAD_P(); phase_route(p, c, REPS(PH_ROUTE), c.gw * 8, c.ngw * 8, T); SEAM(PH_ROUTE); }
#endif
#if !NO_SCATTER
    if (IN(PH_SCATTER)) { LOAD_P(); phase_scatter(p, c); SEAM(PH_SCATTER); }
#endif

    if (IN(PH_MOE1)) { LOAD_P();
        REPLOOP(PH_MOE1) {
#if NO_SCATTER
        moe_scan_tables(p, c);
        const int n_my = gm::moe_preload_scan<1>(lds, (const LAS int*)lds, c.G, (int)blockIdx.x, (const int*)(ws + WS_SLOTTOK), (const float*)(ws + WS_SLOTW));
#else
        const int nrt = __builtin_amdgcn_readfirstlane(ld_i32_agent((const int*)(ws + WS_NRT)));
        const int n_my = gm::moe_preload<1, true>(lds, (const int*)(ws + WS_TILETAB), nrt * 2, c.G, (int)blockIdx.x, (const int*)(ws + WS_ROWTOK), (const float*)(ws + WS_ROWW));
#endif
        const LAS int* xd = (const LAS int*)(lds + LDS_XTRA);
        gm::MoeSched<1, DM / 2, true> S{xd, xd + gm::XD_INTS, n_my, c.G, (int)blockIdx.x, (const char*)(ws + WS_WTGU), (size_t)512 * DM};
        gm::EpiMoe1 E{(unsigned char*)(ws + WS_HB), (const LAS float*)(xd + gm::XD_INTS + gm::XT_SLOTS * MOE_ROWS)};
        gm::gemm_phase<gm::EpiMoe1, gm::MoeSched<1, DM / 2, true>, true, 0x7C7C7C7C, MOE_HALFM>(lds, ws, (const char*)(ws + WS_H2Q), DM / 2, S, E);
        }
        SEAM(PH_MOE1);
    }
    if (IN(PH_MOE2)) { LOAD_P();
        REPLOOP(PH_MOE2) {
        const int nrt = __builtin_amdgcn_readfirstlane(ld_i32_agent((const int*)(ws + WS_NRT)));
        const int n_my = gm::moe_preload<2, false>(lds, (const int*)(ws + WS_TILETAB), nrt * 4, c.G, (int)blockIdx.x, nullptr, nullptr);
        const LAS int* xd = (const LAS int*)(lds + LDS_XTRA);
#if MOE2_FLIP
        gm::MoeSchedFlip<2, EDIM / 2> S{xd, n_my, c.G, (int)blockIdx.x, (const char*)(ws + WS_HB), (size_t)DM * EDIM};
        gm::EpiMoe2F E{(unsigned char*)(ws + WS_Y)};
        gm::gemm_phase<gm::EpiMoe2F, gm::MoeSchedFlip<2, EDIM / 2>, true, 0x7B7B7B7B, false, true>(lds, ws, (const char*)(ws + WS_WTD), EDIM / 2, S, E);
#else
        gm::MoeSched<2, EDIM / 2, false> S{xd, xd + gm::XD_INTS, n_my, c.G, (int)blockIdx.x, (const char*)(ws + WS_WTD), (size_t)DM * EDIM};
        gm::EpiMoe2 E{(unsigned char*)(ws + WS_Y)};
        gm::gemm_phase<gm::EpiMoe2, gm::MoeSched<2, EDIM / 2, false>, true, 0x7B7B7B7B, MOE_HALFM, true>(lds, ws, (const char*)(ws + WS_HB), EDIM / 2, S, E);
#endif
        }
        SEAM(PH_MOE2);
    }
    if (IN(PH_COMBINE)) { LOAD_P(); REPLOOP(PH_COMBINE) phase_combine(p, c); }
#ifdef PROBE_A
    STAMP(16);
    __syncthreads();
    if (blockIdx.x == 0 && c.tid == 0) {
        const float da = (float)(stamps[PROBE_A1] - stamps[PROBE_A0]) * 0.01f, db = (float)(stamps[PROBE_B1] - stamps[PROBE_B0]) * 0.01f;
        a.p.out[0] = da * (float)PROBE_SA; a.p.out[1] = db * (float)PROBE_SB;
    }
#endif
#undef IN
#undef SEAM
#undef LOAD_P
#undef LDP_
}

#ifndef MK_MODE
#define MK_MODE 1
#endif
#ifndef NAIVE_MASK
#define NAIVE_MASK 0
#endif

static void fill_params(P& p, void* const* d_in, void* d_out, void* d_ws) {
    p.x = (const float*)d_in[0]; p.mem = (const float*)d_in[1]; p.pos = (const int*)d_in[2];
    p.w_in = (const float*)d_in[3]; p.w_out = (const float*)d_in[4]; p.lq1 = (const float*)d_in[5]; p.lk1 = (const float*)d_in[6]; p.lq2 = (const float*)d_in[7]; p.lk2 = (const float*)d_in[8];
    p.subln_g = (const float*)d_in[9]; p.ln1_g = (const float*)d_in[10]; p.ln1_b = (const float*)d_in[11];
    p.wq = (const float*)d_in[12]; p.wkv = (const float*)d_in[13]; p.wo = (const float*)d_in[14]; p.ln2_g = (const float*)d_in[15]; p.ln2_b = (const float*)d_in[16];
    p.w_router = (const float*)d_in[17]; p.e_bias = (const float*)d_in[18]; p.w_gate = (const float*)d_in[19]; p.w_up = (const float*)d_in[20]; p.w_down = (const float*)d_in[21];
    p.ws_gate = (const float*)d_in[22]; p.ws_up = (const float*)d_in[23]; p.ws_down = (const float*)d_in[24]; p.ln3_g = (const float*)d_in[25]; p.ln3_b = (const float*)d_in[26];
    p.out = (float*)d_out; p.ws = (unsigned char*)d_ws;
}

extern "C" void kernel_launch(void* const* d_in, const int* in_sizes, int n_in, void* d_out, int out_size, void* d_ws, size_t ws_size, hipStream_t stream) {
    static int grid = 0;
    if (grid == 0) {
        if (n_in != 27 || out_size != T * DM || ws_size < WS_END) { fprintf(stderr, "kernel_launch: unexpected shapes: n_in %d out %d ws %zu (need %zu)\n", n_in, out_size, ws_size, (size_t)WS_END); grid = -1; return; }
        int dev = 0, cus = 0, per_cu = 0;
        (void)hipGetDevice(&dev); (void)hipDeviceGetAttribute(&cus, hipDeviceAttributeMultiprocessorCount, dev);
        if (hipFuncSetAttribute((const void*)mk_fwd, hipFuncAttributeMaxDynamicSharedMemorySize, LDS_BYTES) != hipSuccess) { fprintf(stderr, "kernel_launch: hipFuncSetAttribute failed\n"); grid = -1; return; }
        if (hipOccupancyMaxActiveBlocksPerMultiprocessor(&per_cu, (const void*)mk_fwd, NTHR, LDS_BYTES) != hipSuccess || per_cu < 1) { fprintf(stderr, "kernel_launch: occupancy query says %d blocks/CU\n", per_cu); per_cu = 1; }
        (void)hipGetLastError();
        grid = cus;
        fprintf(stderr, "kernel_launch: cus %d per_cu %d grid %d\n", cus, per_cu, grid);
    }
    if (grid < 0) return;
    MKArgs a{};
    fill_params(a.p, d_in, d_out, d_ws);
    P p = a.p; unsigned char* ws = p.ws;
#if MK_MODE == 1
    a.ph_lo = 0; a.ph_hi = PH_COUNT;
    if (hipMemsetAsync(ws + WS_BAR, 0, WS_ZERO_END - WS_BAR, stream) != hipSuccess) { fprintf(stderr, "kernel_launch: memset failed\n"); return; }
    void* args[] = {&a};
    hipError_t e = hipLaunchCooperativeKernel((const void*)mk_fwd, dim3(grid), dim3(NTHR), args, LDS_BYTES, stream);
    if (e != hipSuccess) fprintf(stderr, "cooperative launch failed: %s (grid %d)\n", hipGetErrorString(e), grid);
#elif MK_MODE == 2
    auto run = [&](int lo, int hi) { a.ph_lo = lo; a.ph_hi = hi; hipLaunchKernelGGL(mk_fwd, dim3(grid), dim3(NTHR), LDS_BYTES, stream, a); };
    auto nv = [&](int k) { return ((NAIVE_MASK >> k) & 1) != 0; };
    run(PH_PROLOGUE, PH_PROLOGUE + 1);
    if (nv(PH_INPROJ)) { ngemm<FInProj><<<dim3(T / 64, INW / 64, 1), 256, 0, stream>>>(FInProj{p}); ngemm<FKV><<<dim3(BATCH * MEML / 64, 2048 / 64, 1), 256, 0, stream>>>(FKV{p}); } else run(PH_INPROJ, PH_INPROJ + 1);
    if (nv(PH_ATTN)) { nattnA<<<3 * 8 * T / 256, 256, 0, stream>>>(p); nattnB<<<16 * T / 256, 256, 0, stream>>>(p); sublnB<<<T * 4 / 4, 256, 0, stream>>>(p); } else run(PH_ATTN, PH_ATTN + 1);
    if (nv(PH_MERGE)) mergeA<<<T * 512 / 256, 256, 0, stream>>>(p); else run(PH_MERGE, PH_MERGE + 1);
    if (nv(PH_OUTPROJ)) ngemm<FOutProj><<<dim3(T / 64, DM / 64, 1), 256, 0, stream>>>(FOutProj{p}); else run(PH_OUTPROJ, PH_OUTPROJ + 1);
    if (nv(PH_LN1)) ln_pass<<<T / 4, 256, 0, stream>>>((const bf16*)(ws + WS_Y1), (bf16*)(ws + WS_H1), p.ln1_g, p.ln1_b); else run(PH_LN1, PH_LN1 + 1);
    if (nv(PH_QMEM)) ngemm<FQMem><<<dim3(T / 64, DM / 64, 1), 256, 0, stream>>>(FQMem{p}); else run(PH_QMEM, PH_QMEM + 1);
    if (nv(PH_MEMATTN)) { ngemm<FMemS><<<dim3(T / 64, 256 / 64, 4), 256, 0, stream>>>(FMemS{p}); softmaxM<<<T * 4 / 4, 256, 0, stream>>>(p); ngemm<FMemO><<<dim3(T / 64, 256 / 64, 4), 256, 0, stream>>>(FMemO{p}); } else run(PH_MEMATTN, PH_MEMATTN + 1);
    if (nv(PH_WO)) ngemm<FWo><<<dim3(T / 64, DM / 64, 1), 256, 0, stream>>>(FWo{p}); else run(PH_WO, PH_WO + 1);
    if (nv(PH_LN2)) ln_pass<<<T / 4, 256, 0, stream>>>((const bf16*)(ws + WS_Y2), (bf16*)(ws + WS_H2), p.ln2_g, p.ln2_b); else run(PH_LN2, PH_LN2 + 1);
    if (nv(PH_ROUTER)) ngemm<FRouter><<<dim3(T / 64, NEXP / 64, 1), 256, 0, stream>>>(FRouter{p}); else run(PH_ROUTER, PH_ROUTER + 1);
    if (nv(PH_ROUTE)) route_pass<<<T / 4, 256, 0, stream>>>(p); else run(PH_ROUTE, PH_ROUTE + 1);
    run(PH_SCATTER, PH_SCATTER + 1);
    if (nv(PH_MOE1)) ngemm<FMoe1><<<dim3(T / 64, 512 / 64, NEXP + 1), 256, 0, stream>>>(FMoe1{p}); else run(PH_MOE1, PH_MOE1 + 1);
    if (nv(PH_MOE2)) ngemm<FMoe2><<<dim3(T / 64, DM / 64, NEXP + 1), 256, 0, stream>>>(FMoe2{p}); else run(PH_MOE2, PH_MOE2 + 1);
    if (nv(PH_COMBINE)) combine_pass<<<T / 4, 256, 0, stream>>>(p); else run(PH_COMBINE, PH_COMBINE + 1);
#else
    prep_kernel<<<T * 8 / 256, 256, 0, stream>>>(p);
    ngemm<FInProj><<<dim3(T / 64, INW / 64, 1), 256, 0, stream>>>(FInProj{p});
    nattnA<<<3 * 8 * T / 256, 256, 0, stream>>>(p);
    mergeA<<<T * 512 / 256, 256, 0, stream>>>(p);
    nattnB<<<16 * T / 256, 256, 0, stream>>>(p);
    sublnB<<<T * 4 / 4, 256, 0, stream>>>(p);
    ngemm<FOutProj><<<dim3(T / 64, DM / 64, 1), 256, 0, stream>>>(FOutProj{p});
    ln_pass<<<T / 4, 256, 0, stream>>>((const bf16*)(ws + WS_Y1), (bf16*)(ws + WS_H1), p.ln1_g, p.ln1_b);
    ngemm<FQMem><<<dim3(T / 64, DM / 64, 1), 256, 0, stream>>>(FQMem{p});
    ngemm<FKV><<<dim3(BATCH * MEML / 64, 2048 / 64, 1), 256, 0, stream>>>(FKV{p});
    ngemm<FMemS><<<dim3(T / 64, 256 / 64, 4), 256, 0, stream>>>(FMemS{p});
    softmaxM<<<T * 4 / 4, 256, 0, stream>>>(p);
    ngemm<FMemO><<<dim3(T / 64, 256 / 64, 4), 256, 0, stream>>>(FMemO{p});
    ngemm<FWo><<<dim3(T / 64, DM / 64, 1), 256, 0, stream>>>(FWo{p});
    ln_pass<<<T / 4, 256, 0, stream>>>((const bf16*)(ws + WS_Y2), (bf16*)(ws + WS_H2), p.ln2_g, p.ln2_b);
    ngemm<FRouter><<<dim3(T / 64, NEXP / 64, 1), 256, 0, stream>>>(FRouter{p});
    route_pass<<<T / 4, 256, 0, stream>>>(p);
    scan_pass<<<1, 256, 0, stream>>>(p);
    scatter_pass<<<T * 8 / 256, 256, 0, stream>>>(p);
    ngemm<FMoe1><<<dim3(T / 64, 512 / 64, NEXP + 1), 256, 0, stream>>>(FMoe1{p});
    ngemm<FMoe2><<<dim3(T / 64, DM / 64, NEXP + 1), 256, 0, stream>>>(FMoe2{p});
    combine_pass<<<T / 4, 256, 0, stream>>>(p);
#endif
}
```

```cpp
#define MK_MODE 1
#define NAIVE_MASK 0
#define REP_MASK 0
#include <hip/hip_runtime.h>
#include <hip/hip_cooperative_groups.h>
#include <cstdio>
#include <cstdint>
#include <cmath>
namespace cg = cooperative_groups;

constexpr int BATCH = 8, SEQ = 4096, DM = 1024, T = BATCH * SEQ;
constexpr int MEML = 256;
constexpr int INW = 3072;
constexpr int NEXP = 256, TOPK = 8, EDIM = 256;
constexpr int AROWS = T * TOPK;
constexpr float LN_EPS = 1e-5f, SUBLN_EPS = 1e-5f;
constexpr float DN_ALPHA = 1.189207115002721f;
constexpr float LOG2E = 1.4426950408889634f;
constexpr float QSCALE64 = 0.125f * LOG2E;
constexpr float QSCALE256 = 0.0625f * LOG2E;
constexpr float LAMBDA_INIT = 0.2f;
constexpr float ROUTED_SCALE = 2.5f;

constexpr size_t MiB = 1u << 20;
constexpr size_t WS_CNT = 0;
constexpr int CNT_STRIDE = 32;
constexpr size_t WS_CNTP = 321 * MiB;
constexpr size_t WS_START = 4096;
constexpr size_t WS_SCAL = 8192;
constexpr size_t WS_NRT = 12288;
constexpr size_t WS_TILETAB = 16384;
constexpr size_t WS_BAR = 65536;
constexpr size_t WS_SN = 81920;
constexpr size_t WS_CN = 86016;
constexpr size_t WS_ECTR = 90112;
constexpr size_t WS_LCTR = 90240;
constexpr size_t WS_SN2 = 94208;
constexpr size_t WS_CN2 = 95232;
constexpr size_t WS_STATS1 = 131072;
constexpr size_t WS_STATS2 = 131072 + 262144;
constexpr size_t WS_ZERO_END = 131072 + 2 * 262144;
constexpr size_t WS_CS = 1 * MiB;
constexpr size_t WS_RIDX = 4 * MiB, WS_RW = 5 * MiB, WS_RRANK = 6 * MiB, WS_POS = 7 * MiB;
constexpr size_t WS_ROWTOK = 8 * MiB, WS_ROWW = 10 * MiB;
constexpr size_t WS_LSEA = 12 * MiB;
constexpr size_t WS_KVM = 16 * MiB;
constexpr size_t WS_MEMB = 24 * MiB;
constexpr size_t WS_WINT = 32 * MiB;
constexpr size_t WS_WOUTT = 38 * MiB;
constexpr size_t WS_WQT = 40 * MiB;
constexpr size_t WS_WKVT = 42 * MiB;
constexpr size_t WS_WOT = 46 * MiB;
constexpr size_t WS_WRT = 48 * MiB;
constexpr size_t WS_WTD = 64 * MiB;
constexpr size_t WS_H2Q = 129 * MiB;
constexpr size_t WS_H2 = 193 * MiB;
constexpr size_t WS_MIXIN = 193 * MiB;
constexpr size_t WS_Y1 = 257 * MiB;
constexpr size_t WS_DD = 257 * MiB;
constexpr size_t WS_H1 = 321 * MiB;
constexpr size_t WS_SLOTTOK = 321 * MiB;
constexpr size_t WS_SLOTW = 353 * MiB;
constexpr size_t WS_HB = 257 * MiB;
constexpr size_t WS_WTGU = 401 * MiB;
constexpr size_t WS_Y = 448 * MiB;
constexpr size_t WS_PROJ = 658 * MiB;
constexpr size_t WS_QM = 658 * MiB;
constexpr size_t WS_MO = 722 * MiB;
constexpr size_t WS_Y2 = 786 * MiB;
constexpr size_t WS_PARTA = 850 * MiB;
constexpr size_t WS_LOGITS = 850 * MiB;
constexpr size_t WS_SS = 850 * MiB;
constexpr size_t WS_XB = 946 * MiB;
constexpr size_t WS_END = 1024 * MiB;

typedef unsigned short bf16;
__device__ __forceinline__ float bf2f(bf16 v) { return __uint_as_float(((unsigned)v) << 16); }
__device__ __forceinline__ bf16 f2bf(float f) { unsigned u = __float_as_uint(f); return (bf16)((u + 0x7fffu + ((u >> 16) & 1u)) >> 16); }

struct P {
    const float *x, *mem; const int* pos;
    const float *w_in, *w_out, *lq1, *lk1, *lq2, *lk2, *subln_g, *ln1_g, *ln1_b;
    const float *wq, *wkv, *wo, *ln2_g, *ln2_b, *w_router, *e_bias, *w_gate, *w_up, *w_down;
    const float *ws_gate, *ws_up, *ws_down, *ln3_g, *ln3_b;
    float* out; unsigned char* ws;
};

__host__ __device__ __forceinline__ int sigma_dim(int p) { return p < 16 ? (p >> 1) + 8 * (p & 1) : p; }
__device__ __forceinline__ int proj_src_col(int c) {
    const int seg = c >> 9;
    if (seg == 2 || seg == 5) return c;
    return (c & ~63) | sigma_dim(c & 63);
}

__global__ void prep_kernel(P p) {
    const int i = blockIdx.x * blockDim.x + threadIdx.x;
    if (i < T * 8) {
        const int t = i >> 3, j = i & 7;
        const float inv = powf(500000.0f, -(float)(2 * j) / 16.0f);
        const float ang = (float)p.pos[t] * inv;
        float2* cs = (float2*)(p.ws + WS_CS);
        cs[i] = make_float2(cosf(ang), sinf(ang));
    }
    if (i < 256) ((int*)(p.ws + WS_CNT))[i] = 0;
    if (i == 0) {
        float a = 0.f, b = 0.f;
        for (int k = 0; k < 64; ++k) { a += p.lq1[k] * p.lk1[k]; b += p.lq2[k] * p.lk2[k]; }
        ((float*)(p.ws + WS_SCAL))[0] = expf(a) - expf(b) + LAMBDA_INIT;
    }
}

template <class F> __global__ void __launch_bounds__(256) ngemm(F f) {
    __shared__ float As[16][65], Bs[16][65];
    const int g = blockIdx.z, M = f.rows(g);
    const int m0 = blockIdx.x * 64, n0 = blockIdx.y * 64;
    if (m0 >= M) return;
    const int K = f.kdim();
    const int tid = threadIdx.x, tx = tid & 15, ty = tid >> 4;
    float acc[4][4];
#pragma unroll
    for (int i = 0; i < 4; ++i)
#pragma unroll
        for (int j = 0; j < 4; ++j) acc[i][j] = 0.f;
    for (int k0 = 0; k0 < K; k0 += 16) {
#pragma unroll
        for (int i = 0; i < 4; ++i) {
            const int idx = tid + i * 256;
            { const int k = idx & 15, r = idx >> 4; As[k][r] = (m0 + r < M) ? f.a(g, m0 + r, k0 + k) : 0.f; }
            { const int c = idx & 63, k = idx >> 6; Bs[k][c] = f.b(g, k0 + k, n0 + c); }
        }
        __syncthreads();
#pragma unroll
        for (int k = 0; k < 16; ++k) {
            float av[4], bv[4];
#pragma unroll
            for (int i = 0; i < 4; ++i) { av[i] = As[k][ty * 4 + i]; bv[i] = Bs[k][tx * 4 + i]; }
#pragma unroll
            for (int i = 0; i < 4; ++i)
#pragma unroll
                for (int j = 0; j < 4; ++j) acc[i][j] += av[i] * bv[j];
        }
        __syncthreads();
    }
#pragma unroll
    for (int i = 0; i < 4; ++i) { const int r = m0 + ty * 4 + i; if (r < M) f.epi(g, r, n0 + tx * 4, acc[i]); }
}

struct FInProj {
    P p;
    __device__ int rows(int) const { return T; }
    __device__ int kdim() const { return DM; }
    __device__ float a(int, int r, int k) const { return bf2f(f2bf(p.x[(size_t)r * DM + k])); }
    __device__ float b(int, int k, int c) const { return bf2f(f2bf(p.w_in[(size_t)k * INW + proj_src_col(c)])); }
    __device__ void epi(int, int r, int c0, const float (&v)[4]) const {
        bf16* proj = (bf16*)(p.ws + WS_PROJ);
        const int seg = c0 >> 9; float o[4] = {v[0], v[1], v[2], v[3]};
        if (seg != 2 && seg != 5) {
            const int pp = c0 & 63;
            if (pp < 16) {
                const float2* cs = (const float2*)(p.ws + WS_CS) + (size_t)r * 8;
#pragma unroll
                for (int q = 0; q < 2; ++q) { const float2 c = cs[(pp >> 1) + q]; const float t1 = v[2 * q], t2 = v[2 * q + 1]; o[2 * q] = t1 * c.x - t2 * c.y; o[2 * q + 1] = t2 * c.x + t1 * c.y; }
            }
            if (seg == 0 || seg == 3) {
#pragma unroll
                for (int q = 0; q < 4; ++q) o[q] *= QSCALE64;
            }
        }
#pragma unroll
        for (int q = 0; q < 4; ++q) proj[(size_t)r * INW + c0 + q] = f2bf(o[q]);
    }
};
struct FOutProj {
    P p;
    __device__ int rows(int) const { return T; }
    __device__ int kdim() const { return DM; }
    __device__ float a(int, int r, int k) const { return bf2f(((const bf16*)(p.ws + WS_MIXIN))[(size_t)r * DM + k]); }
    __device__ float b(int, int k, int c) const { return bf2f(f2bf(p.w_out[(size_t)k * DM + c])); }
    __device__ void epi(int, int r, int c0, const float (&v)[4]) const {
        bf16* y = (bf16*)(p.ws + WS_Y1);
#pragma unroll
        for (int q = 0; q < 4; ++q) y[(size_t)r * DM + c0 + q] = f2bf(DN_ALPHA * p.x[(size_t)r * DM + c0 + q] + v[q]);
    }
};
struct FQMem {
    P p;
    __device__ int rows(int) const { return T; }
    __device__ int kdim() const { return DM; }
    __device__ float a(int, int r, int k) const { return bf2f(((const bf16*)(p.ws + WS_H1))[(size_t)r * DM + k]); }
    __device__ float b(int, int k, int c) const { return bf2f(f2bf(p.wq[(size_t)k * DM + c])); }
    __device__ void epi(int, int r, int c0, const float (&v)[4]) const {
        bf16* y = (bf16*)(p.ws + WS_QM);
#pragma unroll
        for (int q = 0; q < 4; ++q) y[(size_t)r * DM + c0 + q] = f2bf(v[q] * QSCALE256);
    }
};
struct FKV {
    P p;
    __device__ int rows(int) const { return BATCH * MEML; }
    __device__ int kdim() const { return DM; }
    __device__ float a(int, int r, int k) const { return bf2f(f2bf(p.mem[(size_t)r * DM + k])); }
    __device__ float b(int, int k, int c) const { return bf2f(f2bf(p.wkv[(size_t)k * 2048 + c])); }
    __device__ void epi(int, int r, int c0, const float (&v)[4]) const {
        bf16* y = (bf16*)(p.ws + WS_KVM);
#pragma unroll
        for (int q = 0; q < 4; ++q) y[(size_t)r * 2048 + c0 + q] = f2bf(v[q]);
    }
};
struct FMemS {
    P p;
    __device__ int rows(int) const { return T; }
    __device__ int kdim() const { return 256; }
    __device__ float a(int g, int r, int k) const { return bf2f(((const bf16*)(p.ws + WS_QM))[(size_t)r * DM + g * 256 + k]); }
    __device__ float b(int g, int k, int c) const { const int bb = (blockIdx.x * 64) / SEQ; return bf2f(((const bf16*)(p.ws + WS_KVM))[(size_t)(bb * MEML + c) * 2048 + g * 256 + k]); }
    __device__ void epi(int g, int r, int c0, const float (&v)[4]) const {
        float* s = (float*)(p.ws + WS_SS);
#pragma unroll
        for (int q = 0; q < 4; ++q) s[(size_t)r * DM + g * 256 + c0 + q] = v[q];
    }
};
struct FMemO {
    P p;
    __device__ int rows(int) const { return T; }
    __device__ int kdim() const { return 256; }
    __device__ float a(int g, int r, int k) const { return bf2f(f2bf(((const float*)(p.ws + WS_SS))[(size_t)r * DM + g * 256 + k])); }
    __device__ float b(int g, int k, int c) const { const int bb = (blockIdx.x * 64) / SEQ; return bf2f(((const bf16*)(p.ws + WS_KVM))[(size_t)(bb * MEML + k) * 2048 + 1024 + g * 256 + c]); }
    __device__ void epi(int g, int r, int c0, const float (&v)[4]) const {
        bf16* y = (bf16*)(p.ws + WS_MO);
#pragma unroll
        for (int q = 0; q < 4; ++q) y[(size_t)r * DM + g * 256 + c0 + q] = f2bf(v[q]);
    }
};
struct FWo {
    P p;
    __device__ int rows(int) const { return T; }
    __device__ int kdim() const { return DM; }
    __device__ float a(int, int r, int k) const { return bf2f(((const bf16*)(p.ws + WS_MO))[(size_t)r * DM + k]); }
    __device__ float b(int, int k, int c) const { return bf2f(f2bf(p.wo[(size_t)k * DM + c])); }
    __device__ void epi(int, int r, int c0, const float (&v)[4]) const {
        bf16* y = (bf16*)(p.ws + WS_Y2); const bf16* h1 = (const bf16*)(p.ws + WS_H1);
#pragma unroll
        for (int q = 0; q < 4; ++q) y[(size_t)r * DM + c0 + q] = f2bf(DN_ALPHA * bf2f(h1[(size_t)r * DM + c0 + q]) + v[q]);
    }
};
struct FRouter {
    P p;
    __device__ int rows(int) const { return T; }
    __device__ int kdim() const { return DM; }
    __device__ float a(int, int r, int k) const { return bf2f(((const bf16*)(p.ws + WS_H2))[(size_t)r * DM + k]); }
    __device__ float b(int, int k, int c) const { return bf2f(f2bf(p.w_router[(size_t)k * NEXP + c])); }
    __device__ void epi(int, int r, int c0, const float (&v)[4]) const {
        float* y = (float*)(p.ws + WS_LOGITS);
#pragma unroll
        for (int q = 0; q < 4; ++q) y[(size_t)r * NEXP + c0 + q] = v[q];
    }
};
struct FMoe1 {
    P p;
    __device__ int rows(int g) const { const int* st = (const int*)(p.ws + WS_START); return g < NEXP ? st[g + 1] - st[g] : T; }
    __device__ int kdim() const { return DM; }
    __device__ float a(int g, int r, int k) const {
        const int* st = (const int*)(p.ws + WS_START); const int* rt = (const int*)(p.ws + WS_ROWTOK);
        const int tok = g < NEXP ? rt[st[g] + r] : r;
        return bf2f(((const bf16*)(p.ws + WS_H2))[(size_t)tok * DM + k]);
    }
    __device__ float b(int g, int k, int c) const {
        const float* w = (c & 1) ? (g < NEXP ? p.w_up + (size_t)g * DM * EDIM : p.ws_up) : (g < NEXP ? p.w_gate + (size_t)g * DM * EDIM : p.ws_gate);
        return bf2f(f2bf(w[(size_t)k * EDIM + (c >> 1)]));
    }
    __device__ void epi(int g, int r, int c0, const float (&v)[4]) const {
        const int* st = (const int*)(p.ws + WS_START); bf16* H = (bf16*)(p.ws + WS_HB);
        const size_t row = g < NEXP ? (size_t)st[g] + r : (size_t)AROWS + r;
        const float w = g < NEXP ? ((const float*)(p.ws + WS_ROWW))[row] : 1.f;
#pragma unroll
        for (int q = 0; q < 2; ++q) { const float gg = v[2 * q], uu = v[2 * q + 1]; H[row * EDIM + (c0 >> 1) + q] = f2bf(gg / (1.f + expf(-gg)) * uu * w); }
    }
};
struct FMoe2 {
    P p;
    __device__ int rows(int g) const { const int* st = (const int*)(p.ws + WS_START); return g < NEXP ? st[g + 1] - st[g] : T; }
    __device__ int kdim() const { return EDIM; }
    __device__ float a(int g, int r, int k) const {
        const int* st = (const int*)(p.ws + WS_START); const bf16* H = (const bf16*)(p.ws + WS_HB);
        const size_t row = g < NEXP ? (size_t)st[g] + r : (size_t)AROWS + r;
        return bf2f(H[row * EDIM + k]);
    }
    __device__ float b(int g, int k, int c) const { const float* w = g < NEXP ? p.w_down + (size_t)g * EDIM * DM : p.ws_down; return bf2f(f2bf(w[(size_t)k * DM + c])); }
    __device__ void epi(int g, int r, int c0, const float (&v)[4]) const {
        const int* st = (const int*)(p.ws + WS_START); bf16* Y = (bf16*)(p.ws + WS_Y);
        const size_t row = g < NEXP ? (size_t)st[g] + r : (size_t)AROWS + r;
#pragma unroll
        for (int q = 0; q < 4; ++q) Y[row * DM + c0 + q] = f2bf(v[q]);
    }
};

__global__ void __launch_bounds__(256) nattnA(P p) {
    const int i = blockIdx.x * blockDim.x + threadIdx.x;
    if (i >= 3 * 8 * T) return;
    const int t = i % T, h = (i / T) & 7, br = i / (8 * T);
    const int dil = br == 0 ? 1 : (br == 1 ? 4 : 16);
    const int s = t % SEQ, b0 = t - s;
    const bf16* proj = (const bf16*)(p.ws + WS_PROJ);
    float q[64], o[64];
#pragma unroll
    for (int e = 0; e < 64; ++e) { q[e] = bf2f(proj[(size_t)t * INW + h * 64 + e]); o[e] = 0.f; }
    float m = -INFINITY, l = 0.f;
    for (int j = 0; j <= 128; ++j) {
        const int ks = s - j * dil; if (ks < 0) break;
        const bf16* kr = proj + (size_t)(b0 + ks) * INW + 512 + h * 64;
        const bf16* vr = proj + (size_t)(b0 + ks) * INW + 1024 + h * 64;
        float sc = 0.f;
#pragma unroll
        for (int e = 0; e < 64; ++e) sc += q[e] * bf2f(kr[e]);
        const float mn = fmaxf(m, sc), al = exp2f(m - mn), pe = exp2f(sc - mn);
        l = l * al + pe;
#pragma unroll
        for (int e = 0; e < 64; ++e) o[e] = o[e] * al + pe * bf2f(vr[e]);
        m = mn;
    }
    bf16* pa = (bf16*)(p.ws + WS_PARTA) + ((size_t)br * T + t) * 512 + h * 64;
    const float il = 1.f / l;
#pragma unroll
    for (int e = 0; e < 64; ++e) pa[e] = f2bf(o[e] * il);
    ((float*)(p.ws + WS_LSEA))[((size_t)br * T + t) * 8 + h] = m + log2f(l);
}
__global__ void mergeA(P p) {
    const int i = blockIdx.x * blockDim.x + threadIdx.x;
    if (i >= T * 512) return;
    const int t = i >> 9, c = i & 511, h = c >> 6;
    const float* lse = (const float*)(p.ws + WS_LSEA);
    const float l0 = lse[(size_t)t * 8 + h], l1 = lse[((size_t)T + t) * 8 + h], l2 = lse[((size_t)2 * T + t) * 8 + h];
    const float mx = fmaxf(l0, fmaxf(l1, l2));
    const float w0 = exp2f(l0 - mx), w1 = exp2f(l1 - mx), w2 = exp2f(l2 - mx), inv = 1.f / (w0 + w1 + w2);
    const bf16* pa = (const bf16*)(p.ws + WS_PARTA);
    const float v = (w0 * bf2f(pa[(size_t)t * 512 + c]) + w1 * bf2f(pa[((size_t)T + t) * 512 + c]) + w2 * bf2f(pa[((size_t)2 * T + t) * 512 + c])) * inv;
    ((bf16*)(p.ws + WS_MIXIN))[(size_t)t * DM + c] = f2bf(v);
}
__global__ void __launch_bounds__(256) nattnB(P p) {
    const int i = blockIdx.x * blockDim.x + threadIdx.x;
    if (i >= 16 * T) return;
    const int t = i % T, ch = (i / T) & 3, h = i / (4 * T);
    const int s = t % SEQ, b0 = t - s;
    const bf16* proj = (const bf16*)(p.ws + WS_PROJ);
    float q0[64], q1[64], o0[32], o1[32];
#pragma unroll
    for (int e = 0; e < 64; ++e) { q0[e] = bf2f(proj[(size_t)t * INW + 1536 + h * 128 + e]); q1[e] = bf2f(proj[(size_t)t * INW + 1536 + h * 128 + 64 + e]); }
#pragma unroll
    for (int e = 0; e < 32; ++e) { o0[e] = 0.f; o1[e] = 0.f; }
    float m0 = -INFINITY, l0 = 0.f, m1 = -INFINITY, l1 = 0.f;
    for (int ks = 0; ks <= s; ++ks) {
        const bf16* kr = proj + (size_t)(b0 + ks) * INW + 2048 + h * 128;
        const bf16* vr = proj + (size_t)(b0 + ks) * INW + 2560 + h * 128 + ch * 32;
        float s0 = 0.f, s1 = 0.f;
#pragma unroll
        for (int e = 0; e < 64; ++e) { s0 += q0[e] * bf2f(kr[e]); s1 += q1[e] * bf2f(kr[64 + e]); }
        const float mn0 = fmaxf(m0, s0), a0 = exp2f(m0 - mn0), p0 = exp2f(s0 - mn0);
        const float mn1 = fmaxf(m1, s1), a1 = exp2f(m1 - mn1), p1 = exp2f(s1 - mn1);
        l0 = l0 * a0 + p0; l1 = l1 * a1 + p1; m0 = mn0; m1 = mn1;
#pragma unroll
        for (int e = 0; e < 32; ++e) { const float v = bf2f(vr[e]); o0[e] = o0[e] * a0 + p0 * v; o1[e] = o1[e] * a1 + p1 * v; }
    }
    const float lam = ((const float*)(p.ws + WS_SCAL))[0];
    float* dd = (float*)(p.ws + WS_DD) + (size_t)t * 512 + h * 128 + ch * 32;
    const float i0 = 1.f / l0, i1 = 1.f / l1;
#pragma unroll
    for (int e = 0; e < 32; ++e) dd[e] = o0[e] * i0 - lam * o1[e] * i1;
}
__global__ void sublnB(P p) {
    const int w = (blockIdx.x * blockDim.x + threadIdx.x) >> 6, lane = threadIdx.x & 63;
    if (w >= T * 4) return;
    const int t = w >> 2, h = w & 3;
    const float* dd = (const float*)(p.ws + WS_DD) + (size_t)t * 512 + h * 128;
    const float a = dd[lane], b = dd[lane + 64];
    float ss = a * a + b * b;
    for (int o = 1; o < 64; o <<= 1) ss += __shfl_xor(ss, o);
    const float r = rsqrtf(ss * (1.f / 128.f) + SUBLN_EPS) * (1.f - LAMBDA_INIT);
    bf16* mx = (bf16*)(p.ws + WS_MIXIN) + (size_t)t * DM + 512 + h * 128;
    mx[lane] = f2bf(a * r * p.subln_g[lane]); mx[lane + 64] = f2bf(b * r * p.subln_g[lane + 64]);
}
__global__ void softmaxM(P p) {
    const int w = (blockIdx.x * blockDim.x + threadIdx.x) >> 6, lane = threadIdx.x & 63;
    if (w >= T * 4) return;
    float* s = (float*)(p.ws + WS_SS) + (size_t)w * 256;
    float v[4]; float mx = -INFINITY;
#pragma unroll
    for (int j = 0; j < 4; ++j) { v[j] = s[lane + 64 * j]; mx = fmaxf(mx, v[j]); }
    for (int o = 1; o < 64; o <<= 1) mx = fmaxf(mx, __shfl_xor(mx, o));
    float sum = 0.f;
#pragma unroll
    for (int j = 0; j < 4; ++j) { v[j] = exp2f(v[j] - mx); sum += v[j]; }
    for (int o = 1; o < 64; o <<= 1) sum += __shfl_xor(sum, o);
    const float inv = 1.f / sum;
#pragma unroll
    for (int j = 0; j < 4; ++j) s[lane + 64 * j] = v[j] * inv;
}

__global__ void __launch_bounds__(256) ln_pass(const bf16* __restrict__ in, bf16* __restrict__ outp, const float* __restrict__ g, const float* __restrict__ b) {
    const int w = (blockIdx.x * blockDim.x + threadIdx.x) >> 6, lane = threadIdx.x & 63;
    if (w >= T) return;
    const bf16* r = in + (size_t)w * DM;
    float v[16]; float s = 0.f;
#pragma unroll
    for (int j = 0; j < 4; ++j) { const uint2 u = *(const uint2*)(r + j * 256 + lane * 4);
        v[4 * j] = __uint_as_float(u.x << 16); v[4 * j + 1] = __uint_as_float(u.x & 0xffff0000u); v[4 * j + 2] = __uint_as_float(u.y << 16); v[4 * j + 3] = __uint_as_float(u.y & 0xffff0000u); }
#pragma unroll
    for (int j = 0; j < 16; ++j) s += v[j];
    for (int o = 1; o < 64; o <<= 1) s += __shfl_xor(s, o);
    const float mu = s * (1.f / DM); float q = 0.f;
#pragma unroll
    for (int j = 0; j < 16; ++j) { v[j] -= mu; q += v[j] * v[j]; }
    for (int o = 1; o < 64; o <<= 1) q += __shfl_xor(q, o);
    const float rs = rsqrtf(q * (1.f / DM) + LN_EPS);
#pragma unroll
    for (int j = 0; j < 4; ++j) { const int c = j * 256 + lane * 4; const float4 gg = *(const float4*)(g + c), bb = *(const float4*)(b + c);
        uint2 u; u.x = (unsigned)f2bf(v[4 * j] * rs * gg.x + bb.x) | ((unsigned)f2bf(v[4 * j + 1] * rs * gg.y + bb.y) << 16);
        u.y = (unsigned)f2bf(v[4 * j + 2] * rs * gg.z + bb.z) | ((unsigned)f2bf(v[4 * j + 3] * rs * gg.w + bb.w) << 16);
        *(uint2*)(outp + (size_t)w * DM + c) = u; }
}

__global__ void __launch_bounds__(256) route_pass(P p) {
    const int w = (blockIdx.x * blockDim.x + threadIdx.x) >> 6, lane = threadIdx.x & 63;
    if (w >= T) return;
    const float4 lg = *(const float4*)((const float*)(p.ws + WS_LOGITS) + (size_t)w * NEXP + lane * 4);
    const float4 eb = *(const float4*)(p.e_bias + lane * 4);
    float sc[4] = {1.f / (1.f + expf(-lg.x)), 1.f / (1.f + expf(-lg.y)), 1.f / (1.f + expf(-lg.z)), 1.f / (1.f + expf(-lg.w))};
    float bs[4] = {sc[0] + eb.x, sc[1] + eb.y, sc[2] + eb.z, sc[3] + eb.w};
    float m1 = fmaxf(bs[0], bs[1]), m2 = fminf(bs[0], bs[1]);
    { const float c = bs[2]; const float n1 = fmaxf(m1, c); m2 = fmaxf(m2, fminf(m1, c)); m1 = n1; }
    { const float c = bs[3]; const float n1 = fmaxf(m1, c); m2 = fmaxf(m2, fminf(m1, c)); m1 = n1; }
#pragma unroll
    for (int o = 1; o < 8; o <<= 1) { const float b1 = __shfl_xor(m1, o), b2 = __shfl_xor(m2, o); const float n1 = fmaxf(m1, b1); m2 = fmaxf(fminf(m1, b1), fmaxf(m2, b2)); m1 = n1; }
    const float gs = m1 + m2; const int grp = lane >> 3;
    int rank = 0;
#pragma unroll
    for (int g2 = 0; g2 < 8; ++g2) { const float o = __shfl(gs, g2 * 8); rank += (o > gs || (o == gs && g2 < grp)) ? 1 : 0; }
    const bool sel = rank < 4;
    float cand[4];
#pragma unroll
    for (int j = 0; j < 4; ++j) cand[j] = sel ? bs[j] : -INFINITY;
    int myidx = 0; float myw = 0.f; float wsum = 0.f;
    for (int k = 0; k < TOPK; ++k) {
        float bv = cand[0]; int bi = lane * 4;
#pragma unroll
        for (int j = 1; j < 4; ++j) if (cand[j] > bv) { bv = cand[j]; bi = lane * 4 + j; }
#pragma unroll
        for (int o = 1; o < 64; o <<= 1) { const float ov = __shfl_xor(bv, o); const int oi = __shfl_xor(bi, o); if (ov > bv || (ov == bv && oi < bi)) { bv = ov; bi = oi; } }
        const int own = bi >> 2, el = bi & 3;
        const float sv = el == 0 ? sc[0] : (el == 1 ? sc[1] : (el == 2 ? sc[2] : sc[3]));
        const float wv = __shfl(sv, own);
        if (lane == own) { if (el == 0) cand[0] = -INFINITY; else if (el == 1) cand[1] = -INFINITY; else if (el == 2) cand[2] = -INFINITY; else cand[3] = -INFINITY; }
        wsum += wv;
        if (lane == k) { myidx = bi; myw = wv; }
    }
    if (lane < TOPK) {
        const float wn = myw / wsum * ROUTED_SCALE;
        const int rk = atomicAdd((int*)(p.ws + WS_CNT) + myidx, 1);
        ((int*)(p.ws + WS_RIDX))[(size_t)w * 8 + lane] = myidx;
        ((float*)(p.ws + WS_RW))[(size_t)w * 8 + lane] = wn;
        ((int*)(p.ws + WS_RRANK))[(size_t)w * 8 + lane] = rk;
    }
}
__global__ void scan_pass(P p) {
    __shared__ int sh[256];
    const int i = threadIdx.x; const int c = ((const int*)(p.ws + WS_CNT))[i];
    sh[i] = c; __syncthreads();
    for (int o = 1; o < 256; o <<= 1) { const int v = i >= o ? sh[i - o] : 0; __syncthreads(); sh[i] += v; __syncthreads(); }
    int* st = (int*)(p.ws + WS_START);
    st[i + 1] = sh[i]; if (i == 0) st[0] = 0;
}
__global__ void scatter_pass(P p) {
    const int i = blockIdx.x * blockDim.x + threadIdx.x;
    if (i >= T * 8) return;
    const int e = ((const int*)(p.ws + WS_RIDX))[i], rk = ((const int*)(p.ws + WS_RRANK))[i];
    const int pos = ((const int*)(p.ws + WS_START))[e] + rk;
    ((int*)(p.ws + WS_ROWTOK))[pos] = i >> 3;
    ((float*)(p.ws + WS_ROWW))[pos] = ((const float*)(p.ws + WS_RW))[i];
    ((int*)(p.ws + WS_POS))[i] = pos;
}
__global__ void __launch_bounds__(256) combine_pass(P p) {
    const int w = (blockIdx.x * blockDim.x + threadIdx.x) >> 6, lane = threadIdx.x & 63;
    if (w >= T) return;
    const bf16* h2 = (const bf16*)(p.ws + WS_H2) + (size_t)w * DM;
    const bf16* Y = (const bf16*)(p.ws + WS_Y);
    const int* pos = (const int*)(p.ws + WS_POS) + (size_t)w * 8;
    float v[16];
#pragma unroll
    for (int j = 0; j < 4; ++j) { const uint2 u = *(const uint2*)(h2 + j * 256 + lane * 4);
        v[4 * j] = DN_ALPHA * __uint_as_float(u.x << 16); v[4 * j + 1] = DN_ALPHA * __uint_as_float(u.x & 0xffff0000u); v[4 * j + 2] = DN_ALPHA * __uint_as_float(u.y << 16); v[4 * j + 3] = DN_ALPHA * __uint_as_float(u.y & 0xffff0000u); }
#pragma unroll
    for (int k = 0; k < 9; ++k) {
        const size_t row = k < 8 ? (size_t)pos[k < 8 ? k : 0] : (size_t)AROWS + w;
        const bf16* yr = Y + row * DM;
#pragma unroll
        for (int j = 0; j < 4; ++j) { const uint2 u = *(const uint2*)(yr + j * 256 + lane * 4);
            v[4 * j] += __uint_as_float(u.x << 16); v[4 * j + 1] += __uint_as_float(u.x & 0xffff0000u); v[4 * j + 2] += __uint_as_float(u.y << 16); v[4 * j + 3] += __uint_as_float(u.y & 0xffff0000u); }
    }
    float s = 0.f;
#pragma unroll
    for (int j = 0; j < 16; ++j) s += v[j];
    for (int o = 1; o < 64; o <<= 1) s += __shfl_xor(s, o);
    const float mu = s * (1.f / DM); float q = 0.f;
#pragma unroll
    for (int j = 0; j < 16; ++j) { v[j] -= mu; q += v[j] * v[j]; }
    for (int o = 1; o < 64; o <<= 1) q += __shfl_xor(q, o);
    const float rs = rsqrtf(q * (1.f / DM) + LN_EPS);
#pragma unroll
    for (int j = 0; j < 4; ++j) { const int c = j * 256 + lane * 4; const float4 gg = *(const float4*)(p.ln3_g + c), bb = *(const float4*)(p.ln3_b + c);
        float4 o; o.x = v[4 * j] * rs * gg.x + bb.x; o.y = v[4 * j + 1] * rs * gg.y + bb.y; o.z = v[4 * j + 2] * rs * gg.z + bb.z; o.w = v[4 * j + 3] * rs * gg.w + bb.w;
        *(float4*)(p.out + (size_t)w * DM + c) = o; }
}

#define LAS __attribute__((address_space(3)))
typedef short bf16x8 __attribute__((ext_vector_type(8)));
typedef short s16x4 __attribute__((ext_vector_type(4)));
typedef float f32x2 __attribute__((ext_vector_type(2)));
typedef float f32x4 __attribute__((ext_vector_type(4)));
typedef float f32x16 __attribute__((ext_vector_type(16)));
typedef unsigned u32x2 __attribute__((ext_vector_type(2)));
typedef unsigned u32x4 __attribute__((ext_vector_type(4)));
typedef __bf16 bf16x2_t __attribute__((ext_vector_type(2)));

constexpr int NWAVES = 8, NTHR = 512;
constexpr int LDS_BYTES = 163840;
constexpr int LDS_XTRA = 131072;
#ifndef MOE_ROWS_DEF
#define MOE_ROWS_DEF 256
#endif
#ifndef LN2_SPLIT
#define LN2_SPLIT 24576
#endif
#ifndef LN2_FOLD
#define LN2_FOLD 1
#endif
#ifndef WO_STATS
#define WO_STATS LN2_FOLD
#endif
#ifndef ECHUNK_CFG
#define ECHUNK_CFG 8
#endif
#ifndef NT_OUT
#define NT_OUT 0
#endif
#if NT_OUT
#define OUT_ST16(ptr, val) __builtin_nontemporal_store((val), (u32x4*)(ptr))
#define OUT_AUX 2
#else
#define OUT_ST16(ptr, val) (*(u32x4*)(ptr) = (val))
#define OUT_AUX 0
#endif
#ifndef XB_FLAT_WAIT
#define XB_FLAT_WAIT 1
#endif
#ifndef NO_SCATTER
#define NO_SCATTER 0
#endif
#ifndef QMEM_FUSE
#define QMEM_FUSE 1
#endif
#ifndef MOE2_FLIP
#define MOE2_FLIP 1
#endif
#ifndef NDC_CFG
#define NDC_CFG 0
#endif
#ifndef CONV_SPLIT
#define CONV_SPLIT 3600
#endif
#ifndef ROUTE_IL
#define ROUTE_IL 4
#endif
#ifndef EXP_WG
#define EXP_WG 1
#endif
#ifndef NCJ_CFG
#define NCJ_CFG 12
#endif
constexpr int MOE_ROWS = MOE_ROWS_DEF;
constexpr int MOE_RSH = MOE_ROWS == 256 ? 8 : 7; constexpr bool MOE_HALFM = MOE_ROWS == 128;

__device__ __forceinline__ unsigned cvtpk(float lo, float hi) { f32x2 v = {lo, hi}; bf16x2_t b = __builtin_convertvector(v, bf16x2_t); return __builtin_bit_cast(unsigned, b); }
__device__ __forceinline__ int ld_i32_agent(const int* p) { return __hip_atomic_load(p, __ATOMIC_RELAXED, __HIP_MEMORY_SCOPE_AGENT); }
__device__ __forceinline__ float fast_exp2(float x) { return __builtin_amdgcn_exp2f(x); }
__device__ __forceinline__ float fast_rcp(float x) { return __builtin_amdgcn_rcpf(x); }

namespace gm {
constexpr int BM = 256, BK = 64, HALF = 128, HTB = HALF * BK * 2, STAGE_BYTES = 8 * HTB, NXCD = 8, WGM = 8;
__device__ __forceinline__ int lds_byte(int r, int c) { const int st = (r >> 4) * 2 + (c >> 5), rr = r & 15, cc = c & 31, ob = rr * 64 + cc * 2; return st * 1024 + (ob ^ (((ob >> 9) & 1) << 5)); }
__device__ __forceinline__ void stage_rc(int b, int& R, int& C) { const int st = b / 1024, sb = b % 1024, swz = sb ^ (((sb >> 9) & 1) << 5); R = (st >> 1) * 16 + swz / 64; C = (st & 1) * 32 + (swz % 64) / 2; }
__device__ __forceinline__ int perm32(int rho) { const int n = rho >> 4, i = rho & 15; return 8 * (i >> 2) + 4 * n + (i & 3); }

struct Unit { int pm, pn, e, nvalid, rowbase, slot; unsigned boff; };

struct DenseSched {
    static constexpr bool GATHER_A = false;
    int nM, nN, nwg, G, c, K; const char* Bt; int i_lo = 0, i_cnt = 1 << 30;
    __device__ __forceinline__ void init(int M, int N, int K_, const void* Bt_, int G_, int c_) { nM = M / BM; nN = N / BM; nwg = nM * nN; G = G_; c = c_; K = K_; Bt = (const char*)Bt_; }
    __device__ __forceinline__ bool next(int i, Unit& u) const {
        if (i >= i_cnt) return false;
        const long L = (long)(i + i_lo) * G + c; if (L >= nwg) return false;
        int wgid = (int)L; { const int q = nwg / NXCD, r = nwg % NXCD, xcd = wgid % NXCD, off = wgid / NXCD; wgid = (xcd < r ? xcd * (q + 1) : r * (q + 1) + (xcd - r) * q) + off; }
        const int nig = WGM * nN, gid = wgid / nig, fm = gid * WGM, gsz = (nM - fm) < WGM ? (nM - fm) : WGM;
        u.pm = fm + ((wgid % nig) % gsz); u.pn = (wgid % nig) / gsz; u.e = 0; u.nvalid = 256; u.rowbase = u.pm * 256; u.slot = i;
        u.boff = (unsigned)u.pn * 256u * (unsigned)(K * 2); return true;
    }
    __device__ __forceinline__ unsigned aoff(const Unit& u, int r) const { return (unsigned)(u.rowbase + r) * (unsigned)(K * 2); }
    __device__ __forceinline__ unsigned abase(const Unit& u) const { return (unsigned)u.rowbase * (unsigned)(K * 2); }
    __device__ __forceinline__ const char* bbase() const { return Bt; }
};
__device__ __forceinline__ int moe_uidx(int i, int G, int c) { return (G == 256) ? ((i * 8 + (c & 7)) * 32) + (c >> 3) : i * G + c; }
template <int NPN_LOG2, int KB  , bool GATHER> struct MoeSched {
    static constexpr bool GATHER_A = GATHER;
    const LAS int* xd; const LAS int* xt; int n_my, G, c; const char* Wt; size_t estride;
    __device__ bool next(int i, Unit& u) const {
        if (i >= n_my) return false;
        const int uidx = moe_uidx(i, G, c); u.pn = uidx & ((1 << NPN_LOG2) - 1); u.slot = i;
        u.e = __builtin_amdgcn_readfirstlane(xd[4 * i]); u.pm = __builtin_amdgcn_readfirstlane(xd[4 * i + 1]);
        u.rowbase = __builtin_amdgcn_readfirstlane(xd[4 * i + 2]); u.nvalid = __builtin_amdgcn_readfirstlane(xd[4 * i + 3]);
        u.boff = (unsigned)u.e * (unsigned)estride + (unsigned)u.pn * 256u * (unsigned)(KB * 2); return true;
    }
    __device__ unsigned aoff(const Unit& u, int r) const { return (unsigned)xt[u.slot * MOE_ROWS + (r & (MOE_ROWS - 1))] * (unsigned)(KB * 2); }
    __device__ unsigned abase(const Unit& u) const { return (unsigned)u.rowbase * (unsigned)(KB * 2); }
    __device__ const char* bbase() const { return Wt; }
};
template <int NPN_LOG2, int KB> struct MoeSchedFlip {
    static constexpr bool GATHER_A = false;
    const LAS int* xd; int n_my, G, c; const char* Hb; size_t estride;
    __device__ bool next(int i, Unit& u) const {
        if (i >= n_my) return false;
        const int uidx = moe_uidx(i, G, c); u.pn = uidx & ((1 << NPN_LOG2) - 1); u.slot = i;
        u.e = __builtin_amdgcn_readfirstlane(xd[4 * i]); u.pm = __builtin_amdgcn_readfirstlane(xd[4 * i + 1]);
        u.rowbase = __builtin_amdgcn_readfirstlane(xd[4 * i + 2]); u.nvalid = __builtin_amdgcn_readfirstlane(xd[4 * i + 3]);
        u.boff = (unsigned)u.rowbase * (unsigned)(KB * 2); return true;
    }
    __device__ unsigned abase(const Unit& u) const { return (unsigned)u.e * (unsigned)estride + (unsigned)u.pn * 256u * (unsigned)(KB * 2); }
    __device__ const char* bbase() const { return Hb; }
};
constexpr int XD_INTS = 256, XT_SLOTS = MOE_ROWS == 256 ? 11 : 22;
template <int NPN_LOG2, bool WITH_ROWS> __device__ __forceinline__ int moe_preload(LAS unsigned char* lds, const int* tab, int nunits, int G, int c, const int* rowtok, const float* roww) {
    LAS int* xd = (LAS int*)(lds + LDS_XTRA); LAS int* xt = xd + XD_INTS; LAS float* xw = (LAS float*)(xt + XT_SLOTS * MOE_ROWS);
    int n_my = 0;
    while (n_my < (WITH_ROWS ? XT_SLOTS : 64) && moe_uidx(n_my, G, c) < nunits) ++n_my;
    const int tid = threadIdx.x;
    if (tid < n_my * 4) xd[tid] = ld_i32_agent(tab + 4 * (moe_uidx(tid >> 2, G, c) >> NPN_LOG2) + (tid & 3));
    if (WITH_ROWS) {
        for (int idx = tid; idx < n_my * MOE_ROWS; idx += NTHR) {
            const int slot = idx >> MOE_RSH, r = idx & (MOE_ROWS - 1), rt = moe_uidx(slot, G, c) >> NPN_LOG2;
            const int e = ld_i32_agent(tab + 4 * rt), rowbase = ld_i32_agent(tab + 4 * rt + 2), nvalid = ld_i32_agent(tab + 4 * rt + 3);
            const int rr = r < nvalid ? r : nvalid - 1;
            int tok; float w;
            if (e < NEXP) { tok = ld_i32_agent(rowtok + rowbase + rr); w = __hip_atomic_load(roww + rowbase + rr, __ATOMIC_RELAXED, __HIP_MEMORY_SCOPE_AGENT); } else { tok = rowbase - AROWS + r; w = 1.f; }
            xt[idx] = tok; xw[idx] = w;
        }
    }
    __syncthreads();
    return n_my;
}
template <int NPN_LOG2> __device__ __forceinline__ int moe_preload_scan(LAS unsigned char* lds, const LAS int* sh, int G, int c, const int* slottok, const float* slotw) {
    LAS int* xd = (LAS int*)(lds + LDS_XTRA); LAS int* xt = xd + XD_INTS; LAS float* xw = (LAS float*)(xt + XT_SLOTS * MOE_ROWS);
    const int nrt_r = sh[511], nunits = (nrt_r + T / MOE_ROWS) << NPN_LOG2;
    int n_my = 0;
    while (n_my < XT_SLOTS && moe_uidx(n_my, G, c) < nunits) ++n_my;
    const int tid = threadIdx.x;
    if (tid < n_my) {
        const int rt = moe_uidx(tid, G, c) >> NPN_LOG2; int e, ti, rowbase, nvalid;
        if (rt >= nrt_r) { e = NEXP; ti = rt - nrt_r; rowbase = AROWS + MOE_ROWS * ti; nvalid = MOE_ROWS; }
        else { int lo = 0, hi = NEXP - 1; while (lo < hi) { const int mid = (lo + hi) >> 1; if (sh[256 + mid] > rt) hi = mid; else lo = mid + 1; }
            e = lo; ti = rt - (e ? sh[256 + e - 1] : 0); const int st_e = e ? sh[e - 1] : 0; rowbase = st_e + MOE_ROWS * ti; nvalid = min(MOE_ROWS, sh[e] - st_e - MOE_ROWS * ti); }
        xd[4 * tid] = e; xd[4 * tid + 1] = ti; xd[4 * tid + 2] = rowbase; xd[4 * tid + 3] = nvalid;
    }
    __syncthreads();
    for (int idx = tid; idx < n_my * MOE_ROWS; idx += NTHR) {
        const int slot = idx >> MOE_RSH, r = idx & (MOE_ROWS - 1);
        const int e = xd[4 * slot], ti = xd[4 * slot + 1], nvalid = xd[4 * slot + 3];
        const int rr = r < nvalid ? r : nvalid - 1;
        int tok; float w;
        if (e < NEXP) { const size_t q = (size_t)e * T + ti * MOE_ROWS + rr; tok = ld_i32_agent(slottok + q); w = __hip_atomic_load(slotw + q, __ATOMIC_RELAXED, __HIP_MEMORY_SCOPE_AGENT); } else { tok = ti * MOE_ROWS + r; w = 1.f; }
        xt[idx] = tok; xw[idx] = w;
    }
    __syncthreads();
    return n_my;
}

typedef f32x4 Acc[2][2][4][2];
__device__ __forceinline__ u32x4 pack8(const f32x4 a, const f32x4 b) { u32x4 w; w.x = cvtpk(a[0], a[1]); w.y = cvtpk(a[2], a[3]); w.z = cvtpk(b[0], b[1]); w.w = cvtpk(b[2], b[3]); return w; }

struct EpiInProj {
    static constexpr bool PERM = true; static constexpr bool FLIP = false; static constexpr int NSTORE = 0; bf16* proj; const float* cs;
    __device__ __forceinline__ void operator()(const Acc& acc, const Unit& u, int wr, int wc, int fr, int fq, const __amdgpu_buffer_rsrc_t rs, const unsigned char* wsbase) const {
#pragma unroll
        for (int ai = 0; ai < 2; ++ai)
#pragma unroll
            for (int m = 0; m < 4; ++m) { const int row = u.pm * 256 + ai * 128 + wr * 64 + m * 16 + fr;
#pragma unroll
                for (int bj = 0; bj < 2; ++bj) { const int c0 = u.pn * 256 + wc * 64 + fq * 16 + bj * 8; const int seg = c0 >> 9;
                    f32x4 v0 = acc[ai][bj][m][0], v1 = acc[ai][bj][m][1];
                    if (seg != 2 && seg != 5) {
                        if ((c0 & 63) < 16) { const int j0 = (c0 & 63) >> 1; const f32x4 ca = *(const f32x4*)(cs + (size_t)row * 16 + 2 * j0), cb = *(const f32x4*)(cs + (size_t)row * 16 + 2 * j0 + 4);
                            { const float t1 = v0[0], t2 = v0[1]; v0[0] = t1 * ca[0] - t2 * ca[1]; v0[1] = t2 * ca[0] + t1 * ca[1]; }
                            { const float t1 = v0[2], t2 = v0[3]; v0[2] = t1 * ca[2] - t2 * ca[3]; v0[3] = t2 * ca[2] + t1 * ca[3]; }
                            { const float t1 = v1[0], t2 = v1[1]; v1[0] = t1 * cb[0] - t2 * cb[1]; v1[1] = t2 * cb[0] + t1 * cb[1]; }
                            { const float t1 = v1[2], t2 = v1[3]; v1[2] = t1 * cb[2] - t2 * cb[3]; v1[3] = t2 * cb[2] + t1 * cb[3]; } }
                        if (seg == 0 || seg == 3) { v0 = v0 * QSCALE64; v1 = v1 * QSCALE64; }
                    }
                    OUT_ST16(proj + (size_t)row * INW + c0, pack8(v0, v1)); } }
    }
};
__device__ __forceinline__ void stats_flush(LAS float* red, float* dst) {
    asm volatile("s_waitcnt lgkmcnt(0)" ::: "memory"); __builtin_amdgcn_s_barrier();
    const int t = threadIdx.x;
    const float v = (red[t] + red[512 + t]) + (red[1024 + t] + red[1536 + t]);
    atomicAdd(dst + t, v);
}
struct EpiOutProj {
    static constexpr bool PERM = true; static constexpr bool FLIP = false; static constexpr int NSTORE = 0; bf16* y; const bf16* xb; float* stats; LAS float* red;
    __device__ __forceinline__ void operator()(const Acc& acc, const Unit& u, int wr, int wc, int fr, int fq, const __amdgpu_buffer_rsrc_t rs, const unsigned char* wsbase) const {
        const int cb = u.pn * 256 + wc * 64 + fq * 16;
        u32x4 xq[2][4][2];
#pragma unroll
        for (int ai = 0; ai < 2; ++ai)
#pragma unroll
            for (int m = 0; m < 4; ++m) { const bf16* xr = xb + (size_t)(u.pm * 256 + ai * 128 + wr * 64 + m * 16 + fr) * DM + cb; xq[ai][m][0] = *(const u32x4*)xr; xq[ai][m][1] = *(const u32x4*)(xr + 8); }
#pragma unroll
        for (int ai = 0; ai < 2; ++ai) {
#pragma unroll
            for (int m = 0; m < 4; ++m) { const int lrow = ai * 128 + wr * 64 + m * 16 + fr, row = u.pm * 256 + lrow; float s1 = 0.f, s2 = 0.f;
#pragma unroll
                for (int bj = 0; bj < 2; ++bj) { const u32x4 w = xq[ai][m][bj]; f32x4 x0, x1;
                    x0[0] = __uint_as_float(w.x << 16); x0[1] = __uint_as_float(w.x & 0xffff0000u); x0[2] = __uint_as_float(w.y << 16); x0[3] = __uint_as_float(w.y & 0xffff0000u);
                    x1[0] = __uint_as_float(w.z << 16); x1[1] = __uint_as_float(w.z & 0xffff0000u); x1[2] = __uint_as_float(w.w << 16); x1[3] = __uint_as_float(w.w & 0xffff0000u);
                    const f32x4 v0 = x0 * DN_ALPHA + acc[ai][bj][m][0], v1 = x1 * DN_ALPHA + acc[ai][bj][m][1];
                    OUT_ST16(y + (size_t)row * DM + cb + bj * 8, pack8(v0, v1));
                    s1 += (v0[0] + v0[1]) + (v0[2] + v0[3]) + (v1[0] + v1[1]) + (v1[2] + v1[3]);
                    s2 += (v0[0] * v0[0] + v0[1] * v0[1]) + (v0[2] * v0[2] + v0[3] * v0[3]) + (v1[0] * v1[0] + v1[1] * v1[1]) + (v1[2] * v1[2] + v1[3] * v1[3]); }
                s1 += __shfl_xor(s1, 16); s2 += __shfl_xor(s2, 16); s1 += __shfl_xor(s1, 32); s2 += __shfl_xor(s2, 32);
                if (fq == 0) { f32x2 sv2 = {s1, s2}; *(LAS f32x2*)(red + (wc * 256 + lrow) * 2) = sv2; } }
        }
        stats_flush(red, stats + (size_t)u.pm * 512);
    }
};
struct EpiQMemLN {
    static constexpr bool PERM = true; static constexpr bool FLIP = false; static constexpr int NSTORE = 0; bf16* o; const float* stats; const float* sn; const float* cn; float sc;
    __device__ __forceinline__ void operator()(const Acc& acc, const Unit& u, int wr, int wc, int fr, int fq, const __amdgpu_buffer_rsrc_t rs, const unsigned char* wsbase) const {
        f32x4 sv[2][2], cv[2][2];
#pragma unroll
        for (int bj = 0; bj < 2; ++bj) { const int c0 = u.pn * 256 + wc * 64 + fq * 16 + bj * 8;
            sv[bj][0] = *(const f32x4*)(sn + c0); sv[bj][1] = *(const f32x4*)(sn + c0 + 4); cv[bj][0] = *(const f32x4*)(cn + c0); cv[bj][1] = *(const f32x4*)(cn + c0 + 4); }
        f32x2 stv[2][4];
#pragma unroll
        for (int ai = 0; ai < 2; ++ai)
#pragma unroll
            for (int m = 0; m < 4; ++m) stv[ai][m] = *(const f32x2*)(stats + (size_t)(u.pm * 256 + ai * 128 + wr * 64 + m * 16 + fr) * 2);
#pragma unroll
        for (int ai = 0; ai < 2; ++ai)
#pragma unroll
            for (int m = 0; m < 4; ++m) { const int row = u.pm * 256 + ai * 128 + wr * 64 + m * 16 + fr;
                const f32x2 st = stv[ai][m]; const float mu = st[0] * (1.f / DM), rstd = rsqrtf(st[1] * (1.f / DM) - mu * mu + LN_EPS);
#pragma unroll
                for (int bj = 0; bj < 2; ++bj) { const int c0 = u.pn * 256 + wc * 64 + fq * 16 + bj * 8;
                    const f32x4 v0 = ((acc[ai][bj][m][0] - sv[bj][0] * mu) * rstd + cv[bj][0]) * sc, v1 = ((acc[ai][bj][m][1] - sv[bj][1] * mu) * rstd + cv[bj][1]) * sc;
                    OUT_ST16(o + (size_t)row * DM + c0, pack8(v0, v1)); } }
    }
};
struct EpiScale {
    static constexpr bool PERM = true; static constexpr bool FLIP = false; static constexpr int NSTORE = 16; bf16* o; int ldc; float sc;
    __device__ __forceinline__ void operator()(const Acc& acc, const Unit& u, int wr, int wc, int fr, int fq, const __amdgpu_buffer_rsrc_t rs, const unsigned char* wsbase) const {
#pragma unroll
        for (int ai = 0; ai < 2; ++ai)
#pragma unroll
            for (int m = 0; m < 4; ++m) { const int row = u.pm * 256 + ai * 128 + wr * 64 + m * 16 + fr;
#pragma unroll
                for (int bj = 0; bj < 2; ++bj) { const int c0 = u.pn * 256 + wc * 64 + fq * 16 + bj * 8;
                    OUT_ST16(o + (size_t)row * ldc + c0, pack8(acc[ai][bj][m][0] * sc, acc[ai][bj][m][1] * sc)); } }
    }
};
struct EpiWo {
    static constexpr bool PERM = true; static constexpr bool FLIP = false; static constexpr int NSTORE = 0; bf16* y; const bf16* y1; const float* stats; const float* g; const float* b; float* stats2; LAS float* red;
    __device__ __forceinline__ void operator()(const Acc& acc, const Unit& u, int wr, int wc, int fr, int fq, const __amdgpu_buffer_rsrc_t rs, const unsigned char* wsbase) const {
        f32x4 gv[2][2], bv[2][2];
#pragma unroll
        for (int bj = 0; bj < 2; ++bj) { const int c0 = u.pn * 256 + wc * 64 + fq * 16 + bj * 8;
            gv[bj][0] = *(const f32x4*)(g + c0); gv[bj][1] = *(const f32x4*)(g + c0 + 4); bv[bj][0] = *(const f32x4*)(b + c0); bv[bj][1] = *(const f32x4*)(b + c0 + 4); }
#pragma unroll
        for (int ai = 0; ai < 2; ++ai) {
            u32x4 hvv[4][2]; f32x2 stv[4];
#pragma unroll
            for (int m = 0; m < 4; ++m) { const int row = u.pm * 256 + ai * 128 + wr * 64 + m * 16 + fr; stv[m] = *(const f32x2*)(stats + (size_t)row * 2);
#pragma unroll
                for (int bj = 0; bj < 2; ++bj) hvv[m][bj] = *(const u32x4*)(y1 + (size_t)row * DM + u.pn * 256 + wc * 64 + fq * 16 + bj * 8); }
#pragma unroll
            for (int m = 0; m < 4; ++m) { const int lrow = ai * 128 + wr * 64 + m * 16 + fr, row = u.pm * 256 + lrow;
                const f32x2 st = stv[m]; const float mu = st[0] * (1.f / DM), rstd = rsqrtf(st[1] * (1.f / DM) - mu * mu + LN_EPS); float s1 = 0.f, s2 = 0.f;
#pragma unroll
                for (int bj = 0; bj < 2; ++bj) { const int c0 = u.pn * 256 + wc * 64 + fq * 16 + bj * 8;
                    const u32x4 hv = hvv[m][bj];
                    f32x4 a, bb; a[0] = __uint_as_float(hv.x << 16); a[1] = __uint_as_float(hv.x & 0xffff0000u); a[2] = __uint_as_float(hv.y << 16); a[3] = __uint_as_float(hv.y & 0xffff0000u);
                    bb[0] = __uint_as_float(hv.z << 16); bb[1] = __uint_as_float(hv.z & 0xffff0000u); bb[2] = __uint_as_float(hv.w << 16); bb[3] = __uint_as_float(hv.w & 0xffff0000u);
                    const f32x4 h0 = (a - mu) * rstd * gv[bj][0] + bv[bj][0], h1 = (bb - mu) * rstd * gv[bj][1] + bv[bj][1];
                    const f32x4 v0 = h0 * DN_ALPHA + acc[ai][bj][m][0], v1 = h1 * DN_ALPHA + acc[ai][bj][m][1];
                    OUT_ST16(y + (size_t)row * DM + c0, pack8(v0, v1));
                    s1 += (v0[0] + v0[1]) + (v0[2] + v0[3]) + (v1[0] + v1[1]) + (v1[2] + v1[3]);
                    s2 += (v0[0] * v0[0] + v0[1] * v0[1]) + (v0[2] * v0[2] + v0[3] * v0[3]) + (v1[0] * v1[0] + v1[1] * v1[1]) + (v1[2] * v1[2] + v1[3] * v1[3]); }
                if (WO_STATS) { s1 += __shfl_xor(s1, 16); s2 += __shfl_xor(s2, 16); s1 += __shfl_xor(s1, 32); s2 += __shfl_xor(s2, 32);
                    if (fq == 0) { f32x2 sv2 = {s1, s2}; *(LAS f32x2*)(red + (wc * 256 + lrow) * 2) = sv2; } } }
        }
        if (WO_STATS) stats_flush(red, stats2 + (size_t)u.pm * 512);
    }
};
struct EpiRouterLN {
    static constexpr bool PERM = false; static constexpr bool FLIP = false; static constexpr int NSTORE = 0; float* C; int ldc; const float* stats; const float* sn; const float* cn;
    __device__ __forceinline__ void operator()(const Acc& acc, const Unit& u, int wr, int wc, int fr, int fq, const __amdgpu_buffer_rsrc_t rs, const unsigned char* wsbase) const {
        f32x4 sv[2][2], cv[2][2];
#pragma unroll
        for (int bj = 0; bj < 2; ++bj)
#pragma unroll
            for (int n = 0; n < 2; ++n) { const int c0 = u.pn * 256 + bj * 128 + wc * 32 + n * 16 + 4 * fq; sv[bj][n] = *(const f32x4*)(sn + c0); cv[bj][n] = *(const f32x4*)(cn + c0); }
        f32x2 stv[2][4];
#pragma unroll
        for (int ai = 0; ai < 2; ++ai)
#pragma unroll
            for (int m = 0; m < 4; ++m) stv[ai][m] = *(const f32x2*)(stats + (size_t)(u.pm * 256 + ai * 128 + wr * 64 + m * 16 + fr) * 2);
#pragma unroll
        for (int ai = 0; ai < 2; ++ai)
#pragma unroll
            for (int m = 0; m < 4; ++m) { const int row = u.pm * 256 + ai * 128 + wr * 64 + m * 16 + fr;
                const f32x2 st = stv[ai][m]; const float mu = st[0] * (1.f / DM), rstd = rsqrtf(st[1] * (1.f / DM) - mu * mu + LN_EPS);
#pragma unroll
                for (int bj = 0; bj < 2; ++bj)
#pragma unroll
                    for (int n = 0; n < 2; ++n) *(f32x4*)(C + (size_t)row * ldc + u.pn * 256 + bj * 128 + wc * 32 + n * 16 + 4 * fq) = (acc[ai][bj][m][n] - sv[bj][n] * mu) * rstd + cv[bj][n]; }
    }
};
struct EpiF32 {
    static constexpr bool PERM = false; static constexpr bool FLIP = false; static constexpr int NSTORE = 0; float* C; int ldc;
    __device__ __forceinline__ void operator()(const Acc& acc, const Unit& u, int wr, int wc, int fr, int fq, const __amdgpu_buffer_rsrc_t rs, const unsigned char* wsbase) const {
#pragma unroll
        for (int ai = 0; ai < 2; ++ai)
#pragma unroll
            for (int m = 0; m < 4; ++m) { const int row = u.pm * 256 + ai * 128 + wr * 64 + m * 16 + fr;
#pragma unroll
                for (int bj = 0; bj < 2; ++bj)
#pragma unroll
                    for (int n = 0; n < 2; ++n) *(f32x4*)(C + (size_t)row * ldc + u.pn * 256 + bj * 128 + wc * 32 + n * 16 + 4 * fq) = acc[ai][bj][m][n]; }
    }
};
__device__ __forceinline__ float silu_mul(float g, float uu) { return g * fast_rcp(1.f + fast_exp2(-g * LOG2E)) * uu; }
constexpr float H8_SCALE = 8.f, W8_SCALE = 16.f, WD8_SCALE = 32.f, X8_SCALE = 4.f;
struct EpiMoe1 {
    static constexpr bool PERM = true; static constexpr bool FLIP = false; static constexpr int NSTORE = MOE_ROWS / 32; unsigned char* H; const LAS float* xw;
    __device__ __forceinline__ void operator()(const Acc& acc, const Unit& u, int wr, int wc, int fr, int fq, const __amdgpu_buffer_rsrc_t rs, const unsigned char* wsbase) const {
        const unsigned base = (unsigned)(H - wsbase) + (unsigned)u.rowbase * (unsigned)EDIM + (unsigned)(u.pn * 128 + wc * 32 + 8 * fq);
#pragma unroll
        for (int ai = 0; ai < MOE_ROWS / 128; ++ai)
#pragma unroll
            for (int m = 0; m < 4; ++m) { const int rl = ai * 128 + wr * 64 + m * 16 + fr;
                const f32x4 g0 = acc[ai][0][m][0], g1 = acc[ai][0][m][1], u0 = acc[ai][1][m][0], u1 = acc[ai][1][m][1]; f32x4 h0, h1; const float w = xw[u.slot * MOE_ROWS + rl] * H8_SCALE;
#pragma unroll
                for (int q = 0; q < 4; ++q) { h0[q] = silu_mul(g0[q], u0[q]) * w; h1[q] = silu_mul(g1[q], u1[q]) * w; }
                int t0 = 0, t1 = 0;
                t0 = __builtin_amdgcn_cvt_pk_fp8_f32(h0[0], h0[1], t0, false); t0 = __builtin_amdgcn_cvt_pk_fp8_f32(h0[2], h0[3], t0, true);
                t1 = __builtin_amdgcn_cvt_pk_fp8_f32(h1[0], h1[1], t1, false); t1 = __builtin_amdgcn_cvt_pk_fp8_f32(h1[2], h1[3], t1, true);
                u32x2 w8; w8.x = (unsigned)t0; w8.y = (unsigned)t1;
                const unsigned voff = (rl < u.nvalid) ? base + (unsigned)rl * (unsigned)EDIM : 0xffffffffu;
                __builtin_amdgcn_raw_buffer_store_b64(w8, rs, (int)voff, 0, OUT_AUX);
                asm volatile("" ::: "memory"); __builtin_amdgcn_sched_barrier(0); }
    }
};
constexpr float Y8_SCALE = 16.f, Y8_INV = 1.f / 16.f;
struct EpiMoe2 {
    static constexpr bool PERM = true; static constexpr bool FLIP = false; static constexpr int NSTORE = MOE_ROWS / 32; unsigned char* Y;
    __device__ __forceinline__ void operator()(const Acc& acc, const Unit& u, int wr, int wc, int fr, int fq, const __amdgpu_buffer_rsrc_t rs, const unsigned char* wsbase) const {
        const unsigned base = (unsigned)(Y - wsbase) + (unsigned)u.rowbase * (unsigned)DM + (unsigned)(u.pn * 256 + wc * 64 + fq * 16);
#pragma unroll
        for (int ai = 0; ai < MOE_ROWS / 128; ++ai)
#pragma unroll
            for (int m = 0; m < 4; ++m) { const int rl = ai * 128 + wr * 64 + m * 16 + fr; u32x4 w;
#pragma unroll
                for (int bj = 0; bj < 2; ++bj) {
                    const f32x4 a = acc[ai][bj][m][0] * Y8_SCALE, b = acc[ai][bj][m][1] * Y8_SCALE; int t0 = 0, t1 = 0;
                    t0 = __builtin_amdgcn_cvt_pk_fp8_f32(a[0], a[1], t0, false); t0 = __builtin_amdgcn_cvt_pk_fp8_f32(a[2], a[3], t0, true);
                    t1 = __builtin_amdgcn_cvt_pk_fp8_f32(b[0], b[1], t1, false); t1 = __builtin_amdgcn_cvt_pk_fp8_f32(b[2], b[3], t1, true);
                    if (bj == 0) { w.x = (unsigned)t0; w.y = (unsigned)t1; } else { w.z = (unsigned)t0; w.w = (unsigned)t1; } }
                const unsigned voff = (rl < u.nvalid) ? base + (unsigned)rl * (unsigned)DM : 0xffffffffu;
                __builtin_amdgcn_raw_buffer_store_b128(w, rs, (int)voff, 0, OUT_AUX);
                asm volatile("" ::: "memory"); __builtin_amdgcn_sched_barrier(0); }
    }
};
struct EpiMoe2F {
    static constexpr bool PERM = false; static constexpr bool FLIP = true; static constexpr int NSTORE = 8; unsigned char* Y;
    __device__ __forceinline__ void operator()(const Acc& acc, const Unit& u, int wr, int wc, int fr, int fq, const __amdgpu_buffer_rsrc_t rs, const unsigned char* wsbase) const {
        unsigned ones_ = ~0u; asm volatile("" : "+s"(ones_));
        const int t_ = (int)__builtin_amdgcn_mbcnt_hi(ones_, __builtin_amdgcn_mbcnt_lo(ones_, 0u));
        const int fr_ = t_ & 15, fq_ = (t_ >> 4) & 3;
        const bool odd = (fr_ & 1) != 0;
        const unsigned base = (unsigned)(Y - wsbase) + (unsigned)u.rowbase * (unsigned)DM + (unsigned)(u.pn * 256 + wr * 128 + fq_ * 32 + (odd ? 16 : 0)) + (unsigned)(wc * 32 + (fr_ & ~1)) * (unsigned)DM;
#pragma unroll
        for (int bj = 0; bj < 2; ++bj)
#pragma unroll
            for (int n = 0; n < 2; ++n) {
                u32x4 s1, s2;
#pragma unroll
                for (int m = 0; m < 4; ++m) {
                    const f32x4 a = acc[0][bj][m][n] * Y8_SCALE, b = acc[1][bj][m][n] * Y8_SCALE; int t0 = 0, t1 = 0;
                    t0 = __builtin_amdgcn_cvt_pk_fp8_f32(a[0], a[1], t0, false); t0 = __builtin_amdgcn_cvt_pk_fp8_f32(a[2], a[3], t0, true);
                    t1 = __builtin_amdgcn_cvt_pk_fp8_f32(b[0], b[1], t1, false); t1 = __builtin_amdgcn_cvt_pk_fp8_f32(b[2], b[3], t1, true);
                    const int give = odd ? t0 : t1;
                    const int got = __builtin_amdgcn_mov_dpp(give, 0xB1, 0xf, 0xf, true);
                    s1[m] = (unsigned)(odd ? got : t0); s2[m] = (unsigned)(odd ? t1 : got); }
                const int re = bj * 128 + wc * 32 + n * 16 + (fr_ & ~1);
                const unsigned v1 = (re < u.nvalid) ? base + (unsigned)(bj * 128 + n * 16) * (unsigned)DM : 0xffffffffu, v2 = (re + 1 < u.nvalid) ? base + (unsigned)(bj * 128 + n * 16 + 1) * (unsigned)DM : 0xffffffffu;
                __builtin_amdgcn_raw_buffer_store_b128(s1, rs, (int)v1, 0, OUT_AUX);
                asm volatile("" ::: "memory"); __builtin_amdgcn_sched_barrier(0);
                __builtin_amdgcn_raw_buffer_store_b128(s2, rs, (int)v2, 0, OUT_AUX);
                asm volatile("" ::: "memory"); __builtin_amdgcn_sched_barrier(0); }
    }
};

typedef int v8i32 __attribute__((ext_vector_type(8)));
typedef int v4i32 __attribute__((ext_vector_type(4)));
template <class Epi, class Sched, bool FP8 = false, int SCW = 0x7F7F7F7F, bool HALFM = false, bool PIN_ACC = false>
__device__ __forceinline__ void gemm_phase(LAS unsigned char* lds, const unsigned char* wsbase, const char* Abase, const int K, const Sched& S, const Epi& E) {
    int tid_ = threadIdx.x; asm volatile("" : "+v"(tid_));
    const int tid = tid_, wid = __builtin_amdgcn_readfirstlane(tid >> 6), lane = tid & 63, wr = wid >> 2, wc = wid & 3, fr = lane & 15, fq = lane >> 4;
    const int nt = K / BK;
    constexpr bool GA = Sched::GATHER_A;
    int Rr[2]; unsigned Cb[2]; unsigned vB, vA;
#pragma unroll
    for (int i = 0; i < 2; ++i) { int R, C; stage_rc(tid * 16 + i * 8192, R, C); Rr[i] = R; Cb[i] = (unsigned)C * 2u; }
    { const int R = Rr[0]; const int Rb = Epi::PERM ? (64 * (R >> 5) + 16 * ((R >> 2) & 3) + 4 * ((R >> 4) & 1) + (R & 3)) : R; vB = (unsigned)Rb * (unsigned)(K * 2) + Cb[0];
      const int Ra = Epi::FLIP ? (32 * ((R >> 2) & 3) + 4 * ((R >> 4) & 3) + (R & 3)) : R; vA = (unsigned)Ra * (unsigned)(K * 2) + Cb[0]; }
    const unsigned p1step = (Epi::FLIP ? 128u : 64u) * (unsigned)(K * 2), p1stepB = (Epi::PERM ? 128u : 64u) * (unsigned)(K * 2), hstepB = (Epi::PERM ? 8u : 128u) * (unsigned)(K * 2);
    const unsigned kstep = (unsigned)(BK * 2);
    const unsigned hstep = (Epi::FLIP ? 16u : (unsigned)HALF) * (unsigned)K * 2u;
    const unsigned ldsw = (unsigned)wid * 1024u;
    const int aoff = lds_byte(wr * 64 + fr, fq * 8), boff = lds_byte(wc * 32 + fr, fq * 8);
    const __amdgpu_buffer_rsrc_t rsA = __builtin_amdgcn_make_buffer_rsrc((void*)wsbase, 0, 0x7ffff000, 0x00020000);
#define rsB rsA
    const unsigned offA = (unsigned)((const char*)Abase - (const char*)wsbase), offB = (unsigned)((const char*)S.bbase() - (const char*)wsbase);
#define G_SA(b, h) (((b) * 2 + (h)) * HTB)
#define G_SB(b, h) ((4 + (b) * 2 + (h)) * HTB)
#define G_STAGE(bufoff, rs, soff, voff) do { _Pragma("unroll") for (int _i = 0; _i < 2; ++_i) \
        __builtin_amdgcn_raw_ptr_buffer_load_lds(rs, (LAS unsigned*)(lds + (bufoff) + ldsw + _i * 8192), 16, (int)(voff)[_i], (int)(soff), 0, 0); } while (0)
#define G_STAGE1(bufoff, rs, soff, v0) do { _Pragma("unroll") for (int _i = 0; _i < 2; ++_i) \
        __builtin_amdgcn_raw_ptr_buffer_load_lds(rs, (LAS unsigned*)(lds + (bufoff) + ldsw + _i * 8192), 16, (int)(v0), (int)((soff) + _i * p1step), 0, 0); } while (0)
#define G_STAGE_B(bufoff, soff) do { _Pragma("unroll") for (int _i = 0; _i < 2; ++_i) \
        __builtin_amdgcn_raw_ptr_buffer_load_lds(rsB, (LAS unsigned*)(lds + (bufoff) + ldsw + _i * 8192), 16, (int)(vB), (int)((soff) + _i * p1stepB), 0, 0); } while (0)
#define G_STAGE_A(bufoff, soff, h, vg) do { if constexpr (GA) { G_STAGE(bufoff, rsA, soff, vg); } else { G_STAGE1(bufoff, rsA, (soff) + (h) * hstep, vA); } } while (0)
#define G_LD32(p) __builtin_shufflevector(*(const LAS v4i32*)(p), *(const LAS v4i32*)((p) + 1024), 0, 1, 2, 3, 4, 5, 6, 7)
#define G_LDA(dst, b, h) do { if constexpr (FP8) { _Pragma("unroll") for (int m = 0; m < 4; ++m) dst##8[m] = G_LD32(lds + G_SA(b, h) + aoff + m * 2048); } \
        else { _Pragma("unroll") for (int m = 0; m < 4; ++m) _Pragma("unroll") for (int k = 0; k < 2; ++k) dst[m][k] = *(const LAS bf16x8*)(lds + G_SA(b, h) + aoff + m * 2048 + k * 1024); } } while (0)
#define G_LDB(dst, b, h) do { if constexpr (FP8) { _Pragma("unroll") for (int n = 0; n < 2; ++n) dst##8[n] = G_LD32(lds + G_SB(b, h) + boff + n * 2048); } \
        else { _Pragma("unroll") for (int n = 0; n < 2; ++n) _Pragma("unroll") for (int k = 0; k < 2; ++k) dst[n][k] = *(const LAS bf16x8*)(lds + G_SB(b, h) + boff + n * 2048 + k * 1024); } } while (0)
#define G_MMA(ai, bj, At, Bt) do { __builtin_amdgcn_s_setprio(1); _Pragma("unroll") for (int m = 0; m < 4; ++m) _Pragma("unroll") for (int n = 0; n < 2; ++n) { \
        if constexpr (FP8 && Epi::FLIP) { acc[ai][bj][m][n] = __builtin_amdgcn_mfma_scale_f32_16x16x128_f8f6f4(At##8[m], Bt##8[n], acc[ai][bj][m][n], 0, 0, 0, SCW, 0, SCW); } \
        else if constexpr (FP8) { acc[ai][bj][m][n] = __builtin_amdgcn_mfma_scale_f32_16x16x128_f8f6f4(Bt##8[n], At##8[m], acc[ai][bj][m][n], 0, 0, 0, SCW, 0, SCW); } \
        else { _Pragma("unroll") for (int k = 0; k < 2; ++k) acc[ai][bj][m][n] = __builtin_amdgcn_mfma_f32_16x16x32_bf16(Bt[n][k], At[m][k], acc[ai][bj][m][n], 0, 0, 0); } } \
        __builtin_amdgcn_s_setprio(0); \
        if constexpr (PIN_ACC) { asm volatile("" : "+v"(acc[ai][bj][0][0]), "+v"(acc[ai][bj][0][1]), "+v"(acc[ai][bj][1][0]), "+v"(acc[ai][bj][1][1]), \
                                                   "+v"(acc[ai][bj][2][0]), "+v"(acc[ai][bj][2][1]), "+v"(acc[ai][bj][3][0]), "+v"(acc[ai][bj][3][1])); } } while (0)
#define G_WAIT_V(n) asm volatile("s_waitcnt vmcnt(" #n ")" ::: "memory")
#define G_WAIT_V8S() do { if (Epi::NSTORE == 0 || !post_epi) { asm volatile("s_waitcnt vmcnt(8)" ::: "memory"); } else if (Epi::NSTORE == 4) { asm volatile("s_waitcnt vmcnt(12)" ::: "memory"); } else if (Epi::NSTORE == 8) { asm volatile("s_waitcnt vmcnt(16)" ::: "memory"); } else { static_assert(Epi::NSTORE == 0 || Epi::NSTORE == 4 || Epi::NSTORE == 8 || Epi::NSTORE == 16, "NSTORE"); asm volatile("s_waitcnt vmcnt(24)" ::: "memory"); } } while (0)
#define G_WAIT_L(n) asm volatile("s_waitcnt lgkmcnt(" #n ")" ::: "memory")
#define G_WAIT_V6S() do { if (Epi::NSTORE == 0 || !post_epi) { asm volatile("s_waitcnt vmcnt(6)" ::: "memory"); } else if (Epi::NSTORE == 4) { asm volatile("s_waitcnt vmcnt(10)" ::: "memory"); } else { static_assert(Epi::NSTORE == 0 || Epi::NSTORE == 4 || Epi::NSTORE == 8, "NSTORE"); asm volatile("s_waitcnt vmcnt(14)" ::: "memory"); } } while (0)
#define G_BAR __builtin_amdgcn_s_barrier()
#define G_SCHED __builtin_amdgcn_sched_barrier(0)
    Unit cur, nxt; int ui = 0;
    if (!S.next(0, cur)) return;
    Acc acc;
#pragma unroll
    for (int a = 0; a < 2; ++a)
#pragma unroll
        for (int b = 0; b < 2; ++b)
#pragma unroll
            for (int m = 0; m < 4; ++m)
#pragma unroll
                for (int n = 0; n < 2; ++n) acc[a][b][m][n] = (f32x4){0.f, 0.f, 0.f, 0.f};
    bf16x8 At[4][2], B0[2][2], B1[2][2]; v8i32 At8[4], B08[2], B18[2];
    unsigned vAc0[2], vAc1[2];
    unsigned cA = 0u, nA = 0u;
    if constexpr (GA) {
#pragma unroll
        for (int i = 0; i < 2; ++i) { vAc0[i] = S.aoff(cur, Rr[i]) + Cb[i]; vAc1[i] = S.aoff(cur, 128 + Rr[i]) + Cb[i]; }
    } else { cA = S.abase(cur); }
    cA += offA;
    unsigned cB = cur.boff + offB;
    if constexpr (HALFM) {
        G_STAGE_B(G_SB(0, 0), cB); G_STAGE_B(G_SB(0, 1), cB + hstepB); G_STAGE_A(G_SA(0, 0), cA, 0, vAc0);
        if (wr == 1) G_BAR;
        G_STAGE_B(G_SB(1, 0), cB + kstep); G_STAGE_B(G_SB(1, 1), cB + hstepB + kstep); G_STAGE_A(G_SA(1, 0), cA + kstep, 0, vAc0);
        G_WAIT_V(6); G_BAR; G_BAR;
    } else {
    G_STAGE_B(G_SB(0, 0), cB); G_STAGE_B(G_SB(0, 1), cB + hstepB); G_STAGE_A(G_SA(0, 0), cA, 0, vAc0); G_STAGE_A(G_SA(0, 1), cA, 1, vAc1);
    if (wr == 1) G_BAR;
    G_WAIT_V(2); G_BAR;
    G_STAGE_B(G_SB(1, 0), cB + kstep); G_STAGE_A(G_SA(1, 0), cA + kstep, 0, vAc0); G_STAGE_B(G_SB(1, 1), cB + hstepB + kstep);
    G_WAIT_V(6); G_BAR;
    }
    for (;;) {
        const bool has_next = S.next(ui + 1, nxt);
        const unsigned nB = has_next ? nxt.boff + offB : cB;
        if constexpr (!GA) { nA = has_next ? S.abase(nxt) + offA : cA; } else { nA = cA; }
#pragma unroll 1
        for (int t = 0; t < nt; t += 2) {
            const bool last = (t == nt - 2);
            const unsigned a1 = cA + (unsigned)(t + 1) * kstep;
            const unsigned a2 = last ? nA : cA + (unsigned)(t + 2) * kstep; const unsigned b2 = last ? nB : cB + (unsigned)(t + 2) * kstep;
            const unsigned a3 = a2 + kstep; const unsigned b3 = b2 + kstep;
            unsigned v20[2], v21[2];
#pragma unroll
            for (int i = 0; i < 2; ++i) { if constexpr (GA) { v20[i] = vAc0[i]; v21[i] = vAc1[i]; } else { v20[i] = 0u; v21[i] = 0u; } }
            if constexpr (GA) { if (last && has_next) { int t_ = threadIdx.x; asm volatile("" : "+v"(t_));
#pragma unroll
                for (int i = 0; i < 2; ++i) { int R_, C_; stage_rc(t_ * 16 + i * 8192, R_, C_); v20[i] = S.aoff(nxt, R_) + (unsigned)C_ * 2u; v21[i] = S.aoff(nxt, 128 + R_) + (unsigned)C_ * 2u; } } }
            const bool post_epi = (t == 0) && (ui > 0);
            if constexpr (HALFM) {
            G_LDB(B0, 0, 0); G_LDB(B1, 0, 1); G_SCHED; G_LDA(At, 0, 0);
            G_WAIT_L(0); G_BAR; G_MMA(0, 0, At, B0); G_MMA(0, 1, At, B1); G_BAR; G_SCHED;
            G_STAGE_B(G_SB(0, 0), b2); G_STAGE_B(G_SB(0, 1), b2 + hstepB); G_STAGE_A(G_SA(0, 0), a2, 0, v20);
            G_WAIT_V6S(); G_BAR; G_BAR; G_SCHED;
            G_LDB(B0, 1, 0); G_LDB(B1, 1, 1); G_SCHED; G_LDA(At, 1, 0);
            G_WAIT_L(0); G_BAR; G_MMA(0, 0, At, B0); G_MMA(0, 1, At, B1); G_BAR; G_SCHED;
            G_STAGE_B(G_SB(1, 0), b3); G_STAGE_B(G_SB(1, 1), b3 + hstepB); G_STAGE_A(G_SA(1, 0), a3, 0, v20);
            G_WAIT_V(6); G_BAR; G_BAR; G_SCHED;
            } else {
            G_LDB(B0, 0, 0); G_LDB(B1, 0, 1); G_SCHED; G_LDA(At, 0, 0); G_STAGE_A(G_SA(1, 1), a1, 1, vAc1);
            G_WAIT_V8S(); G_WAIT_L(0); G_BAR; G_MMA(0, 0, At, B0); G_MMA(0, 1, At, B1); G_BAR; G_SCHED;
            G_LDA(At, 0, 1); G_STAGE_B(G_SB(0, 0), b2); G_STAGE_B(G_SB(0, 1), b2 + hstepB); G_STAGE_A(G_SA(0, 0), a2, 0, v20);
            G_WAIT_V8S(); G_WAIT_L(0); G_BAR; G_MMA(1, 0, At, B0); G_MMA(1, 1, At, B1); G_BAR; G_SCHED;
            G_LDB(B0, 1, 0); G_LDB(B1, 1, 1); G_SCHED; G_LDA(At, 1, 0); G_STAGE_A(G_SA(0, 1), a2, 1, v21);
            G_WAIT_V(8); G_WAIT_L(0); G_BAR; G_MMA(0, 0, At, B0); G_MMA(0, 1, At, B1); G_BAR; G_SCHED;
            G_LDA(At, 1, 1); G_STAGE_B(G_SB(1, 0), b3); G_STAGE_B(G_SB(1, 1), b3 + hstepB); G_STAGE_A(G_SA(1, 0), a3, 0, v20);
            G_WAIT_V(8); G_WAIT_L(0); G_BAR; G_MMA(1, 0, At, B0); G_MMA(1, 1, At, B1); G_BAR; G_SCHED;
            }
        }
        if (wr == 0) G_BAR;
        E(acc, cur, wr, wc, fr, fq, rsA, wsbase);
        G_SCHED;
        if (!has_next) break;
#pragma unroll
        for (int a = 0; a < 2; ++a)
#pragma unroll
            for (int b = 0; b < 2; ++b)
#pragma unroll
                for (int m = 0; m < 4; ++m)
#pragma unroll
                    for (int n = 0; n < 2; ++n) acc[a][b][m][n] = (f32x4){0.f, 0.f, 0.f, 0.f};
        cur = nxt; cB = nB; ++ui;
        if constexpr (GA) { int t_ = threadIdx.x; asm volatile("" : "+v"(t_));
#pragma unroll
            for (int i = 0; i < 2; ++i) { int R_, C_; stage_rc(t_ * 16 + i * 8192, R_, C_); vAc0[i] = S.aoff(cur, R_) + (unsigned)C_ * 2u; vAc1[i] = S.aoff(cur, 128 + R_) + (unsigned)C_ * 2u; }
        } else cA = nA;
        if (wr == 1) G_BAR;
    }
    G_WAIT_V(0);
    G_BAR;
#undef G_SA
#undef G_SB
#undef rsB
#undef G_STAGE
#undef G_STAGE1
#undef G_STAGE_A
#undef G_STAGE_B
#undef G_LDA
#undef G_LDB
#undef G_MMA
#undef G_LD32
#undef G_WAIT_V
#undef G_WAIT_V8S
#undef G_WAIT_V6S
#undef G_WAIT_L
#undef G_BAR
#undef G_SCHED
}
}

__device__ __forceinline__ void lds_barrier() { asm volatile("s_waitcnt lgkmcnt(0)\n\ts_barrier" ::: "memory"); }
namespace fa {
__device__ __forceinline__ int crow(int r, int hi) { return (r & 3) + 8 * (r >> 2) + 4 * hi; }
typedef short v4i16_t __attribute__((ext_vector_type(4)));
__device__ __forceinline__ s16x4 vtr(const LAS char* p) { return __builtin_bit_cast(s16x4, __builtin_amdgcn_ds_read_tr16_b64_v4i16((LAS v4i16_t*)p)); }
__device__ __forceinline__ float max3f(float a, float b, float c) { float r; asm("v_max3_f32 %0, %1, %2, %3" : "=v"(r) : "v"(a), "v"(b), "v"(c)); return r; }
__device__ __forceinline__ float max2f(float a, float b) { float r; asm("v_max_f32_e32 %0, %1, %2" : "=v"(r) : "v"(a), "v"(b)); return r; }
__device__ __forceinline__ float rowmax32(const f32x16& p0, const f32x16& p1) {
    float a = max3f(p0[0], p0[1], p1[0]), b = max3f(p0[2], p0[3], p1[1]); a = max3f(a, p1[2], p1[3]);
#pragma unroll
    for (int r = 4; r < 16; r += 4) { a = max3f(a, p0[r], p0[r + 1]); b = max3f(b, p0[r + 2], p0[r + 3]); a = max3f(a, p1[r], p1[r + 1]); b = max3f(b, p1[r + 2], p1[r + 3]); }
    return max2f(a, b);
}
__device__ __forceinline__ float halfmax(float m) { auto rr = __builtin_amdgcn_permlane32_swap(__float_as_uint(m), __float_as_uint(m), false, false); return fmaxf(__uint_as_float(rr[0]), __uint_as_float(rr[1])); }
__device__ __forceinline__ float halfsum(float m) { auto rr = __builtin_amdgcn_permlane32_swap(__float_as_uint(m), __float_as_uint(m), false, false); return __uint_as_float(rr[0]) + __uint_as_float(rr[1]); }

template <int NQ, int KSTR> __device__ __forceinline__ f32x16 qk(const LAS char* Kl, int j, const bf16x8 (&qf)[NQ], int lane) {
    f32x16 s = {0.f, 0.f, 0.f, 0.f, 0.f, 0.f, 0.f, 0.f, 0.f, 0.f, 0.f, 0.f, 0.f, 0.f, 0.f, 0.f};
    const LAS char* kp = Kl + (32 * j + (lane & 31)) * KSTR + (lane >> 5) * 16;
#pragma unroll
    for (int ds = 0; ds < NQ; ++ds) { const bf16x8 kf = *(const LAS bf16x8*)(kp + ds * 32); s = __builtin_amdgcn_mfma_f32_32x32x16_bf16(kf, qf[ds], s, 0, 0, 0); }
    return s;
}
template <int NQ, int KSTR> __device__ __forceinline__ f32x16 qk_c(const LAS char* Kl, int j, const bf16x8 (&qf)[NQ], int lane, const f32x16& c0) {
    f32x16 s = c0;
    const LAS char* kp = Kl + (32 * j + (lane & 31)) * KSTR + (lane >> 5) * 16;
#pragma unroll
    for (int ds = 0; ds < NQ; ++ds) { const bf16x8 kf = *(const LAS bf16x8*)(kp + ds * 32); s = __builtin_amdgcn_mfma_f32_32x32x16_bf16(kf, qf[ds], s, 0, 0, 0); }
    return s;
}
template <int NO> __device__ __forceinline__ void softmax_step_dm(f32x16& p0, f32x16& p1, float& mref, f32x16& negm, float& l, f32x16 (&o)[NO], bf16x8 (&pf)[4]) {
    constexpr float THR = 8.f;
    float mx = halfmax(rowmax32(p0, p1));
    if (__any(mx > THR)) {
        const float dl = fmaxf(mx, 0.f), al = fast_exp2(-dl);
        mref += dl; l *= al;
#pragma unroll
        for (int r = 0; r < 16; ++r) { p0[r] -= dl; p1[r] -= dl; negm[r] = -mref; }
#pragma unroll
        for (int d = 0; d < NO; ++d)
#pragma unroll
            for (int r = 0; r < 16; ++r) o[d][r] *= al;
    }
    float sum = 0.f;
#pragma unroll
    for (int r = 0; r < 16; ++r) { p0[r] = fast_exp2(p0[r]); p1[r] = fast_exp2(p1[r]); sum += p0[r] + p1[r]; }
    l += sum;
#pragma unroll
    for (int s = 0; s < 2; ++s) {
        u32x4 a, b;
        a.x = cvtpk(p0[8 * s], p0[8 * s + 1]); a.y = cvtpk(p0[8 * s + 2], p0[8 * s + 3]); a.z = cvtpk(p0[8 * s + 4], p0[8 * s + 5]); a.w = cvtpk(p0[8 * s + 6], p0[8 * s + 7]);
        b.x = cvtpk(p1[8 * s], p1[8 * s + 1]); b.y = cvtpk(p1[8 * s + 2], p1[8 * s + 3]); b.z = cvtpk(p1[8 * s + 4], p1[8 * s + 5]); b.w = cvtpk(p1[8 * s + 6], p1[8 * s + 7]);
        pf[s] = __builtin_bit_cast(bf16x8, a); pf[2 + s] = __builtin_bit_cast(bf16x8, b);
    }
}
template <int NO> __device__ __forceinline__ void softmax_step_dm2(f32x16& p0, f32x16& p1, float& mref, float& l, f32x16 (&o)[NO], bf16x8 (&pf)[4]) {
    constexpr float THR = 8.f;
    float mx = halfmax(rowmax32(p0, p1)) - mref;
    if (__any(mx > THR)) {
        const float dl = fmaxf(mx, 0.f), al = fast_exp2(-dl);
        mref += dl; l *= al;
#pragma unroll
        for (int d = 0; d < NO; ++d)
#pragma unroll
            for (int r = 0; r < 16; ++r) o[d][r] *= al;
    }
    float sum = 0.f;
#pragma unroll
    for (int r = 0; r < 16; ++r) { p0[r] = fast_exp2(p0[r] - mref); p1[r] = fast_exp2(p1[r] - mref); sum += p0[r] + p1[r]; }
    l += sum;
#pragma unroll
    for (int s = 0; s < 2; ++s) {
        u32x4 a, b;
        a.x = cvtpk(p0[8 * s], p0[8 * s + 1]); a.y = cvtpk(p0[8 * s + 2], p0[8 * s + 3]); a.z = cvtpk(p0[8 * s + 4], p0[8 * s + 5]); a.w = cvtpk(p0[8 * s + 6], p0[8 * s + 7]);
        b.x = cvtpk(p1[8 * s], p1[8 * s + 1]); b.y = cvtpk(p1[8 * s + 2], p1[8 * s + 3]); b.z = cvtpk(p1[8 * s + 4], p1[8 * s + 5]); b.w = cvtpk(p1[8 * s + 6], p1[8 * s + 7]);
        pf[s] = __builtin_bit_cast(bf16x8, a); pf[2 + s] = __builtin_bit_cast(bf16x8, b);
    }
}
template <int NO> __device__ __forceinline__ void softmax_step(f32x16& p0, f32x16& p1, float& m, float& l, f32x16 (&o)[NO], bf16x8 (&pf)[4]) {
    float mx = halfmax(rowmax32(p0, p1));
    const float mn = fmaxf(m, mx), mu = (mn == -INFINITY) ? 0.f : mn;
    const float al = fast_exp2(m - mu);
    float sum = 0.f;
#pragma unroll
    for (int r = 0; r < 16; ++r) { p0[r] = fast_exp2(p0[r] - mu); p1[r] = fast_exp2(p1[r] - mu); sum += p0[r] + p1[r]; }
    l = l * al + sum; m = mn;
#pragma unroll
    for (int d = 0; d < NO; ++d)
#pragma unroll
        for (int r = 0; r < 16; ++r) o[d][r] *= al;
#pragma unroll
    for (int s = 0; s < 2; ++s) {
        u32x4 a, b;
        a.x = cvtpk(p0[8 * s], p0[8 * s + 1]); a.y = cvtpk(p0[8 * s + 2], p0[8 * s + 3]); a.z = cvtpk(p0[8 * s + 4], p0[8 * s + 5]); a.w = cvtpk(p0[8 * s + 6], p0[8 * s + 7]);
        b.x = cvtpk(p1[8 * s], p1[8 * s + 1]); b.y = cvtpk(p1[8 * s + 2], p1[8 * s + 3]); b.z = cvtpk(p1[8 * s + 4], p1[8 * s + 5]); b.w = cvtpk(p1[8 * s + 6], p1[8 * s + 7]);
        pf[s] = __builtin_bit_cast(bf16x8, a); pf[2 + s] = __builtin_bit_cast(bf16x8, b);
    }
}
template <int NO, int VSTR> __device__ __forceinline__ void pv(f32x16 (&o)[NO], const LAS char* Vl, const bf16x8 (&pf)[4], int lane) {
    const LAS char* vb = Vl + (4 * (lane >> 5) + ((lane & 15) >> 2)) * VSTR + (16 * ((lane >> 4) & 1) + 4 * (lane & 3)) * 2;
#pragma unroll
    for (int d = 0; d < NO; ++d)
#pragma unroll
        for (int ks = 0; ks < 4; ++ks) {
            const s16x4 lo = vtr(vb + (16 * ks) * VSTR + d * 64), hi = vtr(vb + (16 * ks + 8) * VSTR + d * 64);
            const bf16x8 vf = (bf16x8){lo[0], lo[1], lo[2], lo[3], hi[0], hi[1], hi[2], hi[3]};
            o[d] = __builtin_amdgcn_mfma_f32_32x32x16_bf16(vf, pf[ks], o[d], 0, 0, 0);
        }
}
template <int NO> __device__ __forceinline__ void store_o(const f32x16 (&o)[NO], float inv, bf16* rowp, int hi) {
#pragma unroll
    for (int d = 0; d < NO; ++d)
#pragma unroll
        for (int g = 0; g < 4; g += 2) {
            u32x2 a, b;
            a.x = cvtpk(o[d][4 * g] * inv, o[d][4 * g + 1] * inv); a.y = cvtpk(o[d][4 * g + 2] * inv, o[d][4 * g + 3] * inv);
            b.x = cvtpk(o[d][4 * g + 4] * inv, o[d][4 * g + 5] * inv); b.y = cvtpk(o[d][4 * g + 6] * inv, o[d][4 * g + 7] * inv);
            { auto r = __builtin_amdgcn_permlane32_swap(a.x, b.x, false, false); a.x = r[0]; b.x = r[1]; }
            { auto r = __builtin_amdgcn_permlane32_swap(a.y, b.y, false, false); a.y = r[0]; b.y = r[1]; }
            u32x4 w; w.x = a.x; w.y = a.y; w.z = b.x; w.w = b.y;
            OUT_ST16(rowp + 32 * d + 8 * g + 8 * hi, w); }
}
}

__device__ __forceinline__ void diff_unit(const P& p, int b, int h, int qb, LAS unsigned char* ldsu, float lam) {
    constexpr int KSTR = 144, VSTR = 320, KB = 64 * KSTR, VB = 64 * VSTR, BUF = 2 * KB + VB;
    LAS char* lds = (LAS char*)ldsu;
    const int tid = threadIdx.x, lane = tid & 63, wid = __builtin_amdgcn_readfirstlane(tid >> 6), hi = lane >> 5;
    const int comp = wid >> 2, w4 = wid & 3;
    const bf16* proj = (const bf16*)(p.ws + WS_PROJ);
    const size_t rb = (size_t)b * SEQ;
    const int q0 = qb * 128, qmin = q0 + 32 * w4, qpos = qmin + (lane & 31);
    bf16x8 qf[4];
#pragma unroll
    for (int ds = 0; ds < 4; ++ds) qf[ds] = *(const bf16x8*)(proj + (rb + qpos) * INW + 1536 + h * 128 + comp * 64 + ds * 16 + hi * 8);
    const int ntiles = 2 * qb + 2;
    const int krow = tid >> 3, kch = tid & 7;
    const bf16* ksrc = proj + (rb + krow) * INW + 2048 + h * 128 + kch * 8;
    const int vrow0 = tid >> 4, vch = tid & 15;
    const bf16* vsrc = proj + (rb + vrow0) * INW + 2560 + h * 128 + vch * 8;
    const int kdst = krow * KSTR + kch * 16, vdst = 2 * KB + vrow0 * VSTR + vch * 16;
    u32x4 rk0, rk1, rv0, rv1;
    { rk0 = *(const u32x4*)(ksrc); rk1 = *(const u32x4*)(ksrc + 64); rv0 = *(const u32x4*)(vsrc); rv1 = *(const u32x4*)(vsrc + (size_t)32 * INW); }
    *(LAS u32x4*)(lds + kdst) = rk0; *(LAS u32x4*)(lds + KB + kdst) = rk1; *(LAS u32x4*)(lds + vdst) = rv0; *(LAS u32x4*)(lds + vdst + 32 * VSTR) = rv1;
    __syncthreads();
    float mref = 0.f, l = 0.f; f32x16 o[4]; f32x16 negm;
#pragma unroll
    for (int r = 0; r < 16; ++r) negm[r] = 0.f;
#pragma unroll
    for (int d = 0; d < 4; ++d)
#pragma unroll
        for (int r = 0; r < 16; ++r) o[d][r] = 0.f;
    for (int kt = 0; kt < ntiles; ++kt) {
        const bool more = kt + 1 < ntiles;
        if (more) { const size_t off = (size_t)(kt + 1) * 64 * INW; rk0 = *(const u32x4*)(ksrc + off); rk1 = *(const u32x4*)(ksrc + off + 64); rv0 = *(const u32x4*)(vsrc + off); rv1 = *(const u32x4*)(vsrc + off + (size_t)32 * INW); }
        const LAS char* buf = lds + (kt & 1) * BUF;
        const int k0 = kt * 64;
        if (k0 <= qmin + 31) {
            const LAS char* Kl = buf + comp * KB;
            f32x16 p0 = fa::qk_c<4, KSTR>(Kl, 0, qf, lane, negm), p1 = fa::qk_c<4, KSTR>(Kl, 1, qf, lane, negm);
            if (k0 + 63 > qmin) {
#pragma unroll
                for (int r = 0; r < 16; ++r) { const int key = k0 + fa::crow(r, hi); if (key > qpos) p0[r] = -INFINITY; if (key + 32 > qpos) p1[r] = -INFINITY; }
            }
            bf16x8 pf[4];
            fa::softmax_step_dm<4>(p0, p1, mref, negm, l, o, pf);
            fa::pv<4, VSTR>(o, buf + 2 * KB, pf, lane);
        }
        if (more) { LAS char* nb = lds + ((kt + 1) & 1) * BUF; *(LAS u32x4*)(nb + kdst) = rk0; *(LAS u32x4*)(nb + KB + kdst) = rk1; *(LAS u32x4*)(nb + vdst) = rv0; *(LAS u32x4*)(nb + vdst + 32 * VSTR) = rv1; }
        __syncthreads();
    }
    l = fa::halfsum(l);
    const float inv = fast_rcp(l);
    LAS float* ex = (LAS float*)lds + w4 * 4096;
    if (comp == 1) {
#pragma unroll
        for (int d = 0; d < 4; ++d)
#pragma unroll
            for (int r = 0; r < 16; ++r) ex[(d * 16 + r) * 64 + lane] = o[d][r] * inv;
    }
    __syncthreads();
    if (comp == 0) {
        float ss = 0.f;
#pragma unroll
        for (int d = 0; d < 4; ++d)
#pragma unroll
            for (int r = 0; r < 16; ++r) { const float v = o[d][r] * inv - lam * ex[(d * 16 + r) * 64 + lane]; o[d][r] = v; ss += v * v; }
        ss = fa::halfsum(ss);
        const float rs = rsqrtf(ss * (1.f / 128.f) + SUBLN_EPS) * (1.f - LAMBDA_INIT);
        bf16* rowp = (bf16*)(p.ws + WS_MIXIN) + (rb + qpos) * DM + 512 + h * 128;
#pragma unroll
        for (int d = 0; d < 4; ++d)
#pragma unroll
            for (int g = 0; g < 4; ++g) { const int dd = 32 * d + 8 * g + 4 * hi; const f32x4 gg = *(const f32x4*)(p.subln_g + dd);
                u32x2 w; w.x = cvtpk(o[d][4 * g] * rs * gg[0], o[d][4 * g + 1] * rs * gg[1]); w.y = cvtpk(o[d][4 * g + 2] * rs * gg[2], o[d][4 * g + 3] * rs * gg[3]);
                *(u32x2*)(rowp + dd) = w; }
    }
    __syncthreads();
}

struct DilGeo { int b, h, br, dil, res, i0; };
__device__ __forceinline__ DilGeo dil_decode(int u) { DilGeo g; const int grp = u & 15, t3 = u >> 4; g.br = t3 % 3; const int bh = t3 / 3; g.b = bh >> 3; g.h = bh & 7;
    g.dil = g.br == 0 ? 1 : (g.br == 1 ? 4 : 16); const int ngr = 16 / g.dil; g.res = grp / ngr; g.i0 = 256 * (grp % ngr); return g; }
__device__ __forceinline__ void dil_phase(const P& p, int u0, int ustride, int nunits, LAS unsigned char* ldsu) {
    constexpr int KSTR = 144, VSTR = 192, KALL = 384 * KSTR;
    LAS char* lds = (LAS char*)ldsu;
    const int tid = threadIdx.x, lane = tid & 63, wid = __builtin_amdgcn_readfirstlane(tid >> 6), hi = lane >> 5;
    const bf16* proj = (const bf16*)(p.ws + WS_PROJ);
    int u = u0; if (u >= nunits) return;
    DilGeo g = dil_decode(u);
    u32x4 rk[6], rv[6]; bf16x8 qf[4], qn[4];
#define DIL_LOAD(G, QF) do { const size_t rb_ = (size_t)(G).b * SEQ; \
        _Pragma("unroll") for (int i = 0; i < 6; ++i) { const int pidx = tid + 512 * i, row = pidx >> 3, ch = pidx & 7; int kidx = (G).i0 - 128 + row; if (kidx < 0) kidx = 0; \
            const bf16* src = proj + (rb_ + (size_t)kidx * (G).dil + (G).res) * INW + (G).h * 64 + ch * 8; rk[i] = *(const u32x4*)(src + 512); rv[i] = *(const u32x4*)(src + 1024); } \
        { const size_t qrow_ = rb_ + (size_t)((G).i0 + 32 * wid + (lane & 31)) * (G).dil + (G).res; \
          _Pragma("unroll") for (int ds = 0; ds < 4; ++ds) QF[ds] = *(const bf16x8*)(proj + qrow_ * INW + (G).h * 64 + ds * 16 + hi * 8); } } while (0)
    DIL_LOAD(g, qf);
    for (;;) {
#pragma unroll
        for (int i = 0; i < 6; ++i) { const int pidx = tid + 512 * i, row = pidx >> 3, ch = pidx & 7; *(LAS u32x4*)(lds + row * KSTR + ch * 16) = rk[i]; *(LAS u32x4*)(lds + KALL + row * VSTR + ch * 16) = rv[i]; }
        lds_barrier();
        const int un = u + ustride; const bool more = un < nunits;
        DilGeo gn = g; if (more) { gn = dil_decode(un); DIL_LOAD(gn, qn); }
        const int qi = g.i0 + 32 * wid + (lane & 31);
        const size_t qrow = (size_t)g.b * SEQ + (size_t)qi * g.dil + g.res;
        f32x16 sc[6];
        const int kt0 = wid >> 1;
#pragma unroll
        for (int kk = 0; kk < 3; ++kk) {
            const LAS char* Kl = lds + (kt0 + kk) * 64 * KSTR;
            sc[2 * kk] = fa::qk<4, KSTR>(Kl, 0, qf, lane); sc[2 * kk + 1] = fa::qk<4, KSTR>(Kl, 1, qf, lane);
            const int kb = g.i0 - 128 + 64 * (kt0 + kk);
            if (kk != 1 || kb < 0) {
#pragma unroll
                for (int r = 0; r < 16; ++r) { const int k0i = kb + fa::crow(r, hi), k1i = k0i + 32;
                    if (k0i < 0 || k0i > qi || qi - k0i > 128) sc[2 * kk][r] = -INFINITY;
                    if (k1i < 0 || k1i > qi || qi - k1i > 128) sc[2 * kk + 1][r] = -INFINITY; }
            }
        }
        float m = fa::max3f(fa::rowmax32(sc[0], sc[1]), fa::rowmax32(sc[2], sc[3]), fa::rowmax32(sc[4], sc[5]));
        m = fa::halfmax(m);
        float l = 0.f;
#pragma unroll
        for (int t = 0; t < 6; ++t)
#pragma unroll
            for (int r = 0; r < 16; ++r) { sc[t][r] = fast_exp2(sc[t][r] - m); l += sc[t][r]; }
        l = fa::halfsum(l);
        f32x16 o[2];
#pragma unroll
        for (int d = 0; d < 2; ++d)
#pragma unroll
            for (int r = 0; r < 16; ++r) o[d][r] = 0.f;
#pragma unroll
        for (int kk = 0; kk < 3; ++kk) {
            bf16x8 pf[4];
#pragma unroll
            for (int j = 0; j < 2; ++j)
#pragma unroll
                for (int s2 = 0; s2 < 2; ++s2) { const f32x16& q = sc[2 * kk + j]; u32x4 a;
                    a.x = cvtpk(q[8 * s2], q[8 * s2 + 1]); a.y = cvtpk(q[8 * s2 + 2], q[8 * s2 + 3]); a.z = cvtpk(q[8 * s2 + 4], q[8 * s2 + 5]); a.w = cvtpk(q[8 * s2 + 6], q[8 * s2 + 7]);
                    pf[2 * j + s2] = __builtin_bit_cast(bf16x8, a); }
            fa::pv<2, VSTR>(o, lds + KALL + (kt0 + kk) * 64 * VSTR, pf, lane);
        }
        const float inv = fast_rcp(l);
        fa::store_o<2>(o, inv, (bf16*)(p.ws + WS_PARTA) + ((size_t)g.br * T + qrow) * 512 + g.h * 64, hi);
        if (hi == 0) ((float*)(p.ws + WS_LSEA))[((size_t)g.br * T + qrow) * 8 + g.h] = m + log2f(l);
        lds_barrier();
        if (!more) break;
        u = un; g = gn;
#pragma unroll
        for (int ds = 0; ds < 4; ++ds) qf[ds] = qn[ds];
    }
#undef DIL_LOAD
}

__device__ __forceinline__ void mem_unit(const P& p, int b, int h, int qblk, LAS unsigned char* ldsu) {
    constexpr int KSTR = 528, VSTR = 320, KB = 64 * KSTR, VB = 64 * VSTR;
    LAS char* lds = (LAS char*)ldsu;
    int tid_ = threadIdx.x; asm volatile("" : "+v"(tid_));
    const int tid = tid_, lane = tid & 63, wid = __builtin_amdgcn_readfirstlane(tid >> 6), hi = lane >> 5;
    const bf16* qm = (const bf16*)(p.ws + WS_QM); const bf16* kvm = (const bf16*)(p.ws + WS_KVM);
    const size_t qrow = (size_t)b * SEQ + qblk * 256 + 32 * wid + (lane & 31);
    const bf16* kbase = kvm + (size_t)(b * MEML) * 2048 + h * 256;
    const bf16* vbase = kbase + 1024;
    u32x4 rr[4];
#define MEMK_LOAD(kt) do { _Pragma("unroll") for (int i = 0; i < 4; ++i) { const int pidx = tid + 512 * i, row = pidx >> 5, ch = pidx & 31; rr[i] = *(const u32x4*)(kbase + (size_t)((kt) * 64 + row) * 2048 + ch * 8); } } while (0)
#define MEMK_WRITE(bufp) do { _Pragma("unroll") for (int i = 0; i < 4; ++i) { const int pidx = tid + 512 * i, row = pidx >> 5, ch = pidx & 31; *(LAS u32x4*)((bufp) + row * KSTR + ch * 16) = rr[i]; } } while (0)
#define MEMV_LOAD(hf, kt) do { _Pragma("unroll") for (int i = 0; i < 2; ++i) { const int pidx = tid + 512 * i, row = pidx >> 4, ch = pidx & 15; rr[i] = *(const u32x4*)(vbase + (hf) * 128 + (size_t)((kt) * 64 + row) * 2048 + ch * 8); } } while (0)
#define MEMV_WRITE(bufp) do { _Pragma("unroll") for (int i = 0; i < 2; ++i) { const int pidx = tid + 512 * i, row = pidx >> 4, ch = pidx & 15; *(LAS u32x4*)((bufp) + row * VSTR + ch * 16) = rr[i]; } } while (0)
    bf16x8 pf[16];
    float l;
    {
        f32x16 sc[8];
#pragma unroll
        for (int t = 0; t < 8; ++t)
#pragma unroll
            for (int r = 0; r < 16; ++r) sc[t][r] = 0.f;
        MEMK_LOAD(0); MEMK_WRITE(lds);
        __syncthreads();
#pragma unroll
        for (int dh = 0; dh < 2; ++dh) {
            bf16x8 qf[8];
#pragma unroll
            for (int ds = 0; ds < 8; ++ds) qf[ds] = *(const bf16x8*)(qm + qrow * DM + h * 256 + dh * 128 + ds * 16 + hi * 8);
#pragma unroll
            for (int kt = 0; kt < 4; ++kt) {
                const int step = dh * 4 + kt;
                if (step < 7) MEMK_LOAD((step + 1) & 3);
                const LAS char* buf = lds + (step & 1) * KB + dh * 256;
                sc[2 * kt] = fa::qk_c<8, KSTR>(buf, 0, qf, lane, sc[2 * kt]); sc[2 * kt + 1] = fa::qk_c<8, KSTR>(buf, 1, qf, lane, sc[2 * kt + 1]);
                if (step < 7) { MEMK_WRITE(lds + ((step + 1) & 1) * KB); }
                __syncthreads();
            }
        }
        MEMV_LOAD(0, 0);
        float mx = fa::max2f(fa::max2f(fa::rowmax32(sc[0], sc[1]), fa::rowmax32(sc[2], sc[3])), fa::max2f(fa::rowmax32(sc[4], sc[5]), fa::rowmax32(sc[6], sc[7])));
        mx = fa::halfmax(mx);
        float sum = 0.f;
#pragma unroll
        for (int t = 0; t < 8; ++t)
#pragma unroll
            for (int r = 0; r < 16; ++r) { sc[t][r] = fast_exp2(sc[t][r] - mx); sum += sc[t][r]; }
        l = fa::halfsum(sum);
#pragma unroll
        for (int t = 0; t < 8; ++t)
#pragma unroll
            for (int s2 = 0; s2 < 2; ++s2) { u32x4 a;
                a.x = cvtpk(sc[t][8 * s2], sc[t][8 * s2 + 1]); a.y = cvtpk(sc[t][8 * s2 + 2], sc[t][8 * s2 + 3]); a.z = cvtpk(sc[t][8 * s2 + 4], sc[t][8 * s2 + 5]); a.w = cvtpk(sc[t][8 * s2 + 6], sc[t][8 * s2 + 7]);
                pf[2 * t + s2] = __builtin_bit_cast(bf16x8, a); }
    }
    const float inv = fast_rcp(l);
    MEMV_WRITE(lds);
    __syncthreads();
#pragma unroll
    for (int hf = 0; hf < 2; ++hf) {
        f32x16 o[4];
#pragma unroll
        for (int d = 0; d < 4; ++d)
#pragma unroll
            for (int r = 0; r < 16; ++r) o[d][r] = 0.f;
#pragma unroll
        for (int kt = 0; kt < 4; ++kt) {
            const int step = hf * 4 + kt;
            if (step < 7) MEMV_LOAD((step + 1) >> 2, (step + 1) & 3);
            const bf16x8 pk[4] = {pf[4 * kt], pf[4 * kt + 1], pf[4 * kt + 2], pf[4 * kt + 3]};
            fa::pv<4, VSTR>(o, lds + (step & 1) * VB, pk, lane);
            if (step < 7) { MEMV_WRITE(lds + ((step + 1) & 1) * VB); }
            __syncthreads();
        }
        fa::store_o<4>(o, inv, (bf16*)(p.ws + WS_MO) + qrow * DM + h * 256 + hf * 128, hi);
    }
#undef MEMK_LOAD
#undef MEMK_WRITE
#undef MEMV_LOAD
#undef MEMV_WRITE
}

struct Ctx { int tid, lane, wave, G, vcu, gw, ngw; LAS unsigned char* lds; };

template <class RowMap> __device__ __forceinline__ void transpose_tile(const float* W, int N, int k0, int n0, bf16* dst, int dstK, LAS float* scr, int lane, const RowMap& rm) {
    f32x4 v[16];
#pragma unroll
    for (int i = 0; i < 16; ++i) v[i] = *(const f32x4*)(W + (size_t)(k0 + 4 * i + (lane >> 4)) * N + n0 + (lane & 15) * 4);
#pragma unroll
    for (int i = 0; i < 16; ++i) { LAS float* s = scr + (4 * i + (lane >> 4)) * 65 + (lane & 15) * 4; s[0] = v[i][0]; s[1] = v[i][1]; s[2] = v[i][2]; s[3] = v[i][3]; }
    asm volatile("s_waitcnt lgkmcnt(0)" ::: "memory");
    const int c = lane & 7;
#pragma unroll
    for (int j = 0; j < 8; ++j) { const int n = (lane >> 3) + 8 * j; const LAS float* s = scr + (8 * c) * 65 + n;
        u32x4 w; w.x = cvtpk(s[0], s[65]); w.y = cvtpk(s[2 * 65], s[3 * 65]); w.z = cvtpk(s[4 * 65], s[5 * 65]); w.w = cvtpk(s[6 * 65], s[7 * 65]);
        *(u32x4*)(dst + (size_t)rm(n0 + n) * dstK + k0 + 8 * c) = w; }
    asm volatile("s_waitcnt lgkmcnt(0)" ::: "memory");
}
template <int N> __device__ __forceinline__ void tile_load_n(const float* W, int k0, int n0, int lane, f32x4 (&v)[16]) {
    const __amdgpu_buffer_rsrc_t rs = __builtin_amdgcn_make_buffer_rsrc((void*)W, 0, 0x7ffff000, 0x00020000);
    const int voff = ((64 * (lane >> 5)) * N + (lane & 31)) * 4, sbase = (k0 * N + n0) * 4;
#pragma unroll
    for (int i = 0; i < 64; ++i) v[i >> 2][i & 3] = __uint_as_float(__builtin_amdgcn_raw_buffer_load_b32(rs, voff, sbase + i * N * 4, 2));
}
__device__ __forceinline__ void tile_load(const float* W, int N, int k0, int n0, int lane, f32x4 (&v)[16]) {
    if (N == EDIM) tile_load_n<EDIM>(W, k0, n0, lane, v); else tile_load_n<DM>(W, k0, n0, lane, v);
}
__device__ __forceinline__ void tile_store8(const f32x4 (&v)[16], int k0, unsigned char* dstrow0, int dstK, int rowmul  , int rowadd, LAS float* scr, int lane, float sc) {
    LAS unsigned char* sb = (LAS unsigned char*)scr;
    LAS unsigned char* wp = sb + (lane & 31) * 144 + 64 * (lane >> 5);
#pragma unroll
    for (int q = 0; q < 4; ++q) { int t[4];
#pragma unroll
        for (int m = 0; m < 4; ++m) { const f32x4 x = v[4 * q + m]; int tt = 0; tt = __builtin_amdgcn_cvt_pk_fp8_f32(x[0] * sc, x[1] * sc, tt, false); tt = __builtin_amdgcn_cvt_pk_fp8_f32(x[2] * sc, x[3] * sc, tt, true); t[m] = tt; }
        u32x4 w; w.x = (unsigned)t[0]; w.y = (unsigned)t[1]; w.z = (unsigned)t[2]; w.w = (unsigned)t[3];
        *(LAS u32x4*)(wp + 16 * q) = w; }
    asm volatile("s_waitcnt lgkmcnt(0)" ::: "memory");
    const int c = lane & 7;
#pragma unroll
    for (int j = 0; j < 4; ++j) { const int n = (lane >> 3) + 8 * j;
        const u32x4 w = *(const LAS u32x4*)(sb + n * 144 + 16 * c);
        const int drow = rowadd + (rowmul ? n : 16 * (n >> 3) + (n & 7));
        __builtin_nontemporal_store(w, (u32x4*)(dstrow0 + (size_t)drow * dstK + k0 + 16 * c)); }
    asm volatile("s_waitcnt lgkmcnt(0)" ::: "memory");
}
struct EItem { const float* W; int N, k0, n0, dstK, rowadd, rowmul; unsigned char* dst; float sc; };
__device__ __forceinline__ EItem eitem_decode(const P& p, int r) {
    constexpr int I_E = 64; EItem it;
    const int e = r / (3 * I_E), q = r % (3 * I_E), which = q / I_E, ti = q % I_E;
    if (which == 0) { it.W = e < NEXP ? p.w_gate + (size_t)e * DM * EDIM : p.ws_gate; it.N = EDIM; it.k0 = (ti / 8) * 128; it.n0 = (ti % 8) * 32; it.dst = (unsigned char*)(p.ws + WS_WTGU) + (size_t)e * 512 * DM; it.dstK = DM;
        it.rowadd = (it.n0 >> 7) * 256 + 64 * ((it.n0 & 127) >> 5); it.rowmul = 0; it.sc = gm::W8_SCALE; }
    else if (which == 1) { it.W = e < NEXP ? p.w_up + (size_t)e * DM * EDIM : p.ws_up; it.N = EDIM; it.k0 = (ti / 8) * 128; it.n0 = (ti % 8) * 32; it.dst = (unsigned char*)(p.ws + WS_WTGU) + (size_t)e * 512 * DM; it.dstK = DM;
        it.rowadd = (it.n0 >> 7) * 256 + 64 * ((it.n0 & 127) >> 5) + 8; it.rowmul = 0; it.sc = gm::W8_SCALE; }
    else { it.W = e < NEXP ? p.w_down + (size_t)e * EDIM * DM : p.ws_down; it.N = DM; it.k0 = (ti / 32) * 128; it.n0 = (ti % 32) * 32; it.dst = (unsigned char*)(p.ws + WS_WTD) + (size_t)e * DM * EDIM; it.dstK = EDIM; it.rowadd = it.n0; it.rowmul = 1; it.sc = gm::WD8_SCALE; }
    return it;
}
__device__ __forceinline__ void transpose_tile_ln(const float* W, int N, int k0, int n0, bf16* dst, int dstK, LAS float* scr, int lane, const float* g, const float* b, float* sn, float* cn) {
    f32x4 v[16];
#pragma unroll
    for (int i = 0; i < 16; ++i) v[i] = *(const f32x4*)(W + (size_t)(k0 + 4 * i + (lane >> 4)) * N + n0 + (lane & 15) * 4);
#pragma unroll
    for (int i = 0; i < 16; ++i) { LAS float* s = scr + (4 * i + (lane >> 4)) * 65 + (lane & 15) * 4; s[0] = v[i][0]; s[1] = v[i][1]; s[2] = v[i][2]; s[3] = v[i][3]; }
    asm volatile("s_waitcnt lgkmcnt(0)" ::: "memory");
    const int c = lane & 7;
    float gk[8];
#pragma unroll
    for (int e = 0; e < 8; ++e) gk[e] = g[k0 + 8 * c + e];
#pragma unroll
    for (int j = 0; j < 8; ++j) { const int n = (lane >> 3) + 8 * j; const LAS float* s = scr + (8 * c) * 65 + n;
        u32x4 w; w.x = cvtpk(s[0] * gk[0], s[65] * gk[1]); w.y = cvtpk(s[2 * 65] * gk[2], s[3 * 65] * gk[3]); w.z = cvtpk(s[4 * 65] * gk[4], s[5 * 65] * gk[5]); w.w = cvtpk(s[6 * 65] * gk[6], s[7 * 65] * gk[7]);
        *(u32x4*)(dst + (size_t)(n0 + n) * dstK + k0 + 8 * c) = w; }
    float sa = 0.f, sb = 0.f;
#pragma unroll 8
    for (int k = 0; k < 64; ++k) { const float wv = scr[k * 65 + lane]; const float gw = wv * g[k0 + k]; sa += __uint_as_float((cvtpk(gw, 0.f) & 0xffffu) << 16); sb += wv * b[k0 + k]; }
    atomicAdd(sn + n0 + lane, sa); atomicAdd(cn + n0 + lane, sb);
    asm volatile("s_waitcnt lgkmcnt(0)" ::: "memory");
}
struct RmId { __device__ int operator()(int n) const { return n; } };
struct RmInProj { __device__ int operator()(int n) const { const int seg = n >> 9; if (seg == 2 || seg == 5) return n; const int d = n & 63; return (n & ~63) | (d < 16 ? 2 * (d & 7) + (d >> 3) : d); } };
struct RmGU { int up; __device__ int operator()(int n) const { return (n >> 7) * 256 + up * 128 + (n & 127); } };

__device__ __forceinline__ int etick(int* ctr, int lane) { int v = 0; if (lane == 0) v = __hip_atomic_fetch_add(ctr, 1, __ATOMIC_RELAXED, __HIP_MEMORY_SCOPE_AGENT); return __builtin_amdgcn_readfirstlane(v); }
constexpr int ECONV_NCH = 3 * 64 * (NEXP + 1) / ECHUNK_CFG;
__device__ __forceinline__ void prologue_experts(const P& p, const Ctx& c, int* ctr, const int ch_lo, const int NCH  ) {
    LAS float* scr = (LAS float*)(c.lds + c.wave * 16896);
    constexpr int NE = 3 * 64 * (NEXP + 1), CH = ECHUNK_CFG;
    static_assert(NE % CH == 0, "chunking");
    const int ch = ch_lo + etick(ctr, c.lane); f32x4 va[16], vb[16], vc[16]; EItem e0, e1, e2;
    if (ch >= NCH) return;
    int chn = ch_lo + etick(ctr, c.lane);
    int it = ch * CH, k = 0; bool have1 = true, have2 = true;
    auto advance = [&](bool& have) { if (++k == CH) { k = 0; have = chn < NCH; it = chn * CH; if (have) chn = ch_lo + etick(ctr, c.lane); } else ++it; };
    e0 = eitem_decode(p, it); tile_load(e0.W, e0.N, e0.k0, e0.n0, c.lane, va);
    advance(have1);
    if (have1) { e1 = eitem_decode(p, it); tile_load(e1.W, e1.N, e1.k0, e1.n0, c.lane, vb); }
    while (true) {
        have2 = have1;
        if (have1) { advance(have2); if (have2) { e2 = eitem_decode(p, it); tile_load(e2.W, e2.N, e2.k0, e2.n0, c.lane, vc); } }
        tile_store8(va, e0.k0, e0.dst, e0.dstK, e0.rowmul, e0.rowadd, scr, c.lane, e0.sc);
        if (!have1) break;
        e0 = e1; e1 = e2; have1 = have2;
#pragma unroll
        for (int i = 0; i < 16; ++i) { va[i] = vb[i]; vb[i] = vc[i]; }
    }
}
__device__ __forceinline__ void prologue_experts_wg(const P& p, const Ctx& c, int* ctr, const int ch_lo, const int NCH) {
    static_assert(ECHUNK_CFG == NWAVES, "one item per wave per ticket");
    LAS float* scr = (LAS float*)(c.lds + c.wave * 16896);
    volatile LAS int* tq = (volatile LAS int*)(c.lds + LDS_BYTES - 64) + 8;
    if (c.tid == 0) { const int a0 = __hip_atomic_fetch_add(ctr, 3, __ATOMIC_RELAXED, __HIP_MEMORY_SCOPE_AGENT); tq[0] = ch_lo + a0; tq[1] = ch_lo + a0 + 1; tq[2] = ch_lo + a0 + 2; }
    __syncthreads();
    f32x4 va[16], vb[16], vc[16]; EItem e0, e1, e2;
    const int t0 = __builtin_amdgcn_readfirstlane(tq[0]), t1 = __builtin_amdgcn_readfirstlane(tq[1]);
    if (t0 >= NCH) { __syncthreads(); return; }
    e0 = eitem_decode(p, t0 * NWAVES + c.wave); tile_load(e0.W, e0.N, e0.k0, e0.n0, c.lane, va);
    bool have1 = t1 < NCH, have2;
    if (have1) { e1 = eitem_decode(p, t1 * NWAVES + c.wave); tile_load(e1.W, e1.N, e1.k0, e1.n0, c.lane, vb); }
    for (int i = 0;; ++i) {
        int tk3 = 0;
        if (c.tid == 0) tk3 = ch_lo + __hip_atomic_fetch_add(ctr, 1, __ATOMIC_RELAXED, __HIP_MEMORY_SCOPE_AGENT);
        const int t2 = __builtin_amdgcn_readfirstlane(tq[(i + 2) & 3]);
        have2 = have1 && t2 < NCH;
        if (have2) { e2 = eitem_decode(p, t2 * NWAVES + c.wave); tile_load(e2.W, e2.N, e2.k0, e2.n0, c.lane, vc); }
        tile_store8(va, e0.k0, e0.dst, e0.dstK, e0.rowmul, e0.rowadd, scr, c.lane, e0.sc);
        if (c.tid == 0) tq[(i + 3) & 3] = tk3;
        __syncthreads();
        if (!have1) break;
        e0 = e1; e1 = e2; have1 = have2;
#pragma unroll
        for (int q = 0; q < 16; ++q) { va[q] = vb[q]; vb[q] = vc[q]; }
    }
}
__device__ __forceinline__ void phase_prologue(const P& p, const Ctx& c) {
    LAS float* scr = (LAS float*)(c.lds + c.wave * 16896);
    unsigned char* ws = p.ws;
    constexpr int I_IN = 16 * 48, I_SQ = 16 * 16, I_KV = 16 * 32, I_R = 16 * 4, I_E = 64;
    constexpr int ND = I_IN + 3 * I_SQ + I_KV + I_R;
    for (int it = c.gw; it < ND; it += c.ngw) {
        int r = it;
        if (r < I_IN) { transpose_tile(p.w_in, INW, (r / 48) * 64, (r % 48) * 64, (bf16*)(ws + WS_WINT), DM, scr, c.lane, RmInProj{}); continue; } r -= I_IN;
        if (r < I_SQ) { transpose_tile(p.w_out, DM, (r / 16) * 64, (r % 16) * 64, (bf16*)(ws + WS_WOUTT), DM, scr, c.lane, RmId{}); continue; } r -= I_SQ;
        if (r < I_SQ) { transpose_tile_ln(p.wq, DM, (r / 16) * 64, (r % 16) * 64, (bf16*)(ws + WS_WQT), DM, scr, c.lane, p.ln1_g, p.ln1_b, (float*)(ws + WS_SN), (float*)(ws + WS_CN)); continue; } r -= I_SQ;
        if (r < I_KV) { transpose_tile(p.wkv, 2048, (r / 32) * 64, (r % 32) * 64, (bf16*)(ws + WS_WKVT), DM, scr, c.lane, RmId{}); continue; } r -= I_KV;
        if (r < I_SQ) { transpose_tile(p.wo, DM, (r / 16) * 64, (r % 16) * 64, (bf16*)(ws + WS_WOT), DM, scr, c.lane, RmId{}); continue; } r -= I_SQ;
        if (LN2_FOLD) transpose_tile_ln(p.w_router, NEXP, (r / 4) * 64, (r % 4) * 64, (bf16*)(ws + WS_WRT), DM, scr, c.lane, p.ln2_g, p.ln2_b, (float*)(ws + WS_SN2), (float*)(ws + WS_CN2));
        else transpose_tile(p.w_router, NEXP, (r / 4) * 64, (r % 4) * 64, (bf16*)(ws + WS_WRT), DM, scr, c.lane, RmId{});
    }
    const int gt = c.vcu * NTHR + c.tid, ngt = c.G * NTHR;
    for (int i0 = gt; i0 < T * DM / 8; i0 += ngt * 4) { f32x4 a[4], b[4];
#pragma unroll
        for (int q = 0; q < 4; ++q) { const size_t i = (size_t)i0 + (size_t)q * ngt; a[q] = __builtin_nontemporal_load((const f32x4*)(p.x + i * 8)); b[q] = __builtin_nontemporal_load((const f32x4*)(p.x + i * 8 + 4)); }
#pragma unroll
        for (int q = 0; q < 4; ++q) { const size_t i = (size_t)i0 + (size_t)q * ngt; *(u32x4*)((bf16*)(ws + WS_XB) + i * 8) = gm::pack8(a[q], b[q]); } }
    for (int i = gt; i < BATCH * MEML * DM / 8; i += ngt) { const f32x4 a = *(const f32x4*)(p.mem + (size_t)i * 8), b = *(const f32x4*)(p.mem + (size_t)i * 8 + 4); *(u32x4*)((bf16*)(ws + WS_MEMB) + (size_t)i * 8) = gm::pack8(a, b); }
    for (int i = gt; i < T * 8; i += ngt) { const int t = i >> 3, j = i & 7; const float inv = powf(500000.0f, -(float)(2 * j) / 16.0f); const float ang = (float)p.pos[t] * inv;
        ((float2*)(ws + WS_CS))[i] = make_float2(cosf(ang), sinf(ang)); }
    if (gt < 256) ((int*)(ws + WS_CNTP))[gt * CNT_STRIDE] = 0;
    if (gt == 0) { float a = 0.f, b = 0.f; for (int k = 0; k < 64; ++k) { a += p.lq1[k] * p.lk1[k]; b += p.lq2[k] * p.lk2[k]; } ((float*)(ws + WS_SCAL))[0] = expf(a) - expf(b) + LAMBDA_INIT; }
}

__device__ __forceinline__ void unpack8(const u32x4 u, float (&v)[8]) {
    v[0] = __uint_as_float(u.x << 16); v[1] = __uint_as_float(u.x & 0xffff0000u); v[2] = __uint_as_float(u.y << 16); v[3] = __uint_as_float(u.y & 0xffff0000u);
    v[4] = __uint_as_float(u.z << 16); v[5] = __uint_as_float(u.z & 0xffff0000u); v[6] = __uint_as_float(u.w << 16); v[7] = __uint_as_float(u.w & 0xffff0000u);
}
__device__ __forceinline__ void phase_merge(const P& p, const Ctx& c, const int gt, const int ngt) {
    const float* lse = (const float*)(p.ws + WS_LSEA); const bf16* pa = (const bf16*)(p.ws + WS_PARTA); bf16* mx = (bf16*)(p.ws + WS_MIXIN);
    for (int i0 = gt; i0 < T * 64; i0 += ngt * 4) {
        u32x4 ua[4], ub[4], ud[4]; float l0[4], l1[4], l2[4];
#pragma unroll
        for (int q = 0; q < 4; ++q) { const int i = i0 + q * ngt; if (i < T * 64) { const int t = i >> 6, c8 = (i & 63) * 8, h = c8 >> 6;
            l0[q] = lse[(size_t)t * 8 + h]; l1[q] = lse[((size_t)T + t) * 8 + h]; l2[q] = lse[((size_t)2 * T + t) * 8 + h];
            ua[q] = __builtin_nontemporal_load((const u32x4*)(pa + (size_t)t * 512 + c8)); ub[q] = __builtin_nontemporal_load((const u32x4*)(pa + ((size_t)T + t) * 512 + c8)); ud[q] = __builtin_nontemporal_load((const u32x4*)(pa + ((size_t)2 * T + t) * 512 + c8)); } }
#pragma unroll
        for (int q = 0; q < 4; ++q) { const int i = i0 + q * ngt; if (i < T * 64) { const int t = i >> 6, c8 = (i & 63) * 8;
            const float mxl = fmaxf(l0[q], fmaxf(l1[q], l2[q]));
            float w0 = fast_exp2(l0[q] - mxl), w1 = fast_exp2(l1[q] - mxl), w2 = fast_exp2(l2[q] - mxl); const float inv = 1.f / (w0 + w1 + w2); w0 *= inv; w1 *= inv; w2 *= inv;
            float a[8], b[8], d[8]; unpack8(ua[q], a); unpack8(ub[q], b); unpack8(ud[q], d);
            u32x4 o; o.x = cvtpk(w0 * a[0] + w1 * b[0] + w2 * d[0], w0 * a[1] + w1 * b[1] + w2 * d[1]); o.y = cvtpk(w0 * a[2] + w1 * b[2] + w2 * d[2], w0 * a[3] + w1 * b[3] + w2 * d[3]);
            o.z = cvtpk(w0 * a[4] + w1 * b[4] + w2 * d[4], w0 * a[5] + w1 * b[5] + w2 * d[5]); o.w = cvtpk(w0 * a[6] + w1 * b[6] + w2 * d[6], w0 * a[7] + w1 * b[7] + w2 * d[7]);
            OUT_ST16(mx + (size_t)t * DM + c8, o); } }
    }
}
__device__ __forceinline__ void phase_ln(const bf16* in, bf16* outp, const float* g, const float* bb_, const Ctx& c, unsigned char* q8, int row_lo, int row_hi, int gw, int ngw) {
    constexpr int LNR = 4;
    u32x2 raw[LNR][4], nraw[LNR][4];
    int w = row_lo + gw * LNR;
    if (w < row_hi) {
#pragma unroll
        for (int rr = 0; rr < LNR; ++rr)
#pragma unroll
            for (int j = 0; j < 4; ++j) raw[rr][j] = *(const u32x2*)(in + (size_t)(w + rr) * DM + j * 256 + c.lane * 4); }
    for (; w < row_hi; w += ngw * LNR) {
        const int wn = w + ngw * LNR;
        if (wn < row_hi) {
#pragma unroll
            for (int rr = 0; rr < LNR; ++rr)
#pragma unroll
                for (int j = 0; j < 4; ++j) nraw[rr][j] = *(const u32x2*)(in + (size_t)(wn + rr) * DM + j * 256 + c.lane * 4); }
        float v[LNR][16]; float s[LNR], q[LNR];
#pragma unroll
        for (int rr = 0; rr < LNR; ++rr) {
#pragma unroll
            for (int j = 0; j < 4; ++j) { const u32x2 u = raw[rr][j];
                v[rr][4 * j] = __uint_as_float(u.x << 16); v[rr][4 * j + 1] = __uint_as_float(u.x & 0xffff0000u); v[rr][4 * j + 2] = __uint_as_float(u.y << 16); v[rr][4 * j + 3] = __uint_as_float(u.y & 0xffff0000u); } }
#pragma unroll
        for (int rr = 0; rr < LNR; ++rr) { s[rr] = 0.f;
#pragma unroll
            for (int j = 0; j < 16; ++j) s[rr] += v[rr][j]; }
#pragma unroll
        for (int o = 1; o < 64; o <<= 1) {
#pragma unroll
            for (int rr = 0; rr < LNR; ++rr) s[rr] += __shfl_xor(s[rr], o); }
#pragma unroll
        for (int rr = 0; rr < LNR; ++rr) { const float mu = s[rr] * (1.f / DM); q[rr] = 0.f;
#pragma unroll
            for (int j = 0; j < 16; ++j) { v[rr][j] -= mu; q[rr] += v[rr][j] * v[rr][j]; } }
#pragma unroll
        for (int o = 1; o < 64; o <<= 1) {
#pragma unroll
            for (int rr = 0; rr < LNR; ++rr) q[rr] += __shfl_xor(q[rr], o); }
#pragma unroll
        for (int rr = 0; rr < LNR; ++rr) { const float rs = rsqrtf(q[rr] * (1.f / DM) + LN_EPS);
#pragma unroll
            for (int j = 0; j < 4; ++j) { const int cc = j * 256 + c.lane * 4; const f32x4 gg = *(const f32x4*)(g + cc), bb = *(const f32x4*)(bb_ + cc);
                const float y0 = v[rr][4 * j] * rs * gg[0] + bb[0], y1 = v[rr][4 * j + 1] * rs * gg[1] + bb[1], y2 = v[rr][4 * j + 2] * rs * gg[2] + bb[2], y3 = v[rr][4 * j + 3] * rs * gg[3] + bb[3];
                u32x2 u; u.x = cvtpk(y0, y1); u.y = cvtpk(y2, y3);
                *(u32x2*)(outp + (size_t)(w + rr) * DM + cc) = u;
                if (q8) { int t8 = 0; t8 = __builtin_amdgcn_cvt_pk_fp8_f32(y0 * gm::X8_SCALE, y1 * gm::X8_SCALE, t8, false); t8 = __builtin_amdgcn_cvt_pk_fp8_f32(y2 * gm::X8_SCALE, y3 * gm::X8_SCALE, t8, true); *(int*)(q8 + (size_t)(w + rr) * DM + cc) = t8; } } }
#pragma unroll
        for (int rr = 0; rr < LNR; ++rr)
#pragma unroll
            for (int j = 0; j < 4; ++j) raw[rr][j] = nraw[rr][j];
    }
}
#define DPP_F(old, src, ctrl, rmask) __uint_as_float(__builtin_amdgcn_update_dpp(__float_as_uint(old), __float_as_uint(src), (ctrl), (rmask), 0xf, false))
__device__ __forceinline__ float wave_max_f32(float v) {
    asm("s_nop 1\n\tv_max_f32_dpp %0, %0, %0 row_shr:1 row_mask:0xf bank_mask:0xf\n\t"
        "s_nop 1\n\tv_max_f32_dpp %0, %0, %0 row_shr:2 row_mask:0xf bank_mask:0xf\n\t"
        "s_nop 1\n\tv_max_f32_dpp %0, %0, %0 row_shr:4 row_mask:0xf bank_mask:0xf\n\t"
        "s_nop 1\n\tv_max_f32_dpp %0, %0, %0 row_shr:8 row_mask:0xf bank_mask:0xf\n\t"
        "s_nop 1\n\tv_max_f32_dpp %0, %0, %0 row_bcast:15 row_mask:0xa bank_mask:0xf\n\t"
        "s_nop 1\n\tv_max_f32_dpp %0, %0, %0 row_bcast:31 row_mask:0xc bank_mask:0xf" : "+v"(v));
    return __uint_as_float(__builtin_amdgcn_readlane(__float_as_uint(v), 63));
}
__device__ __forceinline__ void phase_route(const P& p, const Ctx& c, int nrep) {
    const int lane = c.lane;
    for (int rep = 0; rep < nrep; ++rep)
    for (int w0 = c.gw * 8; w0 < T; w0 += c.ngw * 8) {
        f32x4 lgs[8];
#pragma unroll
        for (int tt = 0; tt < 8; ++tt) lgs[tt] = *(const f32x4*)((const float*)(p.ws + WS_LOGITS) + (size_t)(w0 + tt) * NEXP + lane * 4);
        const f32x4 eb = *(const f32x4*)(p.e_bias + lane * 4);
        float sc[8][4], cand[8][4], m1[8], m2[8];
#pragma unroll
        for (int tt = 0; tt < 8; ++tt) {
#pragma unroll
            for (int j = 0; j < 4; ++j) { sc[tt][j] = 1.f / (1.f + expf(-lgs[tt][j])); cand[tt][j] = sc[tt][j] + eb[j]; }
            float a1 = fmaxf(cand[tt][0], cand[tt][1]), a2 = fminf(cand[tt][0], cand[tt][1]);
            { const float cc = cand[tt][2]; const float n1 = fmaxf(a1, cc); a2 = fmaxf(a2, fminf(a1, cc)); a1 = n1; }
            { const float cc = cand[tt][3]; const float n1 = fmaxf(a1, cc); a2 = fmaxf(a2, fminf(a1, cc)); a1 = n1; }
            m1[tt] = a1; m2[tt] = a2;
        }
#pragma unroll
        for (int tt = 0; tt < 8; ++tt) { const float b1 = DPP_F(m1[tt], m1[tt], 0xB1, 0xf), b2 = DPP_F(m2[tt], m2[tt], 0xB1, 0xf); const float n1 = fmaxf(m1[tt], b1); m2[tt] = fmaxf(fminf(m1[tt], b1), fmaxf(m2[tt], b2)); m1[tt] = n1; }
#pragma unroll
        for (int tt = 0; tt < 8; ++tt) { const float b1 = DPP_F(m1[tt], m1[tt], 0x4E, 0xf), b2 = DPP_F(m2[tt], m2[tt], 0x4E, 0xf); const float n1 = fmaxf(m1[tt], b1); m2[tt] = fmaxf(fminf(m1[tt], b1), fmaxf(m2[tt], b2)); m1[tt] = n1; }
#pragma unroll
        for (int tt = 0; tt < 8; ++tt) { const float b1 = DPP_F(m1[tt], m1[tt], 0x141, 0xf), b2 = DPP_F(m2[tt], m2[tt], 0x141, 0xf); const float n1 = fmaxf(m1[tt], b1); m2[tt] = fmaxf(fminf(m1[tt], b1), fmaxf(m2[tt], b2)); m1[tt] = n1; }
        const int grp = lane >> 3;
#pragma unroll
        for (int tt = 0; tt < 8; ++tt) { const float gs = m1[tt] + m2[tt]; int rank = 0;
#pragma unroll
            for (int g2 = 0; g2 < 8; ++g2) { const float o = __uint_as_float(__builtin_amdgcn_readlane(__float_as_uint(gs), g2 * 8)); rank += (int)((o > gs) | ((o == gs) & (g2 < grp))); }
            const bool sel = rank < 4;
#pragma unroll
            for (int j = 0; j < 4; ++j) cand[tt][j] = __uint_as_float(sel ? ((__float_as_uint(cand[tt][j]) & ~3u) | (unsigned)(3 - j)) : (0xFF7FFFFCu | (unsigned)(3 - j))); }
        int myidx = 0, mywb = 0; float mysum = 1.f; float wsum[8];
#pragma unroll
        for (int tt = 0; tt < 8; ++tt) wsum[tt] = 0.f;
#pragma unroll
        for (int th = 0; th < 8; th += ROUTE_IL) {
#pragma unroll
        for (int k = 0; k < TOPK; ++k) {
#pragma unroll
            for (int tt = th; tt < th + ROUTE_IL; ++tt) {
                const float lm = fa::max2f(fa::max3f(cand[tt][0], cand[tt][1], cand[tt][2]), cand[tt][3]);
                const float wm = wave_max_f32(lm);
                const unsigned long long bal = __ballot(lm == wm);
                const int own = __builtin_ctzll(bal);
                const unsigned wmb = __builtin_amdgcn_readfirstlane(__float_as_uint(wm));
                const int jwin = 3 - (int)(wmb & 3u);
                const bool jb0 = (jwin & 1) != 0, jb1 = (jwin & 2) != 0;
                const float c0_ = sc[tt][0], c1_ = sc[tt][1], c2_ = sc[tt][2], c3_ = sc[tt][3];
                const float sv01 = jb0 ? c1_ : c0_, sv23 = jb0 ? c3_ : c2_;
                const float wv = __uint_as_float(__builtin_amdgcn_readlane(__float_as_uint(jb1 ? sv23 : sv01), own));
                const bool isown = lane == own;
#pragma unroll
                for (int j = 0; j < 4; ++j) cand[tt][j] = (isown & (jwin == j)) ? __uint_as_float(0xFF7FFFFCu | (unsigned)(3 - j)) : cand[tt][j];
                wsum[tt] += wv;
                { const int eidx = __builtin_amdgcn_readfirstlane(own * 4 + jwin), wbits = __builtin_amdgcn_readfirstlane((int)__float_as_uint(wv));
                  asm("s_nop 1\n\tv_writelane_b32 %0, %2, %4\n\tv_writelane_b32 %1, %3, %4" : "+v"(myidx), "+v"(mywb) : "s"(eidx), "s"(wbits), "n"(tt * 8 + k)); }
            }
        }
        __builtin_amdgcn_sched_barrier(0);
        }
#pragma unroll
        for (int tt = 0; tt < 8; ++tt) if ((lane >> 3) == tt) mysum = wsum[tt];
        const float myw = __uint_as_float((unsigned)mywb);
        if (rep == nrep - 1) {
            const int rk = atomicAdd((int*)(p.ws + WS_CNTP) + myidx * CNT_STRIDE, 1);
            ((int*)(p.ws + WS_RIDX))[(size_t)w0 * 8 + lane] = myidx;
            ((float*)(p.ws + WS_RW))[(size_t)w0 * 8 + lane] = myw / mysum * ROUTED_SCALE;
            ((int*)(p.ws + WS_RRANK))[(size_t)w0 * 8 + lane] = rk;
#if NO_SCATTER
            ((int*)(p.ws + WS_SLOTTOK))[(size_t)myidx * T + rk] = w0 + (lane >> 3);
            ((float*)(p.ws + WS_SLOTW))[(size_t)myidx * T + rk] = myw / mysum * ROUTED_SCALE;
#endif
        }
    }
}
__device__ __forceinline__ void phase_scatter(const P& p, const Ctx& c) {
    LAS int* sh = (LAS int*)c.lds;
    const int tid = c.tid;
    int cnt = 0;
    if (tid < 256) { cnt = ld_i32_agent((const int*)(p.ws + WS_CNTP) + tid * CNT_STRIDE); sh[tid] = cnt; sh[256 + tid] = (cnt + MOE_ROWS - 1) >> MOE_RSH; }
    __syncthreads();
    for (int o = 1; o < 256; o <<= 1) { int v = 0, v2 = 0; if (tid < 256 && tid >= o) { v = sh[tid - o]; v2 = sh[256 + tid - o]; } __syncthreads(); if (tid < 256) { sh[tid] += v; sh[256 + tid] += v2; } __syncthreads(); }
    if (blockIdx.x == 0) {
        int* st = (int*)(p.ws + WS_START); int* tab = (int*)(p.ws + WS_TILETAB);
        if (tid < 256) { const int st_e = sh[tid] - cnt; st[tid + 1] = sh[tid]; if (tid == 0) st[0] = 0;
            const int nte = (cnt + MOE_ROWS - 1) >> MOE_RSH, tb = sh[256 + tid] - nte;
            for (int ti = 0; ti < nte; ++ti) { int* q = tab + 4 * (tb + ti); q[0] = tid; q[1] = ti; q[2] = st_e + MOE_ROWS * ti; q[3] = min(MOE_ROWS, cnt - MOE_ROWS * ti); } }
        const int nrt_r = sh[511];
        if (tid < T / MOE_ROWS) { int* q = tab + 4 * (nrt_r + tid); q[0] = NEXP; q[1] = tid; q[2] = AROWS + MOE_ROWS * tid; q[3] = MOE_ROWS; }
        if (tid == 0) ((int*)(p.ws + WS_NRT))[0] = nrt_r + T / MOE_ROWS;
    }
    const int gt = c.vcu * NTHR + tid, ngt = c.G * NTHR;
    for (int i0 = gt; i0 < T * 8; i0 += ngt * 2) {
        int e[2], rk[2]; float wv[2];
#pragma unroll
        for (int q = 0; q < 2; ++q) { const int i = i0 + q * ngt; e[q] = ((const int*)(p.ws + WS_RIDX))[i]; rk[q] = ((const int*)(p.ws + WS_RRANK))[i]; wv[q] = ((const float*)(p.ws + WS_RW))[i]; }
#pragma unroll
        for (int q = 0; q < 2; ++q) { const int i = i0 + q * ngt; const int pos = (e[q] == 0 ? 0 : sh[e[q] - 1]) + rk[q];
            ((int*)(p.ws + WS_ROWTOK))[pos] = i >> 3; ((float*)(p.ws + WS_ROWW))[pos] = wv[q]; ((int*)(p.ws + WS_POS))[i] = pos; }
    }
    __syncthreads();
}
__device__ __forceinline__ void moe_scan_tables(const P& p, const Ctx& c) {
    LAS int* sh = (LAS int*)c.lds;
    const int tid = c.tid;
    int cnt = 0;
    if (tid < 256) { cnt = ld_i32_agent((const int*)(p.ws + WS_CNTP) + tid * CNT_STRIDE); sh[tid] = cnt; sh[256 + tid] = (cnt + MOE_ROWS - 1) >> MOE_RSH; }
    __syncthreads();
    for (int o = 1; o < 256; o <<= 1) { int v = 0, v2 = 0; if (tid < 256 && tid >= o) { v = sh[tid - o]; v2 = sh[256 + tid - o]; } __syncthreads(); if (tid < 256) { sh[tid] += v; sh[256 + tid] += v2; } __syncthreads(); }
    if (blockIdx.x == 0) {
        int* st = (int*)(p.ws + WS_START); int* tab = (int*)(p.ws + WS_TILETAB);
        if (tid < 256) { const int st_e = sh[tid] - cnt; st[tid + 1] = sh[tid]; if (tid == 0) st[0] = 0;
            const int nte = (cnt + MOE_ROWS - 1) >> MOE_RSH, tb = sh[256 + tid] - nte;
            for (int ti = 0; ti < nte; ++ti) { int* q = tab + 4 * (tb + ti); q[0] = tid; q[1] = ti; q[2] = st_e + MOE_ROWS * ti; q[3] = min(MOE_ROWS, cnt - MOE_ROWS * ti); } }
        const int nrt_r = sh[511];
        if (tid < T / MOE_ROWS) { int* q = tab + 4 * (nrt_r + tid); q[0] = NEXP; q[1] = tid; q[2] = AROWS + MOE_ROWS * tid; q[3] = MOE_ROWS; }
        if (tid == 0) ((int*)(p.ws + WS_NRT))[0] = nrt_r + T / MOE_ROWS;
    }
    const int gt = c.vcu * NTHR + tid, ngt = c.G * NTHR;
    for (int i = gt; i < T * 8; i += ngt) { const int e = ((const int*)(p.ws + WS_RIDX))[i], rk = ((const int*)(p.ws + WS_RRANK))[i];
        ((int*)(p.ws + WS_POS))[i] = (e == 0 ? 0 : sh[e - 1]) + rk; }
}
__device__ __forceinline__ void phase_combine(const P& p, const Ctx& c) {
    const int lane = c.lane;
    const unsigned char* Y = (const unsigned char*)(p.ws + WS_Y);
    for (int w = c.gw; w < T; w += c.ngw) {
        const int pv = ((const int*)(p.ws + WS_POS))[(size_t)w * 8 + (lane & 7)];
        const bf16* h2 = (const bf16*)(p.ws + WS_H2) + (size_t)w * DM;
        float v[16]; u32x2 hu[4]; int yu[9][4];
#pragma unroll
        for (int j = 0; j < 4; ++j) hu[j] = __builtin_nontemporal_load((const u32x2*)(h2 + j * 256 + lane * 4));
#pragma unroll
        for (int k = 0; k < 9; ++k) {
            const size_t row = k < 8 ? (size_t)__builtin_amdgcn_readlane(pv, k < 8 ? k : 0) : (size_t)AROWS + w;
#pragma unroll
            for (int j = 0; j < 4; ++j) yu[k][j] = __builtin_nontemporal_load((const int*)(Y + row * DM + j * 256 + lane * 4));
        }
#pragma unroll
        for (int j = 0; j < 4; ++j) { const u32x2 u = hu[j];
            v[4 * j] = DN_ALPHA * __uint_as_float(u.x << 16); v[4 * j + 1] = DN_ALPHA * __uint_as_float(u.x & 0xffff0000u); v[4 * j + 2] = DN_ALPHA * __uint_as_float(u.y << 16); v[4 * j + 3] = DN_ALPHA * __uint_as_float(u.y & 0xffff0000u); }
#pragma unroll
        for (int j = 0; j < 4; ++j) { float a0 = 0.f, a1 = 0.f, a2 = 0.f, a3 = 0.f;
#pragma unroll
            for (int k = 0; k < 9; ++k) { const f32x2 lo = __builtin_amdgcn_cvt_pk_f32_fp8(yu[k][j], false), hi = __builtin_amdgcn_cvt_pk_f32_fp8(yu[k][j], true); a0 += lo[0]; a1 += lo[1]; a2 += hi[0]; a3 += hi[1]; }
            v[4 * j] += a0 * gm::Y8_INV; v[4 * j + 1] += a1 * gm::Y8_INV; v[4 * j + 2] += a2 * gm::Y8_INV; v[4 * j + 3] += a3 * gm::Y8_INV; }
        float s = 0.f;
#pragma unroll
        for (int j = 0; j < 16; ++j) s += v[j];
#pragma unroll
        for (int o = 1; o < 64; o <<= 1) s += __shfl_xor(s, o);
        const float mu = s * (1.f / DM); float q = 0.f;
#pragma unroll
        for (int j = 0; j < 16; ++j) { v[j] -= mu; q += v[j] * v[j]; }
#pragma unroll
        for (int o = 1; o < 64; o <<= 1) q += __shfl_xor(q, o);
        const float rs = rsqrtf(q * (1.f / DM) + LN_EPS);
#pragma unroll
        for (int j = 0; j < 4; ++j) { const int cc = j * 256 + lane * 4; const f32x4 gg = *(const f32x4*)(p.ln3_g + cc), bb = *(const f32x4*)(p.ln3_b + cc);
            f32x4 o; o[0] = v[4 * j] * rs * gg[0] + bb[0]; o[1] = v[4 * j + 1] * rs * gg[1] + bb[1]; o[2] = v[4 * j + 2] * rs * gg[2] + bb[2]; o[3] = v[4 * j + 3] * rs * gg[3] + bb[3];
            __builtin_nontemporal_store(o, (f32x4*)(p.out + (size_t)w * DM + cc)); }
    }
}

#define XB_TMO      128
#define XB_XCNT(j)  (256  + 64 * (j))
#define XB_XSUB(j)  (1280 + 64 * (j))
#define XB_XGEN(j)  (2304 + 64 * (j))
#define XB_TOP      3328
#define XB_TOPGEN   3392
#define XCD_BAR_WORDS 3456
#define XB_SPIN_CAP (1u << 18)
__device__ __forceinline__ unsigned xb_ld(unsigned* p)              { return __hip_atomic_load(p, __ATOMIC_RELAXED, __HIP_MEMORY_SCOPE_AGENT); }
__device__ __forceinline__ unsigned xb_add(unsigned* p, unsigned v) { return __hip_atomic_fetch_add(p, v, __ATOMIC_RELAXED, __HIP_MEMORY_SCOPE_AGENT); }
__device__ __forceinline__ unsigned xb_xcc_id() { return (unsigned)__builtin_amdgcn_s_getreg((3 << 11) | 20) & 0xFu; }
#define XB_SPIN(cond, bar) do { unsigned _sp = 0; while (cond) { __builtin_amdgcn_s_sleep(1); \
    if ((++_sp & 255u) == 0u) { if (xb_ld(&(bar)[XB_TMO])) break; if (_sp > XB_SPIN_CAP) { atomicAdd(&(bar)[XB_TMO], 1u); break; } } } } while (0)
struct XcdBarrier { unsigned* bar; unsigned x; volatile LAS unsigned* st; };
__device__ __forceinline__ XcdBarrier xcd_barrier_post(unsigned* bar, volatile LAS unsigned* st) {
    XcdBarrier b; b.bar = bar; b.x = xb_xcc_id(); b.st = st;
    if (threadIdx.x == 0) (void)xb_add(&bar[XB_XCNT(b.x)], 1u);
    return b;
}
__device__ __forceinline__ void xcd_barrier_complete(unsigned* bar, unsigned x, unsigned& nloc, unsigned& nx) {
    const unsigned G = gridDim.x * gridDim.y * gridDim.z;
    unsigned sum, cnt, mine, sp = 0u;
    for (;;) {
        sum = 0u; cnt = 0u; mine = 0u;
#pragma unroll
        for (unsigned j = 0; j < 16; ++j) { const unsigned c = xb_ld(&bar[XB_XCNT(j)]); sum += c; cnt += (c > 0u) ? 1u : 0u; mine = (j == x) ? c : mine; }
        if (sum == G) break;
        __builtin_amdgcn_s_sleep(1);
        if ((++sp & 255u) == 0u) { if (xb_ld(&bar[XB_TMO])) break; if (sp > XB_SPIN_CAP) { atomicAdd(&bar[XB_TMO], 1u); break; } }
    }
    nloc = mine > 0u ? mine : 1u; nx = cnt > 0u ? cnt : 1u;
}
__device__ __forceinline__ void xcd_barrier(const XcdBarrier& b) {
    asm volatile("s_waitcnt vmcnt(0)" ::: "memory");
    __syncthreads();
    if (threadIdx.x == 0) {
        unsigned* bar = b.bar;
        __builtin_amdgcn_s_waitcnt(0);
        unsigned nloc = b.st[0], nx = b.st[1];
        if (nloc == 0u) { xcd_barrier_complete(bar, b.x, nloc, nx); b.st[0] = nloc; b.st[1] = nx; }
        const unsigned old = xb_add(&bar[XB_XSUB(b.x)], 1u);
        const unsigned gen = old / nloc;
        if (old + 1u == (gen + 1u) * nloc) {
            __builtin_amdgcn_fence(__ATOMIC_RELEASE, "agent");
            asm volatile("s_waitcnt vmcnt(0)" ::: "memory");
            const unsigned og = xb_add(&bar[XB_TOP], 1u);
            const unsigned tg = og / nx;
            if (og + 1u == (tg + 1u) * nx) xb_add(&bar[XB_TOPGEN], 1u);
            else XB_SPIN(xb_ld(&bar[XB_TOPGEN]) == tg, bar);
            __builtin_amdgcn_fence(__ATOMIC_ACQUIRE, "agent");
#if !XB_FLAT_WAIT
            xb_add(&bar[XB_XGEN(b.x)], 1u);
#endif
            asm volatile("s_waitcnt vmcnt(0)" ::: "memory");
        } else {
#if XB_FLAT_WAIT
            XB_SPIN(xb_ld(&bar[XB_TOPGEN]) == gen, bar);
#else
            XB_SPIN(xb_ld(&bar[XB_XGEN(b.x)]) == gen, bar);
#endif
            __builtin_amdgcn_fence(__ATOMIC_ACQUIRE, "agent");
            asm volatile("s_waitcnt vmcnt(0)" ::: "memory");
        }
    }
    __syncthreads();
}

enum Phase { PH_PROLOGUE = 0, PH_INPROJ, PH_ATTN, PH_MERGE, PH_OUTPROJ, PH_LN1, PH_QMEM, PH_MEMATTN, PH_WO, PH_LN2, PH_ROUTER, PH_ROUTE, PH_SCATTER, PH_MOE1, PH_MOE2, PH_COMBINE, PH_COUNT };
struct MKArgs { P p; int ph_lo, ph_hi; };

__global__ void __launch_bounds__(NTHR, 2) mk_fwd(MKArgs a) {
    extern __shared__ __attribute__((aligned(16))) unsigned char lds_raw[];
    LAS unsigned char* lds = (LAS unsigned char*)lds_raw;
    typedef const __attribute__((address_space(4))) MKArgs* KArgP;
    const KArgP kargs = (KArgP)__builtin_amdgcn_kernarg_segment_ptr();
#define LDP_(field, idx) p.field = (decltype(p.field))(__attribute__((address_space(1))) char*)(src_[idx])
#define LOAD_P() KArgP kq_ = kargs; asm volatile("" : "+s"(kq_)); P p; { const __attribute__((address_space(4))) unsigned long long* src_ = (const __attribute__((address_space(4))) unsigned long long*)kq_; \
        LDP_(x, 0); LDP_(mem, 1); LDP_(pos, 2); LDP_(w_in, 3); LDP_(w_out, 4); LDP_(lq1, 5); LDP_(lk1, 6); LDP_(lq2, 7); LDP_(lk2, 8); LDP_(subln_g, 9); LDP_(ln1_g, 10); LDP_(ln1_b, 11); \
        LDP_(wq, 12); LDP_(wkv, 13); LDP_(wo, 14); LDP_(ln2_g, 15); LDP_(ln2_b, 16); LDP_(w_router, 17); LDP_(e_bias, 18); LDP_(w_gate, 19); LDP_(w_up, 20); LDP_(w_down, 21); \
        LDP_(ws_gate, 22); LDP_(ws_up, 23); LDP_(ws_down, 24); LDP_(ln3_g, 25); LDP_(ln3_b, 26); LDP_(out, 27); LDP_(ws, 28); } unsigned char* const ws = p.ws; \
        { int t_ = threadIdx.x; asm volatile("" : "+v"(t_)); c.tid = t_; c.lane = t_ & 63; }
    Ctx c; c.tid = threadIdx.x; c.lane = c.tid & 63; c.wave = __builtin_amdgcn_readfirstlane(c.tid >> 6); c.G = gridDim.x;
    { const int bx = blockIdx.x; c.vcu = (c.G % 8 == 0) ? (bx % 8) * (c.G / 8) + bx / 8 : bx; }
    c.gw = c.vcu * NWAVES + c.wave; c.ngw = c.G * NWAVES; c.lds = lds;
    const int lo = a.ph_lo, hi = a.ph_hi;
    unsigned char* const ws0 = a.p.ws;
#ifdef ONLY_PH
#define IN(k) ((k) == ONLY_PH)
#else
#define IN(k) (lo <= (k) && (k) < hi)
#endif
#ifndef USE_CG_SYNC
#define USE_CG_SYNC 0
#endif
    volatile LAS unsigned* MISC = (volatile LAS unsigned*)(lds + LDS_BYTES - 64);
    if (c.tid == 0) { MISC[0] = 0u; MISC[1] = 0u; }
    __syncthreads();
    XcdBarrier gbar; gbar.bar = (unsigned*)(ws0 + WS_BAR); gbar.x = 0; gbar.st = MISC;
    if (!USE_CG_SYNC && hi - lo > 1) gbar = xcd_barrier_post((unsigned*)(ws0 + WS_BAR), MISC);
#ifndef REP_MASK
#define REP_MASK 0
#endif
#define REPS(k) (1 + ((REP_MASK >> (k)) & 1))
#if REP_MASK == 0
#define REPLOOP(k)
#else
#define REPLOOP(k) for (int rep = 0; rep < REPS(k); ++rep)
#endif
#define SEAM(k) do { if (IN(k) && IN((k) + 1)) { if (USE_CG_SYNC) cg::this_grid().sync(); else { xcd_barrier(gbar); if ((REP_MASK >> 24) & 1) xcd_barrier(gbar); } } STAMP((k) + 1); } while (0)

#ifdef PROBE_A
    volatile LAS unsigned long long* stamps = (volatile LAS unsigned long long*)(lds + LDS_XTRA + 30720);
#define STAMP(k) do { if (blockIdx.x == 0 && c.tid == 0) stamps[(k)] = __builtin_amdgcn_s_memrealtime(); } while (0)
#else
#define STAMP(k) do {} while (0)
#endif
    STAMP(0);
    if (IN(PH_PROLOGUE)) { LOAD_P(); REPLOOP(PH_PROLOGUE) phase_prologue(p, c); SEAM(PH_PROLOGUE); }

    if (IN(PH_INPROJ)) { LOAD_P();
        constexpr int NCJ = NCJ_CFG;
        const int bx = (int)blockIdx.x, j = bx >> 3;
        const bool part = (c.G == 256) && NCJ > 0;
        const int cjlo = part ? (j * NCJ) / 32 : 0, cjhi = part ? ((j + 1) * NCJ) / 32 : 0;
        const bool conv = cjhi > cjlo;
        const int Gg = part ? 256 - 8 * NCJ : c.G, cg_ = part ? (j - cjlo) * 8 + (bx & 7) : bx;
        if (!conv) {
        REPLOOP(PH_INPROJ)
        { gm::DenseSched S; S.init(T, INW, DM, ws + WS_WINT, Gg, cg_);
          gm::EpiInProj E{(bf16*)(ws + WS_PROJ), (const float*)(ws + WS_CS)};
          gm::gemm_phase(lds, ws, (const char*)(ws + WS_XB), DM, S, E); }
        { gm::DenseSched S; S.init(BATCH * MEML, 2048, DM, ws + WS_WKVT, Gg, cg_);
          gm::EpiScale E{(bf16*)(ws + WS_KVM), 2048, 1.f};
          gm::gemm_phase(lds, ws, (const char*)(ws + WS_MEMB), DM, S, E); }
        __syncthreads();
        }
        {
          const int nch_ = (c.G == 256 && NDC_CFG > 0) ? CONV_SPLIT : ECONV_NCH;
          if (c.tid == 0) MISC[2] = (unsigned)__hip_atomic_load((int*)(ws + WS_ECTR), __ATOMIC_RELAXED, __HIP_MEMORY_SCOPE_AGENT);
          __syncthreads();
          const int seen = (int)MISC[2];
          if (seen < nch_) { if (EXP_WG) prologue_experts_wg(p, c, (int*)(ws + WS_ECTR), 0, nch_); else prologue_experts(p, c, (int*)(ws + WS_ECTR), 0, nch_); } }
        SEAM(PH_INPROJ);
    }

    if (IN(PH_ATTN)) { LOAD_P();
        const float lam = __hip_atomic_load((const float*)(ws + WS_SCAL), __ATOMIC_RELAXED, __HIP_MEMORY_SCOPE_AGENT);
        REPLOOP(16)
        if (c.G == 256) { const int bh = c.vcu >> 3, s = c.vcu & 7;
            for (int i = 0; i < 4; ++i) { const int qb = (i == 0) ? s : (i == 1) ? 15 - s : (i == 2) ? 16 + s : 31 - s; diff_unit(p, bh >> 2, bh & 3, qb, lds, lam); } }
        else { for (int u = blockIdx.x; u < 1024; u += c.G) diff_unit(p, u >> 7, (u >> 5) & 3, u & 31, lds, lam); }
        STAMP(20);
        REPLOOP(17)
        if (c.G == 256 && NDC_CFG > 0) {
            constexpr int NDC = NDC_CFG;
            const int bx = (int)blockIdx.x, j = bx >> 3, cjlo = (j * NDC) / 32, cjhi = ((j + 1) * NDC) / 32;
            if (cjhi == cjlo) dil_phase(p, (bx & 7) * (32 - NDC) + (j - cjlo), 256 - 8 * NDC, 3072, lds);
            __syncthreads();
            prologue_experts(p, c, (int*)(ws + WS_LCTR), CONV_SPLIT, ECONV_NCH);
        } else
        dil_phase(p, c.vcu, c.G, 3072, lds);
        SEAM(PH_ATTN);
    }

    if (IN(PH_MERGE)) { LOAD_P(); REPLOOP(PH_MERGE) phase_merge(p, c, c.vcu * NTHR + c.tid, c.G * NTHR); SEAM(PH_MERGE); }

    if (IN(PH_OUTPROJ)) { LOAD_P();
        REPLOOP(PH_OUTPROJ) {
        gm::DenseSched S; S.init(T, DM, DM, ws + WS_WOUTT, c.G, (int)blockIdx.x);
        gm::EpiOutProj E{(bf16*)(ws + WS_Y1), (const bf16*)(ws + WS_XB), (float*)(ws + WS_STATS1), (LAS float*)(lds + LDS_XTRA)};
        gm::gemm_phase(lds, ws, (const char*)(ws + WS_MIXIN), DM, S, E);
        }
        SEAM(PH_OUTPROJ);
    }
#if QMEM_FUSE
    if (IN(PH_QMEM)) { LOAD_P();
        for (int k = 0; ; ++k) {
            gm::DenseSched S; S.init(T, DM, DM, ws + WS_WQT, c.G, (int)blockIdx.x); S.i_lo = k; S.i_cnt = 1;
            gm::Unit u0; if (!S.next(0, u0)) break;
            gm::EpiQMemLN E{(bf16*)(ws + WS_QM), (const float*)(ws + WS_STATS1), (const float*)(ws + WS_SN), (const float*)(ws + WS_CN), QSCALE256};
            gm::gemm_phase(lds, ws, (const char*)(ws + WS_Y1), DM, S, E);
            __syncthreads();
            mem_unit(p, u0.pm >> 4, u0.pn, u0.pm & 15, lds);
            __syncthreads();
        }
        SEAM(PH_QMEM);
    }
#else
    if (IN(PH_QMEM)) { LOAD_P();
        REPLOOP(PH_QMEM) {
        gm::DenseSched S; S.init(T, DM, DM, ws + WS_WQT, c.G, (int)blockIdx.x);
        gm::EpiQMemLN E{(bf16*)(ws + WS_QM), (const float*)(ws + WS_STATS1), (const float*)(ws + WS_SN), (const float*)(ws + WS_CN), QSCALE256};
        gm::gemm_phase(lds, ws, (const char*)(ws + WS_Y1), DM, S, E);
        }
        SEAM(PH_QMEM);
    }
    if (IN(PH_MEMATTN)) { LOAD_P();
        REPLOOP(PH_MEMATTN)
        for (int u = c.vcu; u < 512; u += c.G) { const int qblk = u & 15, bh = u >> 4; mem_unit(p, bh >> 2, bh & 3, qblk, lds); }
        SEAM(PH_MEMATTN);
    }
#endif
    if (IN(PH_WO)) { LOAD_P();
        REPLOOP(PH_WO) {
        gm::DenseSched S; S.init(T, DM, DM, ws + WS_WOT, c.G, (int)blockIdx.x);
        gm::EpiWo E{(bf16*)(ws + WS_Y2), (const bf16*)(ws + WS_Y1), (const float*)(ws + WS_STATS1), p.ln1_g, p.ln1_b, (float*)(ws + WS_STATS2), (LAS float*)(lds + LDS_XTRA)};
        gm::gemm_phase(lds, ws, (const char*)(ws + WS_MO), DM, S, E);
        }
        SEAM(PH_WO);
    }
#if LN2_FOLD
    if (IN(PH_ROUTER)) { LOAD_P();
        REPLOOP(PH_ROUTER) {
        gm::DenseSched S; S.init(T, NEXP, DM, ws + WS_WRT, c.G, (int)blockIdx.x);
        gm::EpiRouterLN E{(float*)(ws + WS_LOGITS), NEXP, (const float*)(ws + WS_STATS2), (const float*)(ws + WS_SN2), (const float*)(ws + WS_CN2)};
        gm::gemm_phase(lds, ws, (const char*)(ws + WS_Y2), DM, S, E);
        }
        { const int bx = (int)blockIdx.x; const bool has_unit = bx < 128 && c.G == 256;
          if (c.G != 256) phase_ln((const bf16*)(ws + WS_Y2), (bf16*)(ws + WS_H2), p.ln2_g, p.ln2_b, c, (unsigned char*)(ws + WS_H2Q), 0, T, c.gw, c.ngw);
          else if (!has_unit) phase_ln((const bf16*)(ws + WS_Y2), (bf16*)(ws + WS_H2), p.ln2_g, p.ln2_b, c, (unsigned char*)(ws + WS_H2Q), 0, LN2_SPLIT, (bx - 128) * NWAVES + c.wave, 128 * NWAVES);
          else phase_ln((const bf16*)(ws + WS_Y2), (bf16*)(ws + WS_H2), p.ln2_g, p.ln2_b, c, (unsigned char*)(ws + WS_H2Q), LN2_SPLIT, T, bx * NWAVES + c.wave, 128 * NWAVES); }
        SEAM(PH_ROUTER);
    }
#else
    if (IN(PH_LN2)) { LOAD_P(); REPLOOP(PH_LN2) phase_ln((const bf16*)(ws + WS_Y2), (bf16*)(ws + WS_H2), p.ln2_g, p.ln2_b, c, (unsigned char*)(ws + WS_H2Q), 0, T, c.gw, c.ngw); SEAM(PH_LN2); }

    if (IN(PH_ROUTER)) { LOAD_P();
        REPLOOP(PH_ROUTER) {
        gm::DenseSched S; S.init(T, NEXP, DM, ws + WS_WRT, c.G, (int)blockIdx.x);
        gm::EpiF32 E{(float*)(ws + WS_LOGITS), NEXP};
        gm::gemm_phase(lds, ws, (const char*)(ws + WS_H2), DM, S, E);
        }
        SEAM(PH_ROUTER);
    }
#endif
    if (IN(PH_ROUTE)) { LOAD_P(); phase_route(p, c, REPS(PH_ROUTE)); SEAM(PH_ROUTE); }
#if !NO_SCATTER
    if (IN(PH_SCATTER)) { LOAD_P(); phase_scatter(p, c); SEAM(PH_SCATTER); }
#endif

    if (IN(PH_MOE1)) { LOAD_P();
        REPLOOP(PH_MOE1) {
#if NO_SCATTER
        moe_scan_tables(p, c);
        const int n_my = gm::moe_preload_scan<1>(lds, (const LAS int*)lds, c.G, (int)blockIdx.x, (const int*)(ws + WS_SLOTTOK), (const float*)(ws + WS_SLOTW));
#else
        const int nrt = __builtin_amdgcn_readfirstlane(ld_i32_agent((const int*)(ws + WS_NRT)));
        const int n_my = gm::moe_preload<1, true>(lds, (const int*)(ws + WS_TILETAB), nrt * 2, c.G, (int)blockIdx.x, (const int*)(ws + WS_ROWTOK), (const float*)(ws + WS_ROWW));
#endif
        const LAS int* xd = (const LAS int*)(lds + LDS_XTRA);
        gm::MoeSched<1, DM / 2, true> S{xd, xd + gm::XD_INTS, n_my, c.G, (int)blockIdx.x, (const char*)(ws + WS_WTGU), (size_t)512 * DM};
        gm::EpiMoe1 E{(unsigned char*)(ws + WS_HB), (const LAS float*)(xd + gm::XD_INTS + gm::XT_SLOTS * MOE_ROWS)};
        gm::gemm_phase<gm::EpiMoe1, gm::MoeSched<1, DM / 2, true>, true, 0x7C7C7C7C, MOE_HALFM>(lds, ws, (const char*)(ws + WS_H2Q), DM / 2, S, E);
        }
        SEAM(PH_MOE1);
    }
    if (IN(PH_MOE2)) { LOAD_P();
        REPLOOP(PH_MOE2) {
        const int nrt = __builtin_amdgcn_readfirstlane(ld_i32_agent((const int*)(ws + WS_NRT)));
        const int n_my = gm::moe_preload<2, false>(lds, (const int*)(ws + WS_TILETAB), nrt * 4, c.G, (int)blockIdx.x, nullptr, nullptr);
        const LAS int* xd = (const LAS int*)(lds + LDS_XTRA);
#if MOE2_FLIP
        gm::MoeSchedFlip<2, EDIM / 2> S{xd, n_my, c.G, (int)blockIdx.x, (const char*)(ws + WS_HB), (size_t)DM * EDIM};
        gm::EpiMoe2F E{(unsigned char*)(ws + WS_Y)};
        gm::gemm_phase<gm::EpiMoe2F, gm::MoeSchedFlip<2, EDIM / 2>, true, 0x7B7B7B7B, false, true>(lds, ws, (const char*)(ws + WS_WTD), EDIM / 2, S, E);
#else
        gm::MoeSched<2, EDIM / 2, false> S{xd, xd + gm::XD_INTS, n_my, c.G, (int)blockIdx.x, (const char*)(ws + WS_WTD), (size_t)DM * EDIM};
        gm::EpiMoe2 E{(unsigned char*)(ws + WS_Y)};
        gm::gemm_phase<gm::EpiMoe2, gm::MoeSched<2, EDIM / 2, false>, true, 0x7B7B7B7B, MOE_HALFM, true>(lds, ws, (const char*)(ws + WS_HB), EDIM / 2, S, E);
#endif
        }
        SEAM(PH_MOE2);
    }
    if (IN(PH_COMBINE)) { LOAD_P(); REPLOOP(PH_COMBINE) phase_combine(p, c); }
#ifdef PROBE_A
    STAMP(16);
    __syncthreads();
    if (blockIdx.x == 0 && c.tid == 0) {
        const float da = (float)(stamps[PROBE_A1] - stamps[PROBE_A0]) * 0.01f, db = (float)(stamps[PROBE_B1] - stamps[PROBE_B0]) * 0.01f;
        a.p.out[0] = da * (float)PROBE_SA; a.p.out[1] = db * (float)PROBE_SB;
    }
#endif
#undef IN
#undef SEAM
#undef LOAD_P
#undef LDP_
}

#ifndef MK_MODE
#define MK_MODE 1
#endif
#ifndef NAIVE_MASK
#define NAIVE_MASK 0
#endif

static void fill_params(P& p, void* const* d_in, void* d_out, void* d_ws) {
    p.x = (const float*)d_in[0]; p.mem = (const float*)d_in[1]; p.pos = (const int*)d_in[2];
    p.w_in = (const float*)d_in[3]; p.w_out = (const float*)d_in[4]; p.lq1 = (const float*)d_in[5]; p.lk1 = (const float*)d_in[6]; p.lq2 = (const float*)d_in[7]; p.lk2 = (const float*)d_in[8];
    p.subln_g = (const float*)d_in[9]; p.ln1_g = (const float*)d_in[10]; p.ln1_b = (const float*)d_in[11];
    p.wq = (const float*)d_in[12]; p.wkv = (const float*)d_in[13]; p.wo = (const float*)d_in[14]; p.ln2_g = (const float*)d_in[15]; p.ln2_b = (const float*)d_in[16];
    p.w_router = (const float*)d_in[17]; p.e_bias = (const float*)d_in[18]; p.w_gate = (const float*)d_in[19]; p.w_up = (const float*)d_in[20]; p.w_down = (const float*)d_in[21];
    p.ws_gate = (const float*)d_in[22]; p.ws_up = (const float*)d_in[23]; p.ws_down = (const float*)d_in[24]; p.ln3_g = (const float*)d_in[25]; p.ln3_b = (const float*)d_in[26];
    p.out = (float*)d_out; p.ws = (unsigned char*)d_ws;
}

extern "C" void kernel_launch(void* const* d_in, const int* in_sizes, int n_in, void* d_out, int out_size, void* d_ws, size_t ws_size, hipStream_t stream) {
    static int grid = 0;
    if (grid == 0) {
        if (n_in != 27 || out_size != T * DM || ws_size < WS_END) { fprintf(stderr, "kernel_launch: unexpected shapes: n_in %d out %d ws %zu (need %zu)\n", n_in, out_size, ws_size, (size_t)WS_END); grid = -1; return; }
        int dev = 0, cus = 0, per_cu = 0;
        (void)hipGetDevice(&dev); (void)hipDeviceGetAttribute(&cus, hipDeviceAttributeMultiprocessorCount, dev);
        if (hipFuncSetAttribute((const void*)mk_fwd, hipFuncAttributeMaxDynamicSharedMemorySize, LDS_BYTES) != hipSuccess) { fprintf(stderr, "kernel_launch: hipFuncSetAttribute failed\n"); grid = -1; return; }
        if (hipOccupancyMaxActiveBlocksPerMultiprocessor(&per_cu, (const void*)mk_fwd, NTHR, LDS_BYTES) != hipSuccess || per_cu < 1) { fprintf(stderr, "kernel_launch: occupancy query says %d blocks/CU\n", per_cu); per_cu = 1; }
        (void)hipGetLastError();
        grid = cus;
        fprintf(stderr, "kernel_launch: cus %d per_cu %d grid %d\n", cus, per_cu, grid);
    }
    if (grid < 0) return;
    MKArgs a{};
    fill_params(a.p, d_in, d_out, d_ws);
    P p = a.p; unsigned char* ws = p.ws;
#if MK_MODE == 1
    a.ph_lo = 0; a.ph_hi = PH_COUNT;
    if (hipMemsetAsync(ws + WS_BAR, 0, WS_ZERO_END - WS_BAR, stream) != hipSuccess) { fprintf(stderr, "kernel_launch: memset failed\n"); return; }
    void* args[] = {&a};
    hipError_t e = hipLaunchCooperativeKernel((const void*)mk_fwd, dim3(grid), dim3(NTHR), args, LDS_BYTES, stream);
    if (e != hipSuccess) fprintf(stderr, "cooperative launch failed: %s (grid %d)\n", hipGetErrorString(e), grid);
#elif MK_MODE == 2
    auto run = [&](int lo, int hi) { a.ph_lo = lo; a.ph_hi = hi; hipLaunchKernelGGL(mk_fwd, dim3(grid), dim3(NTHR), LDS_BYTES, stream, a); };
    auto nv = [&](int k) { return ((NAIVE_MASK >> k) & 1) != 0; };
    run(PH_PROLOGUE, PH_PROLOGUE + 1);
    if (nv(PH_INPROJ)) { ngemm<FInProj><<<dim3(T / 64, INW / 64, 1), 256, 0, stream>>>(FInProj{p}); ngemm<FKV><<<dim3(BATCH * MEML / 64, 2048 / 64, 1), 256, 0, stream>>>(FKV{p}); } else run(PH_INPROJ, PH_INPROJ + 1);
    if (nv(PH_ATTN)) { nattnA<<<3 * 8 * T / 256, 256, 0, stream>>>(p); nattnB<<<16 * T / 256, 256, 0, stream>>>(p); sublnB<<<T * 4 / 4, 256, 0, stream>>>(p); } else run(PH_ATTN, PH_ATTN + 1);
    if (nv(PH_MERGE)) mergeA<<<T * 512 / 256, 256, 0, stream>>>(p); else run(PH_MERGE, PH_MERGE + 1);
    if (nv(PH_OUTPROJ)) ngemm<FOutProj><<<dim3(T / 64, DM / 64, 1), 256, 0, stream>>>(FOutProj{p}); else run(PH_OUTPROJ, PH_OUTPROJ + 1);
    if (nv(PH_LN1)) ln_pass<<<T / 4, 256, 0, stream>>>((const bf16*)(ws + WS_Y1), (bf16*)(ws + WS_H1), p.ln1_g, p.ln1_b); else run(PH_LN1, PH_LN1 + 1);
    if (nv(PH_QMEM)) ngemm<FQMem><<<dim3(T / 64, DM / 64, 1), 256, 0, stream>>>(FQMem{p}); else run(PH_QMEM, PH_QMEM + 1);
    if (nv(PH_MEMATTN)) { ngemm<FMemS><<<dim3(T / 64, 256 / 64, 4), 256, 0, stream>>>(FMemS{p}); softmaxM<<<T * 4 / 4, 256, 0, stream>>>(p); ngemm<FMemO><<<dim3(T / 64, 256 / 64, 4), 256, 0, stream>>>(FMemO{p}); } else run(PH_MEMATTN, PH_MEMATTN + 1);
    if (nv(PH_WO)) ngemm<FWo><<<dim3(T / 64, DM / 64, 1), 256, 0, stream>>>(FWo{p}); else run(PH_WO, PH_WO + 1);
    if (nv(PH_LN2)) ln_pass<<<T / 4, 256, 0, stream>>>((const bf16*)(ws + WS_Y2), (bf16*)(ws + WS_H2), p.ln2_g, p.ln2_b); else run(PH_LN2, PH_LN2 + 1);
    if (nv(PH_ROUTER)) ngemm<FRouter><<<dim3(T / 64, NEXP / 64, 1), 256, 0, stream>>>(FRouter{p}); else run(PH_ROUTER, PH_ROUTER + 1);
    if (nv(PH_ROUTE)) route_pass<<<T / 4, 256, 0, stream>>>(p); else run(PH_ROUTE, PH_ROUTE + 1);
    run(PH_SCATTER, PH_SCATTER + 1);
    if (nv(PH_MOE1)) ngemm<FMoe1><<<dim3(T / 64, 512 / 64, NEXP + 1), 256, 0, stream>>>(FMoe1{p}); else run(PH_MOE1, PH_MOE1 + 1);
    if (nv(PH_MOE2)) ngemm<FMoe2><<<dim3(T / 64, DM / 64, NEXP + 1), 256, 0, stream>>>(FMoe2{p}); else run(PH_MOE2, PH_MOE2 + 1);
    if (nv(PH_COMBINE)) combine_pass<<<T / 4, 256, 0, stream>>>(p); else run(PH_COMBINE, PH_COMBINE + 1);
#else
    prep_kernel<<<T * 8 / 256, 256, 0, stream>>>(p);
    ngemm<FInProj><<<dim3(T / 64, INW / 64, 1), 256, 0, stream>>>(FInProj{p});
    nattnA<<<3 * 8 * T / 256, 256, 0, stream>>>(p);
    mergeA<<<T * 512 / 256, 256, 0, stream>>>(p);
    nattnB<<<16 * T / 256, 256, 0, stream>>>(p);
    sublnB<<<T * 4 / 4, 256, 0, stream>>>(p);
    ngemm<FOutProj><<<dim3(T / 64, DM / 64, 1), 256, 0, stream>>>(FOutProj{p});
    ln_pass<<<T / 4, 256, 0, stream>>>((const bf16*)(ws + WS_Y1), (bf16*)(ws + WS_H1), p.ln1_g, p.ln1_b);
    ngemm<FQMem><<<dim3(T / 64, DM / 64, 1), 256, 0, stream>>>(FQMem{p});
    ngemm<FKV><<<dim3(BATCH * MEML / 64, 2048 / 64, 1), 256, 0, stream>>>(FKV{p});
    ngemm<FMemS><<<dim3(T / 64, 256 / 64, 4), 256, 0, stream>>>(FMemS{p});
    softmaxM<<<T * 4 / 4, 256, 0, stream>>>(p);
    ngemm<FMemO><<<dim3(T / 64, 256 / 64, 4), 256, 0, stream>>>(FMemO{p});
    ngemm<FWo><<<dim3(T / 64, DM / 64, 1), 256, 0, stream>>>(FWo{p});
    ln_pass<<<T / 4, 256, 0, stream>>>((const bf16*)(ws + WS_Y2), (bf16*)(ws + WS_H2), p.ln2_g, p.ln2_b);
    ngemm<FRouter><<<dim3(T / 64, NEXP / 64, 1), 256, 0, stream>>>(FRouter{p});
    route_pass<<<T / 4, 256, 0, stream>>>(p);
    scan_pass<<<1, 256, 0, stream>>>(p);
    scatter_pass<<<T * 8 / 256, 256, 0, stream>>>(p);
    ngemm<FMoe1><<<dim3(T / 64, 512 / 64, NEXP + 1), 256, 0, stream>>>(FMoe1{p});
    ngemm<FMoe2><<<dim3(T / 64, DM / 64, NEXP + 1), 256, 0, stream>>>(FMoe2{p});
    combine_pass<<<T / 4, 256, 0, stream>>>(p);
#endif
}
```
